# Optimizing an MI355X kernel written in HIP

```python
import math
import jax, jax.numpy as jnp
from jax import lax
import numpy as np

D_MODEL = 2048
BATCH = 1
SEQ = 8192
DEPTH = 4

GRID_W = 64
CTX_LEN = 256
N_MIXERS = 4
ALPHA = (2.0 * DEPTH) ** 0.25
BETA = (8.0 * DEPTH) ** -0.25
Q_BLOCK = 128
ROPE_THETA = 10000.0
LN_EPS = 1e-6
RMS_EPS = 1e-6
N_MOD = 6

HEAD_DIM = 128
GQA_HEADS = D_MODEL // HEAD_DIM
GQA_KV_HEADS = GQA_HEADS // 4
GQA_GROUP = GQA_HEADS // GQA_KV_HEADS
GQA_QKV = (GQA_HEADS + 2 * GQA_KV_HEADS) * HEAD_DIM
DIFF_HEADS = D_MODEL // (2 * HEAD_DIM)

POOL_WINDOWS = (2, 4, 8, 16)
POOL_GROUP = D_MODEL // len(POOL_WINDOWS)

N_GROUPS = 4
EXPERTS_PER_GROUP = 4
N_EXPERTS = N_GROUPS * EXPERTS_PER_GROUP
TOP_K = 2
EXPERT_FF = 3 * D_MODEL // 8

kernel_name = "hybrid_interleaved_diffusion_trunk"


def _n_uses(mixer):
    return len(range(mixer, DEPTH, N_MIXERS))


def layer_norm(x, g, b):
    xf = x.astype(jnp.float32)
    mu = jnp.mean(xf, axis=-1, keepdims=True)
    var = jnp.mean(jnp.square(xf - mu), axis=-1, keepdims=True)
    return ((xf - mu) * lax.rsqrt(var + LN_EPS)).astype(x.dtype) * g + b


def rms_norm(x, g):
    xf = x.astype(jnp.float32)
    return (xf * lax.rsqrt(jnp.mean(xf * xf, axis=-1, keepdims=True) + RMS_EPS)).astype(x.dtype) * g


def modulate(t, shift, scale):
    return t * (1.0 + scale) + shift


def axial_rope_tables(rows, dtype):
    row = jnp.repeat(jnp.arange(rows, dtype=jnp.float32), GRID_W)
    col = jnp.tile(jnp.arange(GRID_W, dtype=jnp.float32), rows)
    axis_dim = HEAD_DIM // 2
    inv = ROPE_THETA ** (-jnp.arange(0, axis_dim, 2, dtype=jnp.float32) / axis_dim)
    ang = jnp.concatenate([row[:, None] * inv, col[:, None] * inv], axis=-1)
    return jnp.cos(ang).astype(dtype), jnp.sin(ang).astype(dtype)


def apply_axial_rope(x, cos, sin):
    qd = x.shape[-1] // 4
    xr1, xr2, xc1, xc2 = jnp.split(x, 4, axis=-1)
    cr, cc = cos[:, :qd], cos[:, qd:]
    sr, sc = sin[:, :qd], sin[:, qd:]
    return jnp.concatenate([xr1 * cr - xr2 * sr, xr2 * cr + xr1 * sr,
                            xc1 * cc - xc2 * sc, xc2 * cc + xc1 * sc], axis=-1)


def sweep_query_blocks(fn, q):
    n = q.shape[-2]
    qb = jnp.moveaxis(q.reshape(q.shape[:-2] + (n // Q_BLOCK, Q_BLOCK, q.shape[-1])), -3, 0)
    ob = jnp.moveaxis(lax.map(fn, qb), 0, -3)
    return ob.reshape(ob.shape[:-3] + (n, ob.shape[-1]))


def depthwise_conv3(u, w):
    return lax.conv_general_dilated(u, w[:, None, :], window_strides=(1,), padding=((1, 1),),
                                    dimension_numbers=('NWC', 'WIO', 'NWC'),
                                    feature_group_count=u.shape[-1])


def conv_mixer(h, hc, w_in, w_conv, w_out, need_ctx):
    def run(t):
        gate_b, gate_c, val = jnp.split(t @ w_in, 3, axis=-1)
        return (gate_b * depthwise_conv3(gate_c * val, w_conv)) @ w_out
    return run(h), (run(hc) if need_ctx else None)


def window_mean_minus_self(u, window):
    n = u.shape[1]
    cs = jnp.pad(jnp.cumsum(u.astype(jnp.float32), axis=1), ((0, 0), (1, 0), (0, 0)))
    t = jnp.arange(n)
    lo = jnp.clip(t - window // 2, 0, n)
    hi = jnp.clip(t + window - window // 2, 0, n)
    mean = (cs[:, hi] - cs[:, lo]) / (hi - lo).astype(jnp.float32)[None, :, None]
    return mean.astype(u.dtype) - u


def pool_mixer(h, hc, w_grp, scale, need_ctx):
    def run(t):
        parts = jnp.split(t, len(POOL_WINDOWS), axis=-1)
        pooled = jnp.stack([window_mean_minus_self(p, w) for p, w in zip(parts, POOL_WINDOWS)], axis=2)
        mixed = jnp.einsum('bngc,gce->bnge', pooled, w_grp)
        return mixed.reshape(t.shape) * scale
    return run(h), (run(hc) if need_ctx else None)


def gqa_mixer(h, hc, w_qkv, qk_norm, w_out, cos, sin, need_ctx):
    b = h.shape[0]
    scale = HEAD_DIM ** -0.5

    def project(t):
        n = t.shape[1]
        q, k, v = jnp.split(t @ w_qkv, [GQA_HEADS * HEAD_DIM, (GQA_HEADS + GQA_KV_HEADS) * HEAD_DIM], axis=-1)
        q = q.reshape(b, n, GQA_KV_HEADS, GQA_GROUP, HEAD_DIM).transpose(0, 2, 3, 1, 4)
        k = k.reshape(b, n, GQA_KV_HEADS, HEAD_DIM).transpose(0, 2, 1, 3)
        v = v.reshape(b, n, GQA_KV_HEADS, HEAD_DIM).transpose(0, 2, 1, 3)
        return rms_norm(q, qk_norm[0]), rms_norm(k, qk_norm[1]), v

    def attend(qb, k, v):
        s = jnp.einsum('bkgqd,bkld->bkgql', qb, k).astype(jnp.float32) * scale
        p = jax.nn.softmax(s, axis=-1).astype(v.dtype)
        return jnp.einsum('bkgql,bkld->bkgqd', p, v)

    def finish(o):
        return o.transpose(0, 3, 1, 2, 4).reshape(b, o.shape[3], -1) @ w_out

    q, k, v = project(h)
    qc, kc, vc = project(hc)
    q = apply_axial_rope(q, cos, sin)
    k = apply_axial_rope(k, cos, sin)
    k_all = jnp.concatenate([kc, k], axis=2)
    v_all = jnp.concatenate([vc, v], axis=2)
    out = finish(sweep_query_blocks(lambda qb: attend(qb, k_all, v_all), q))
    out_c = finish(attend(qc, kc, vc)) if need_ctx else None
    return out, out_c


def diff_mixer(h, hc, w_qkv, lam_vecs, subln, w_out, lam_init, cos, sin, need_ctx):
    b = h.shape[0]
    scale = HEAD_DIM ** -0.5
    lv = lam_vecs.astype(jnp.float32)
    lam = jnp.exp(jnp.sum(lv[0] * lv[1])) - jnp.exp(jnp.sum(lv[2] * lv[3])) + lam_init

    def project(t):
        n = t.shape[1]
        q, k, v = jnp.split(t @ w_qkv, 3, axis=-1)
        q = q.reshape(b, n, DIFF_HEADS, 2, HEAD_DIM).transpose(0, 2, 3, 1, 4)
        k = k.reshape(b, n, DIFF_HEADS, 2, HEAD_DIM).transpose(0, 2, 3, 1, 4)
        v = v.reshape(b, n, DIFF_HEADS, 2 * HEAD_DIM).transpose(0, 2, 1, 3)
        return q, k, v

    def attend(qb, k, v):
        s = jnp.einsum('bhmqd,bhmld->bhmql', qb, k).astype(jnp.float32) * scale
        p = jax.nn.softmax(s, axis=-1)
        a = p[:, :, 0] - lam * p[:, :, 1]
        return jnp.einsum('bhql,bhle->bhqe', a.astype(v.dtype), v)

    def finish(o):
        o = rms_norm(o, subln) * (1.0 - lam_init)
        return o.transpose(0, 2, 1, 3).reshape(b, o.shape[2], -1) @ w_out

    q, k, v = project(h)
    kc_q = project(hc)
    qc, kc, vc = kc_q
    q = apply_axial_rope(q, cos, sin)
    k = apply_axial_rope(k, cos, sin)
    k_all = jnp.concatenate([kc, k], axis=3)
    v_all = jnp.concatenate([vc, v], axis=2)
    out = finish(sweep_query_blocks(lambda qb: attend(qb, k_all, v_all), q))
    out_c = finish(attend(qc, kc, vc)) if need_ctx else None
    return out, out_c


def hier_moe(h, w_grp, b_grp, w_exp, b_exp, w_gate, w_up, w_down):
    b, n, _ = h.shape
    lg = (h @ w_grp).astype(jnp.float32) + b_grp
    g_star = jnp.argmax(lg, axis=-1)
    p_group = jnp.take_along_axis(jax.nn.softmax(lg, axis=-1), g_star[..., None], axis=-1)
    le = ((h @ w_exp).astype(jnp.float32) + b_exp).reshape(b, n, N_GROUPS, EXPERTS_PER_GROUP)
    le = jnp.take_along_axis(le, g_star[..., None, None], axis=2)[:, :, 0]
    top_v, top_i = lax.top_k(jax.nn.softmax(le, axis=-1), TOP_K)
    top_v = top_v / jnp.sum(top_v, axis=-1, keepdims=True)
    expert_idx = g_star[..., None] * EXPERTS_PER_GROUP + top_i
    combine = jnp.sum(jax.nn.one_hot(expert_idx, N_EXPERTS, dtype=jnp.float32)
                      * (p_group * top_v)[..., None], axis=-2)
    act = jax.nn.silu(jnp.einsum('bnd,edf->bnef', h, w_gate)) * jnp.einsum('bnd,edf->bnef', h, w_up)
    return jnp.einsum('bnef,efd->bnd', act * combine.astype(h.dtype)[..., None], w_down)


def setup_inputs(seed: int = 0) -> dict:
    key = jax.random.key(seed)
    ks = iter(jax.random.split(key, 32))
    d, L = D_MODEL, DEPTH
    nA, nB, nC, nD = _n_uses(0), _n_uses(1), _n_uses(2), _n_uses(3)

    def nrm(shape, std):
        return jax.random.normal(next(ks), shape, jnp.float32) * std

    return {
        'x': nrm((BATCH, SEQ, d), 1.0),
        'c': nrm((BATCH, d), 1.0),
        'ctx': nrm((BATCH, CTX_LEN, d), 1.0),
        'c_ctx': nrm((d,), 1.0),
        'mod_w': nrm((L, d, N_MOD * d), 0.5 * d ** -0.5),
        'mod_b': nrm((L, N_MOD * d), 0.02),
        'ln_g': 1.0 + nrm((L, 2, d), 0.05),
        'ln_b': nrm((L, 2, d), 0.02),
        'rt_grp_w': nrm((L, d, N_GROUPS), d ** -0.5),
        'rt_grp_b': nrm((L, N_GROUPS), 0.01),
        'rt_exp_w': nrm((L, d, N_EXPERTS), d ** -0.5),
        'rt_exp_b': nrm((L, N_EXPERTS), 0.01),
        'ex_w_gate': nrm((L, N_EXPERTS, d, EXPERT_FF), d ** -0.5),
        'ex_w_up': nrm((L, N_EXPERTS, d, EXPERT_FF), d ** -0.5),
        'ex_w_down': nrm((L, N_EXPERTS, EXPERT_FF, d), BETA * EXPERT_FF ** -0.5),
        'conv_in_w': nrm((nA, d, 3 * d), d ** -0.5),
        'conv_w': nrm((nA, 3, d), 3 ** -0.5),
        'conv_out_w': nrm((nA, d, d), BETA * d ** -0.5),
        'pool_w': nrm((nB, len(POOL_WINDOWS), POOL_GROUP, POOL_GROUP), BETA * POOL_GROUP ** -0.5),
        'pool_scale': 1.0 + nrm((nB, d), 0.1),
        'gqa_qkv_w': nrm((nC, d, GQA_QKV), d ** -0.5),
        'gqa_qk_norm': 1.0 + nrm((nC, 2, HEAD_DIM), 0.05),
        'gqa_out_w': nrm((nC, GQA_HEADS * HEAD_DIM, d), BETA * d ** -0.5),
        'diff_qkv_w': nrm((nD, d, 3 * d), d ** -0.5),
        'diff_lambda': nrm((nD, 4, HEAD_DIM), 0.1),
        'diff_subln': 1.0 + nrm((nD, 2 * HEAD_DIM), 0.05),
        'diff_out_w': nrm((nD, d, d), BETA * d ** -0.5),
    }


def reference(x, c, ctx, c_ctx, mod_w, mod_b, ln_g, ln_b, rt_grp_w, rt_grp_b, rt_exp_w, rt_exp_b,
              ex_w_gate, ex_w_up, ex_w_down, conv_in_w, conv_w, conv_out_w, pool_w, pool_scale,
              gqa_qkv_w, gqa_qk_norm, gqa_out_w, diff_qkv_w, diff_lambda, diff_subln, diff_out_w):
    rows = x.shape[1] // GRID_W
    cos, sin = axial_rope_tables(rows, x.dtype)
    s_lat = jax.nn.silu(c)[:, None, :]
    s_ctx = jax.nn.silu(c_ctx)[None, None, :]
    xc = ctx
    for i in range(DEPTH):
        mixer, j = i % N_MIXERS, i // N_MIXERS
        need_ctx = i < DEPTH - 1
        mod = jnp.split(s_lat @ mod_w[i] + mod_b[i], N_MOD, axis=-1)
        modc = jnp.split(s_ctx @ mod_w[i] + mod_b[i], N_MOD, axis=-1)
        h = modulate(x, mod[0], mod[1])
        hc = modulate(xc, modc[0], modc[1])
        if mixer == 0:
            o, oc = conv_mixer(h, hc, conv_in_w[j], conv_w[j], conv_out_w[j], need_ctx)
        elif mixer == 1:
            o, oc = pool_mixer(h, hc, pool_w[j], pool_scale[j], need_ctx)
        elif mixer == 2:
            o, oc = gqa_mixer(h, hc, gqa_qkv_w[j], gqa_qk_norm[j], gqa_out_w[j], cos, sin, need_ctx)
        else:
            lam_init = 0.8 - 0.6 * math.exp(-0.3 * i)
            o, oc = diff_mixer(h, hc, diff_qkv_w[j], diff_lambda[j], diff_subln[j], diff_out_w[j],
                               lam_init, cos, sin, need_ctx)
        moe_w = (rt_grp_w[i], rt_grp_b[i], rt_exp_w[i], rt_exp_b[i], ex_w_gate[i], ex_w_up[i], ex_w_down[i])
        x = layer_norm(ALPHA * x + mod[2] * o, ln_g[i, 0], ln_b[i, 0])
        x = layer_norm(ALPHA * x + mod[5] * hier_moe(modulate(x, mod[3], mod[4]), *moe_w),
                       ln_g[i, 1], ln_b[i, 1])
        if need_ctx:
            xc = layer_norm(ALPHA * xc + modc[2] * oc, ln_g[i, 0], ln_b[i, 0])
            xc = layer_norm(ALPHA * xc + modc[5] * hier_moe(modulate(xc, modc[3], modc[4]), *moe_w),
                            ln_g[i, 1], ln_b[i, 1])
    return x
```

```cpp
#include <hip/hip_runtime.h>
#include <hip/hip_bf16.h>
#include <cstdio>
#include <cstdint>

#ifndef MK_ONE_LAUNCH
#define MK_ONE_LAUNCH 1
#endif
#ifndef PROBE_REP_MASK
#define PROBE_REP_MASK 0ull
#endif
#if MK_ONE_LAUNCH
#define REPC(k) ((int)((PROBE_REP_MASK >> (k)) & 1ull))
#else
#define REPC(k) 0
#endif

#define LAS __attribute__((address_space(3)))
#define GAS __attribute__((address_space(1)))
typedef unsigned short bf16_t;
typedef short bf16x8 __attribute__((ext_vector_type(8)));
typedef short s16x4 __attribute__((ext_vector_type(4)));
typedef float f32x4 __attribute__((ext_vector_type(4)));
typedef float f32x16 __attribute__((ext_vector_type(16)));
typedef unsigned u32x4 __attribute__((ext_vector_type(4)));
typedef unsigned u32x2 __attribute__((ext_vector_type(2)));

constexpr int DM = 2048, NLAT = 8192, NCTX = 256, MTOT = NLAT + NCTX, NMT = MTOT / 256;
constexpr int NMOD = 6 * DM;
constexpr int EFF = 768, NEXP = 16;
constexpr float ALPHA = 1.6817928305074290f;
constexpr float LN_EPS = 1e-6f, RMS_EPS = 1e-6f;
constexpr float LAM_INIT3 = 0.55605820415f;
constexpr int MAXT = 82;
constexpr size_t KVHS = (size_t)MTOT * 128;

constexpr size_t MiB = 1ull << 20;
constexpr size_t WS_CTL = 0, CTL_ZERO_BYTES = 1 * MiB;
constexpr size_t WS_MODV = 1 * MiB;
constexpr size_t WS_ROPE = 1 * MiB + 512 * 1024;
constexpr size_t WS_SCAL = WS_ROPE + 64 * 1024;
constexpr size_t WS_ROUTE = 2 * MiB;
constexpr size_t WS_WET = 3 * MiB;
constexpr size_t WS_WCI = 4 * MiB, WS_WCO = 28 * MiB, WS_WPL = 36 * MiB, WS_WGQ = 38 * MiB, WS_WGO = 50 * MiB, WS_WDQ = 58 * MiB, WS_WDO = 82 * MiB;
constexpr size_t WS_WGU = 90 * MiB, WS_WDN = 474 * MiB;
constexpr size_t WS_X = 666 * MiB, WS_H = 732 * MiB;
constexpr size_t WS_MIX = 765 * MiB;
constexpr size_t WS_MOE = 965 * MiB;
constexpr size_t MOE_ACT = 528 * MiB, MOE_Y2 = 559 * MiB;
constexpr size_t WS_D = 1606 * MiB;
constexpr size_t WS_END = 1639 * MiB;
constexpr size_t WS_DUMX = 1640 * MiB, WS_DUMH = 1707 * MiB, WS_DUMQ = 1741 * MiB;
constexpr int CW_BAR = 4096;
constexpr int CW_CNT = 8192;

__device__ __forceinline__ unsigned cvt_pk_bf16(float lo, float hi) { unsigned r; asm volatile("v_cvt_pk_bf16_f32 %0, %1, %2" : "=v"(r) : "v"(lo), "v"(hi)); return r; }
__device__ __forceinline__ float bf_lo(unsigned w) { return __uint_as_float(w << 16); }
__device__ __forceinline__ float bf_hi(unsigned w) { return __uint_as_float(w & 0xffff0000u); }
__device__ __forceinline__ float wave_sum(float v) {
#pragma unroll
    for (int o = 1; o < 64; o <<= 1) v += __shfl_xor(v, o);
    return v;
}
template <int N> __device__ __forceinline__ void wave_sum_n(float (&x)[N], const int lane) {
#pragma unroll
    for (int o = 1; o < 64; o <<= 1) { const int idx = (lane ^ o) << 2;
#pragma unroll
        for (int i = 0; i < N; ++i) x[i] += __builtin_bit_cast(float, __builtin_amdgcn_ds_bpermute(idx, __builtin_bit_cast(int, x[i])));
    }
}
__device__ __forceinline__ int lane_id_fresh() { int l; asm volatile("v_mbcnt_lo_u32_b32 %0, -1, 0\n\tv_mbcnt_hi_u32_b32 %0, -1, %0" : "=v"(l)); return l; }
#define ULD4(base, cb, lo) (*(const f32x4*)((const char*)(base) + (size_t)(cb) + (lo)))
#define UST4(base, cb, lo, val) (*(f32x4*)((char*)(base) + (size_t)(cb) + (lo)) = (val))
#define ULD4N(base, cb, lo) __builtin_nontemporal_load((const f32x4*)((const char*)(base) + (size_t)(cb) + (lo)))
#define UST4N(base, cb, lo, val) __builtin_nontemporal_store((val), (f32x4*)((char*)(base) + (size_t)(cb) + (lo)))
#define LDS_WAIT() asm volatile("s_waitcnt lgkmcnt(0)" ::: "memory")
#define VM_WAIT() asm volatile("s_waitcnt vmcnt(0)" ::: "memory")

namespace pg8 {
constexpr int BM = 256, BK = 64, HALF = 128, HTB = HALF * BK * 2, STAGE_BYTES = 8 * HTB, NXCD = 8, WGM = 8;
__host__ __device__ __forceinline__ int lds_byte(int r, int c) { const int st = (r >> 4) * 2 + (c >> 5), rr = r & 15, cc = c & 31, ob = rr * 64 + cc * 2; return st * 1024 + (ob ^ (((ob >> 9) & 1) << 5)); }
__host__ __device__ __forceinline__ void stage_rc(int b, int& R, int& C) { const int st = b / 1024, sb = b % 1024, swz = sb ^ (((sb >> 9) & 1) << 5); R = (st >> 1) * 16 + swz / 64; C = (st & 1) * 32 + (swz % 64) / 2; }
__host__ __device__ __forceinline__ int perm32(int rho) { const int n = rho >> 4, i = rho & 15; return 8 * (i >> 2) + 4 * n + (i & 3); }

struct Unit { int pm, pn, bsel, pa; };
struct Gemm { const bf16_t* A; const bf16_t* Bt; int K; size_t bstride; };

struct GridOrder {
    int nM, nN, nwg, G, c;
    __device__ void init(int nM_, int nN_, int G_, int c_) { nM = nM_; nN = nN_; nwg = nM * nN; G = G_; c = c_; }
    __device__ bool base_next(int i, Unit& u) const {
        const long L = (long)i * G + c; if (L >= nwg) return false;
        int wgid = (int)L; { const int q = nwg / NXCD, r = nwg % NXCD, xcd = wgid % NXCD, off = wgid / NXCD; wgid = (xcd < r ? xcd * (q + 1) : r * (q + 1) + (xcd - r) * q) + off; }
        const int nig = WGM * nN, gid = wgid / nig, fm = gid * WGM, gsz = (nM - fm) < WGM ? (nM - fm) : WGM;
        u.pm = fm + ((wgid % nig) % gsz); u.pn = (wgid % nig) / gsz; u.bsel = 0; u.pa = u.pm; return true;
    }
    __device__ bool next(int i, Unit& u) const { return base_next(i, u); }
};
struct PoolOrder : GridOrder {
    __device__ bool next(int i, Unit& u) const { if (!base_next(i, u)) return false; u.bsel = u.pm / NMT; return true; }
};
struct MoeOrder : GridOrder {
    const LAS int* t2e; const LAS int* tb; bool sparse_a;
    __device__ bool next(int i, Unit& u) const { if (!base_next(i, u)) return false; const int e = __builtin_amdgcn_readfirstlane(t2e[u.pm]); u.bsel = e;
        if (sparse_a) u.pa = e * NMT + (u.pm - __builtin_amdgcn_readfirstlane(tb[e])); return true; }
};

__device__ __forceinline__ u32x4 pack8(const f32x4 v0, const f32x4 v1) { u32x4 w; w.x = cvt_pk_bf16(v0[0], v0[1]); w.y = cvt_pk_bf16(v0[2], v0[3]); w.z = cvt_pk_bf16(v1[0], v1[1]); w.w = cvt_pk_bf16(v1[2], v1[3]); return w; }

struct EpiQKV {
    static constexpr bool PERM = true;
    bf16_t* P0; int ld0; int pn1; bf16_t* P1; int pn2; bf16_t* P2; size_t hs;
    __device__ __forceinline__ void operator()(const f32x4 (&acc)[2][2][4][2], const Unit& u, int wr, int wc, int fr, int fq) const {
        const int row0 = u.pm * BM + wr * 64 + fr;
        if (u.pn < pn1) {
            bf16_t* base = P0 + u.pn * BM + wc * 32 + 8 * fq;
#pragma unroll
            for (int ai = 0; ai < 2; ++ai)
#pragma unroll
                for (int m = 0; m < 4; ++m) { bf16_t* rowp = base + (size_t)(row0 + ai * HALF + m * 16) * ld0;
#pragma unroll
                    for (int bj = 0; bj < 2; ++bj) *(u32x4*)(rowp + bj * HALF) = pack8(acc[ai][bj][m][0], acc[ai][bj][m][1]); }
        } else {
            const bool s1 = u.pn < pn2; bf16_t* base = (s1 ? P1 : P2) + (size_t)(2 * (u.pn - (s1 ? pn1 : pn2))) * hs + wc * 32 + 8 * fq;
#pragma unroll
            for (int ai = 0; ai < 2; ++ai)
#pragma unroll
                for (int m = 0; m < 4; ++m) { bf16_t* rowp = base + (size_t)(row0 + ai * HALF + m * 16) * 128;
#pragma unroll
                    for (int bj = 0; bj < 2; ++bj) *(u32x4*)(rowp + bj * hs) = pack8(acc[ai][bj][m][0], acc[ai][bj][m][1]); }
        }
    }
};
struct EpiQKVRope {
    static constexpr bool PERM = true;
    bf16_t* Q; bf16_t* Kb; bf16_t* Vb; size_t hs; const float* rope;
    __device__ __forceinline__ void operator()(const f32x4 (&acc)[2][2][4][2], const Unit& u, int wr, int wc, int fr, int fq) const {
        const int row0 = u.pm * BM + wr * 64 + fr;
        if (u.pn >= 16) {
            bf16_t* base = Vb + (size_t)(2 * (u.pn - 16)) * hs + wc * 32 + 8 * fq;
#pragma unroll
            for (int ai = 0; ai < 2; ++ai)
#pragma unroll
                for (int m = 0; m < 4; ++m) { bf16_t* rowp = base + (size_t)(row0 + ai * HALF + m * 16) * 128;
#pragma unroll
                    for (int bj = 0; bj < 2; ++bj) *(u32x4*)(rowp + bj * hs) = pack8(acc[ai][bj][m][0], acc[ai][bj][m][1]); }
        } else {
            const bool isk = u.pn >= 8; const int head = (u.pn - (isk ? 8 : 0)) * 2 + (wc >> 1), qp = wc & 1;
            const bool dorope = u.pm != 0;
            const float* tab = rope + (qp ? 8192 : 0) + 8 * fq; const int sno = qp ? 2048 : 4096;
#pragma unroll
            for (int ai = 0; ai < 2; ++ai)
#pragma unroll
                for (int m = 0; m < 4; ++m) { const int row = row0 + ai * HALF + m * 16;
                    f32x4 a0 = acc[ai][0][m][0], a1 = acc[ai][0][m][1], b0 = acc[ai][1][m][0], b1 = acc[ai][1][m][1];
                    if (dorope) { const int t = row - NCTX, pos = qp ? (t & 63) : (t >> 6); const float* cs = tab + pos * 32;
                        const f32x4 c0 = *(const f32x4*)cs, c1 = *(const f32x4*)(cs + 4), s0 = *(const f32x4*)(cs + sno), s1 = *(const f32x4*)(cs + sno + 4);
                        const f32x4 na0 = a0 * c0 - b0 * s0, na1 = a1 * c1 - b1 * s1, nb0 = b0 * c0 + a0 * s0, nb1 = b1 * c1 + a1 * s1;
                        a0 = na0; a1 = na1; b0 = nb0; b1 = nb1; }
                    bf16_t* dst = isk ? Kb + (size_t)head * hs + (size_t)row * 128 : Q + (size_t)row * DM + head * 128;
                    *(u32x4*)(dst + (2 * qp) * 32 + 8 * fq) = pack8(a0, a1); *(u32x4*)(dst + (2 * qp + 1) * 32 + 8 * fq) = pack8(b0, b1); }
        }
    }
};
struct EpiConv1 {
    static constexpr bool PERM = true;
    bf16_t* GB; bf16_t* PP;
    __device__ __forceinline__ void operator()(const f32x4 (&acc)[2][2][4][2], const Unit& u, int wr, int wc, int fr, int fq) const {
        const int row0 = u.pm * BM + wr * 64 + fr;
        if (u.pn < 8) {
            const int col0 = u.pn * BM + wc * 32 + 8 * fq;
#pragma unroll
            for (int ai = 0; ai < 2; ++ai)
#pragma unroll
                for (int m = 0; m < 4; ++m) { bf16_t* rowp = GB + (size_t)(row0 + ai * HALF + m * 16) * DM + col0;
#pragma unroll
                    for (int bj = 0; bj < 2; ++bj) *(u32x4*)(rowp + bj * HALF) = pack8(acc[ai][bj][m][0], acc[ai][bj][m][1]); }
        } else {
            const int col0 = (u.pn - 8) * HALF + wc * 32 + 8 * fq;
#pragma unroll
            for (int ai = 0; ai < 2; ++ai)
#pragma unroll
                for (int m = 0; m < 4; ++m) { bf16_t* rowp = PP + (size_t)(row0 + ai * HALF + m * 16) * DM + col0;
                    *(u32x4*)rowp = pack8(acc[ai][0][m][0] * acc[ai][1][m][0], acc[ai][0][m][1] * acc[ai][1][m][1]); }
        }
    }
};
struct EpiMoeA {
    static constexpr bool PERM = true;
    bf16_t* ACT;
    __device__ __forceinline__ f32x4 act(const f32x4 g, const f32x4 u) const { f32x4 r;
#pragma unroll
        for (int j = 0; j < 4; ++j) r[j] = g[j] * __builtin_amdgcn_rcpf(1.0f + __expf(-g[j])) * u[j];
        return r; }
    __device__ __forceinline__ void operator()(const f32x4 (&acc)[2][2][4][2], const Unit& u, int wr, int wc, int fr, int fq) const {
        const int row0 = u.pm * BM + wr * 64 + fr, col0 = u.pn * HALF + wc * 32 + 8 * fq;
#pragma unroll
        for (int ai = 0; ai < 2; ++ai)
#pragma unroll
            for (int m = 0; m < 4; ++m) { bf16_t* rowp = ACT + (size_t)(row0 + ai * HALF + m * 16) * EFF + col0;
                *(u32x4*)rowp = pack8(act(acc[ai][0][m][0], acc[ai][1][m][0]), act(acc[ai][0][m][1], acc[ai][1][m][1])); }
    }
};
struct EpiDelta {
    static constexpr bool PERM = true;
    bf16_t* D; int rowbase; int mper; int gcols;
    __device__ __forceinline__ void operator()(const f32x4 (&acc)[2][2][4][2], const Unit& u, int wr, int wc, int fr, int fq) const {
        const int g = u.pm / mper, rt = u.pm - g * mper;
        const int row0 = rowbase + rt * BM + wr * 64 + fr, col0 = g * gcols + u.pn * BM + wc * 32 + 8 * fq;
#pragma unroll
        for (int ai = 0; ai < 2; ++ai)
#pragma unroll
            for (int m = 0; m < 4; ++m) { bf16_t* rowp = D + (size_t)(row0 + ai * HALF + m * 16) * DM + col0;
#pragma unroll
                for (int bj = 0; bj < 2; ++bj) *(u32x4*)(rowp + bj * HALF) = pack8(acc[ai][bj][m][0], acc[ai][bj][m][1]); }
    }
};
struct EpiResid {
    static constexpr bool PERM = false;
    float* X; const float* gate_lat; const float* gate_ctx; const float* colscale; int rowbase; int mper; int gcols;
    __device__ __forceinline__ void operator()(const f32x4 (&acc)[2][2][4][2], const Unit& u, int wr, int wc, int fr, int fq) const {
        const int g = u.pm / mper, rt = u.pm - g * mper;
        const int rowt = rowbase + rt * BM, row0 = rowt + wr * 64 + fr, col0 = g * gcols + u.pn * BM + wc * 32 + 4 * fq;
        const float* gate = (rowt < NCTX) ? gate_ctx : gate_lat;
        f32x4 gv[2][2];
#pragma unroll
        for (int bj = 0; bj < 2; ++bj)
#pragma unroll
            for (int n = 0; n < 2; ++n) { gv[bj][n] = *(const f32x4*)(gate + col0 + bj * HALF + n * 16); if (colscale) gv[bj][n] = gv[bj][n] * *(const f32x4*)(colscale + col0 + bj * HALF + n * 16); }
#pragma unroll
        for (int ai = 0; ai < 2; ++ai)
#pragma unroll
            for (int m = 0; m < 4; ++m) { float* rowp = X + (size_t)(row0 + ai * HALF + m * 16) * DM + col0;
#pragma unroll
                for (int bj = 0; bj < 2; ++bj)
#pragma unroll
                    for (int n = 0; n < 2; ++n) { float* p = rowp + bj * HALF + n * 16; const f32x4 xv = *(const f32x4*)p; *(f32x4*)p = xv * ALPHA + gv[bj][n] * acc[ai][bj][m][n]; }
                asm volatile("" ::: "memory"); }
    }
};

template <class Epi, class Sched, bool ALIGN_EPI, bool SP2>
__device__ __forceinline__ void gemm_phase(LAS unsigned char* lds, const Gemm g, const Sched& S, const Epi& E, const int tid) {
    const int wid = __builtin_amdgcn_readfirstlane(tid >> 6), lane = tid & 63, wr = wid >> 2, wc = wid & 3, fr = lane & 15, fq = lane >> 4;
    const int K = g.K, nt = K / BK;
    unsigned voffA[2], voffB[2];
#pragma unroll
    for (int i = 0; i < 2; ++i) { int R, C; stage_rc(tid * 16 + i * 8192, R, C); const int Rb = Epi::PERM ? ((R & ~31) + perm32(R & 31)) : R;
        voffA[i] = (unsigned)(R * K + C) * 2u; voffB[i] = (unsigned)(Rb * K + C) * 2u; }
    const size_t kstep = (size_t)(BK * 2);
    const size_t hstep = (size_t)HALF * K * 2;
    const size_t tstep = 2 * hstep;
    const size_t bstep = g.bstride * 2;
    const unsigned ldsw = (unsigned)wid * 1024u;
    const int aoff = lds_byte(wr * 64 + fr, fq * 8), boff = lds_byte(wc * 32 + fr, fq * 8);
#define PG8_SA(b, h) (((b) * 2 + (h)) * HTB)
#define PG8_SB(b, h) ((4 + (b) * 2 + (h)) * HTB)
#define PG8_STAGE(bufoff, gbase, voff) do { _Pragma("unroll") for (int _i = 0; _i < 2; ++_i) \
        __builtin_amdgcn_global_load_lds((const unsigned*)((const char*)(gbase) + (voff)[_i]), (LAS unsigned*)(lds + (bufoff) + ldsw + _i * 8192), 16, 0, 0); } while (0)
#define PG8_LDA(dst, b, h) do { _Pragma("unroll") for (int m = 0; m < 4; ++m) _Pragma("unroll") for (int k = 0; k < 2; ++k) dst[m][k] = *(const LAS bf16x8*)(lds + PG8_SA(b, h) + aoff + m * 2048 + k * 1024); } while (0)
#define PG8_LDB(dst, b, h) do { _Pragma("unroll") for (int n = 0; n < 2; ++n) _Pragma("unroll") for (int k = 0; k < 2; ++k) dst[n][k] = *(const LAS bf16x8*)(lds + PG8_SB(b, h) + boff + n * 2048 + k * 1024); } while (0)
#define PG8_MMA(ai, bj, At, Bt) do { __builtin_amdgcn_s_setprio(1); _Pragma("unroll") for (int m = 0; m < 4; ++m) _Pragma("unroll") for (int n = 0; n < 2; ++n) _Pragma("unroll") for (int k = 0; k < 2; ++k) \
        acc[ai][bj][m][n] = __builtin_amdgcn_mfma_f32_16x16x32_bf16(Bt[n][k], At[m][k], acc[ai][bj][m][n], 0, 0, 0); __builtin_amdgcn_s_setprio(0); } while (0)
#define PG8_WAIT_V(n) asm volatile("s_waitcnt vmcnt(" #n ")" ::: "memory")
#define PG8_WAIT_L(n) asm volatile("s_waitcnt lgkmcnt(" #n ")" ::: "memory")
#define PG8_BAR __builtin_amdgcn_s_barrier()
#define PG8_SCHED __builtin_amdgcn_sched_barrier(0)
    Unit cur, nxt; int ui = 0;
    if (!S.next(0, cur)) return;
    f32x4 acc[2][2][4][2];
#pragma unroll
    for (int a = 0; a < 2; ++a)
#pragma unroll
        for (int b = 0; b < 2; ++b)
#pragma unroll
            for (int m = 0; m < 4; ++m)
#pragma unroll
                for (int n = 0; n < 2; ++n) acc[a][b][m][n] = (f32x4){0.f, 0.f, 0.f, 0.f};
    bf16x8 At[4][2], B0[2][2], B1[2][2];
    const char* cA = (const char*)g.A + (size_t)cur.pa * tstep; const char* cB = (const char*)g.Bt + (size_t)cur.bsel * bstep + (size_t)cur.pn * tstep;
    if constexpr (SP2) {
        PG8_STAGE(PG8_SB(0, 0), cB, voffB); PG8_STAGE(PG8_SB(0, 1), cB + hstep, voffB); PG8_STAGE(PG8_SA(0, 0), cA, voffA); PG8_STAGE(PG8_SA(0, 1), cA + hstep, voffA);
        if (wr == 1) PG8_BAR;
        PG8_WAIT_V(2); PG8_BAR;
        PG8_STAGE(PG8_SB(1, 0), cB + kstep, voffB); PG8_STAGE(PG8_SA(1, 0), cA + kstep, voffA); PG8_STAGE(PG8_SB(1, 1), cB + hstep + kstep, voffB);
        PG8_WAIT_V(6); PG8_BAR;
    } else {
        PG8_STAGE(PG8_SB(0, 0), cB, voffB); PG8_STAGE(PG8_SA(0, 0), cA, voffA); PG8_STAGE(PG8_SB(0, 1), cB + hstep, voffB); PG8_STAGE(PG8_SA(0, 1), cA + hstep, voffA);
        if (wr == 1) PG8_BAR;
        PG8_WAIT_V(4); PG8_BAR;
        PG8_STAGE(PG8_SB(1, 0), cB + kstep, voffB); PG8_STAGE(PG8_SA(1, 0), cA + kstep, voffA); PG8_STAGE(PG8_SB(1, 1), cB + hstep + kstep, voffB);
        PG8_WAIT_V(6); PG8_BAR;
    }
    for (;;) {
        const bool has_next = S.next(ui + 1, nxt);
        const char* nA = has_next ? (const char*)g.A + (size_t)nxt.pa * tstep : cA; const char* nB = has_next ? (const char*)g.Bt + (size_t)nxt.bsel * bstep + (size_t)nxt.pn * tstep : cB;
        for (int t = 0; t < nt; t += 2) {
            const bool last = (t == nt - 2);
            const char* a1 = cA + (size_t)(t + 1) * kstep;
            const char* a2 = last ? nA : cA + (size_t)(t + 2) * kstep; const char* b2 = last ? nB : cB + (size_t)(t + 2) * kstep;
            const char* a3 = a2 + kstep; const char* b3 = b2 + kstep;
            if constexpr (SP2) {
            PG8_LDB(B0, 0, 0); PG8_LDB(B1, 0, 1); PG8_SCHED; PG8_LDA(At, 0, 0); PG8_STAGE(PG8_SA(1, 1), a1 + hstep, voffA);
            PG8_WAIT_V(8); PG8_WAIT_L(0); PG8_BAR; PG8_MMA(0, 0, At, B0); PG8_MMA(0, 1, At, B1); PG8_BAR; PG8_SCHED;
            PG8_LDA(At, 0, 1); PG8_STAGE(PG8_SB(0, 0), b2, voffB); PG8_STAGE(PG8_SB(0, 1), b2 + hstep, voffB); PG8_STAGE(PG8_SA(0, 0), a2, voffA);
            PG8_WAIT_V(8); PG8_WAIT_L(0); PG8_BAR; PG8_MMA(1, 0, At, B0); PG8_MMA(1, 1, At, B1); PG8_BAR; PG8_SCHED;
            PG8_LDB(B0, 1, 0); PG8_LDB(B1, 1, 1); PG8_SCHED; PG8_LDA(At, 1, 0); PG8_STAGE(PG8_SA(0, 1), a2 + hstep, voffA);
            PG8_WAIT_V(8); PG8_WAIT_L(0); PG8_BAR; PG8_MMA(0, 0, At, B0); PG8_MMA(0, 1, At, B1); PG8_BAR; PG8_SCHED;
            PG8_LDA(At, 1, 1); PG8_STAGE(PG8_SB(1, 0), b3, voffB); PG8_STAGE(PG8_SB(1, 1), b3 + hstep, voffB); PG8_STAGE(PG8_SA(1, 0), a3, voffA);
            PG8_WAIT_V(8); PG8_WAIT_L(0); PG8_BAR; PG8_MMA(1, 0, At, B0); PG8_MMA(1, 1, At, B1); PG8_BAR; PG8_SCHED;
            } else {
            PG8_LDB(B0, 0, 0); PG8_SCHED; PG8_LDA(At, 0, 0); PG8_STAGE(PG8_SA(1, 1), a1 + hstep, voffA);
            PG8_WAIT_L(8); PG8_BAR; PG8_WAIT_L(0); PG8_MMA(0, 0, At, B0); PG8_BAR; PG8_SCHED;
            PG8_LDB(B1, 0, 1); PG8_STAGE(PG8_SB(0, 0), b2, voffB);
            PG8_BAR; PG8_WAIT_L(0); PG8_MMA(0, 1, At, B1); PG8_BAR;
            PG8_LDA(At, 0, 1); PG8_STAGE(PG8_SA(0, 0), a2, voffA);
            PG8_BAR; PG8_WAIT_L(0); PG8_MMA(1, 0, At, B0); PG8_BAR; PG8_SCHED;
            PG8_STAGE(PG8_SB(0, 1), b2 + hstep, voffB);
            PG8_WAIT_V(6); PG8_BAR; PG8_MMA(1, 1, At, B1); PG8_BAR;
            PG8_LDB(B0, 1, 0); PG8_SCHED; PG8_LDA(At, 1, 0); PG8_STAGE(PG8_SA(0, 1), a2 + hstep, voffA);
            PG8_WAIT_L(8); PG8_BAR; PG8_WAIT_L(0); PG8_MMA(0, 0, At, B0); PG8_BAR; PG8_SCHED;
            PG8_LDB(B1, 1, 1); PG8_STAGE(PG8_SB(1, 0), b3, voffB);
            PG8_BAR; PG8_WAIT_L(0); PG8_MMA(0, 1, At, B1); PG8_BAR;
            PG8_LDA(At, 1, 1); PG8_STAGE(PG8_SA(1, 0), a3, voffA);
            PG8_BAR; PG8_WAIT_L(0); PG8_MMA(1, 0, At, B0); PG8_BAR; PG8_SCHED;
            PG8_STAGE(PG8_SB(1, 1), b3 + hstep, voffB);
            PG8_WAIT_V(6); PG8_BAR; PG8_MMA(1, 1, At, B1); PG8_BAR;
            }
        }
        if constexpr (ALIGN_EPI) { if (wr == 0) PG8_BAR; }
        E(acc, cur, wr, wc, fr, fq);
        if (!has_next) break;
#pragma unroll
        for (int a = 0; a < 2; ++a)
#pragma unroll
            for (int b = 0; b < 2; ++b)
#pragma unroll
                for (int m = 0; m < 4; ++m)
#pragma unroll
                    for (int n = 0; n < 2; ++n) acc[a][b][m][n] = (f32x4){0.f, 0.f, 0.f, 0.f};
        cur = nxt; cA = nA; cB = nB; ++ui;
        if constexpr (ALIGN_EPI) { if (wr == 1) PG8_BAR; }
    }
    PG8_WAIT_V(0);
    if constexpr (!ALIGN_EPI) { if (wr == 0) PG8_BAR; }
    PG8_BAR;
#undef PG8_SA
#undef PG8_SB
#undef PG8_STAGE
#undef PG8_LDA
#undef PG8_LDB
#undef PG8_MMA
#undef PG8_WAIT_V
#undef PG8_WAIT_L
#undef PG8_BAR
#undef PG8_SCHED
}
}

namespace att {
constexpr int D = 128, NW = 8, QBLK = 32, KVBLK = 64;
constexpr float SCALE = 0.088388347648318440f;
constexpr float THR = 8.f;
constexpr size_t SHM_V = KVBLK * D * 2, SHM_K = KVBLK * D * 2, SHM_ATTN = 2 * SHM_V + 2 * SHM_K + NW * 64 * 4;
#define KSWZ(row, colB) ((row) * 256 + ((colB) ^ (((row) & 7) << 4)))
#define SBAR() __builtin_amdgcn_sched_barrier(0)
__device__ __forceinline__ int crow(int r, int hi) { return (r & 3) + 8 * (r >> 2) + 4 * hi; }
__device__ __forceinline__ unsigned cvtpk(float lo, float hi) { unsigned r; asm volatile("v_cvt_pk_bf16_f32 %0, %1, %2" : "=v"(r) : "v"(lo), "v"(hi)); return r; }
__device__ __forceinline__ void partialSM(f32x16& p0, f32x16& p1, float& m_reg, float& mn, float& alpha) {
  constexpr float C = SCALE * 1.4426950408889634f;
  float pmax = p0[0]; for (int r = 1; r < 16; ++r) pmax = fmaxf(pmax, p0[r]); for (int r = 0; r < 16; ++r) pmax = fmaxf(pmax, p1[r]);
  { auto rr = __builtin_amdgcn_permlane32_swap(__float_as_uint(pmax), __float_as_uint(pmax), false, false);
    pmax = fmaxf(__uint_as_float(rr[0]), __uint_as_float(rr[1])); }
  if (__builtin_expect(__all(pmax - m_reg <= THR / SCALE), 1)) { mn = m_reg; alpha = 1.f; }
  else { mn = fmaxf(m_reg, pmax); alpha = __builtin_amdgcn_exp2f((m_reg - mn) * C); m_reg = mn; }
  float mnC = -mn * C;
  for (int r = 0; r < 16; ++r) p0[r] = fmaf(p0[r], C, mnC); for (int r = 0; r < 16; ++r) p1[r] = fmaf(p1[r], C, mnC);
  for (int r = 0; r < 16; ++r) p0[r] = __builtin_amdgcn_exp2f(p0[r]);
}
__device__ __forceinline__ void finishSM(f32x16& p0, f32x16& p1, float alpha, float& l_reg, bf16x8& pa0, bf16x8& pa1, bf16x8& pa2, bf16x8& pa3) {
  for (int r = 0; r < 16; ++r) p1[r] = __builtin_amdgcn_exp2f(p1[r]);
  float ps = 0; for (int r = 0; r < 16; ++r) ps += p0[r]; for (int r = 0; r < 16; ++r) ps += p1[r];
  { auto rr = __builtin_amdgcn_permlane32_swap(__float_as_uint(ps), __float_as_uint(ps), false, false);
    ps = __uint_as_float(rr[0]) + __uint_as_float(rr[1]); }
  l_reg = l_reg * alpha + ps;
#define PK4(P, BASE, OUT) do { unsigned a0 = cvtpk(P[BASE + 0], P[BASE + 1]), a1 = cvtpk(P[BASE + 2], P[BASE + 3]);   \
    unsigned b0 = cvtpk(P[BASE + 4], P[BASE + 5]), b1 = cvtpk(P[BASE + 6], P[BASE + 7]);                              \
    auto r0 = __builtin_amdgcn_permlane32_swap(a0, b0, false, false); auto r1 = __builtin_amdgcn_permlane32_swap(a1, b1, false, false); \
    u32x4 w = {r0[0], r1[0], r0[1], r1[1]}; OUT = *reinterpret_cast<bf16x8*>(&w); } while (0)
  PK4(p0, 0, pa0); PK4(p0, 8, pa1); PK4(p1, 0, pa2); PK4(p1, 8, pa3);
#undef PK4
}
__device__ __forceinline__ void qkt(f32x16& p0, f32x16& p1, const bf16_t* Ks, const bf16x8* qr, int r32, int hi) {
  p0 = f32x16{}; p1 = f32x16{};
  for (int d0 = 0; d0 < 8; ++d0) { int cb = (d0 * 16 + hi * 8) * 2;
    bf16x8 b0 = *reinterpret_cast<const bf16x8*>((const char*)Ks + KSWZ(r32, cb));
    bf16x8 b1 = *reinterpret_cast<const bf16x8*>((const char*)Ks + KSWZ(32 + r32, cb));
    p0 = __builtin_amdgcn_mfma_f32_32x32x16_bf16(b0, qr[d0], p0, 0, 0, 0);
    p1 = __builtin_amdgcn_mfma_f32_32x32x16_bf16(b1, qr[d0], p1, 0, 0, 0); }
}
__device__ __forceinline__ int v_st(int k, int c) { const int kk = (k & ~0xC) | ((k & 4) << 1) | ((k & 8) >> 1); return ((kk >> 3) * 4 + (c >> 5)) * 512 + ((kk & 7) * 32 + (c & 31)) * 2; }
__device__ __forceinline__ int v_rd_base(int lane) { return ((lane & 3) << 3) | (((lane >> 2) & 3) << 6) | (((lane >> 4) & 1) << 5) | (((lane >> 5) & 1) << 8); }
constexpr int v_rd_off(int d0, int ks, int half) { return d0 * 512 + ks * 4096 + half * 2048; }
template <int OFF> __device__ __forceinline__ s16x4 tr_read(int vb) {
  s16x4 r; asm volatile("ds_read_b64_tr_b16 %0, %1 offset:%2" : "=&v"(r) : "v"(vb), "i"(OFF) : "memory"); return r;
}
template <int D0> __device__ __forceinline__ void pv_one(f32x16& od, int vb, bf16x8 pa0, bf16x8 pa1, bf16x8 pa2, bf16x8 pa3) {
  const s16x4 l0 = tr_read<v_rd_off(D0, 0, 0)>(vb), h0 = tr_read<v_rd_off(D0, 0, 1)>(vb), l1 = tr_read<v_rd_off(D0, 1, 0)>(vb), h1 = tr_read<v_rd_off(D0, 1, 1)>(vb);
  const s16x4 l2 = tr_read<v_rd_off(D0, 2, 0)>(vb), h2 = tr_read<v_rd_off(D0, 2, 1)>(vb), l3 = tr_read<v_rd_off(D0, 3, 0)>(vb), h3 = tr_read<v_rd_off(D0, 3, 1)>(vb);
  asm volatile("s_waitcnt lgkmcnt(0)" ::: "memory"); SBAR();
#define PK(L, H) (bf16x8){L[0], L[1], L[2], L[3], H[0], H[1], H[2], H[3]}
  od = __builtin_amdgcn_mfma_f32_32x32x16_bf16(pa0, PK(l0, h0), od, 0, 0, 0);
  od = __builtin_amdgcn_mfma_f32_32x32x16_bf16(pa1, PK(l1, h1), od, 0, 0, 0);
  od = __builtin_amdgcn_mfma_f32_32x32x16_bf16(pa2, PK(l2, h2), od, 0, 0, 0);
  od = __builtin_amdgcn_mfma_f32_32x32x16_bf16(pa3, PK(l3, h3), od, 0, 0, 0);
#undef PK
}
__device__ __forceinline__ void pv_d0(f32x16* o, int vb, bf16x8 pa0, bf16x8 pa1, bf16x8 pa2, bf16x8 pa3) {
  pv_one<0>(o[0], vb, pa0, pa1, pa2, pa3); pv_one<1>(o[1], vb, pa0, pa1, pa2, pa3); pv_one<2>(o[2], vb, pa0, pa1, pa2, pa3); pv_one<3>(o[3], vb, pa0, pa1, pa2, pa3);
}
template <int LDQ, int LDK, int LDV, int LDO>
__device__ __forceinline__ void attn_unit(const bf16_t* __restrict__ Qb, const bf16_t* __restrict__ Kh, const bf16_t* __restrict__ Vh, bf16_t* __restrict__ Ob, int seq, char* lds, const int wid,
                                          const float* qgain = nullptr, const float* rope = nullptr, int qpos0 = -1) {
  const int lane = lane_id_fresh(), tid = wid * 64 + lane, r32 = lane & 31, hi = lane >> 5;
  bf16_t* V_lds = (bf16_t*)lds; bf16_t* K_lds = (bf16_t*)(lds + 2 * SHM_V);
  float* ws = (float*)(lds + 2 * SHM_V + 2 * SHM_K) + wid * 64; float* li_l = ws; float* al_l = ws + 32;
  float m_reg = -1e30f, l_reg = 0; f32x16 o[4] = {}; bf16x8 qr[8];
  { const unsigned offQ = (unsigned)((wid * QBLK + r32) * LDQ + hi * 8) * 2u;
#pragma unroll
  for (int d0 = 0; d0 < 8; ++d0) qr[d0] = *reinterpret_cast<const bf16x8*>((const char*)Qb + offQ + d0 * 32); }
  if (qgain) {
    float x[8][8]; float ss = 0.f;
#pragma unroll
    for (int d0 = 0; d0 < 8; ++d0) { const u32x4 w = *reinterpret_cast<const u32x4*>(&qr[d0]);
#pragma unroll
      for (int q = 0; q < 4; ++q) { x[d0][2 * q] = bf_lo(w[q]); x[d0][2 * q + 1] = bf_hi(w[q]); ss += x[d0][2 * q] * x[d0][2 * q] + x[d0][2 * q + 1] * x[d0][2 * q + 1]; } }
    { auto rr = __builtin_amdgcn_permlane32_swap(__float_as_uint(ss), __float_as_uint(ss), false, false); ss = __uint_as_float(rr[0]) + __uint_as_float(rr[1]); }
    const float rstd = 1.0f / sqrtf(ss * (1.0f / 128.0f) + RMS_EPS);
#pragma unroll
    for (int d0 = 0; d0 < 8; ++d0) { const f32x4 g0 = *(const f32x4*)(qgain + d0 * 16 + hi * 8), g1 = *(const f32x4*)(qgain + d0 * 16 + hi * 8 + 4);
#pragma unroll
      for (int j = 0; j < 4; ++j) { x[d0][j] *= rstd * g0[j]; x[d0][4 + j] *= rstd * g1[j]; } }
    if (qpos0 >= 0) { const int t = qpos0 + wid * QBLK + r32;
#pragma unroll
      for (int pr = 0; pr < 4; ++pr) { const int da = (pr >> 1) * 4 + (pr & 1), db = da + 2;
        const int pos = (pr < 2) ? (t >> 6) : (t & 63); const float* cs = rope + ((pr < 2) ? 0 : 8192) + pos * 32 + (pr & 1) * 16 + hi * 8; const float* sn = cs + ((pr < 2) ? 4096 : 2048);
        const f32x4 c0 = *(const f32x4*)cs, c1 = *(const f32x4*)(cs + 4), s0 = *(const f32x4*)sn, s1 = *(const f32x4*)(sn + 4);
#pragma unroll
        for (int j = 0; j < 8; ++j) { const float c = j < 4 ? c0[j & 3] : c1[j & 3], sv = j < 4 ? s0[j & 3] : s1[j & 3]; const float xa = x[da][j], xb = x[db][j];
          x[da][j] = xa * c - xb * sv; x[db][j] = xb * c + xa * sv; } } }
#pragma unroll
    for (int d0 = 0; d0 < 8; ++d0) { u32x4 w; w.x = cvtpk(x[d0][0], x[d0][1]); w.y = cvtpk(x[d0][2], x[d0][3]); w.z = cvtpk(x[d0][4], x[d0][5]); w.w = cvtpk(x[d0][6], x[d0][7]); qr[d0] = *reinterpret_cast<bf16x8*>(&w); }
  }
  const int sr = tid >> 4, sc = (tid & 15) * 8, vst0 = v_st(sr, sc), vst1 = v_st(32 + sr, sc);
  const int vb0 = (int)(uintptr_t)V_lds + v_rd_base(lane);
  struct { bf16x8 vs0, vs1, ks0, ks1; } sr_[2];
  const int offV = (sr * LDV + sc) * 2, offK = (sr * LDK + sc) * 2;
  const __amdgpu_buffer_rsrc_t rV = __builtin_amdgcn_make_buffer_rsrc((void*)Vh, 0, 0x7ffffff0, 0x00020000);
  const __amdgpu_buffer_rsrc_t rK = __builtin_amdgcn_make_buffer_rsrc((void*)Kh, 0, 0x7ffffff0, 0x00020000);
#define SLOAD(i, k0) do { const int sv_ = (k0) * (LDV * 2), sk_ = (k0) * (LDK * 2); \
    { u32x4 t_ = __builtin_amdgcn_raw_buffer_load_b128(rV, offV, sv_, 0); sr_[i].vs0 = *reinterpret_cast<bf16x8*>(&t_); } \
    { u32x4 t_ = __builtin_amdgcn_raw_buffer_load_b128(rV, offV, sv_ + 32 * LDV * 2, 0); sr_[i].vs1 = *reinterpret_cast<bf16x8*>(&t_); } \
    { u32x4 t_ = __builtin_amdgcn_raw_buffer_load_b128(rK, offK, sk_, 0); sr_[i].ks0 = *reinterpret_cast<bf16x8*>(&t_); } \
    { u32x4 t_ = __builtin_amdgcn_raw_buffer_load_b128(rK, offK, sk_ + 32 * LDK * 2, 0); sr_[i].ks1 = *reinterpret_cast<bf16x8*>(&t_); } } while (0)
#define SWRITE(b, i) do { *(bf16x8*)((char*)V_lds + (b) * SHM_V + vst0) = sr_[i].vs0;          \
    *(bf16x8*)((char*)V_lds + (b) * SHM_V + vst1) = sr_[i].vs1; int kc = sc * 2;               \
    *(bf16x8*)((char*)K_lds + (b) * SHM_K + KSWZ(sr, kc)) = sr_[i].ks0;                       \
    *(bf16x8*)((char*)K_lds + (b) * SHM_K + KSWZ(32 + sr, kc)) = sr_[i].ks1; } while (0)
#define SWAIT() asm volatile("s_waitcnt vmcnt(4)" ::: "memory")
#define RESC(a) do { if (__any((a) < 1.f)) { if (hi == 0) al_l[r32] = (a); asm volatile("s_waitcnt lgkmcnt(0)" ::: "memory"); \
    for (int d = 0; d < 4; ++d) for (int r = 0; r < 16; ++r) o[d][r] *= al_l[crow(r, hi)]; } } while (0)
  f32x16 pA0, pA1, pB0, pB1; float mnA, mnB, alA, alB; bf16x8 pa0, pa1, pa2, pa3; const int NT = seq / KVBLK;
  constexpr int SE = 0, SO = 1;
  SLOAD(SE, 0); asm volatile("s_waitcnt vmcnt(0)" ::: "memory"); SWRITE(0, SE); __syncthreads();
  qkt(pA0, pA1, K_lds, qr, r32, hi); partialSM(pA0, pA1, m_reg, mnA, alA);
  SLOAD(SO, KVBLK); if (2 < NT) SLOAD(SE, 2 * KVBLK);
  SWAIT(); SWRITE(1, SO); __syncthreads();
  for (int j = 1; j + 1 < NT; j += 2) {
    SBAR(); qkt(pB0, pB1, (bf16_t*)((char*)K_lds + SHM_K), qr, r32, hi);
    finishSM(pA0, pA1, alA, l_reg, pa0, pa1, pa2, pa3); SBAR();
    SLOAD(SO, (j + 2) * KVBLK); SBAR();
    pv_d0(o, vb0, pa0, pa1, pa2, pa3); partialSM(pB0, pB1, m_reg, mnB, alB);
    __syncthreads(); SWAIT(); SWRITE(0, SE);
    RESC(alB); __syncthreads();
    SBAR(); qkt(pA0, pA1, K_lds, qr, r32, hi);
    finishSM(pB0, pB1, alB, l_reg, pa0, pa1, pa2, pa3); SBAR();
    if (j + 3 < NT) SLOAD(SE, (j + 3) * KVBLK); SBAR();
    pv_d0(o, vb0 + (int)SHM_V, pa0, pa1, pa2, pa3); partialSM(pA0, pA1, m_reg, mnA, alA);
    __syncthreads(); SWAIT(); SWRITE(1, SO);
    RESC(alA); __syncthreads();
  }
  SBAR(); qkt(pB0, pB1, (bf16_t*)((char*)K_lds + SHM_K), qr, r32, hi);
  finishSM(pA0, pA1, alA, l_reg, pa0, pa1, pa2, pa3); SBAR();
  pv_d0(o, vb0, pa0, pa1, pa2, pa3); partialSM(pB0, pB1, m_reg, mnB, alB);
  __syncthreads(); RESC(alB);
  finishSM(pB0, pB1, alB, l_reg, pa0, pa1, pa2, pa3); SBAR();
  pv_d0(o, vb0 + (int)SHM_V, pa0, pa1, pa2, pa3);
  if (hi == 0) li_l[r32] = l_reg; asm volatile("s_waitcnt lgkmcnt(0)" ::: "memory");
  float rli[16];
#pragma unroll
  for (int r = 0; r < 16; ++r) rli[r] = __builtin_amdgcn_rcpf(li_l[crow(r, hi)]);
#pragma unroll
  for (int r = 0; r < 16; ++r) { const unsigned offO = (unsigned)((wid * QBLK + crow(r, hi)) * LDO + r32) * 2u;
    for (int d0 = 0; d0 < 4; ++d0) { const float v = o[d0][r] * rli[r]; *(bf16_t*)((char*)Ob + offO + d0 * 64) = (bf16_t)(cvtpk(v, v) & 0xffffu); } }
  asm volatile("s_waitcnt lgkmcnt(0)" ::: "memory"); __syncthreads();
#undef SLOAD
#undef SWRITE
#undef SWAIT
#undef RESC
}
constexpr size_t SHM_V2 = 2 * SHM_V;
template <int LDQ, int LDK, int LDV, class EPI>
__device__ __forceinline__ void attn_unit2(const bf16_t* __restrict__ Qb, const bf16_t* __restrict__ Kh, const bf16_t* __restrict__ Vh0, const bf16_t* __restrict__ Vh1, int seq, char* lds, const int wid, EPI&& epi) {
  const int lane = lane_id_fresh(), tid = wid * 64 + lane, r32 = lane & 31, hi = lane >> 5;
  bf16_t* V_lds = (bf16_t*)lds; bf16_t* K_lds = (bf16_t*)(lds + 2 * SHM_V2);
  float* ws = (float*)(lds + 2 * SHM_V2 + 2 * SHM_K) + wid * 64; float* li_l = ws; float* al_l = ws + 32;
  float m_reg = -1e30f, l_reg = 0; f32x16 o[8] = {}; bf16x8 qr[8];
  { const unsigned offQ = (unsigned)((wid * QBLK + r32) * LDQ + hi * 8) * 2u;
#pragma unroll
  for (int d0 = 0; d0 < 8; ++d0) qr[d0] = *reinterpret_cast<const bf16x8*>((const char*)Qb + offQ + d0 * 32); }
  const int sr = tid >> 4, sc = (tid & 15) * 8, vst0 = v_st(sr, sc), vst1 = v_st(32 + sr, sc);
  const int vb0 = (int)(uintptr_t)V_lds + v_rd_base(lane);
  const int offV = (sr * LDV + sc) * 2, offK = (sr * LDK + sc) * 2;
  const __amdgpu_buffer_rsrc_t rV0 = __builtin_amdgcn_make_buffer_rsrc((void*)Vh0, 0, 0x7ffffff0, 0x00020000);
  const __amdgpu_buffer_rsrc_t rV1 = __builtin_amdgcn_make_buffer_rsrc((void*)Vh1, 0, 0x7ffffff0, 0x00020000);
  const __amdgpu_buffer_rsrc_t rK = __builtin_amdgcn_make_buffer_rsrc((void*)Kh, 0, 0x7ffffff0, 0x00020000);
  u32x4 sv0, sv1, sv2, sv3, sk0, sk1;
#define SLOAD2(k0) do { const int sv_ = (k0) * (LDV * 2), sk_ = (k0) * (LDK * 2); \
    sv0 = __builtin_amdgcn_raw_buffer_load_b128(rV0, offV, sv_, 0); sv1 = __builtin_amdgcn_raw_buffer_load_b128(rV0, offV, sv_ + 32 * LDV * 2, 0); \
    sv2 = __builtin_amdgcn_raw_buffer_load_b128(rV1, offV, sv_, 0); sv3 = __builtin_amdgcn_raw_buffer_load_b128(rV1, offV, sv_ + 32 * LDV * 2, 0); \
    sk0 = __builtin_amdgcn_raw_buffer_load_b128(rK, offK, sk_, 0); sk1 = __builtin_amdgcn_raw_buffer_load_b128(rK, offK, sk_ + 32 * LDK * 2, 0); } while (0)
#define SWRITE2(b) do { char* vb_ = (char*)V_lds + (b) * SHM_V2; const int kc = sc * 2; \
    *(u32x4*)(vb_ + vst0) = sv0; *(u32x4*)(vb_ + vst1) = sv1; *(u32x4*)(vb_ + SHM_V + vst0) = sv2; *(u32x4*)(vb_ + SHM_V + vst1) = sv3; \
    *(u32x4*)((char*)K_lds + (b) * SHM_K + KSWZ(sr, kc)) = sk0; *(u32x4*)((char*)K_lds + (b) * SHM_K + KSWZ(32 + sr, kc)) = sk1; } while (0)
#define RESC2(a) do { if (__any((a) < 1.f)) { if (hi == 0) al_l[r32] = (a); asm volatile("s_waitcnt lgkmcnt(0)" ::: "memory"); \
    for (int d = 0; d < 8; ++d) for (int r = 0; r < 16; ++r) o[d][r] *= al_l[crow(r, hi)]; } } while (0)
  f32x16 p0, p1; float mn, al; bf16x8 pa0, pa1, pa2, pa3; const int NT = seq / KVBLK;
  SLOAD2(0); SWRITE2(0); __syncthreads();
  for (int j = 0; j < NT; ++j) { const int b = j & 1;
    if (j + 1 < NT) SLOAD2((j + 1) * KVBLK);
    SBAR(); qkt(p0, p1, (bf16_t*)((char*)K_lds + b * SHM_K), qr, r32, hi);
    partialSM(p0, p1, m_reg, mn, al); RESC2(al);
    finishSM(p0, p1, al, l_reg, pa0, pa1, pa2, pa3); SBAR();
    pv_d0(o, vb0 + b * (int)SHM_V2, pa0, pa1, pa2, pa3);
    pv_d0(o + 4, vb0 + b * (int)SHM_V2 + (int)SHM_V, pa0, pa1, pa2, pa3);
    __syncthreads();
    if (j + 1 < NT) SWRITE2(b ^ 1);
    __syncthreads();
  }
  const int le = lane_id_fresh(), r32e = le & 31, hie = le >> 5;
  if (hie == 0) li_l[r32e] = l_reg; asm volatile("s_waitcnt lgkmcnt(0)" ::: "memory");
  float rli[16];
#pragma unroll
  for (int r = 0; r < 16; ++r) rli[r] = __builtin_amdgcn_rcpf(li_l[crow(r, hie)]);
  epi(o, rli, wid, le);
  asm volatile("s_waitcnt lgkmcnt(0)" ::: "memory"); __syncthreads();
#undef SLOAD2
#undef SWRITE2
#undef RESC2
}
#undef KSWZ
#undef SBAR
}

#define XB_TMO      128
#define XB_XCNT(j)  (256  + 64 * (j))
#define XB_XSUB(j)  (1280 + 64 * (j))
#define XB_XGEN(j)  (2304 + 64 * (j))
#define XB_TOP      3328
#define XB_TOPGEN   3392
#define XCD_BAR_WORDS 3456
#define XB_SPIN_CAP (1u << 18)
__device__ __forceinline__ unsigned xb_ld(unsigned* p)              { return __hip_atomic_load(p, __ATOMIC_RELAXED, __HIP_MEMORY_SCOPE_AGENT); }
__device__ __forceinline__ unsigned xb_add(unsigned* p, unsigned v) { return __hip_atomic_fetch_add(p, v, __ATOMIC_RELAXED, __HIP_MEMORY_SCOPE_AGENT); }
__device__ __forceinline__ unsigned xb_xcc_id() { return (unsigned)__builtin_amdgcn_s_getreg((3 << 11) | 20) & 0xFu; }
#define XB_SPIN(cond, bar) do { unsigned _sp = 0; while (cond) { __builtin_amdgcn_s_sleep(1); \
    if ((++_sp & 255u) == 0u) { if (xb_ld(&(bar)[XB_TMO])) break; if (_sp > XB_SPIN_CAP) { atomicAdd(&(bar)[XB_TMO], 1u); break; } } } } while (0)
struct XcdBarrier { unsigned* bar; unsigned x; volatile LAS unsigned* st; };
__device__ __forceinline__ XcdBarrier xcd_barrier_post(unsigned* bar, volatile LAS unsigned* st, const int tid) {
    XcdBarrier b; b.bar = bar; b.x = xb_xcc_id(); b.st = st;
    if (tid == 0) (void)xb_add(&bar[XB_XCNT(b.x)], 1u);
    return b;
}
__device__ __forceinline__ void xcd_barrier_complete(unsigned* bar, unsigned x, unsigned& nloc, unsigned& nx) {
    const unsigned G = gridDim.x * gridDim.y * gridDim.z;
    unsigned sum, cnt, mine, sp = 0u;
    for (;;) {
        sum = 0u; cnt = 0u; mine = 0u;
#pragma unroll
        for (unsigned j = 0; j < 16; ++j) { const unsigned c = xb_ld(&bar[XB_XCNT(j)]); sum += c; cnt += (c > 0u) ? 1u : 0u; mine = (j == x) ? c : mine; }
        if (sum == G) break;
        __builtin_amdgcn_s_sleep(1);
        if ((++sp & 255u) == 0u) { if (xb_ld(&bar[XB_TMO])) break; if (sp > XB_SPIN_CAP) { atomicAdd(&bar[XB_TMO], 1u); break; } }
    }
    nloc = mine > 0u ? mine : 1u; nx = cnt > 0u ? cnt : 1u;
}
__device__ __forceinline__ void xcd_barrier(const XcdBarrier& b, const int tid) {
    asm volatile("s_waitcnt vmcnt(0)" ::: "memory");
    __syncthreads();
    if (tid == 0) {
        unsigned* bar = b.bar;
        __builtin_amdgcn_s_waitcnt(0);
        unsigned nloc = b.st[0], nx = b.st[1];
        if (nloc == 0u) { xcd_barrier_complete(bar, b.x, nloc, nx); b.st[0] = nloc; b.st[1] = nx; }
        const unsigned old = xb_add(&bar[XB_XSUB(b.x)], 1u);
        const unsigned gen = old / nloc;
        if (old + 1u == (gen + 1u) * nloc) {
            __builtin_amdgcn_fence(__ATOMIC_RELEASE, "agent");
            asm volatile("s_waitcnt vmcnt(0)" ::: "memory");
            const unsigned og = xb_add(&bar[XB_TOP], 1u);
            const unsigned tg = og / nx;
            if (og + 1u == (tg + 1u) * nx) xb_add(&bar[XB_TOPGEN], 1u);
            else XB_SPIN(xb_ld(&bar[XB_TOPGEN]) == tg, bar);
            __builtin_amdgcn_fence(__ATOMIC_ACQUIRE, "agent");
            xb_add(&bar[XB_XGEN(b.x)], 1u);
            asm volatile("s_waitcnt vmcnt(0)" ::: "memory");
        } else {
            XB_SPIN(xb_ld(&bar[XB_XGEN(b.x)]) == gen, bar);
            __builtin_amdgcn_fence(__ATOMIC_ACQUIRE, "agent");
            asm volatile("s_waitcnt vmcnt(0)" ::: "memory");
        }
    }
    __syncthreads();
}

constexpr int RING_BYTES = 131072;
constexpr int MISC_OFF = RING_BYTES;
constexpr int LDS_BYTES = 147456;

struct RowStats { float mean, rstd; };
__device__ __forceinline__ RowStats ln_stats(const f32x4 (&v)[8]) {
    float s = 0.f;
#pragma unroll
    for (int j = 0; j < 8; ++j) s += (v[j][0] + v[j][1]) + (v[j][2] + v[j][3]);
    const float mean = wave_sum(s) * (1.f / DM); float q = 0.f;
#pragma unroll
    for (int j = 0; j < 8; ++j) { const f32x4 d = v[j] - mean; q += (d[0] * d[0] + d[1] * d[1]) + (d[2] * d[2] + d[3] * d[3]); }
    RowStats r; r.mean = mean; r.rstd = 1.f / sqrtf(wave_sum(q) * (1.f / DM) + LN_EPS); return r;
}
__device__ __forceinline__ void store_bf16x4(bf16_t* p, const f32x4 v) { u32x2 w; w.x = cvt_pk_bf16(v[0], v[1]); w.y = cvt_pk_bf16(v[2], v[3]); *(u32x2*)p = w; }
__device__ __forceinline__ f32x4 load_bf16x4(const bf16_t* p) { const u32x2 w = *(const u32x2*)p; return (f32x4){bf_lo(w.x), bf_hi(w.x), bf_lo(w.y), bf_hi(w.y)}; }

__device__ __forceinline__ void transpose_item(const float* W, int ldw, int scol0, bf16_t* WT, int K, int drow0, int k0, LAS float*  , int lane) {
    const int kr = lane >> 3, n4 = (lane & 7) * 4;
    const float* src = W + (size_t)(k0 + 8 * kr) * ldw + scol0 + n4;
    f32x4 v[8];
#pragma unroll
    for (int i = 0; i < 8; ++i) v[i] = __builtin_nontemporal_load((const f32x4*)(src + (size_t)i * ldw));
    bf16_t* dst = WT + (size_t)(drow0 + n4) * K + k0 + 8 * kr;
#pragma unroll
    for (int q = 0; q < 4; ++q) { u32x4 o; o.x = cvt_pk_bf16(v[0][q], v[1][q]); o.y = cvt_pk_bf16(v[2][q], v[3][q]); o.z = cvt_pk_bf16(v[4][q], v[5][q]); o.w = cvt_pk_bf16(v[6][q], v[7][q]);
        __builtin_nontemporal_store(o, (u32x4*)(dst + (size_t)q * K)); }
}
__device__ __forceinline__ void tr_plain(const float* W, int K, int N, bf16_t* WT, int it, LAS float* scr, int lane) {
    const int nnb = N / 32, kb = it / nnb, nb = it % nnb;
    transpose_item(W, N, 32 * nb, WT, K, 32 * nb, 64 * kb, scr, lane);
}

struct Args { const float* in[27]; float* out; unsigned char* ws; int ph_lo, ph_hi; int probe_dup, pad; };
enum { I_X = 0, I_C, I_CTX, I_CCTX, I_MODW, I_MODB, I_LNG, I_LNB, I_RGW, I_RGB, I_REW, I_REB, I_EG, I_EU, I_ED, I_CIW, I_CW, I_COW, I_PW, I_PS, I_GQW, I_GQN, I_GOW, I_DQW, I_DL, I_DS, I_DOW };

namespace cq {
constexpr int I_GU = 32 * 48, I_DN = 12 * 64, I_EXP = I_GU + I_DN, I_LEXP = 16 * I_EXP;
constexpr int I_PL = 4 * 8 * 16, I_GQ = 32 * 96, I_GO = 32 * 64, I_DQ = 32 * 192, I_DO = 32 * 64;
constexpr int E0 = I_LEXP, E1 = E0 + I_PL, E2 = E1 + I_LEXP, E3 = E2 + I_GQ, E4 = E3 + I_GO, E5 = E4 + I_LEXP, E6 = E5 + I_DQ, E7 = E6 + I_DO, E8 = E7 + I_LEXP;
constexpr int NQ = E8;
}
constexpr int CW_Q = 16384;
struct __attribute__((packed, aligned(4))) F3 { float x, y, z; };
typedef float f32x3u __attribute__((ext_vector_type(3), aligned(4)));
struct TrDesc { const float* W; int ldw, sc; bf16_t* WT; int K, drow, k0; };
__device__ __forceinline__ TrDesc tr_plain_desc(const float* W, int K, int N, bf16_t* WT, int it) { const int nnb = N / 32, kb = it / nnb, nb = it % nnb; return TrDesc{W, N, 32 * nb, WT, K, 32 * nb, 64 * kb}; }
__device__ __forceinline__ TrDesc tr_expert_desc(const Args& a, int L, int r) {
    const int e = r / cq::I_EXP; r -= e * cq::I_EXP; const int le = L * 16 + e;
    if (r < cq::I_GU) {
        const int kb = r / 48, nb = r % 48, n = 32 * nb, pn = n >> 8, bj = (n >> 7) & 1, i = n & 127;
        const float* src = (bj ? a.in[I_EU] : a.in[I_EG]) + (size_t)le * DM * EFF;
        return TrDesc{src, EFF, 128 * pn + i, (bf16_t*)(a.ws + WS_WGU) + (size_t)le * 1536 * DM, DM, n, 64 * kb}; }
    return tr_plain_desc(a.in[I_ED] + (size_t)le * EFF * DM, EFF, DM, (bf16_t*)(a.ws + WS_WDN) + (size_t)le * DM * EFF, r - cq::I_GU);
}
__device__ __forceinline__ TrDesc cvt_queue_desc(const Args& a, int qi) {
    using namespace cq; TrDesc d;
    if (qi < E0) d = tr_expert_desc(a, 0, qi);
    else if (qi < E1) { const int r = qi - E0, g = r / 128; d = tr_plain_desc(a.in[I_PW] + (size_t)g * 512 * 512, 512, 512, (bf16_t*)(a.ws + WS_WPL) + (size_t)g * 512 * 512, r % 128); }
    else if (qi < E2) d = tr_expert_desc(a, 1, qi - E1);
    else if (qi < E3) d = tr_plain_desc(a.in[I_GQW], DM, 3072, (bf16_t*)(a.ws + WS_WGQ), qi - E2);
    else if (qi < E4) d = tr_plain_desc(a.in[I_GOW], DM, DM, (bf16_t*)(a.ws + WS_WGO), qi - E3);
    else if (qi < E5) d = tr_expert_desc(a, 2, qi - E4);
    else if (qi < E6) {
        const int it = qi - E5, kb = it / 192, nb = it % 192, n = 32 * nb; int sc = n;
        if (n < 4096) { const int pn = n >> 8, wi = n & 255, bj = wi >> 7, wc = (wi >> 5) & 3; sc = pn * 256 + (wc >> 1) * 128 + (2 * (wc & 1) + bj) * 32; }
        d = TrDesc{a.in[I_DQW], 3 * DM, sc, (bf16_t*)(a.ws + WS_WDQ), DM, n, 64 * kb}; }
    else if (qi < E7) d = tr_plain_desc(a.in[I_DOW], DM, DM, (bf16_t*)(a.ws + WS_WDO), qi - E6);
    else d = tr_expert_desc(a, 3, qi - E7);
    return d;
}
__device__ __forceinline__ void transpose_pair(const TrDesc& d0, const TrDesc& d1, int lane) {
    const int kr = lane >> 3, n4 = (lane & 7) * 4;
    const float* s0 = d0.W + (size_t)(d0.k0 + 8 * kr) * d0.ldw + d0.sc + n4; const float* s1 = d1.W + (size_t)(d1.k0 + 8 * kr) * d1.ldw + d1.sc + n4;
    f32x4 v0[8], v1[8];
#pragma unroll
    for (int i = 0; i < 8; ++i) v0[i] = *(const f32x4*)(s0 + (size_t)i * d0.ldw);
#pragma unroll
    for (int i = 0; i < 8; ++i) v1[i] = *(const f32x4*)(s1 + (size_t)i * d1.ldw);
    bf16_t* t0 = d0.WT + (size_t)(d0.drow + n4) * d0.K + d0.k0 + 8 * kr; bf16_t* t1 = d1.WT + (size_t)(d1.drow + n4) * d1.K + d1.k0 + 8 * kr;
#pragma unroll
    for (int q = 0; q < 4; ++q) { u32x4 o; o.x = cvt_pk_bf16(v0[0][q], v0[1][q]); o.y = cvt_pk_bf16(v0[2][q], v0[3][q]); o.z = cvt_pk_bf16(v0[4][q], v0[5][q]); o.w = cvt_pk_bf16(v0[6][q], v0[7][q]);
        *(u32x4*)(t0 + (size_t)q * d0.K) = o; }
#pragma unroll
    for (int q = 0; q < 4; ++q) { u32x4 o; o.x = cvt_pk_bf16(v1[0][q], v1[1][q]); o.y = cvt_pk_bf16(v1[2][q], v1[3][q]); o.z = cvt_pk_bf16(v1[4][q], v1[5][q]); o.w = cvt_pk_bf16(v1[6][q], v1[7][q]);
        *(u32x4*)(t1 + (size_t)q * d1.K) = o; }
}
__device__ __forceinline__ void cvt_run(const Args& a, int it, int n, int lane) {
    int k = 0;
    for (; k + 1 < n && it + k + 1 < cq::NQ; k += 2) { const TrDesc d0 = cvt_queue_desc(a, it + k), d1 = cvt_queue_desc(a, it + k + 1); transpose_pair(d0, d1, lane); }
    for (; k < n && it + k < cq::NQ; ++k) { const TrDesc d = cvt_queue_desc(a, it + k); transpose_item(d.W, d.ldw, d.sc, d.WT, d.K, d.drow, d.k0, nullptr, lane); }
}
__device__ __forceinline__ void cvt_opportunistic(const Args& a, int n, LAS unsigned char* lds, int tid, int wave, int lane) {
    if (n <= 0) return;
    unsigned* q = (unsigned*)(a.ws + WS_CTL) + CW_Q; volatile LAS int* qs = (volatile LAS int*)(lds + MISC_OFF + 768);
    __syncthreads();
    if (tid == 0) qs[0] = (int)__hip_atomic_fetch_add(q, (unsigned)(8 * n), __ATOMIC_RELAXED, __HIP_MEMORY_SCOPE_AGENT);
    __syncthreads();
    const int it = __builtin_amdgcn_readfirstlane(qs[0]) + wave * n;
    cvt_run(a, it, n, lane);
}
__device__ __forceinline__ void cvt_catchup(const Args& a, int target, LAS unsigned char* lds, int tid, int wave, int lane) {
    unsigned* q = (unsigned*)(a.ws + WS_CTL) + CW_Q; volatile LAS int* qs = (volatile LAS int*)(lds + MISC_OFF + 768);
    for (;;) {
        __syncthreads();
        if (tid == 0) { int h = (int)__hip_atomic_load(q, __ATOMIC_RELAXED, __HIP_MEMORY_SCOPE_AGENT);
            if (h < target) h = (int)__hip_atomic_fetch_add(q, 64u, __ATOMIC_RELAXED, __HIP_MEMORY_SCOPE_AGENT); else h = 0x7fffffff;
            qs[0] = h; }
        __syncthreads();
        const int base = __builtin_amdgcn_readfirstlane(qs[0]);
        if (base == 0x7fffffff) break;
        const int it = base + wave * 8;
        cvt_run(a, it, 8, lane);
    }
}
__device__ __forceinline__ int idle_units(int nwg, int G, int c) { const int mx = (nwg + G - 1) / G, mine = c < nwg ? (nwg - c + G - 1) / G : 0; return mx - mine; }

__device__ __forceinline__ void ph_prologue(const Args& a, LAS unsigned char* lds, int G, int wave, int lane, int tid) {
    unsigned char* ws = a.ws;
    const int bx = blockIdx.x;
    for (int t = bx; t < 256; t += G) {
        const int L = t >> 6, col0 = (t & 63) * 192;
        LAS float* sl = (LAS float*)lds; LAS float* sx = sl + DM; LAS float* red = sx + DM;
        for (int k = tid; k < DM; k += 512) { const float c = a.in[I_C][k], cc = a.in[I_CCTX][k];
            sl[k] = c / (1.f + __expf(-c)); sx[k] = cc / (1.f + __expf(-cc)); }
        __syncthreads();
        const float* W = a.in[I_MODW] + (size_t)L * DM * NMOD + col0 + 3 * lane;
        float al0 = 0.f, al1 = 0.f, al2 = 0.f, ac0 = 0.f, ac1 = 0.f, ac2 = 0.f;
        const int kb = wave * 256;
#pragma unroll 16
        for (int k = 0; k < 256; ++k) { const f32x3u w = __builtin_nontemporal_load((const f32x3u*)(W + (size_t)(kb + k) * NMOD));     const float s1 = sl[kb + k], s2 = sx[kb + k];
            al0 += w.x * s1; al1 += w.y * s1; al2 += w.z * s1; ac0 += w.x * s2; ac1 += w.y * s2; ac2 += w.z * s2; }
        LAS float* rp = red + (wave * 64 + lane) * 6;
        rp[0] = al0; rp[1] = al1; rp[2] = al2; rp[3] = ac0; rp[4] = ac1; rp[5] = ac2;
        __syncthreads();
        if (tid < 384) { const int which = tid / 192, col = tid % 192; float s_ = 0.f;
#pragma unroll
          for (int w = 0; w < 8; ++w) s_ += red[(w * 64 + col / 3) * 6 + which * 3 + col % 3];
          float* modv = (float*)(ws + WS_MODV);
          modv[(size_t)(L * 2 + which) * NMOD + col0 + col] = s_ + a.in[I_MODB][L * NMOD + col0 + col]; }
        __syncthreads();
    }
    if (bx == 0) {
        float* rope = (float*)(ws + WS_ROPE);
        for (int idx = tid; idx < 6144; idx += 512) {
            const int isc = idx >= 4096, e = isc ? idx - 4096 : idx, pos = e >> 5, i = e & 31;
            const float inv = powf(10000.0f, -(float)(2 * i) / 64.0f), ang = (float)pos * inv;
            float* cs = rope + (isc ? 8192 : 0); const int half = isc ? 2048 : 4096;
            cs[e] = cosf(ang); cs[half + e] = sinf(ang);
        }
    } else if (bx >= 2 && bx < 6) {
        const int L = bx - 2; const float* w = a.in[I_REW] + (size_t)L * DM * 16; float* wt = (float*)(ws + WS_WET) + (size_t)L * 4 * DM * 4;
        for (int idx = tid; idx < DM * 16; idx += 512) { const int c = idx >> 4, e = idx & 15; wt[((size_t)(e >> 2) * DM + c) * 4 + (e & 3)] = w[idx]; }
    } else if (bx == 1) {
        if (wave == 0) {
            const float* lv = a.in[I_DL];
            float s1 = lv[lane] * lv[128 + lane] + lv[64 + lane] * lv[192 + lane];
            float s2 = lv[256 + lane] * lv[384 + lane] + lv[320 + lane] * lv[448 + lane];
            s1 = wave_sum(s1); s2 = wave_sum(s2);
            if (lane == 0) { float* sc = (float*)(ws + WS_SCAL); sc[0] = expf(s1) - expf(s2) + LAM_INIT3; sc[1] = 1.0f - LAM_INIT3; }
        }
        if (tid < 256) ((float*)(ws + WS_SCAL + 1024))[tid] = a.in[I_DS][tid];
    }
    LAS float* scr = (LAS float*)(lds + 32768 + wave * 8448);
    const int gw = bx * 8 + wave, NGW = G * 8;
    constexpr int I_CI = 32 * 192, I_CO = 32 * 64;
    for (int it = gw; it < I_CI + I_CO; it += NGW) {
        int r = it;
        if (r < I_CI) {
            const int kb = r / 192, nb = r % 192, n = 32 * nb; int sc;
            if (n < 2048) sc = n; else { const int q = (n - 2048) >> 8, bj = ((n - 2048) >> 7) & 1, i = n & 127; sc = 2048 + bj * 2048 + 128 * q + i; }
            transpose_item(a.in[I_CIW], 3 * DM, sc, (bf16_t*)(ws + WS_WCI), DM, n, 64 * kb, scr, lane); continue; }
        r -= I_CI;
        tr_plain(a.in[I_COW], DM, DM, (bf16_t*)(ws + WS_WCO), r, scr, lane);
    }
    (void)0;
}

template <int NR>
__device__ __forceinline__ void init_rows(const Args& a, int r0, int rstride, int which) {
    const int lane = lane_id_fresh(); const unsigned lo16 = (unsigned)lane * 16u, lo8 = (unsigned)lane * 8u;
    bf16_t* H = (bf16_t*)(a.ws + WS_H);
    const float* mv = (const float*)(a.ws + WS_MODV) + (size_t)which * NMOD;
    const float* src = which ? a.in[I_CTX] : a.in[I_X] - (size_t)NCTX * DM;
    f32x4 v[NR][8];
#pragma unroll
    for (int k = 0; k < NR; ++k)
#pragma unroll
        for (int j = 0; j < 8; ++j) v[k][j] = ULD4N(src, (size_t)(r0 + k * rstride) * (DM * 4) + j * 1024, lo16);
#pragma unroll
    for (int j = 0; j < 8; ++j) { const f32x4 sh = ULD4(mv, j * 1024, lo16), sc = ULD4(mv, DM * 4 + j * 1024, lo16) + 1.0f;
#pragma unroll
        for (int k = 0; k < NR; ++k) { const size_t rb = (size_t)(r0 + k * rstride) * (DM * 4) + j * 1024;
            const f32x4 h = v[k][j] * sc + sh;
            u32x2 w; w.x = cvt_pk_bf16(h[0], h[1]); w.y = cvt_pk_bf16(h[2], h[3]); *(u32x2*)((char*)H + (rb >> 1) + lo8) = w; } }
}
__device__ __forceinline__ void ph_init(const Args& a, int G, int bx, int wave) {
    const int gw = bx * 8 + wave, NGW = G * 8, gwT = wave * G + bx;
    int r = NCTX + gw;
    for (; r + 3 * NGW < MTOT; r += 4 * NGW) init_rows<4>(a, r, NGW, 0);
    for (; r < MTOT; r += NGW) init_rows<1>(a, r, NGW, 0);
    for (int rc = gwT; rc < NCTX; rc += NGW) init_rows<1>(a, rc, NGW, 1);
}

__device__ __forceinline__ void ph_conv(const Args& a, int gw, int NGW, int lane) {
    const bf16_t* GB = (const bf16_t*)(a.ws + WS_MIX); const bf16_t* PP = GB + (size_t)33 * MiB / 2; bf16_t* Y = (bf16_t*)(a.ws + WS_MIX + 66 * MiB);
    const float* cw = a.in[I_CW];
    for (int st = gw; st < MTOT / 4; st += NGW) {
        const int t0 = st * 4;
#pragma unroll 1
        for (int j = 0; j < 4; ++j) {
            const int c = 8 * lane + 512 * j;
            float w0[8], w1[8], w2[8];
#pragma unroll
            for (int i = 0; i < 8; i += 4) { const f32x4 x0 = *(const f32x4*)(cw + c + i), x1 = *(const f32x4*)(cw + DM + c + i), x2 = *(const f32x4*)(cw + 2 * DM + c + i);
                for (int q = 0; q < 4; ++q) { w0[i + q] = x0[q]; w1[i + q] = x1[q]; w2[i + q] = x2[q]; } }
            u32x4 prev = {0u, 0u, 0u, 0u}, cur, nxt;
            if (t0 != 0 && t0 != NCTX) prev = *(const u32x4*)(PP + (size_t)(t0 - 1) * DM + c);
            cur = *(const u32x4*)(PP + (size_t)t0 * DM + c);
#pragma unroll
            for (int i = 0; i < 4; ++i) { const int t = t0 + i;
                nxt = (u32x4){0u, 0u, 0u, 0u}; if (t + 1 != NCTX && t + 1 != MTOT) nxt = *(const u32x4*)(PP + (size_t)(t + 1) * DM + c);
                const u32x4 gb = __builtin_nontemporal_load((const u32x4*)(GB + (size_t)t * DM + c));
                float y[8];
#pragma unroll
                for (int q = 0; q < 4; ++q) {
                    y[2 * q] = bf_lo(gb[q]) * (w0[2 * q] * bf_lo(prev[q]) + w1[2 * q] * bf_lo(cur[q]) + w2[2 * q] * bf_lo(nxt[q]));
                    y[2 * q + 1] = bf_hi(gb[q]) * (w0[2 * q + 1] * bf_hi(prev[q]) + w1[2 * q + 1] * bf_hi(cur[q]) + w2[2 * q + 1] * bf_hi(nxt[q])); }
                u32x4 o; o.x = cvt_pk_bf16(y[0], y[1]); o.y = cvt_pk_bf16(y[2], y[3]); o.z = cvt_pk_bf16(y[4], y[5]); o.w = cvt_pk_bf16(y[6], y[7]);
                *(u32x4*)(Y + (size_t)t * DM + c) = o; prev = cur; cur = nxt; }
        }
    }
}

template <int GI>
__device__ __forceinline__ void pool_task(const Args& a, int t0, int jj) {
    constexpr int HW = 1 << GI, NRW = 8 + 2 * HW;
    const int lane = lane_id_fresh(); const unsigned lo16 = (unsigned)lane * 16u, lo8 = (unsigned)lane * 8u;
    const float* X = (const float*)(a.ws + WS_X); bf16_t* PO = (bf16_t*)(a.ws + WS_MIX);
    const int which = t0 < NCTX, slo = which ? 0 : NCTX, shi = which ? NCTX : MTOT;
    const float* mv = (const float*)(a.ws + WS_MODV) + (size_t)(2 + which) * NMOD + DM;
    const size_t cb = (size_t)(GI * 512 + 256 * jj) * 4;
    f32x4 xr[NRW];
#pragma unroll
    for (int i = 0; i < NRW; ++i) { const int r = t0 - HW + i; xr[i] = (f32x4){0.f, 0.f, 0.f, 0.f}; if (r >= slo && r < shi) xr[i] = ULD4(X, (size_t)r * (DM * 4) + cb, lo16); }
    const f32x4 sc = ULD4(mv, cb, lo16) + 1.0f;
    f32x4 s = {0.f, 0.f, 0.f, 0.f};
#pragma unroll
    for (int i = 0; i < 2 * HW; ++i) s += xr[i];
#pragma unroll
    for (int o = 0; o < 8; ++o) { const int t = t0 + o; const int lo = (t - HW) > slo ? (t - HW) : slo, hi = (t + HW) < shi ? (t + HW) : shi;
        const f32x4 p = (s * (1.0f / (float)(hi - lo)) - xr[o + HW]) * sc;
        u32x2 w; w.x = cvt_pk_bf16(p[0], p[1]); w.y = cvt_pk_bf16(p[2], p[3]);
        *(u32x2*)((char*)PO + ((size_t)GI * MTOT + t) * 1024 + jj * 512 + lo8) = w;
        if (o < 7) s += xr[o + 2 * HW] - xr[o]; }
}
__device__ __forceinline__ void ph_pool(const Args& a, int gw, int NGW, int  ) {
    int k = 0;
    for (int T = gw; T < MTOT; T += NGW, ++k) { const int strip = T >> 3, sub = ((T & 7) + k) & 7, g = sub >> 1, jj = sub & 1, t0 = strip * 8;
        if (g == 0) pool_task<0>(a, t0, jj); else if (g == 1) pool_task<1>(a, t0, jj); else if (g == 2) pool_task<2>(a, t0, jj); else pool_task<3>(a, t0, jj); }
}

template <bool NORM>
__device__ __forceinline__ void head_pass(bf16_t* p, const float* gain, int quarter, int row, const float* rope, bf16_t* po) {
    u32x4 raw[4], par[4];
#pragma unroll
    for (int k = 0; k < 4; ++k) raw[k] = *(const u32x4*)(p + 8 * k);
    float rstd = 1.0f;
    if (NORM) { float ss = 0.f;
#pragma unroll
        for (int k = 0; k < 4; ++k)
#pragma unroll
            for (int q = 0; q < 4; ++q) { const float lo = bf_lo(raw[k][q]), hi = bf_hi(raw[k][q]); ss += lo * lo + hi * hi; }
        ss += __shfl_xor(ss, 1); ss += __shfl_xor(ss, 2);
        rstd = 1.0f / sqrtf(ss * (1.0f / 128.0f) + RMS_EPS); }
#pragma unroll
    for (int k = 0; k < 4; ++k)
#pragma unroll
        for (int q = 0; q < 4; ++q) par[k][q] = (unsigned)__shfl_xor((int)raw[k][q], 1);
    const bool do_rope = row >= NCTX; const int t = row - NCTX;
    const int pos = (quarter < 2) ? (t >> 6) : (t & 63);
    const float* cs = rope + ((quarter < 2) ? 0 : 8192) + pos * 32; const float* sn = cs + ((quarter < 2) ? 4096 : 2048);
    const float sgn = (quarter & 1) ? 1.0f : -1.0f;
#pragma unroll
    for (int k = 0; k < 4; ++k) {
        float a_[8], b_[8];
#pragma unroll
        for (int q = 0; q < 4; ++q) { a_[2 * q] = bf_lo(raw[k][q]) * rstd; a_[2 * q + 1] = bf_hi(raw[k][q]) * rstd; b_[2 * q] = bf_lo(par[k][q]) * rstd; b_[2 * q + 1] = bf_hi(par[k][q]) * rstd; }
        if (NORM) {
#pragma unroll
            for (int i = 0; i < 8; i += 4) { const f32x4 go = *(const f32x4*)(gain + 32 * quarter + 8 * k + i), gp = *(const f32x4*)(gain + 32 * (quarter ^ 1) + 8 * k + i);
                for (int q = 0; q < 4; ++q) { a_[i + q] *= go[q]; b_[i + q] *= gp[q]; } } }
        float o_[8];
        if (do_rope) {
#pragma unroll
            for (int i = 0; i < 8; i += 4) { const f32x4 c4 = *(const f32x4*)(cs + 8 * k + i), s4 = *(const f32x4*)(sn + 8 * k + i);
                for (int q = 0; q < 4; ++q) o_[i + q] = a_[i + q] * c4[q] + sgn * b_[i + q] * s4[q]; }
        } else {
#pragma unroll
            for (int i = 0; i < 8; ++i) o_[i] = a_[i];
        }
        u32x4 o; o.x = cvt_pk_bf16(o_[0], o_[1]); o.y = cvt_pk_bf16(o_[2], o_[3]); o.z = cvt_pk_bf16(o_[4], o_[5]); o.w = cvt_pk_bf16(o_[6], o_[7]);
        *(u32x4*)(po + 8 * k) = o;
    }
}

#define LLD4(off, lo) (*(const LAS f32x4*)(lds + (off) + (lo)))
__device__ __forceinline__ void ln1_stage(const Args& a, int L, LAS unsigned char* lds, int tid) {
    const float* mv = (const float*)(a.ws + WS_MODV) + (size_t)(L * 2) * NMOD;
    const float* lg_ = a.in[I_LNG] + (size_t)(L * 2 + 0) * DM; const float* lb_ = a.in[I_LNB] + (size_t)(L * 2 + 0) * DM;
    const float* wg = a.in[I_RGW] + (size_t)L * DM * 4; const float* ps = a.in[I_PS];
    LAS f32x4* d = (LAS f32x4*)lds; const int t = tid;
    __syncthreads();
    d[t] = ((const f32x4*)lg_)[t]; d[512 + t] = ((const f32x4*)lb_)[t];
    const f32x4 psv = (L == 1) ? ((const f32x4*)ps)[t] : (f32x4){1.f, 1.f, 1.f, 1.f};
#pragma unroll
    for (int w = 0; w < 2; ++w) { const float* m = mv + (size_t)w * NMOD;
        d[1024 + w * 1536 + t] = ((const f32x4*)(m + 3 * DM))[t]; d[1536 + w * 1536 + t] = ((const f32x4*)(m + 4 * DM))[t] + 1.0f; d[2048 + w * 1536 + t] = ((const f32x4*)(m + 2 * DM))[t] * psv; }
#pragma unroll
    for (int q = 0; q < 4; ++q) d[4096 + q * 512 + t] = ((const f32x4*)wg)[q * 512 + t];
    __syncthreads();
}
struct Ln1Row { f32x4 v[8]; u32x2 dw[8]; };
__device__ __forceinline__ void ln1_load(const Args& a, int L, Ln1Row& R, int r, int which, unsigned lo16, unsigned lo8) {
    const float* X = (L == 0) ? (which ? a.in[I_CTX] : a.in[I_X] - (size_t)NCTX * DM) : (const float*)(a.ws + WS_X);
    const bf16_t* Dm = (const bf16_t*)(a.ws + WS_D);
#pragma unroll
    for (int j = 0; j < 8; ++j) { R.v[j] = ULD4N(X, (size_t)r * (DM * 4) + j * 1024, lo16); R.dw[j] = __builtin_nontemporal_load((const u32x2*)((const char*)Dm + (size_t)r * (DM * 2) + j * 512 + lo8)); }
}
__device__ __forceinline__ void ln1_compute(const Args& a, int L, Ln1Row& R, int r, int which, LAS unsigned char* lds, bool dup, int lane, unsigned lo16, unsigned lo8) {
    bf16_t* HS = (bf16_t*)(a.ws + WS_MOE); bf16_t* XB = (bf16_t*)(a.ws + (dup ? WS_DUMH : WS_H));
    const float* wet = (const float*)(a.ws + WS_WET) + (size_t)L * 4 * DM * 4;
    const float* bg = a.in[I_RGB] + L * 4; const float* be = a.in[I_REB] + L * 16;
    unsigned* cnt = (unsigned*)(a.ws + WS_CTL) + CW_CNT + (dup ? 4 : L) * 16 * 64;
    int* route = (int*)(a.ws + WS_ROUTE + (dup ? 512 * 1024 : 0));
    const unsigned lo64 = (unsigned)lane * 64u, pw = which ? 24576u : 0u;
    asm volatile("" ::: "memory");
#pragma unroll
    for (int j = 0; j < 8; ++j) { const f32x4 g2 = LLD4(32768 + pw + j * 1024, lo16);
        const f32x4 dv = {bf_lo(R.dw[j].x), bf_hi(R.dw[j].x), bf_lo(R.dw[j].y), bf_hi(R.dw[j].y)};
        R.v[j] = R.v[j] * ALPHA + g2 * dv; }
    float s1_[1], q1_[1]; s1_[0] = 0.f;
#pragma unroll
    for (int j = 0; j < 8; ++j) s1_[0] += (R.v[j][0] + R.v[j][1]) + (R.v[j][2] + R.v[j][3]);
    wave_sum_n(s1_, lane);
    const float mean = s1_[0] * (1.f / DM); q1_[0] = 0.f;
#pragma unroll
    for (int j = 0; j < 8; ++j) { const f32x4 d = R.v[j] - mean; q1_[0] += (d[0] * d[0] + d[1] * d[1]) + (d[2] * d[2] + d[3] * d[3]); }
    wave_sum_n(q1_, lane);
    const float rstd = 1.f / sqrtf(q1_[0] * (1.f / DM) + LN_EPS);
    float lg[4] = {0.f, 0.f, 0.f, 0.f};
#pragma unroll
    for (int j = 0; j < 8; ++j) {
        const f32x4 gm = LLD4(j * 1024, lo16), bt = LLD4(8192 + j * 1024, lo16), sh = LLD4(16384 + pw + j * 1024, lo16), sc = LLD4(24576 + pw + j * 1024, lo16);
        f32x4 w4[4];
#pragma unroll
        for (int i = 0; i < 4; ++i) w4[i] = LLD4(65536 + j * 4096 + i * 16, lo64);
        const f32x4 xn = (R.v[j] - mean) * rstd * gm + bt;
        { u32x2 xw_; xw_.x = cvt_pk_bf16(xn[0], xn[1]); xw_.y = cvt_pk_bf16(xn[2], xn[3]); __builtin_nontemporal_store(xw_, (u32x2*)((char*)XB + (size_t)r * (DM * 2) + j * 512 + lo8)); }
        const f32x4 hm = xn * sc + sh; R.v[j] = hm;
#pragma unroll
        for (int i = 0; i < 4; ++i) { lg[0] += hm[i] * w4[i][0]; lg[1] += hm[i] * w4[i][1]; lg[2] += hm[i] * w4[i][2]; lg[3] += hm[i] * w4[i][3]; }
        if (j & 1) asm volatile("" ::: "memory"); }
    wave_sum_n(lg, lane);
    int g_ = 0; float best = lg[0] + bg[0];
#pragma unroll
    for (int q = 1; q < 4; ++q) { const float x = lg[q] + bg[q]; if (x > best) { best = x; g_ = q; } }
    float den = 0.f;
#pragma unroll
    for (int q = 0; q < 4; ++q) den += __expf(lg[q] + bg[q] - best);
    const float pg = 1.0f / den; const int gs = __builtin_amdgcn_readfirstlane(g_);
    float le[4] = {0.f, 0.f, 0.f, 0.f};
#pragma unroll
    for (int j = 0; j < 8; ++j) {
#pragma unroll
        for (int i = 0; i < 4; ++i) { const f32x4 w = ULD4(wet, (size_t)gs * (DM * 16) + j * 4096 + i * 16, lo64); le[0] += R.v[j][i] * w[0]; le[1] += R.v[j][i] * w[1]; le[2] += R.v[j][i] * w[2]; le[3] += R.v[j][i] * w[3]; }
        if ((j & 3) == 3) asm volatile("" ::: "memory"); }
    wave_sum_n(le, lane);
    float l4[4];
#pragma unroll
    for (int q = 0; q < 4; ++q) l4[q] = le[q] + be[gs * 4 + q];
    int i0 = 0; float b0 = l4[0];
#pragma unroll
    for (int q = 1; q < 4; ++q) if (l4[q] > b0) { b0 = l4[q]; i0 = q; }
    int i1 = -1; float b1 = -3.0e38f;
#pragma unroll
    for (int q = 0; q < 4; ++q) if (q != i0 && l4[q] > b1) { b1 = l4[q]; i1 = q; }
    const float tv0 = 1.0f / (1.0f + __expf(b1 - b0));
    const int me0 = gs * 4 + i0, me1 = gs * 4 + i1;
    unsigned p0 = 0u, p1 = 0u;
    if (lane == 0) {
        p0 = __hip_atomic_fetch_add(cnt + me0 * 64, 1u, __ATOMIC_RELAXED, __HIP_MEMORY_SCOPE_AGENT);
        p1 = __hip_atomic_fetch_add(cnt + me1 * 64, 1u, __ATOMIC_RELAXED, __HIP_MEMORY_SCOPE_AGENT);
        int* rp = route + (size_t)r * 8;
        *(u32x4*)rp = (u32x4){(unsigned)me0, (unsigned)me1, p0, p1};
        *(u32x4*)(rp + 4) = (u32x4){__float_as_uint(pg * tv0), __float_as_uint(pg * (1.0f - tv0)), 0u, 0u};
    }
    if (!dup) {
        const size_t d0 = ((size_t)__builtin_amdgcn_readfirstlane(me0) * MTOT + (unsigned)__builtin_amdgcn_readfirstlane((int)p0)) * (DM * 2);
        const size_t d1 = ((size_t)__builtin_amdgcn_readfirstlane(me1) * MTOT + (unsigned)__builtin_amdgcn_readfirstlane((int)p1)) * (DM * 2);
#pragma unroll
        for (int j = 0; j < 8; ++j) { u32x2 w; w.x = cvt_pk_bf16(R.v[j][0], R.v[j][1]); w.y = cvt_pk_bf16(R.v[j][2], R.v[j][3]);
            *(u32x2*)((char*)HS + d0 + j * 512 + lo8) = w; *(u32x2*)((char*)HS + d1 + j * 512 + lo8) = w; }
    }
}
__device__ __forceinline__ void ph_ln1(const Args& a, int L, int rowlo, LAS unsigned char* lds, int tid, int G, int bx, int wave, bool dup = false) {
    const int gw = bx * 8 + wave, NGW = G * 8, gwT = wave * G + bx;
    ln1_stage(a, L, lds, tid);
    int rbase = NCTX + gw;
    for (; rbase + 3 * NGW < MTOT; rbase += 4 * NGW) {
        const int lane = lane_id_fresh(); const unsigned lo16 = (unsigned)lane * 16u, lo8 = (unsigned)lane * 8u;
        Ln1Row A, B;
        ln1_load(a, L, A, rbase, 0, lo16, lo8);
        ln1_load(a, L, B, rbase + NGW, 0, lo16, lo8);
        ln1_compute(a, L, A, rbase, 0, lds, dup, lane, lo16, lo8);
        ln1_load(a, L, A, rbase + 2 * NGW, 0, lo16, lo8);
        ln1_compute(a, L, B, rbase + NGW, 0, lds, dup, lane, lo16, lo8);
        ln1_load(a, L, B, rbase + 3 * NGW, 0, lo16, lo8);
        ln1_compute(a, L, A, rbase + 2 * NGW, 0, lds, dup, lane, lo16, lo8);
        ln1_compute(a, L, B, rbase + 3 * NGW, 0, lds, dup, lane, lo16, lo8);
    }
    for (; rbase < MTOT; rbase += NGW) { const int lane = lane_id_fresh(); const unsigned lo16 = (unsigned)lane * 16u, lo8 = (unsigned)lane * 8u;
        Ln1Row A; ln1_load(a, L, A, rbase, 0, lo16, lo8); ln1_compute(a, L, A, rbase, 0, lds, dup, lane, lo16, lo8); }
    if (rowlo == 0) for (int rc = gwT; rc < NCTX; rc += NGW) { const int lane = lane_id_fresh(); const unsigned lo16 = (unsigned)lane * 16u, lo8 = (unsigned)lane * 8u;
        Ln1Row A; ln1_load(a, L, A, rc, 1, lo16, lo8); ln1_compute(a, L, A, rc, 1, lds, dup, lane, lo16, lo8); }
}

__device__ __forceinline__ void moe_table(const Args& a, int L, LAS unsigned char* lds, int tid) {
    volatile LAS int* tb = (volatile LAS int*)(lds + MISC_OFF + 64); volatile LAS int* t2e = (volatile LAS int*)(lds + MISC_OFF + 192);
    unsigned* cnt = (unsigned*)(a.ws + WS_CTL) + CW_CNT + L * 16 * 64;
    __syncthreads();
    if (tid < 64) {
        int nt = 0;
        if (tid < 16) nt = ((int)__hip_atomic_load(cnt + tid * 64, __ATOMIC_RELAXED, __HIP_MEMORY_SCOPE_AGENT) + 255) >> 8;
        int inc = nt;
#pragma unroll
        for (int o = 1; o < 16; o <<= 1) { const int up = __shfl_up(inc, o); if ((tid & 63) >= o) inc += up; }
        if (tid < 16) { const int ex = inc - nt; tb[tid] = ex < MAXT ? ex : MAXT; if (tid == 15) tb[16] = inc < MAXT ? inc : MAXT; }
    }
    __syncthreads();
    if (tid < 96) { int e = 0;
#pragma unroll
        for (int k = 1; k < 16; ++k) e += (tb[k] <= tid) ? 1 : 0;
        t2e[tid] = e; }
    __syncthreads();
}

__device__ __forceinline__ void ph_gather(const Args& a, int rowlo, LAS unsigned char* lds, int gw, int NGW, int lane) {
    const LAS int* tb = (const LAS int*)(lds + MISC_OFF + 64);
    const bf16_t* H = (const bf16_t*)(a.ws + WS_H); bf16_t* HS = (bf16_t*)(a.ws + WS_MOE);
    const int* route = (const int*)(a.ws + WS_ROUTE);
    for (int r = rowlo + gw; r < MTOT; r += NGW) {
        const u32x4 rt = *(const u32x4*)(route + (size_t)r * 8);
        const size_t s0 = (size_t)tb[rt[0]] * 256 + rt[2], s1 = (size_t)tb[rt[1]] * 256 + rt[3];
        const u32x4* src = (const u32x4*)(H + (size_t)r * DM); u32x4* d0 = (u32x4*)(HS + s0 * DM); u32x4* d1 = (u32x4*)(HS + s1 * DM);
#pragma unroll
        for (int j = 0; j < 4; ++j) { const u32x4 x = src[lane + 64 * j]; d0[lane + 64 * j] = x; d1[lane + 64 * j] = x; }
    }
}

__device__ __forceinline__ void ln2_stage(const Args& a, int L, bool last, LAS unsigned char* lds, int tid) {
    const float* mv = (const float*)(a.ws + WS_MODV) + (size_t)(L * 2) * NMOD;
    const float* mn = (const float*)(a.ws + WS_MODV) + (size_t)((last ? L : L + 1) * 2) * NMOD;
    const float* lg_ = a.in[I_LNG] + (size_t)(L * 2 + 1) * DM; const float* lb_ = a.in[I_LNB] + (size_t)(L * 2 + 1) * DM;
    LAS f32x4* d = (LAS f32x4*)lds; const int t = tid;
    __syncthreads();
    d[t] = ((const f32x4*)lg_)[t]; d[512 + t] = ((const f32x4*)lb_)[t];
#pragma unroll
    for (int w = 0; w < 2; ++w) { const float* m = mv + (size_t)w * NMOD; const float* n = mn + (size_t)w * NMOD;
        d[1024 + w * 1536 + t] = ((const f32x4*)(m + 5 * DM))[t]; d[1536 + w * 1536 + t] = ((const f32x4*)n)[t]; d[2048 + w * 1536 + t] = ((const f32x4*)(n + DM))[t] + 1.0f; }
    __syncthreads();
}
struct Ln2Row { u32x2 xw[8], ya[8], yb[8]; };
__device__ __forceinline__ void ln2_load(const Args& a, Ln2Row& R, int r, int s0, int s1, unsigned lo16, unsigned lo8) {
    const bf16_t* XB = (const bf16_t*)(a.ws + WS_H); const bf16_t* Y2 = (const bf16_t*)(a.ws + WS_MOE + MOE_Y2);
#pragma unroll
    for (int j = 0; j < 8; ++j) { R.xw[j] = __builtin_nontemporal_load((const u32x2*)((const char*)XB + (size_t)r * (DM * 2) + j * 512 + lo8));
        R.ya[j] = __builtin_nontemporal_load((const u32x2*)((const char*)Y2 + (size_t)s0 * (DM * 2) + j * 512 + lo8)); R.yb[j] = __builtin_nontemporal_load((const u32x2*)((const char*)Y2 + (size_t)s1 * (DM * 2) + j * 512 + lo8)); }
}
__device__ __forceinline__ void ln2_compute(const Args& a, int L, Ln2Row& R, int r, float w0, float w1, int which, bool last, LAS unsigned char* lds, bool dup, int lane, unsigned lo16, unsigned lo8) {
    bf16_t* H = (bf16_t*)(a.ws + (dup ? WS_DUMH : WS_H)); float* XO = (float*)(a.ws + (dup ? WS_DUMX : WS_X)); float* OUT = dup ? (float*)(a.ws + WS_DUMX) : a.out;
    const unsigned pw = which ? 24576u : 0u;
    asm volatile("" ::: "memory");
    f32x4 v[8];
#pragma unroll
    for (int j = 0; j < 8; ++j) { const f32x4 g5 = LLD4(16384 + pw + j * 1024, lo16);
        const f32x4 y0 = {bf_lo(R.ya[j].x), bf_hi(R.ya[j].x), bf_lo(R.ya[j].y), bf_hi(R.ya[j].y)}, y1 = {bf_lo(R.yb[j].x), bf_hi(R.yb[j].x), bf_lo(R.yb[j].y), bf_hi(R.yb[j].y)};
        const f32x4 x1 = {bf_lo(R.xw[j].x), bf_hi(R.xw[j].x), bf_lo(R.xw[j].y), bf_hi(R.xw[j].y)};
        v[j] = x1 * ALPHA + g5 * (y0 * w0 + y1 * w1); }
    float s1_[1], q1_[1]; s1_[0] = 0.f;
#pragma unroll
    for (int j = 0; j < 8; ++j) s1_[0] += (v[j][0] + v[j][1]) + (v[j][2] + v[j][3]);
    wave_sum_n(s1_, lane);
    const float mean = s1_[0] * (1.f / DM); q1_[0] = 0.f;
#pragma unroll
    for (int j = 0; j < 8; ++j) { const f32x4 d = v[j] - mean; q1_[0] += (d[0] * d[0] + d[1] * d[1]) + (d[2] * d[2] + d[3] * d[3]); }
    wave_sum_n(q1_, lane);
    const float rstd = 1.f / sqrtf(q1_[0] * (1.f / DM) + LN_EPS);
#pragma unroll
    for (int j = 0; j < 8; ++j) {
        const f32x4 gm = LLD4(j * 1024, lo16), bt = LLD4(8192 + j * 1024, lo16), sh = LLD4(24576 + pw + j * 1024, lo16), sc = LLD4(32768 + pw + j * 1024, lo16);
        const f32x4 xn = (v[j] - mean) * rstd * gm + bt;
        if (last) { UST4(OUT, (size_t)(r - NCTX) * (DM * 4) + j * 1024, lo16, xn); }
        else { UST4N(XO, (size_t)r * (DM * 4) + j * 1024, lo16, xn);
               if (L != 0) { const f32x4 hm = xn * sc + sh;
                   u32x2 w; w.x = cvt_pk_bf16(hm[0], hm[1]); w.y = cvt_pk_bf16(hm[2], hm[3]); *(u32x2*)((char*)H + (size_t)r * (DM * 2) + j * 512 + lo8) = w; } }
        if (j & 1) asm volatile("" ::: "memory"); }
}
__device__ __forceinline__ void ph_ln2(const Args& a, int L, int rowlo, bool last, LAS unsigned char* lds, int tid, int G, int bx, int wave, bool dup = false) {
    const int gw = bx * 8 + wave, NGW = G * 8, gwT = wave * G + bx;
    ln2_stage(a, L, last, lds, tid);
    const LAS int* tb = (const LAS int*)(lds + MISC_OFF + 64);
    const int* route = (const int*)(a.ws + WS_ROUTE);
    int rbase = NCTX + gw;
    for (; rbase + 3 * NGW < MTOT; rbase += 4 * NGW) {
        const int lane = lane_id_fresh(); const unsigned lo16 = (unsigned)lane * 16u, lo8 = (unsigned)lane * 8u;
        int s0[4], s1[4]; float w0[4], w1[4];
#pragma unroll
        for (int i = 0; i < 4; ++i) { const int* rp = route + (size_t)(rbase + i * NGW) * 8; const u32x4 rt = *(const u32x4*)rp; const u32x4 rw = *(const u32x4*)(rp + 4);
            s0[i] = __builtin_amdgcn_readfirstlane(tb[rt[0]] * 256 + (int)rt[2]); s1[i] = __builtin_amdgcn_readfirstlane(tb[rt[1]] * 256 + (int)rt[3]);
            w0[i] = __uint_as_float(__builtin_amdgcn_readfirstlane(rw[0])); w1[i] = __uint_as_float(__builtin_amdgcn_readfirstlane(rw[1])); }
        Ln2Row A, B;
        ln2_load(a, A, rbase, s0[0], s1[0], lo16, lo8);
        ln2_load(a, B, rbase + NGW, s0[1], s1[1], lo16, lo8);
        ln2_compute(a, L, A, rbase, w0[0], w1[0], 0, last, lds, dup, lane, lo16, lo8);
        ln2_load(a, A, rbase + 2 * NGW, s0[2], s1[2], lo16, lo8);
        ln2_compute(a, L, B, rbase + NGW, w0[1], w1[1], 0, last, lds, dup, lane, lo16, lo8);
        ln2_load(a, B, rbase + 3 * NGW, s0[3], s1[3], lo16, lo8);
        ln2_compute(a, L, A, rbase + 2 * NGW, w0[2], w1[2], 0, last, lds, dup, lane, lo16, lo8);
        ln2_compute(a, L, B, rbase + 3 * NGW, w0[3], w1[3], 0, last, lds, dup, lane, lo16, lo8);
    }
    for (; rbase < MTOT; rbase += NGW) {
        const int lane = lane_id_fresh(); const unsigned lo16 = (unsigned)lane * 16u, lo8 = (unsigned)lane * 8u;
        const int* rp = route + (size_t)rbase * 8; const u32x4 rt = *(const u32x4*)rp; const u32x4 rw = *(const u32x4*)(rp + 4);
        const int s0 = __builtin_amdgcn_readfirstlane(tb[rt[0]] * 256 + (int)rt[2]), s1 = __builtin_amdgcn_readfirstlane(tb[rt[1]] * 256 + (int)rt[3]);
        Ln2Row A; ln2_load(a, A, rbase, s0, s1, lo16, lo8);
        ln2_compute(a, L, A, rbase, __uint_as_float(__builtin_amdgcn_readfirstlane(rw[0])), __uint_as_float(__builtin_amdgcn_readfirstlane(rw[1])), 0, last, lds, dup, lane, lo16, lo8);
    }
    if (rowlo == 0) for (int rc = gwT; rc < NCTX; rc += NGW) {
        const int lane = lane_id_fresh(); const unsigned lo16 = (unsigned)lane * 16u, lo8 = (unsigned)lane * 8u;
        const int* rp = route + (size_t)rc * 8; const u32x4 rt = *(const u32x4*)rp; const u32x4 rw = *(const u32x4*)(rp + 4);
        const int s0 = __builtin_amdgcn_readfirstlane(tb[rt[0]] * 256 + (int)rt[2]), s1 = __builtin_amdgcn_readfirstlane(tb[rt[1]] * 256 + (int)rt[3]);
        Ln2Row A; ln2_load(a, A, rc, s0, s1, lo16, lo8);
        ln2_compute(a, L, A, rc, __uint_as_float(__builtin_amdgcn_readfirstlane(rw[0])), __uint_as_float(__builtin_amdgcn_readfirstlane(rw[1])), 1, last, lds, dup, lane, lo16, lo8);
    }
}

constexpr int NPH = 36;
__global__ void __launch_bounds__(512, 2) mega(Args a) {
    extern __shared__ __attribute__((aligned(16))) unsigned char lds_raw[];
    LAS unsigned char* lds = (LAS unsigned char*)lds_raw;
    const int wave = __builtin_amdgcn_readfirstlane((int)threadIdx.x >> 6);
    const int G = gridDim.x, bx = blockIdx.x;
    const int gw = bx * 8 + wave, NGW = G * 8;
    unsigned char* ws = a.ws;
    unsigned* ctl = (unsigned*)(ws + WS_CTL);
#if MK_ONE_LAUNCH
#define PDUP (rp_ != 0)
#else
#define PDUP (a.probe_dup != 0)
#endif
#define FRESH() const int lane = lane_id_fresh(); const int tid = wave * 64 + lane; (void)tid; (void)lane
    { FRESH(); for (int u = tid; u < (LDS_BYTES - MISC_OFF) / 4; u += 512) ((LAS unsigned*)(lds + MISC_OFF))[u] = 0u; }
    __syncthreads();
    const int lo = a.ph_lo, hi = a.ph_hi;
    XcdBarrier bar; bar.bar = ctl + CW_BAR; bar.x = 0; bar.st = (volatile LAS unsigned*)(lds + MISC_OFF);
    if (hi - lo > 1) { FRESH(); bar = xcd_barrier_post(ctl + CW_BAR, (volatile LAS unsigned*)(lds + MISC_OFF), tid); }
#define IN(k) (lo <= (k) && (k) < hi)
#define SEAM(k) do { if (IN(k) && IN((k) + 1)) { FRESH(); xcd_barrier(bar, tid); } } while (0)

    float* X = (float*)(ws + WS_X); bf16_t* H = (bf16_t*)(ws + WS_H);
    const float* modv = (const float*)(ws + WS_MODV);
    unsigned char* mix = ws + WS_MIX; unsigned char* moe = ws + WS_MOE;

#define MOE_TAIL(L, p0, rowlo, last) do { \
    if (IN((p0))) for (int rp_ = 0; rp_ <= REPC((p0)); ++rp_) { FRESH(); cvt_catchup(a, (L) == 0 ? cq::E0 : (L) == 1 ? cq::E2 : (L) == 2 ? cq::E5 : cq::E8, lds, tid, wave, lane); ph_ln1(a, (L), (rowlo), lds, tid, G, bx, wave, PDUP); } SEAM((p0)); \
      \
    if (IN((p0) + 2)) for (int rp_ = 0; rp_ <= REPC((p0) + 2); ++rp_) { FRESH(); moe_table(a, (L), lds, tid); const int T = ((const LAS int*)(lds + MISC_OFF + 64))[16]; \
        pg8::Gemm g{(const bf16_t*)moe, (const bf16_t*)(ws + WS_WGU) + (size_t)(L) * 16 * 1536 * DM, DM, (size_t)1536 * DM}; \
        pg8::MoeOrder S; S.init(T, 6, G, bx); S.t2e = (const LAS int*)(lds + MISC_OFF + 192); S.tb = (const LAS int*)(lds + MISC_OFF + 64); S.sparse_a = true; pg8::EpiMoeA E{(bf16_t*)(moe + MOE_ACT)}; \
        pg8::gemm_phase<pg8::EpiMoeA, pg8::MoeOrder, true, true>(lds, g, S, E, tid); cvt_opportunistic(a, 20 * idle_units(T * 6, G, bx), lds, tid, wave, lane); } SEAM((p0) + 2); \
    if (IN((p0) + 3)) for (int rp_ = 0; rp_ <= REPC((p0) + 3); ++rp_) { FRESH(); moe_table(a, (L), lds, tid); const int T = ((const LAS int*)(lds + MISC_OFF + 64))[16]; \
        pg8::Gemm g{(const bf16_t*)(moe + MOE_ACT), (const bf16_t*)(ws + WS_WDN) + (size_t)(L) * 16 * DM * EFF, EFF, (size_t)DM * EFF}; \
        pg8::MoeOrder S; S.init(T, 8, G, bx); S.t2e = (const LAS int*)(lds + MISC_OFF + 192); S.tb = (const LAS int*)(lds + MISC_OFF + 64); S.sparse_a = false; pg8::EpiQKV E{(bf16_t*)(moe + MOE_Y2), DM, 1 << 20, nullptr, 1 << 20, nullptr, 0}; \
        pg8::gemm_phase<pg8::EpiQKV, pg8::MoeOrder, true, true>(lds, g, S, E, tid); cvt_opportunistic(a, 6 * idle_units(T * 8, G, bx), lds, tid, wave, lane); } SEAM((p0) + 3); \
    if (IN((p0) + 4)) for (int rp_ = 0; rp_ <= REPC((p0) + 4); ++rp_) { FRESH(); if ((L) == 1) cvt_catchup(a, cq::E3, lds, tid, wave, lane); if ((L) == 2) cvt_catchup(a, cq::E6, lds, tid, wave, lane); moe_table(a, (L), lds, tid); ph_ln2(a, (L), (rowlo), (last), lds, tid, G, bx, wave, PDUP); } \
    } while (0)

    if (IN(0)) for (int rp_ = 0; rp_ <= REPC(0); ++rp_) { FRESH(); ph_prologue(a, lds, G, wave, lane, tid); } SEAM(0);
    if (IN(1)) for (int rp_ = 0; rp_ <= REPC(1); ++rp_) { FRESH(); ph_init(a, G, bx, wave); } SEAM(1);
    if (IN(2)) for (int rp_ = 0; rp_ <= REPC(2); ++rp_) { FRESH(); pg8::Gemm g{H, (const bf16_t*)(ws + WS_WCI), DM, 0}; pg8::GridOrder S; S.init(NMT, 24, G, bx);
        pg8::EpiConv1 E{(bf16_t*)mix, (bf16_t*)(mix + 33 * MiB)};
        pg8::gemm_phase<pg8::EpiConv1, pg8::GridOrder, true, true>(lds, g, S, E, tid); cvt_opportunistic(a, 12 * idle_units(NMT * 24, G, bx), lds, tid, wave, lane); } SEAM(2);
    if (IN(3)) for (int rp_ = 0; rp_ <= REPC(3); ++rp_) { FRESH(); ph_conv(a, gw, NGW, lane); } SEAM(3);
    if (IN(4)) for (int rp_ = 0; rp_ <= REPC(4); ++rp_) { FRESH(); pg8::Gemm g{(const bf16_t*)(mix + 66 * MiB), (const bf16_t*)(ws + WS_WCO), DM, 0}; pg8::GridOrder S; S.init(NMT, 8, G, bx);
        pg8::EpiDelta E{(bf16_t*)(ws + WS_D), 0, 1 << 20, 0};
        pg8::gemm_phase<pg8::EpiDelta, pg8::GridOrder, true, true>(lds, g, S, E, tid); cvt_opportunistic(a, 12 * idle_units(NMT * 8, G, bx), lds, tid, wave, lane); } SEAM(4);
    MOE_TAIL(0, 5, 0, false); SEAM(9);
    if (IN(10)) for (int rp_ = 0; rp_ <= REPC(10); ++rp_) { FRESH(); cvt_catchup(a, cq::E1, lds, tid, wave, lane); ph_pool(a, gw, NGW, lane); } SEAM(10);
    if (IN(11)) for (int rp_ = 0; rp_ <= REPC(11); ++rp_) { FRESH(); pg8::Gemm g{(const bf16_t*)mix, (const bf16_t*)(ws + WS_WPL), 512, (size_t)512 * 512}; pg8::PoolOrder S; S.init(4 * NMT, 2, G, bx);
        pg8::EpiDelta E{(bf16_t*)(ws + WS_D), 0, NMT, 512};
        pg8::gemm_phase<pg8::EpiDelta, pg8::PoolOrder, true, true>(lds, g, S, E, tid); cvt_opportunistic(a, 3 * idle_units(4 * NMT * 2, G, bx), lds, tid, wave, lane); } SEAM(11);
    MOE_TAIL(1, 12, 0, false); SEAM(16);
    if (IN(17)) for (int rp_ = 0; rp_ <= REPC(17); ++rp_) { FRESH(); pg8::Gemm g{H, (const bf16_t*)(ws + WS_WGQ), DM, 0}; pg8::GridOrder S; S.init(NMT, 12, G, bx);
        pg8::EpiQKV E{(bf16_t*)mix, DM, 8, (bf16_t*)(mix + 33 * MiB), 10, (bf16_t*)(mix + 42 * MiB), KVHS};
        pg8::gemm_phase<pg8::EpiQKV, pg8::GridOrder, true, true>(lds, g, S, E, tid); cvt_opportunistic(a, 12 * idle_units(NMT * 12, G, bx), lds, tid, wave, lane); } SEAM(17);
    if (IN(18)) for (int rp_ = 0; rp_ <= REPC(18); ++rp_) { FRESH(); cvt_catchup(a, cq::E4, lds, tid, wave, lane);
        bf16_t* Q = (bf16_t*)mix; bf16_t* Kb = (bf16_t*)(mix + 33 * MiB); const float* rope = (const float*)(ws + WS_ROPE);
        const float* gq = a.in[I_GQN]; const float* gk = gq + 128;
        for (int task = gw; task < MTOT / 4; task += NGW) {
            const int r = task * 4 + (lane >> 4); bf16_t* pp = Kb + (size_t)((lane >> 2) & 3) * KVHS + (size_t)r * 128 + (lane & 3) * 32;
            head_pass<true>(pp, gk, lane & 3, r, rope, PDUP ? (bf16_t*)(ws + WS_DUMQ) + (size_t)r * 512 + (lane & 15) * 32 : pp); }
    } SEAM(18);
    if (IN(19)) for (int rp_ = 0; rp_ <= REPC(19); ++rp_) { FRESH();
        const bf16_t* Q = (const bf16_t*)mix; const bf16_t* Kb = (const bf16_t*)(mix + 33 * MiB); const bf16_t* Vb = (const bf16_t*)(mix + 42 * MiB); bf16_t* O = (bf16_t*)(mix + 51 * MiB);
        for (int i = 0;; ++i) { const int idx = i * G + bx; if (idx >= 528) break;
            int h, kvh, row0, seq;
            if (idx < 512) { const int ii = idx >> 8, c = idx & 255, x = c & 7, wl = c >> 3, j = (x >> 2) * 64 + wl * 2 + ii; kvh = x & 3; h = kvh * 4 + (j >> 5); row0 = NCTX + (j & 31) * 256; seq = MTOT; }
            else { h = idx - 512; kvh = h >> 2; row0 = 0; seq = NCTX; }
            att::attn_unit<DM, 128, 128, DM>(Q + (size_t)row0 * DM + h * 128, Kb + (size_t)kvh * KVHS, Vb + (size_t)kvh * KVHS, O + (size_t)row0 * DM + h * 128, seq, (char*)lds_raw, wave, a.in[I_GQN], (const float*)(ws + WS_ROPE), row0 - NCTX);
        }
    } SEAM(19);
    if (IN(20)) for (int rp_ = 0; rp_ <= REPC(20); ++rp_) { FRESH(); pg8::Gemm g{(const bf16_t*)(mix + 51 * MiB), (const bf16_t*)(ws + WS_WGO), DM, 0}; pg8::GridOrder S; S.init(NMT, 8, G, bx);
        pg8::EpiDelta E{(bf16_t*)(ws + WS_D), 0, 1 << 20, 0};
        pg8::gemm_phase<pg8::EpiDelta, pg8::GridOrder, true, true>(lds, g, S, E, tid); cvt_opportunistic(a, 12 * idle_units(NMT * 8, G, bx), lds, tid, wave, lane); } SEAM(20);
    MOE_TAIL(2, 21, 0, false); SEAM(25);
    if (IN(26)) for (int rp_ = 0; rp_ <= REPC(26); ++rp_) { FRESH(); pg8::Gemm g{H, (const bf16_t*)(ws + WS_WDQ), DM, 0}; pg8::GridOrder S; S.init(NMT, 24, G, bx);
        pg8::EpiQKVRope E{(bf16_t*)mix, (bf16_t*)(mix + 33 * MiB), (bf16_t*)(mix + 66 * MiB), KVHS, (const float*)(ws + WS_ROPE)};
        pg8::gemm_phase<pg8::EpiQKVRope, pg8::GridOrder, true, true>(lds, g, S, E, tid); cvt_opportunistic(a, 12 * idle_units(NMT * 24, G, bx), lds, tid, wave, lane); } SEAM(26);
    if (IN(28)) for (int rp_ = 0; rp_ <= REPC(28); ++rp_) { FRESH();
        const bf16_t* Q = (const bf16_t*)mix; const bf16_t* Kb = (const bf16_t*)(mix + 33 * MiB); const bf16_t* Vb = (const bf16_t*)(mix + 66 * MiB);
#pragma unroll 1
        for (int i = 0;; ++i) { const int u = bx + (i >> 1) * G; if (u >= 256) break;
            { const int m = i & 1, h = u & 7, qb = u >> 3;
                auto epi = [&](f32x16 (&o)[8], float (&rli)[16], const int wid, const int le) __attribute__((always_inline)) {
                    int i2 = i; asm volatile("" : "+s"(i2)); const int u2 = bx + (i2 >> 1) * G, m2 = i2 & 1;
                    const int r32e = le & 31, hie = le >> 5;
                    char* st = (char*)a.ws + WS_MIX + 99 * MiB + (size_t)u2 * 131072 + (unsigned)(wid * 16384) + (unsigned)le * 16u;
                    if (m2 == 0) {
#pragma unroll
                        for (int r = 0; r < 16; ++r) { const float s_ = rli[r]; u32x4 w; w.x = cvt_pk_bf16(o[0][r] * s_, o[1][r] * s_); w.y = cvt_pk_bf16(o[2][r] * s_, o[3][r] * s_); w.z = cvt_pk_bf16(o[4][r] * s_, o[5][r] * s_); w.w = cvt_pk_bf16(o[6][r] * s_, o[7][r] * s_);
                            *(u32x4*)(st + r * 1024) = w; }
                    } else {
                        const float lam = __uint_as_float(__hip_atomic_load((unsigned*)(a.ws + WS_SCAL), __ATOMIC_RELAXED, __HIP_MEMORY_SCOPE_AGENT));
                        const float oml = __uint_as_float(__hip_atomic_load((unsigned*)(a.ws + WS_SCAL) + 1, __ATOMIC_RELAXED, __HIP_MEMORY_SCOPE_AGENT));
                        const float* sub = (const float*)(a.ws + WS_SCAL + 1024); char* A2b = (char*)a.ws + WS_MIX + 163 * MiB + ((size_t)((u2 >> 3) * 256) * DM + (u2 & 7) * 256) * 2;
                        float gl[8];
#pragma unroll
                        for (int d0 = 0; d0 < 8; ++d0) gl[d0] = sub[d0 * 32 + r32e];
#pragma unroll
                        for (int r = 0; r < 16; ++r) { if ((r & 3) == 0) asm volatile("" ::: "memory");
                            const unsigned offA = (unsigned)((wid * 32 + att::crow(r, hie)) * DM + r32e) * 2u;
                            const u32x4 w = *(const u32x4*)(st + r * 1024);
                            float d[8]; float ss = 0.f; const float s_ = rli[r] * lam;
                            d[0] = bf_lo(w.x) - o[0][r] * s_; d[1] = bf_hi(w.x) - o[1][r] * s_; d[2] = bf_lo(w.y) - o[2][r] * s_; d[3] = bf_hi(w.y) - o[3][r] * s_;
                            d[4] = bf_lo(w.z) - o[4][r] * s_; d[5] = bf_hi(w.z) - o[5][r] * s_; d[6] = bf_lo(w.w) - o[6][r] * s_; d[7] = bf_hi(w.w) - o[7][r] * s_;
#pragma unroll
                            for (int d0 = 0; d0 < 8; ++d0) ss += d[d0] * d[d0];
#pragma unroll
                            for (int mk = 1; mk < 32; mk <<= 1) ss += __int_as_float(__builtin_amdgcn_ds_bpermute((le ^ mk) << 2, __float_as_int(ss)));
                            const float rs = oml / sqrtf(ss * (1.0f / 256.0f) + RMS_EPS);
#pragma unroll
                            for (int d0 = 0; d0 < 8; ++d0) { const float v = d[d0] * rs * gl[d0]; *(bf16_t*)(A2b + offA + d0 * 64) = (bf16_t)(cvt_pk_bf16(v, v) & 0xffffu); } }
                    }
                };
                att::attn_unit2<DM, 128, 128>(Q + (size_t)(NCTX + qb * 256) * DM + (h * 2 + m) * 128, Kb + (size_t)(h * 2 + m) * KVHS, Vb + (size_t)(h * 2) * KVHS, Vb + (size_t)(h * 2 + 1) * KVHS, MTOT, (char*)lds_raw, wave, epi);
            }
        }
    } SEAM(28);
    if (IN(30)) for (int rp_ = 0; rp_ <= REPC(30); ++rp_) { FRESH(); cvt_catchup(a, cq::E7, lds, tid, wave, lane); pg8::Gemm g{(const bf16_t*)(mix + 163 * MiB), (const bf16_t*)(ws + WS_WDO), DM, 0}; pg8::GridOrder S; S.init(NLAT / 256, 8, G, bx);
        pg8::EpiDelta E{(bf16_t*)(ws + WS_D), NCTX, 1 << 20, 0};
        pg8::gemm_phase<pg8::EpiDelta, pg8::GridOrder, true, true>(lds, g, S, E, tid); } SEAM(30);
    MOE_TAIL(3, 31, NCTX, true);
#undef IN
#undef FRESH
#undef SEAM
#undef MOE_TAIL
}

extern "C" void kernel_launch(void* const* d_in, const int* in_sizes, int n_in, void* d_out, int out_size, void* d_ws, size_t ws_size, hipStream_t stream) {
    static int grid = 0;
    if (grid == 0) {
        if (n_in != 27 || out_size != NLAT * DM || ws_size < WS_END) { fprintf(stderr, "kernel_launch: unexpected shapes (n_in %d out %d ws %zu)\n", n_in, out_size, ws_size); grid = -1; return; }
        int dev = 0, cus = 0, per_cu = 0;
        if (hipGetDevice(&dev) != hipSuccess || hipDeviceGetAttribute(&cus, hipDeviceAttributeMultiprocessorCount, dev) != hipSuccess) { grid = -1; return; }
        if (hipFuncSetAttribute((const void*)mega, hipFuncAttributeMaxDynamicSharedMemorySize, LDS_BYTES) != hipSuccess) { fprintf(stderr, "kernel_launch: hipFuncSetAttribute failed\n"); grid = -1; return; }
        if (hipOccupancyMaxActiveBlocksPerMultiprocessor(&per_cu, (const void*)mega, 512, LDS_BYTES) != hipSuccess || per_cu < 1) fprintf(stderr, "kernel_launch: occupancy query says %d\n", per_cu);
        (void)hipGetLastError();
        grid = cus;
    }
    if (grid < 0) return;
    (void)hipMemsetAsync((char*)d_ws + WS_CTL, 0, CTL_ZERO_BYTES, stream);
    Args a{};
    for (int i = 0; i < 27; ++i) a.in[i] = (const float*)d_in[i];
    a.out = (float*)d_out; a.ws = (unsigned char*)d_ws;
#if MK_ONE_LAUNCH
    a.ph_lo = 0; a.ph_hi = NPH;
    hipLaunchKernelGGL(mega, dim3(grid), dim3(512), LDS_BYTES, stream, a);
#else
    for (int p = 0; p < NPH; ++p) { a.ph_lo = p; a.ph_hi = p + 1; const int reps = 1 + (int)((PROBE_REP_MASK >> p) & 1ull);
        for (int r = 0; r < reps; ++r) { a.probe_dup = r; hipLaunchKernelGGL(mega, dim3(grid), dim3(512), LDS_BYTES, stream, a); } }
#endif
}
```

```cpp
#include <hip/hip_runtime.h>
#include <hip/hip_bf16.h>
#include <cstdio>
#include <cstdint>

#ifndef MK_ONE_LAUNCH
#define MK_ONE_LAUNCH 1
#endif
#ifndef PROBE_REP_MASK
#define PROBE_REP_MASK 0ull
#endif
#if MK_ONE_LAUNCH
#define REPC(k) ((int)((PROBE_REP_MASK >> (k)) & 1ull))
#else
#define REPC(k) 0
#endif

#define LAS __attribute__((address_space(3)))
#define GAS __attribute__((address_space(1)))
typedef unsigned short bf16_t;
typedef short bf16x8 __attribute__((ext_vector_type(8)));
typedef short s16x4 __attribute__((ext_vector_type(4)));
typedef float f32x4 __attribute__((ext_vector_type(4)));
typedef float f32x16 __attribute__((ext_vector_type(16)));
typedef unsigned u32x4 __attribute__((ext_vector_type(4)));
typedef unsigned u32x2 __attribute__((ext_vector_type(2)));

constexpr int DM = 2048, NLAT = 8192, NCTX = 256, MTOT = NLAT + NCTX, NMT = MTOT / 256;
constexpr int NMOD = 6 * DM;
constexpr int EFF = 768, NEXP = 16;
constexpr float ALPHA = 1.6817928305074290f;
constexpr float LN_EPS = 1e-6f, RMS_EPS = 1e-6f;
constexpr float LAM_INIT3 = 0.55605820415f;
constexpr int MAXT = 82;
constexpr size_t KVHS = (size_t)MTOT * 128;

constexpr size_t MiB = 1ull << 20;
constexpr size_t WS_CTL = 0, CTL_ZERO_BYTES = 1 * MiB;
constexpr size_t WS_MODV = 1 * MiB;
constexpr size_t WS_ROPE = 1 * MiB + 512 * 1024;
constexpr size_t WS_SCAL = WS_ROPE + 64 * 1024;
constexpr size_t WS_ROUTE = 2 * MiB;
constexpr size_t WS_WET = 3 * MiB;
constexpr size_t WS_WCI = 4 * MiB, WS_WCO = 28 * MiB, WS_WPL = 36 * MiB, WS_WGQ = 38 * MiB, WS_WGO = 50 * MiB, WS_WDQ = 58 * MiB, WS_WDO = 82 * MiB;
constexpr size_t WS_WGU = 90 * MiB, WS_WDN = 474 * MiB;
constexpr size_t WS_X = 666 * MiB, WS_H = 732 * MiB;
constexpr size_t WS_MIX = 765 * MiB;
constexpr size_t WS_MOE = 965 * MiB;
constexpr size_t MOE_ACT = 528 * MiB, MOE_Y2 = 559 * MiB;
constexpr size_t WS_D = 1606 * MiB;
constexpr size_t WS_END = 1639 * MiB;
constexpr size_t WS_DUMX = 1640 * MiB, WS_DUMH = 1707 * MiB, WS_DUMQ = 1741 * MiB;
constexpr int CW_BAR = 4096;
constexpr int CW_CNT = 8192;

__device__ __forceinline__ unsigned cvt_pk_bf16(float lo, float hi) { unsigned r; asm volatile("v_cvt_pk_bf16_f32 %0, %1, %2" : "=v"(r) : "v"(lo), "v"(hi)); return r; }
__device__ __forceinline__ float bf_lo(unsigned w) { return __uint_as_float(w << 16); }
__device__ __forceinline__ float bf_hi(unsigned w) { return __uint_as_float(w & 0xffff0000u); }
__device__ __forceinline__ float wave_sum(float v) {
#pragma unroll
    for (int o = 1; o < 64; o <<= 1) v += __shfl_xor(v, o);
    return v;
}
template <int N> __device__ __forceinline__ void wave_sum_n(float (&x)[N], const int lane) {
#pragma unroll
    for (int o = 1; o < 64; o <<= 1) { const int idx = (lane ^ o) << 2;
#pragma unroll
        for (int i = 0; i < N; ++i) x[i] += __builtin_bit_cast(float, __builtin_amdgcn_ds_bpermute(idx, __builtin_bit_cast(int, x[i])));
    }
}
__device__ __forceinline__ int lane_id_fresh() { int l; asm volatile("v_mbcnt_lo_u32_b32 %0, -1, 0\n\tv_mbcnt_hi_u32_b32 %0, -1, %0" : "=v"(l)); return l; }
#define ULD4(base, cb, lo) (*(const f32x4*)((const char*)(base) + (size_t)(cb) + (lo)))
#define UST4(base, cb, lo, val) (*(f32x4*)((char*)(base) + (size_t)(cb) + (lo)) = (val))
#define ULD4N(base, cb, lo) __builtin_nontemporal_load((const f32x4*)((const char*)(base) + (size_t)(cb) + (lo)))
#define UST4N(base, cb, lo, val) __builtin_nontemporal_store((val), (f32x4*)((char*)(base) + (size_t)(cb) + (lo)))
#define LDS_WAIT() asm volatile("s_waitcnt lgkmcnt(0)" ::: "memory")
#define VM_WAIT() asm volatile("s_waitcnt vmcnt(0)" ::: "memory")

namespace pg8 {
constexpr int BM = 256, BK = 64, HALF = 128, HTB = HALF * BK * 2, STAGE_BYTES = 8 * HTB, NXCD = 8, WGM = 8;
__host__ __device__ __forceinline__ int lds_byte(int r, int c) { const int st = (r >> 4) * 2 + (c >> 5), rr = r & 15, cc = c & 31, ob = rr * 64 + cc * 2; return st * 1024 + (ob ^ (((ob >> 9) & 1) << 5)); }
__host__ __device__ __forceinline__ void stage_rc(int b, int& R, int& C) { const int st = b / 1024, sb = b % 1024, swz = sb ^ (((sb >> 9) & 1) << 5); R = (st >> 1) * 16 + swz / 64; C = (st & 1) * 32 + (swz % 64) / 2; }
__host__ __device__ __forceinline__ int perm32(int rho) { const int n = rho >> 4, i = rho & 15; return 8 * (i >> 2) + 4 * n + (i & 3); }

struct Unit { int pm, pn, bsel, pa; };
struct Gemm { const bf16_t* A; const bf16_t* Bt; int K; size_t bstride; };

struct GridOrder {
    int nM, nN, nwg, G, c;
    __device__ void init(int nM_, int nN_, int G_, int c_) { nM = nM_; nN = nN_; nwg = nM * nN; G = G_; c = c_; }
    __device__ bool base_next(int i, Unit& u) const {
        const long L = (long)i * G + c; if (L >= nwg) return false;
        int wgid = (int)L; { const int q = nwg / NXCD, r = nwg % NXCD, xcd = wgid % NXCD, off = wgid / NXCD; wgid = (xcd < r ? xcd * (q + 1) : r * (q + 1) + (xcd - r) * q) + off; }
        const int nig = WGM * nN, gid = wgid / nig, fm = gid * WGM, gsz = (nM - fm) < WGM ? (nM - fm) : WGM;
        u.pm = fm + ((wgid % nig) % gsz); u.pn = (wgid % nig) / gsz; u.bsel = 0; u.pa = u.pm; return true;
    }
    __device__ bool next(int i, Unit& u) const { return base_next(i, u); }
};
struct PoolOrder : GridOrder {
    __device__ bool next(int i, Unit& u) const { if (!base_next(i, u)) return false; u.bsel = u.pm / NMT; return true; }
};
struct MoeOrder : GridOrder {
    const LAS int* t2e; const LAS int* tb; bool sparse_a;
    __device__ bool next(int i, Unit& u) const { if (!base_next(i, u)) return false; const int e = __builtin_amdgcn_readfirstlane(t2e[u.pm]); u.bsel = e;
        if (sparse_a) u.pa = e * NMT + (u.pm - __builtin_amdgcn_readfirstlane(tb[e])); return true; }
};

__device__ __forceinline__ u32x4 pack8(const f32x4 v0, const f32x4 v1) { u32x4 w; w.x = cvt_pk_bf16(v0[0], v0[1]); w.y = cvt_pk_bf16(v0[2], v0[3]); w.z = cvt_pk_bf16(v1[0], v1[1]); w.w = cvt_pk_bf16(v1[2], v1[3]); return w; }

struct EpiQKV {
    static constexpr bool PERM = true;
    bf16_t* P0; int ld0; int pn1; bf16_t* P1; int pn2; bf16_t* P2; size_t hs;
    __device__ __forceinline__ void operator()(const f32x4 (&acc)[2][2][4][2], const Unit& u, int wr, int wc, int fr, int fq) const {
        const int row0 = u.pm * BM + wr * 64 + fr;
        if (u.pn < pn1) {
            bf16_t* base = P0 + u.pn * BM + wc * 32 + 8 * fq;
#pragma unroll
            for (int ai = 0; ai < 2; ++ai)
#pragma unroll
                for (int m = 0; m < 4; ++m) { bf16_t* rowp = base + (size_t)(row0 + ai * HALF + m * 16) * ld0;
#pragma unroll
                    for (int bj = 0; bj < 2; ++bj) *(u32x4*)(rowp + bj * HALF) = pack8(acc[ai][bj][m][0], acc[ai][bj][m][1]); }
        } else {
            const bool s1 = u.pn < pn2; bf16_t* base = (s1 ? P1 : P2) + (size_t)(2 * (u.pn - (s1 ? pn1 : pn2))) * hs + wc * 32 + 8 * fq;
#pragma unroll
            for (int ai = 0; ai < 2; ++ai)
#pragma unroll
                for (int m = 0; m < 4; ++m) { bf16_t* rowp = base + (size_t)(row0 + ai * HALF + m * 16) * 128;
#pragma unroll
                    for (int bj = 0; bj < 2; ++bj) *(u32x4*)(rowp + bj * hs) = pack8(acc[ai][bj][m][0], acc[ai][bj][m][1]); }
        }
    }
};
struct EpiQKVRope {
    static constexpr bool PERM = true;
    bf16_t* Q; bf16_t* Kb; bf16_t* Vb; size_t hs; const float* rope;
    __device__ __forceinline__ void operator()(const f32x4 (&acc)[2][2][4][2], const Unit& u, int wr, int wc, int fr, int fq) const {
        const int row0 = u.pm * BM + wr * 64 + fr;
        if (u.pn >= 16) {
            bf16_t* base = Vb + (size_t)(2 * (u.pn - 16)) * hs + wc * 32 + 8 * fq;
#pragma unroll
            for (int ai = 0; ai < 2; ++ai)
#pragma unroll
                for (int m = 0; m < 4; ++m) { bf16_t* rowp = base + (size_t)(row0 + ai * HALF + m * 16) * 128;
#pragma unroll
                    for (int bj = 0; bj < 2; ++bj) *(u32x4*)(rowp + bj * hs) = pack8(acc[ai][bj][m][0], acc[ai][bj][m][1]); }
        } else {
            const bool isk = u.pn >= 8; const int head = (u.pn - (isk ? 8 : 0)) * 2 + (wc >> 1), qp = wc & 1;
            const bool dorope = u.pm != 0;
            const float* tab = rope + (qp ? 8192 : 0) + 8 * fq; const int sno = qp ? 2048 : 4096;
#pragma unroll
            for (int ai = 0; ai < 2; ++ai)
#pragma unroll
                for (int m = 0; m < 4; ++m) { const int row = row0 + ai * HALF + m * 16;
                    f32x4 a0 = acc[ai][0][m][0], a1 = acc[ai][0][m][1], b0 = acc[ai][1][m][0], b1 = acc[ai][1][m][1];
                    if (dorope) { const int t = row - NCTX, pos = qp ? (t & 63) : (t >> 6); const float* cs = tab + pos * 32;
                        const f32x4 c0 = *(const f32x4*)cs, c1 = *(const f32x4*)(cs + 4), s0 = *(const f32x4*)(cs + sno), s1 = *(const f32x4*)(cs + sno + 4);
                        const f32x4 na0 = a0 * c0 - b0 * s0, na1 = a1 * c1 - b1 * s1, nb0 = b0 * c0 + a0 * s0, nb1 = b1 * c1 + a1 * s1;
                        a0 = na0; a1 = na1; b0 = nb0; b1 = nb1; }
                    bf16_t* dst = isk ? Kb + (size_t)head * hs + (size_t)row * 128 : Q + (size_t)row * DM + head * 128;
                    *(u32x4*)(dst + (2 * qp) * 32 + 8 * fq) = pack8(a0, a1); *(u32x4*)(dst + (2 * qp + 1) * 32 + 8 * fq) = pack8(b0, b1); }
        }
    }
};
struct EpiConv1 {
    static constexpr bool PERM = true;
    bf16_t* GB; bf16_t* PP;
    __device__ __forceinline__ void operator()(const f32x4 (&acc)[2][2][4][2], const Unit& u, int wr, int wc, int fr, int fq) const {
        const int row0 = u.pm * BM + wr * 64 + fr;
        if (u.pn < 8) {
            const int col0 = u.pn * BM + wc * 32 + 8 * fq;
#pragma unroll
            for (int ai = 0; ai < 2; ++ai)
#pragma unroll
                for (int m = 0; m < 4; ++m) { bf16_t* rowp = GB + (size_t)(row0 + ai * HALF + m * 16) * DM + col0;
#pragma unroll
                    for (int bj = 0; bj < 2; ++bj) *(u32x4*)(rowp + bj * HALF) = pack8(acc[ai][bj][m][0], acc[ai][bj][m][1]); }
        } else {
            const int col0 = (u.pn - 8) * HALF + wc * 32 + 8 * fq;
#pragma unroll
            for (int ai = 0; ai < 2; ++ai)
#pragma unroll
                for (int m = 0; m < 4; ++m) { bf16_t* rowp = PP + (size_t)(row0 + ai * HALF + m * 16) * DM + col0;
                    *(u32x4*)rowp = pack8(acc[ai][0][m][0] * acc[ai][1][m][0], acc[ai][0][m][1] * acc[ai][1][m][1]); }
        }
    }
};
struct EpiMoeA {
    static constexpr bool PERM = true;
    bf16_t* ACT;
    __device__ __forceinline__ f32x4 act(const f32x4 g, const f32x4 u) const { f32x4 r;
#pragma unroll
        for (int j = 0; j < 4; ++j) r[j] = g[j] * __builtin_amdgcn_rcpf(1.0f + __expf(-g[j])) * u[j];
        return r; }
    __device__ __forceinline__ void operator()(const f32x4 (&acc)[2][2][4][2], const Unit& u, int wr, int wc, int fr, int fq) const {
        const int row0 = u.pm * BM + wr * 64 + fr, col0 = u.pn * HALF + wc * 32 + 8 * fq;
#pragma unroll
        for (int ai = 0; ai < 2; ++ai)
#pragma unroll
            for (int m = 0; m < 4; ++m) { bf16_t* rowp = ACT + (size_t)(row0 + ai * HALF + m * 16) * EFF + col0;
                *(u32x4*)rowp = pack8(act(acc[ai][0][m][0], acc[ai][1][m][0]), act(acc[ai][0][m][1], acc[ai][1][m][1])); }
    }
};
struct EpiDelta {
    static constexpr bool PERM = true;
    bf16_t* D; int rowbase; int mper; int gcols;
    __device__ __forceinline__ void operator()(const f32x4 (&acc)[2][2][4][2], const Unit& u, int wr, int wc, int fr, int fq) const {
        const int g = u.pm / mper, rt = u.pm - g * mper;
        const int row0 = rowbase + rt * BM + wr * 64 + fr, col0 = g * gcols + u.pn * BM + wc * 32 + 8 * fq;
#pragma unroll
        for (int ai = 0; ai < 2; ++ai)
#pragma unroll
            for (int m = 0; m < 4; ++m) { bf16_t* rowp = D + (size_t)(row0 + ai * HALF + m * 16) * DM + col0;
#pragma unroll
                for (int bj = 0; bj < 2; ++bj) *(u32x4*)(rowp + bj * HALF) = pack8(acc[ai][bj][m][0], acc[ai][bj][m][1]); }
    }
};
struct EpiResid {
    static constexpr bool PERM = false;
    float* X; const float* gate_lat; const float* gate_ctx; const float* colscale; int rowbase; int mper; int gcols;
    __device__ __forceinline__ void operator()(const f32x4 (&acc)[2][2][4][2], const Unit& u, int wr, int wc, int fr, int fq) const {
        const int g = u.pm / mper, rt = u.pm - g * mper;
        const int rowt = rowbase + rt * BM, row0 = rowt + wr * 64 + fr, col0 = g * gcols + u.pn * BM + wc * 32 + 4 * fq;
        const float* gate = (rowt < NCTX) ? gate_ctx : gate_lat;
        f32x4 gv[2][2];
#pragma unroll
        for (int bj = 0; bj < 2; ++bj)
#pragma unroll
            for (int n = 0; n < 2; ++n) { gv[bj][n] = *(const f32x4*)(gate + col0 + bj * HALF + n * 16); if (colscale) gv[bj][n] = gv[bj][n] * *(const f32x4*)(colscale + col0 + bj * HALF + n * 16); }
#pragma unroll
        for (int ai = 0; ai < 2; ++ai)
#pragma unroll
            for (int m = 0; m < 4; ++m) { float* rowp = X + (size_t)(row0 + ai * HALF + m * 16) * DM + col0;
#pragma unroll
                for (int bj = 0; bj < 2; ++bj)
#pragma unroll
                    for (int n = 0; n < 2; ++n) { float* p = rowp + bj * HALF + n * 16; const f32x4 xv = *(const f32x4*)p; *(f32x4*)p = xv * ALPHA + gv[bj][n] * acc[ai][bj][m][n]; }
                asm volatile("" ::: "memory"); }
    }
};

template <class Epi, class Sched, bool ALIGN_EPI, bool SP2>
__device__ __forceinline__ void gemm_phase(LAS unsigned char* lds, const Gemm g, const Sched& S, const Epi& E, const int tid) {
    const int wid = __builtin_amdgcn_readfirstlane(tid >> 6), lane = tid & 63, wr = wid >> 2, wc = wid & 3, fr = lane & 15, fq = lane >> 4;
    const int K = g.K, nt = K / BK;
    unsigned voffA[2], voffB[2];
#pragma unroll
    for (int i = 0; i < 2; ++i) { int R, C; stage_rc(tid * 16 + i * 8192, R, C); const int Rb = Epi::PERM ? ((R & ~31) + perm32(R & 31)) : R;
        voffA[i] = (unsigned)(R * K + C) * 2u; voffB[i] = (unsigned)(Rb * K + C) * 2u; }
    const size_t kstep = (size_t)(BK * 2);
    const size_t hstep = (size_t)HALF * K * 2;
    const size_t tstep = 2 * hstep;
    const size_t bstep = g.bstride * 2;
    const unsigned ldsw = (unsigned)wid * 1024u;
    const int aoff = lds_byte(wr * 64 + fr, fq * 8), boff = lds_byte(wc * 32 + fr, fq * 8);
#define PG8_SA(b, h) (((b) * 2 + (h)) * HTB)
#define PG8_SB(b, h) ((4 + (b) * 2 + (h)) * HTB)
#define PG8_STAGE(bufoff, gbase, voff) do { _Pragma("unroll") for (int _i = 0; _i < 2; ++_i) \
        __builtin_amdgcn_global_load_lds((const unsigned*)((const char*)(gbase) + (voff)[_i]), (LAS unsigned*)(lds + (bufoff) + ldsw + _i * 8192), 16, 0, 0); } while (0)
#define PG8_LDA(dst, b, h) do { _Pragma("unroll") for (int m = 0; m < 4; ++m) _Pragma("unroll") for (int k = 0; k < 2; ++k) dst[m][k] = *(const LAS bf16x8*)(lds + PG8_SA(b, h) + aoff + m * 2048 + k * 1024); } while (0)
#define PG8_LDB(dst, b, h) do { _Pragma("unroll") for (int n = 0; n < 2; ++n) _Pragma("unroll") for (int k = 0; k < 2; ++k) dst[n][k] = *(const LAS bf16x8*)(lds + PG8_SB(b, h) + boff + n * 2048 + k * 1024); } while (0)
#define PG8_MMA(ai, bj, At, Bt) do { __builtin_amdgcn_s_setprio(1); _Pragma("unroll") for (int m = 0; m < 4; ++m) _Pragma("unroll") for (int n = 0; n < 2; ++n) _Pragma("unroll") for (int k = 0; k < 2; ++k) \
        acc[ai][bj][m][n] = __builtin_amdgcn_mfma_f32_16x16x32_bf16(Bt[n][k], At[m][k], acc[ai][bj][m][n], 0, 0, 0); __builtin_amdgcn_s_setprio(0); } while (0)
#define PG8_WAIT_V(n) asm volatile("s_waitcnt vmcnt(" #n ")" ::: "memory")
#define PG8_WAIT_L(n) asm volatile("s_waitcnt lgkmcnt(" #n ")" ::: "memory")
#define PG8_BAR __builtin_amdgcn_s_barrier()
#define PG8_SCHED __builtin_amdgcn_sched_barrier(0)
    Unit cur, nxt; int ui = 0;
    if (!S.next(0, cur)) return;
    f32x4 acc[2][2][4][2];
#pragma unroll
    for (int a = 0; a < 2; ++a)
#pragma unroll
        for (int b = 0; b < 2; ++b)
#pragma unroll
            for (int m = 0; m < 4; ++m)
#pragma unroll
                for (int n = 0; n < 2; ++n) acc[a][b][m][n] = (f32x4){0.f, 0.f, 0.f, 0.f};
    bf16x8 At[4][2], B0[2][2], B1[2][2];
    const char* cA = (const char*)g.A + (size_t)cur.pa * tstep; const char* cB = (const char*)g.Bt + (size_t)cur.bsel * bstep + (size_t)cur.pn * tstep;
    if constexpr (SP2) {
        PG8_STAGE(PG8_SB(0, 0), cB, voffB); PG8_STAGE(PG8_SB(0, 1), cB + hstep, voffB); PG8_STAGE(PG8_SA(0, 0), cA, voffA); PG8_STAGE(PG8_SA(0, 1), cA + hstep, voffA);
        if (wr == 1) PG8_BAR;
        PG8_WAIT_V(2); PG8_BAR;
        PG8_STAGE(PG8_SB(1, 0), cB + kstep, voffB); PG8_STAGE(PG8_SA(1, 0), cA + kstep, voffA); PG8_STAGE(PG8_SB(1, 1), cB + hstep + kstep, voffB);
        PG8_WAIT_V(6); PG8_BAR;
    } else {
        PG8_STAGE(PG8_SB(0, 0), cB, voffB); PG8_STAGE(PG8_SA(0, 0), cA, voffA); PG8_STAGE(PG8_SB(0, 1), cB + hstep, voffB); PG8_STAGE(PG8_SA(0, 1), cA + hstep, voffA);
        if (wr == 1) PG8_BAR;
        PG8_WAIT_V(4); PG8_BAR;
        PG8_STAGE(PG8_SB(1, 0), cB + kstep, voffB); PG8_STAGE(PG8_SA(1, 0), cA + kstep, voffA); PG8_STAGE(PG8_SB(1, 1), cB + hstep + kstep, voffB);
        PG8_WAIT_V(6); PG8_BAR;
    }
    for (;;) {
        const bool has_next = S.next(ui + 1, nxt);
        const char* nA = has_next ? (const char*)g.A + (size_t)nxt.pa * tstep : cA; const char* nB = has_next ? (const char*)g.Bt + (size_t)nxt.bsel * bstep + (size_t)nxt.pn * tstep : cB;
        for (int t = 0; t < nt; t += 2) {
            const bool last = (t == nt - 2);
            const char* a1 = cA + (size_t)(t + 1) * kstep;
            const char* a2 = last ? nA : cA + (size_t)(t + 2) * kstep; const char* b2 = last ? nB : cB + (size_t)(t + 2) * kstep;
            const char* a3 = a2 + kstep; const char* b3 = b2 + kstep;
            if constexpr (SP2) {
            PG8_LDB(B0, 0, 0); PG8_LDB(B1, 0, 1); PG8_SCHED; PG8_LDA(At, 0, 0); PG8_STAGE(PG8_SA(1, 1), a1 + hstep, voffA);
            PG8_WAIT_V(8); PG8_WAIT_L(0); PG8_BAR; PG8_MMA(0, 0, At, B0); PG8_MMA(0, 1, At, B1); PG8_BAR; PG8_SCHED;
            PG8_LDA(At, 0, 1); PG8_STAGE(PG8_SB(0, 0), b2, voffB); PG8_STAGE(PG8_SB(0, 1), b2 + hstep, voffB); PG8_STAGE(PG8_SA(0, 0), a2, voffA);
            PG8_WAIT_V(8); PG8_WAIT_L(0); PG8_BAR; PG8_MMA(1, 0, At, B0); PG8_MMA(1, 1, At, B1); PG8_BAR; PG8_SCHED;
            PG8_LDB(B0, 1, 0); PG8_LDB(B1, 1, 1); PG8_SCHED; PG8_LDA(At, 1, 0); PG8_STAGE(PG8_SA(0, 1), a2 + hstep, voffA);
            PG8_WAIT_V(8); PG8_WAIT_L(0); PG8_BAR; PG8_MMA(0, 0, At, B0); PG8_MMA(0, 1, At, B1); PG8_BAR; PG8_SCHED;
            PG8_LDA(At, 1, 1); PG8_STAGE(PG8_SB(1, 0), b3, voffB); PG8_STAGE(PG8_SB(1, 1), b3 + hstep, voffB); PG8_STAGE(PG8_SA(1, 0), a3, voffA);
            PG8_WAIT_V(8); PG8_WAIT_L(0); PG8_BAR; PG8_MMA(1, 0, At, B0); PG8_MMA(1, 1, At, B1); PG8_BAR; PG8_SCHED;
            } else {
            PG8_LDB(B0, 0, 0); PG8_SCHED; PG8_LDA(At, 0, 0); PG8_STAGE(PG8_SA(1, 1), a1 + hstep, voffA);
            PG8_WAIT_L(8); PG8_BAR; PG8_WAIT_L(0); PG8_MMA(0, 0, At, B0); PG8_BAR; PG8_SCHED;
            PG8_LDB(B1, 0, 1); PG8_STAGE(PG8_SB(0, 0), b2, voffB);
            PG8_BAR; PG8_WAIT_L(0); PG8_MMA(0, 1, At, B1); PG8_BAR;
            PG8_LDA(At, 0, 1); PG8_STAGE(PG8_SA(0, 0), a2, voffA);
            PG8_BAR; PG8_WAIT_L(0); PG8_MMA(1, 0, At, B0); PG8_BAR; PG8_SCHED;
            PG8_STAGE(PG8_SB(0, 1), b2 + hstep, voffB);
            PG8_WAIT_V(6); PG8_BAR; PG8_MMA(1, 1, At, B1); PG8_BAR;
            PG8_LDB(B0, 1, 0); PG8_SCHED; PG8_LDA(At, 1, 0); PG8_STAGE(PG8_SA(0, 1), a2 + hstep, voffA);
            PG8_WAIT_L(8); PG8_BAR; PG8_WAIT_L(0); PG8_MMA(0, 0, At, B0); PG8_BAR; PG8_SCHED;
            PG8_LDB(B1, 1, 1); PG8_STAGE(PG8_SB(1, 0), b3, voffB);
            PG8_BAR; PG8_WAIT_L(0); PG8_MMA(0, 1, At, B1); PG8_BAR;
            PG8_LDA(At, 1, 1); PG8_STAGE(PG8_SA(1, 0), a3, voffA);
            PG8_BAR; PG8_WAIT_L(0); PG8_MMA(1, 0, At, B0); PG8_BAR; PG8_SCHED;
            PG8_STAGE(PG8_SB(1, 1), b3 + hstep, voffB);
            PG8_WAIT_V(6); PG8_BAR; PG8_MMA(1, 1, At, B1); PG8_BAR;
            }
        }
        if constexpr (ALIGN_EPI) { if (wr == 0) PG8_BAR; }
        E(acc, cur, wr, wc, fr, fq);
        if (!has_next) break;
#pragma unroll
        for (int a = 0; a < 2; ++a)
#pragma unroll
            for (int b = 0; b < 2; ++b)
#pragma unroll
                for (int m = 0; m < 4; ++m)
#pragma unroll
                    for (int n = 0; n < 2; ++n) acc[a][b][m][n] = (f32x4){0.f, 0.f, 0.f, 0.f};
        cur = nxt; cA = nA; cB = nB; ++ui;
        if constexpr (ALIGN_EPI) { if (wr == 1) PG8_BAR; }
    }
    PG8_WAIT_V(0);
    if constexpr (!ALIGN_EPI) { if (wr == 0) PG8_BAR; }
    PG8_BAR;
#undef PG8_SA
#undef PG8_SB
#undef PG8_STAGE
#undef PG8_LDA
#undef PG8_LDB
#undef PG8_MMA
#undef PG8_WAIT_V
#undef PG8_WAIT_L
#undef PG8_BAR
#undef PG8_SCHED
}
}

namespace att {
constexpr int D = 128, NW = 8, QBLK = 32, KVBLK = 64;
constexpr float SCALE = 0.088388347648318440f;
constexpr float THR = 8.f;
constexpr size_t SHM_V = KVBLK * D * 2, SHM_K = KVBLK * D * 2, SHM_ATTN = 2 * SHM_V + 2 * SHM_K + NW * 64 * 4;
#define KSWZ(row, colB) ((row) * 256 + ((colB) ^ (((row) & 7) << 4)))
#define SBAR() __builtin_amdgcn_sched_barrier(0)
__device__ __forceinline__ int crow(int r, int hi) { return (r & 3) + 8 * (r >> 2) + 4 * hi; }
__device__ __forceinline__ unsigned cvtpk(float lo, float hi) { unsigned r; asm volatile("v_cvt_pk_bf16_f32 %0, %1, %2" : "=v"(r) : "v"(lo), "v"(hi)); return r; }
__device__ __forceinline__ void partialSM(f32x16& p0, f32x16& p1, float& m_reg, float& mn, float& alpha) {
  constexpr float C = SCALE * 1.4426950408889634f;
  float pmax = p0[0]; for (int r = 1; r < 16; ++r) pmax = fmaxf(pmax, p0[r]); for (int r = 0; r < 16; ++r) pmax = fmaxf(pmax, p1[r]);
  { auto rr = __builtin_amdgcn_permlane32_swap(__float_as_uint(pmax), __float_as_uint(pmax), false, false);
    pmax = fmaxf(__uint_as_float(rr[0]), __uint_as_float(rr[1])); }
  if (__builtin_expect(__all(pmax - m_reg <= THR / SCALE), 1)) { mn = m_reg; alpha = 1.f; }
  else { mn = fmaxf(m_reg, pmax); alpha = __builtin_amdgcn_exp2f((m_reg - mn) * C); m_reg = mn; }
  float mnC = -mn * C;
  for (int r = 0; r < 16; ++r) p0[r] = fmaf(p0[r], C, mnC); for (int r = 0; r < 16; ++r) p1[r] = fmaf(p1[r], C, mnC);
  for (int r = 0; r < 16; ++r) p0[r] = __builtin_amdgcn_exp2f(p0[r]);
}
__device__ __forceinline__ void finishSM(f32x16& p0, f32x16& p1, float alpha, float& l_reg, bf16x8& pa0, bf16x8& pa1, bf16x8& pa2, bf16x8& pa3) {
  for (int r = 0; r < 16; ++r) p1[r] = __builtin_amdgcn_exp2f(p1[r]);
  float ps = 0; for (int r = 0; r < 16; ++r) ps += p0[r]; for (int r = 0; r < 16; ++r) ps += p1[r];
  { auto rr = __builtin_amdgcn_permlane32_swap(__float_as_uint(ps), __float_as_uint(ps), false, false);
    ps = __uint_as_float(rr[0]) + __uint_as_float(rr[1]); }
  l_reg = l_reg * alpha + ps;
#define PK4(P, BASE, OUT) do { unsigned a0 = cvtpk(P[BASE + 0], P[BASE + 1]), a1 = cvtpk(P[BASE + 2], P[BASE + 3]);   \
    unsigned b0 = cvtpk(P[BASE + 4], P[BASE + 5]), b1 = cvtpk(P[BASE + 6], P[BASE + 7]);                              \
    auto r0 = __builtin_amdgcn_permlane32_swap(a0, b0, false, false); auto r1 = __builtin_amdgcn_permlane32_swap(a1, b1, false, false); \
    u32x4 w = {r0[0], r1[0], r0[1], r1[1]}; OUT = *reinterpret_cast<bf16x8*>(&w); } while (0)
  PK4(p0, 0, pa0); PK4(p0, 8, pa1); PK4(p1, 0, pa2); PK4(p1, 8, pa3);
#undef PK4
}
__device__ __forceinline__ void qkt(f32x16& p0, f32x16& p1, const bf16_t* Ks, const bf16x8* qr, int r32, int hi) {
  p0 = f32x16{}; p1 = f32x16{};
  for (int d0 = 0; d0 < 8; ++d0) { int cb = (d0 * 16 + hi * 8) * 2;
    bf16x8 b0 = *reinterpret_cast<const bf16x8*>((const char*)Ks + KSWZ(r32, cb));
    bf16x8 b1 = *reinterpret_cast<const bf16x8*>((const char*)Ks + KSWZ(32 + r32, cb));
    p0 = __builtin_amdgcn_mfma_f32_32x32x16_bf16(b0, qr[d0], p0, 0, 0, 0);
    p1 = __builtin_amdgcn_mfma_f32_32x32x16_bf16(b1, qr[d0], p1, 0, 0, 0); }
}
__device__ __forceinline__ int v_st(int k, int c) { const int kk = (k & ~0xC) | ((k & 4) << 1) | ((k & 8) >> 1); return ((kk >> 3) * 4 + (c >> 5)) * 512 + ((kk & 7) * 32 + (c & 31)) * 2; }
__device__ __forceinline__ int v_rd_base(int lane) { return ((lane & 3) << 3) | (((lane >> 2) & 3) << 6) | (((lane >> 4) & 1) << 5) | (((lane >> 5) & 1) << 8); }
constexpr int v_rd_off(int d0, int ks, int half) { return d0 * 512 + ks * 4096 + half * 2048; }
template <int OFF> __device__ __forceinline__ s16x4 tr_read(int vb) {
  s16x4 r; asm volatile("ds_read_b64_tr_b16 %0, %1 offset:%2" : "=&v"(r) : "v"(vb), "i"(OFF) : "memory"); return r;
}
template <int D0> __device__ __forceinline__ void pv_one(f32x16& od, int vb, bf16x8 pa0, bf16x8 pa1, bf16x8 pa2, bf16x8 pa3) {
  const s16x4 l0 = tr_read<v_rd_off(D0, 0, 0)>(vb), h0 = tr_read<v_rd_off(D0, 0, 1)>(vb), l1 = tr_read<v_rd_off(D0, 1, 0)>(vb), h1 = tr_read<v_rd_off(D0, 1, 1)>(vb);
  const s16x4 l2 = tr_read<v_rd_off(D0, 2, 0)>(vb), h2 = tr_read<v_rd_off(D0, 2, 1)>(vb), l3 = tr_read<v_rd_off(D0, 3, 0)>(vb), h3 = tr_read<v_rd_off(D0, 3, 1)>(vb);
  asm volatile("s_waitcnt lgkmcnt(0)" ::: "memory"); SBAR();
#define PK(L, H) (bf16x8){L[0], L[1], L[2], L[3], H[0], H[1], H[2], H[3]}
  od = __builtin_amdgcn_mfma_f32_32x32x16_bf16(pa0, PK(l0, h0), od, 0, 0, 0);
  od = __builtin_amdgcn_mfma_f32_32x32x16_bf16(pa1, PK(l1, h1), od, 0, 0, 0);
  od = __builtin_amdgcn_mfma_f32_32x32x16_bf16(pa2, PK(l2, h2), od, 0, 0, 0);
  od = __builtin_amdgcn_mfma_f32_32x32x16_bf16(pa3, PK(l3, h3), od, 0, 0, 0);
#undef PK
}
__device__ __forceinline__ void pv_d0(f32x16* o, int vb, bf16x8 pa0, bf16x8 pa1, bf16x8 pa2, bf16x8 pa3) {
  pv_one<0>(o[0], vb, pa0, pa1, pa2, pa3); pv_one<1>(o[1], vb, pa0, pa1, pa2, pa3); pv_one<2>(o[2], vb, pa0, pa1, pa2, pa3); pv_one<3>(o[3], vb, pa0, pa1, pa2, pa3);
}
template <int LDQ, int LDK, int LDV, int LDO>
__device__ __forceinline__ void attn_unit(const bf16_t* __restrict__ Qb, const bf16_t* __restrict__ Kh, const bf16_t* __restrict__ Vh, bf16_t* __restrict__ Ob, int seq, char* lds, const int wid,
                                          const float* qgain = nullptr, const float* rope = nullptr, int qpos0 = -1) {
  const int lane = lane_id_fresh(), tid = wid * 64 + lane, r32 = lane & 31, hi = lane >> 5;
  bf16_t* V_lds = (bf16_t*)lds; bf16_t* K_lds = (bf16_t*)(lds + 2 * SHM_V);
  float* ws = (float*)(lds + 2 * SHM_V + 2 * SHM_K) + wid * 64; float* li_l = ws; float* al_l = ws + 32;
  float m_reg = -1e30f, l_reg = 0; f32x16 o[4] = {}; bf16x8 qr[8];
  { const unsigned offQ = (unsigned)((wid * QBLK + r32) * LDQ + hi * 8) * 2u;
#pragma unroll
  for (int d0 = 0; d0 < 8; ++d0) qr[d0] = *reinterpret_cast<const bf16x8*>((const char*)Qb + offQ + d0 * 32); }
  if (qgain) {
    float x[8][8]; float ss = 0.f;
#pragma unroll
    for (int d0 = 0; d0 < 8; ++d0) { const u32x4 w = *reinterpret_cast<const u32x4*>(&qr[d0]);
#pragma unroll
      for (int q = 0; q < 4; ++q) { x[d0][2 * q] = bf_lo(w[q]); x[d0][2 * q + 1] = bf_hi(w[q]); ss += x[d0][2 * q] * x[d0][2 * q] + x[d0][2 * q + 1] * x[d0][2 * q + 1]; } }
    { auto rr = __builtin_amdgcn_permlane32_swap(__float_as_uint(ss), __float_as_uint(ss), false, false); ss = __uint_as_float(rr[0]) + __uint_as_float(rr[1]); }
    const float rstd = 1.0f / sqrtf(ss * (1.0f / 128.0f) + RMS_EPS);
#pragma unroll
    for (int d0 = 0; d0 < 8; ++d0) { const f32x4 g0 = *(const f32x4*)(qgain + d0 * 16 + hi * 8), g1 = *(const f32x4*)(qgain + d0 * 16 + hi * 8 + 4);
#pragma unroll
      for (int j = 0; j < 4; ++j) { x[d0][j] *= rstd * g0[j]; x[d0][4 + j] *= rstd * g1[j]; } }
    if (qpos0 >= 0) { const int t = qpos0 + wid * QBLK + r32;
#pragma unroll
      for (int pr = 0; pr < 4; ++pr) { const int da = (pr >> 1) * 4 + (pr & 1), db = da + 2;
        const int pos = (pr < 2) ? (t >> 6) : (t & 63); const float* cs = rope + ((pr < 2) ? 0 : 8192) + pos * 32 + (pr & 1) * 16 + hi * 8; const float* sn = cs + ((pr < 2) ? 4096 : 2048);
        const f32x4 c0 = *(const f32x4*)cs, c1 = *(const f32x4*)(cs + 4), s0 = *(const f32x4*)sn, s1 = *(const f32x4*)(sn + 4);
#pragma unroll
        for (int j = 0; j < 8; ++j) { const float c = j < 4 ? c0[j & 3] : c1[j & 3], sv = j < 4 ? s0[j & 3] : s1[j & 3]; const float xa = x[da][j], xb = x[db][j];
          x[da][j] = xa * c - xb * sv; x[db][j] = xb * c + xa * sv; } } }
#pragma unroll
    for (int d0 = 0; d0 < 8; ++d0) { u32x4 w; w.x = cvtpk(x[d0][0], x[d0][1]); w.y = cvtpk(x[d0][2], x[d0][3]); w.z = cvtpk(x[d0][4], x[d0][5]); w.w = cvtpk(x[d0][6], x[d0][7]); qr[d0] = *reinterpret_cast<bf16x8*>(&w); }
  }
  const int sr = tid >> 4, sc = (tid & 15) * 8, vst0 = v_st(sr, sc), vst1 = v_st(32 + sr, sc);
  const int vb0 = (int)(uintptr_t)V_lds + v_rd_base(lane);
  struct { bf16x8 vs0, vs1, ks0, ks1; } sr_[2];
  const int offV = (sr * LDV + sc) * 2, offK = (sr * LDK + sc) * 2;
  const __amdgpu_buffer_rsrc_t rV = __builtin_amdgcn_make_buffer_rsrc((void*)Vh, 0, 0x7ffffff0, 0x00020000);
  const __amdgpu_buffer_rsrc_t rK = __builtin_amdgcn_make_buffer_rsrc((void*)Kh, 0, 0x7ffffff0, 0x00020000);
#define SLOAD(i, k0) do { const int sv_ = (k0) * (LDV * 2), sk_ = (k0) * (LDK * 2); \
    { u32x4 t_ = __builtin_amdgcn_raw_buffer_load_b128(rV, offV, sv_, 0); sr_[i].vs0 = *reinterpret_cast<bf16x8*>(&t_); } \
    { u32x4 t_ = __builtin_amdgcn_raw_buffer_load_b128(rV, offV, sv_ + 32 * LDV * 2, 0); sr_[i].vs1 = *reinterpret_cast<bf16x8*>(&t_); } \
    { u32x4 t_ = __builtin_amdgcn_raw_buffer_load_b128(rK, offK, sk_, 0); sr_[i].ks0 = *reinterpret_cast<bf16x8*>(&t_); } \
    { u32x4 t_ = __builtin_amdgcn_raw_buffer_load_b128(rK, offK, sk_ + 32 * LDK * 2, 0); sr_[i].ks1 = *reinterpret_cast<bf16x8*>(&t_); } } while (0)
#define SWRITE(b, i) do { *(bf16x8*)((char*)V_lds + (b) * SHM_V + vst0) = sr_[i].vs0;          \
    *(bf16x8*)((char*)V_lds + (b) * SHM_V + vst1) = sr_[i].vs1; int kc = sc * 2;               \
    *(bf16x8*)((char*)K_lds + (b) * SHM_K + KSWZ(sr, kc)) = sr_[i].ks0;                       \
    *(bf16x8*)((char*)K_lds + (b) * SHM_K + KSWZ(32 + sr, kc)) = sr_[i].ks1; } while (0)
#define SWAIT() asm volatile("s_waitcnt vmcnt(4)" ::: "memory")
#define RESC(a) do { if (__any((a) < 1.f)) { if (hi == 0) al_l[r32] = (a); asm volatile("s_waitcnt lgkmcnt(0)" ::: "memory"); \
    for (int d = 0; d < 4; ++d) for (int r = 0; r < 16; ++r) o[d][r] *= al_l[crow(r, hi)]; } } while (0)
  f32x16 pA0, pA1, pB0, pB1; float mnA, mnB, alA, alB; bf16x8 pa0, pa1, pa2, pa3; const int NT = seq / KVBLK;
  constexpr int SE = 0, SO = 1;
  SLOAD(SE, 0); asm volatile("s_waitcnt vmcnt(0)" ::: "memory"); SWRITE(0, SE); __syncthreads();
  qkt(pA0, pA1, K_lds, qr, r32, hi); partialSM(pA0, pA1, m_reg, mnA, alA);
  SLOAD(SO, KVBLK); if (2 < NT) SLOAD(SE, 2 * KVBLK);
  SWAIT(); SWRITE(1, SO); __syncthreads();
  for (int j = 1; j + 1 < NT; j += 2) {
    SBAR(); qkt(pB0, pB1, (bf16_t*)((char*)K_lds + SHM_K), qr, r32, hi);
    finishSM(pA0, pA1, alA, l_reg, pa0, pa1, pa2, pa3); SBAR();
    SLOAD(SO, (j + 2) * KVBLK); SBAR();
    pv_d0(o, vb0, pa0, pa1, pa2, pa3); partialSM(pB0, pB1, m_reg, mnB, alB);
    __syncthreads(); SWAIT(); SWRITE(0, SE);
    RESC(alB); __syncthreads();
    SBAR(); qkt(pA0, pA1, K_lds, qr, r32, hi);
    finishSM(pB0, pB1, alB, l_reg, pa0, pa1, pa2, pa3); SBAR();
    if (j + 3 < NT) SLOAD(SE, (j + 3) * KVBLK); SBAR();
    pv_d0(o, vb0 + (int)SHM_V, pa0, pa1, pa2, pa3); partialSM(pA0, pA1, m_reg, mnA, alA);
    __syncthreads(); SWAIT(); SWRITE(1, SO);
    RESC(alA); __syncthreads();
  }
  SBAR(); qkt(pB0, pB1, (bf16_t*)((char*)K_lds + SHM_K), qr, r32, hi);
  finishSM(pA0, pA1, alA, l_reg, pa0, pa1, pa2, pa3); SBAR();
  pv_d0(o, vb0, pa0, pa1, pa2, pa3); partialSM(pB0, pB1, m_reg, mnB, alB);
  __syncthreads(); RESC(alB);
  finishSM(pB0, pB1, alB, l_reg, pa0, pa1, pa2, pa3); SBAR();
  pv_d0(o, vb0 + (int)SHM_V, pa0, pa1, pa2, pa3);
  if (hi == 0) li_l[r32] = l_reg; asm volatile("s_waitcnt lgkmcnt(0)" ::: "memory");
  float rli[16];
#pragma unroll
  for (int r = 0; r < 16; ++r) rli[r] = __builtin_amdgcn_rcpf(li_l[crow(r, hi)]);
#pragma unroll
  for (int r = 0; r < 16; ++r) { const unsigned offO = (unsigned)((wid * QBLK + crow(r, hi)) * LDO + r32) * 2u;
    for (int d0 = 0; d0 < 4; ++d0) { const float v = o[d0][r] * rli[r]; *(bf16_t*)((char*)Ob + offO + d0 * 64) = (bf16_t)(cvtpk(v, v) & 0xffffu); } }
  asm volatile("s_waitcnt vmcnt(0) lgkmcnt(0)" ::: "memory"); __syncthreads();
#undef SLOAD
#undef SWRITE
#undef SWAIT
#undef RESC
}
constexpr size_t SHM_V2 = 2 * SHM_V;
template <int LDQ, int LDK, int LDV, class EPI>
__device__ __forceinline__ void attn_unit2(const bf16_t* __restrict__ Qb, const bf16_t* __restrict__ Kh, const bf16_t* __restrict__ Vh0, const bf16_t* __restrict__ Vh1, int seq, char* lds, const int wid, EPI&& epi) {
  const int lane = lane_id_fresh(), tid = wid * 64 + lane, r32 = lane & 31, hi = lane >> 5;
  bf16_t* V_lds = (bf16_t*)lds; bf16_t* K_lds = (bf16_t*)(lds + 2 * SHM_V2);
  float* ws = (float*)(lds + 2 * SHM_V2 + 2 * SHM_K) + wid * 64; float* li_l = ws; float* al_l = ws + 32;
  float m_reg = -1e30f, l_reg = 0; f32x16 o[8] = {}; bf16x8 qr[8];
  { const unsigned offQ = (unsigned)((wid * QBLK + r32) * LDQ + hi * 8) * 2u;
#pragma unroll
  for (int d0 = 0; d0 < 8; ++d0) qr[d0] = *reinterpret_cast<const bf16x8*>((const char*)Qb + offQ + d0 * 32); }
  const int sr = tid >> 4, sc = (tid & 15) * 8, vst0 = v_st(sr, sc), vst1 = v_st(32 + sr, sc);
  const int vb0 = (int)(uintptr_t)V_lds + v_rd_base(lane);
  const int offV = (sr * LDV + sc) * 2, offK = (sr * LDK + sc) * 2;
  const __amdgpu_buffer_rsrc_t rV0 = __builtin_amdgcn_make_buffer_rsrc((void*)Vh0, 0, 0x7ffffff0, 0x00020000);
  const __amdgpu_buffer_rsrc_t rV1 = __builtin_amdgcn_make_buffer_rsrc((void*)Vh1, 0, 0x7ffffff0, 0x00020000);
  const __amdgpu_buffer_rsrc_t rK = __builtin_amdgcn_make_buffer_rsrc((void*)Kh, 0, 0x7ffffff0, 0x00020000);
  u32x4 sv0, sv1, sv2, sv3, sk0, sk1;
#define SLOAD2(k0) do { const int sv_ = (k0) * (LDV * 2), sk_ = (k0) * (LDK * 2); \
    sv0 = __builtin_amdgcn_raw_buffer_load_b128(rV0, offV, sv_, 0); sv1 = __builtin_amdgcn_raw_buffer_load_b128(rV0, offV, sv_ + 32 * LDV * 2, 0); \
    sv2 = __builtin_amdgcn_raw_buffer_load_b128(rV1, offV, sv_, 0); sv3 = __builtin_amdgcn_raw_buffer_load_b128(rV1, offV, sv_ + 32 * LDV * 2, 0); \
    sk0 = __builtin_amdgcn_raw_buffer_load_b128(rK, offK, sk_, 0); sk1 = __builtin_amdgcn_raw_buffer_load_b128(rK, offK, sk_ + 32 * LDK * 2, 0); } while (0)
#define SWRITE2(b) do { char* vb_ = (char*)V_lds + (b) * SHM_V2; const int kc = sc * 2; \
    *(u32x4*)(vb_ + vst0) = sv0; *(u32x4*)(vb_ + vst1) = sv1; *(u32x4*)(vb_ + SHM_V + vst0) = sv2; *(u32x4*)(vb_ + SHM_V + vst1) = sv3; \
    *(u32x4*)((char*)K_lds + (b) * SHM_K + KSWZ(sr, kc)) = sk0; *(u32x4*)((char*)K_lds + (b) * SHM_K + KSWZ(32 + sr, kc)) = sk1; } while (0)
#define RESC2(a) do { if (__any((a) < 1.f)) { if (hi == 0) al_l[r32] = (a); asm volatile("s_waitcnt lgkmcnt(0)" ::: "memory"); \
    for (int d = 0; d < 8; ++d) for (int r = 0; r < 16; ++r) o[d][r] *= al_l[crow(r, hi)]; } } while (0)
  f32x16 p0, p1; float mn, al; bf16x8 pa0, pa1, pa2, pa3; const int NT = seq / KVBLK;
  SLOAD2(0); SWRITE2(0); __syncthreads();
  for (int j = 0; j < NT; ++j) { const int b = j & 1;
    if (j + 1 < NT) SLOAD2((j + 1) * KVBLK);
    SBAR(); qkt(p0, p1, (bf16_t*)((char*)K_lds + b * SHM_K), qr, r32, hi);
    partialSM(p0, p1, m_reg, mn, al); RESC2(al);
    finishSM(p0, p1, al, l_reg, pa0, pa1, pa2, pa3); SBAR();
    pv_d0(o, vb0 + b * (int)SHM_V2, pa0, pa1, pa2, pa3);
    pv_d0(o + 4, vb0 + b * (int)SHM_V2 + (int)SHM_V, pa0, pa1, pa2, pa3);
    __syncthreads();
    if (j + 1 < NT) SWRITE2(b ^ 1);
    __syncthreads();
  }
  const int le = lane_id_fresh(), r32e = le & 31, hie = le >> 5;
  if (hie == 0) li_l[r32e] = l_reg; asm volatile("s_waitcnt lgkmcnt(0)" ::: "memory");
  float rli[16];
#pragma unroll
  for (int r = 0; r < 16; ++r) rli[r] = __builtin_amdgcn_rcpf(li_l[crow(r, hie)]);
  epi(o, rli, wid, le);
  asm volatile("s_waitcnt vmcnt(0) lgkmcnt(0)" ::: "memory"); __syncthreads();
#undef SLOAD2
#undef SWRITE2
#undef RESC2
}
#undef KSWZ
#undef SBAR
}

#define XB_TMO      128
#define XB_XCNT(j)  (256  + 64 * (j))
#define XB_XSUB(j)  (1280 + 64 * (j))
#define XB_XGEN(j)  (2304 + 64 * (j))
#define XB_TOP      3328
#define XB_TOPGEN   3392
#define XCD_BAR_WORDS 3456
#define XB_SPIN_CAP (1u << 18)
__device__ __forceinline__ unsigned xb_ld(unsigned* p)              { return __hip_atomic_load(p, __ATOMIC_RELAXED, __HIP_MEMORY_SCOPE_AGENT); }
__device__ __forceinline__ unsigned xb_add(unsigned* p, unsigned v) { return __hip_atomic_fetch_add(p, v, __ATOMIC_RELAXED, __HIP_MEMORY_SCOPE_AGENT); }
__device__ __forceinline__ unsigned xb_xcc_id() { return (unsigned)__builtin_amdgcn_s_getreg((3 << 11) | 20) & 0xFu; }
#define XB_SPIN(cond, bar) do { unsigned _sp = 0; while (cond) { __builtin_amdgcn_s_sleep(1); \
    if ((++_sp & 255u) == 0u) { if (xb_ld(&(bar)[XB_TMO])) break; if (_sp > XB_SPIN_CAP) { atomicAdd(&(bar)[XB_TMO], 1u); break; } } } } while (0)
struct XcdBarrier { unsigned* bar; unsigned x; volatile LAS unsigned* st; };
__device__ __forceinline__ XcdBarrier xcd_barrier_post(unsigned* bar, volatile LAS unsigned* st, const int tid) {
    XcdBarrier b; b.bar = bar; b.x = xb_xcc_id(); b.st = st;
    if (tid == 0) (void)xb_add(&bar[XB_XCNT(b.x)], 1u);
    return b;
}
__device__ __forceinline__ void xcd_barrier_complete(unsigned* bar, unsigned x, unsigned& nloc, unsigned& nx) {
    const unsigned G = gridDim.x * gridDim.y * gridDim.z;
    unsigned sum, cnt, mine, sp = 0u;
    for (;;) {
        sum = 0u; cnt = 0u; mine = 0u;
#pragma unroll
        for (unsigned j = 0; j < 16; ++j) { const unsigned c = xb_ld(&bar[XB_XCNT(j)]); sum += c; cnt += (c > 0u) ? 1u : 0u; mine = (j == x) ? c : mine; }
        if (sum == G) break;
        __builtin_amdgcn_s_sleep(1);
        if ((++sp & 255u) == 0u) { if (xb_ld(&bar[XB_TMO])) break; if (sp > XB_SPIN_CAP) { atomicAdd(&bar[XB_TMO], 1u); break; } }
    }
    nloc = mine > 0u ? mine : 1u; nx = cnt > 0u ? cnt : 1u;
}
__device__ __forceinline__ void xcd_barrier(const XcdBarrier& b, const int tid) {
    asm volatile("s_waitcnt vmcnt(0)" ::: "memory");
    __syncthreads();
    if (tid == 0) {
        unsigned* bar = b.bar;
        __builtin_amdgcn_s_waitcnt(0);
        unsigned nloc = b.st[0], nx = b.st[1];
        if (nloc == 0u) { xcd_barrier_complete(bar, b.x, nloc, nx); b.st[0] = nloc; b.st[1] = nx; }
        const unsigned old = xb_add(&bar[XB_XSUB(b.x)], 1u);
        const unsigned gen = old / nloc;
        if (old + 1u == (gen + 1u) * nloc) {
            __builtin_amdgcn_fence(__ATOMIC_RELEASE, "agent");
            asm volatile("s_waitcnt vmcnt(0)" ::: "memory");
            const unsigned og = xb_add(&bar[XB_TOP], 1u);
            const unsigned tg = og / nx;
            if (og + 1u == (tg + 1u) * nx) xb_add(&bar[XB_TOPGEN], 1u);
            else XB_SPIN(xb_ld(&bar[XB_TOPGEN]) == tg, bar);
            __builtin_amdgcn_fence(__ATOMIC_ACQUIRE, "agent");
            xb_add(&bar[XB_XGEN(b.x)], 1u);
            asm volatile("s_waitcnt vmcnt(0)" ::: "memory");
        } else {
            XB_SPIN(xb_ld(&bar[XB_XGEN(b.x)]) == gen, bar);
            __builtin_amdgcn_fence(__ATOMIC_ACQUIRE, "agent");
            asm volatile("s_waitcnt vmcnt(0)" ::: "memory");
        }
    }
    __syncthreads();
}

constexpr int RING_BYTES = 131072;
constexpr int MISC_OFF = RING_BYTES;
constexpr int LDS_BYTES = 147456;

struct RowStats { float mean, rstd; };
__device__ __forceinline__ RowStats ln_stats(const f32x4 (&v)[8]) {
    float s = 0.f;
#pragma unroll
    for (int j = 0; j < 8; ++j) s += (v[j][0] + v[j][1]) + (v[j][2] + v[j][3]);
    const float mean = wave_sum(s) * (1.f / DM); float q = 0.f;
#pragma unroll
    for (int j = 0; j < 8; ++j) { const f32x4 d = v[j] - mean; q += (d[0] * d[0] + d[1] * d[1]) + (d[2] * d[2] + d[3] * d[3]); }
    RowStats r; r.mean = mean; r.rstd = 1.f / sqrtf(wave_sum(q) * (1.f / DM) + LN_EPS); return r;
}
__device__ __forceinline__ void store_bf16x4(bf16_t* p, const f32x4 v) { u32x2 w; w.x = cvt_pk_bf16(v[0], v[1]); w.y = cvt_pk_bf16(v[2], v[3]); *(u32x2*)p = w; }
__device__ __forceinline__ f32x4 load_bf16x4(const bf16_t* p) { const u32x2 w = *(const u32x2*)p; return (f32x4){bf_lo(w.x), bf_hi(w.x), bf_lo(w.y), bf_hi(w.y)}; }

__device__ __forceinline__ void transpose_item(const float* W, int ldw, int scol0, bf16_t* WT, int K, int drow0, int k0, LAS float*  , int lane) {
    const int kr = lane >> 3, n4 = (lane & 7) * 4;
    const float* src = W + (size_t)(k0 + 8 * kr) * ldw + scol0 + n4;
    f32x4 v[8];
#pragma unroll
    for (int i = 0; i < 8; ++i) v[i] = __builtin_nontemporal_load((const f32x4*)(src + (size_t)i * ldw));
    bf16_t* dst = WT + (size_t)(drow0 + n4) * K + k0 + 8 * kr;
#pragma unroll
    for (int q = 0; q < 4; ++q) { u32x4 o; o.x = cvt_pk_bf16(v[0][q], v[1][q]); o.y = cvt_pk_bf16(v[2][q], v[3][q]); o.z = cvt_pk_bf16(v[4][q], v[5][q]); o.w = cvt_pk_bf16(v[6][q], v[7][q]);
        *(u32x4*)(dst + (size_t)q * K) = o; }
}
__device__ __forceinline__ void tr_plain(const float* W, int K, int N, bf16_t* WT, int it, LAS float* scr, int lane) {
    const int nnb = N / 32, kb = it / nnb, nb = it % nnb;
    transpose_item(W, N, 32 * nb, WT, K, 32 * nb, 64 * kb, scr, lane);
}

struct Args { const float* in[27]; float* out; unsigned char* ws; int ph_lo, ph_hi; int probe_dup, pad; };
enum { I_X = 0, I_C, I_CTX, I_CCTX, I_MODW, I_MODB, I_LNG, I_LNB, I_RGW, I_RGB, I_REW, I_REB, I_EG, I_EU, I_ED, I_CIW, I_CW, I_COW, I_PW, I_PS, I_GQW, I_GQN, I_GOW, I_DQW, I_DL, I_DS, I_DOW };

namespace cq {
constexpr int I_GU = 32 * 48, I_DN = 12 * 64, I_EXP = I_GU + I_DN, I_LEXP = 16 * I_EXP;
constexpr int I_PL = 4 * 8 * 16, I_GQ = 32 * 96, I_GO = 32 * 64, I_DQ = 32 * 192, I_DO = 32 * 64;
constexpr int E0 = I_LEXP, E1 = E0 + I_PL, E2 = E1 + I_LEXP, E3 = E2 + I_GQ, E4 = E3 + I_GO, E5 = E4 + I_LEXP, E6 = E5 + I_DQ, E7 = E6 + I_DO, E8 = E7 + I_LEXP;
constexpr int NQ = E8;
}
constexpr int CW_Q = 16384;
struct __attribute__((packed, aligned(4))) F3 { float x, y, z; };
typedef float f32x3u __attribute__((ext_vector_type(3), aligned(4)));
struct TrDesc { const float* W; int ldw, sc; bf16_t* WT; int K, drow, k0; };
__device__ __forceinline__ TrDesc tr_plain_desc(const float* W, int K, int N, bf16_t* WT, int it) { const int nnb = N / 32, kb = it / nnb, nb = it % nnb; return TrDesc{W, N, 32 * nb, WT, K, 32 * nb, 64 * kb}; }
__device__ __forceinline__ TrDesc tr_expert_desc(const Args& a, int L, int r) {
    const int e = r / cq::I_EXP; r -= e * cq::I_EXP; const int le = L * 16 + e;
    if (r < cq::I_GU) {
        const int kb = r / 48, nb = r % 48, n = 32 * nb, pn = n >> 8, bj = (n >> 7) & 1, i = n & 127;
        const float* src = (bj ? a.in[I_EU] : a.in[I_EG]) + (size_t)le * DM * EFF;
        return TrDesc{src, EFF, 128 * pn + i, (bf16_t*)(a.ws + WS_WGU) + (size_t)le * 1536 * DM, DM, n, 64 * kb}; }
    return tr_plain_desc(a.in[I_ED] + (size_t)le * EFF * DM, EFF, DM, (bf16_t*)(a.ws + WS_WDN) + (size_t)le * DM * EFF, r - cq::I_GU);
}
__device__ __forceinline__ TrDesc cvt_queue_desc(const Args& a, int qi) {
    using namespace cq; TrDesc d;
    if (qi < E0) d = tr_expert_desc(a, 0, qi);
    else if (qi < E1) { const int r = qi - E0, g = r / 128; d = tr_plain_desc(a.in[I_PW] + (size_t)g * 512 * 512, 512, 512, (bf16_t*)(a.ws + WS_WPL) + (size_t)g * 512 * 512, r % 128); }
    else if (qi < E2) d = tr_expert_desc(a, 1, qi - E1);
    else if (qi < E3) d = tr_plain_desc(a.in[I_GQW], DM, 3072, (bf16_t*)(a.ws + WS_WGQ), qi - E2);
    else if (qi < E4) d = tr_plain_desc(a.in[I_GOW], DM, DM, (bf16_t*)(a.ws + WS_WGO), qi - E3);
    else if (qi < E5) d = tr_expert_desc(a, 2, qi - E4);
    else if (qi < E6) {
        const int it = qi - E5, kb = it / 192, nb = it % 192, n = 32 * nb; int sc = n;
        if (n < 4096) { const int pn = n >> 8, wi = n & 255, bj = wi >> 7, wc = (wi >> 5) & 3; sc = pn * 256 + (wc >> 1) * 128 + (2 * (wc & 1) + bj) * 32; }
        d = TrDesc{a.in[I_DQW], 3 * DM, sc, (bf16_t*)(a.ws + WS_WDQ), DM, n, 64 * kb}; }
    else if (qi < E7) d = tr_plain_desc(a.in[I_DOW], DM, DM, (bf16_t*)(a.ws + WS_WDO), qi - E6);
    else d = tr_expert_desc(a, 3, qi - E7);
    return d;
}
__device__ __forceinline__ void transpose_pair(const TrDesc& d0, const TrDesc& d1, int lane) {
    const int kr = lane >> 3, n4 = (lane & 7) * 4;
    const float* s0 = d0.W + (size_t)(d0.k0 + 8 * kr) * d0.ldw + d0.sc + n4; const float* s1 = d1.W + (size_t)(d1.k0 + 8 * kr) * d1.ldw + d1.sc + n4;
    f32x4 v0[8], v1[8];
#pragma unroll
    for (int i = 0; i < 8; ++i) v0[i] = *(const f32x4*)(s0 + (size_t)i * d0.ldw);
#pragma unroll
    for (int i = 0; i < 8; ++i) v1[i] = *(const f32x4*)(s1 + (size_t)i * d1.ldw);
    bf16_t* t0 = d0.WT + (size_t)(d0.drow + n4) * d0.K + d0.k0 + 8 * kr; bf16_t* t1 = d1.WT + (size_t)(d1.drow + n4) * d1.K + d1.k0 + 8 * kr;
#pragma unroll
    for (int q = 0; q < 4; ++q) { u32x4 o; o.x = cvt_pk_bf16(v0[0][q], v0[1][q]); o.y = cvt_pk_bf16(v0[2][q], v0[3][q]); o.z = cvt_pk_bf16(v0[4][q], v0[5][q]); o.w = cvt_pk_bf16(v0[6][q], v0[7][q]);
        *(u32x4*)(t0 + (size_t)q * d0.K) = o; }
#pragma unroll
    for (int q = 0; q < 4; ++q) { u32x4 o; o.x = cvt_pk_bf16(v1[0][q], v1[1][q]); o.y = cvt_pk_bf16(v1[2][q], v1[3][q]); o.z = cvt_pk_bf16(v1[4][q], v1[5][q]); o.w = cvt_pk_bf16(v1[6][q], v1[7][q]);
        *(u32x4*)(t1 + (size_t)q * d1.K) = o; }
}
__device__ __forceinline__ void cvt_run(const Args& a, int it, int n, int lane) {
    int k = 0;
    for (; k + 1 < n && it + k + 1 < cq::NQ; k += 2) { const TrDesc d0 = cvt_queue_desc(a, it + k), d1 = cvt_queue_desc(a, it + k + 1); transpose_pair(d0, d1, lane); }
    for (; k < n && it + k < cq::NQ; ++k) { const TrDesc d = cvt_queue_desc(a, it + k); transpose_item(d.W, d.ldw, d.sc, d.WT, d.K, d.drow, d.k0, nullptr, lane); }
}
__device__ __forceinline__ void cvt_opportunistic(const Args& a, int n, LAS unsigned char* lds, int tid, int wave, int lane) {
    if (n <= 0) return;
    unsigned* q = (unsigned*)(a.ws + WS_CTL) + CW_Q; volatile LAS int* qs = (volatile LAS int*)(lds + MISC_OFF + 768);
    __syncthreads();
    if (tid == 0) qs[0] = (int)__hip_atomic_fetch_add(q, (unsigned)(8 * n), __ATOMIC_RELAXED, __HIP_MEMORY_SCOPE_AGENT);
    __syncthreads();
    const int it = __builtin_amdgcn_readfirstlane(qs[0]) + wave * n;
    cvt_run(a, it, n, lane);
}
__device__ __forceinline__ void cvt_catchup(const Args& a, int target, LAS unsigned char* lds, int tid, int wave, int lane) {
    unsigned* q = (unsigned*)(a.ws + WS_CTL) + CW_Q; volatile LAS int* qs = (volatile LAS int*)(lds + MISC_OFF + 768);
    for (;;) {
        __syncthreads();
        if (tid == 0) { int h = (int)__hip_atomic_load(q, __ATOMIC_RELAXED, __HIP_MEMORY_SCOPE_AGENT);
            if (h < target) h = (int)__hip_atomic_fetch_add(q, 64u, __ATOMIC_RELAXED, __HIP_MEMORY_SCOPE_AGENT); else h = 0x7fffffff;
            qs[0] = h; }
        __syncthreads();
        const int base = __builtin_amdgcn_readfirstlane(qs[0]);
        if (base == 0x7fffffff) break;
        const int it = base + wave * 8;
        cvt_run(a, it, 8, lane);
    }
}
__device__ __forceinline__ int idle_units(int nwg, int G, int c) { const int mx = (nwg + G - 1) / G, mine = c < nwg ? (nwg - c + G - 1) / G : 0; return mx - mine; }

__device__ __forceinline__ void ph_prologue(const Args& a, LAS unsigned char* lds, int G, int wave, int lane, int tid) {
    unsigned char* ws = a.ws;
    const int bx = blockIdx.x;
    for (int t = bx; t < 256; t += G) {
        const int L = t >> 6, col0 = (t & 63) * 192;
        LAS float* sl = (LAS float*)lds; LAS float* sx = sl + DM; LAS float* red = sx + DM;
        for (int k = tid; k < DM; k += 512) { const float c = a.in[I_C][k], cc = a.in[I_CCTX][k];
            sl[k] = c / (1.f + __expf(-c)); sx[k] = cc / (1.f + __expf(-cc)); }
        __syncthreads();
        const float* W = a.in[I_MODW] + (size_t)L * DM * NMOD + col0 + 3 * lane;
        float al0 = 0.f, al1 = 0.f, al2 = 0.f, ac0 = 0.f, ac1 = 0.f, ac2 = 0.f;
        const int kb = wave * 256;
#pragma unroll 16
        for (int k = 0; k < 256; ++k) { const f32x3u w = __builtin_nontemporal_load((const f32x3u*)(W + (size_t)(kb + k) * NMOD));     const float s1 = sl[kb + k], s2 = sx[kb + k];
            al0 += w.x * s1; al1 += w.y * s1; al2 += w.z * s1; ac0 += w.x * s2; ac1 += w.y * s2; ac2 += w.z * s2; }
        LAS float* rp = red + (wave * 64 + lane) * 6;
        rp[0] = al0; rp[1] = al1; rp[2] = al2; rp[3] = ac0; rp[4] = ac1; rp[5] = ac2;
        __syncthreads();
        if (tid < 384) { const int which = tid / 192, col = tid % 192; float s_ = 0.f;
#pragma unroll
          for (int w = 0; w < 8; ++w) s_ += red[(w * 64 + col / 3) * 6 + which * 3 + col % 3];
          float* modv = (float*)(ws + WS_MODV);
          modv[(size_t)(L * 2 + which) * NMOD + col0 + col] = s_ + a.in[I_MODB][L * NMOD + col0 + col]; }
        __syncthreads();
    }
    if (bx == 0) {
        float* rope = (float*)(ws + WS_ROPE);
        for (int idx = tid; idx < 6144; idx += 512) {
            const int isc = idx >= 4096, e = isc ? idx - 4096 : idx, pos = e >> 5, i = e & 31;
            const float inv = powf(10000.0f, -(float)(2 * i) / 64.0f), ang = (float)pos * inv;
            float* cs = rope + (isc ? 8192 : 0); const int half = isc ? 2048 : 4096;
            cs[e] = cosf(ang); cs[half + e] = sinf(ang);
        }
    } else if (bx >= 2 && bx < 6) {
        const int L = bx - 2; const float* w = a.in[I_REW] + (size_t)L * DM * 16; float* wt = (float*)(ws + WS_WET) + (size_t)L * 4 * DM * 4;
        for (int idx = tid; idx < DM * 16; idx += 512) { const int c = idx >> 4, e = idx & 15; wt[((size_t)(e >> 2) * DM + c) * 4 + (e & 3)] = w[idx]; }
    } else if (bx == 1) {
        if (wave == 0) {
            const float* lv = a.in[I_DL];
            float s1 = lv[lane] * lv[128 + lane] + lv[64 + lane] * lv[192 + lane];
            float s2 = lv[256 + lane] * lv[384 + lane] + lv[320 + lane] * lv[448 + lane];
            s1 = wave_sum(s1); s2 = wave_sum(s2);
            if (lane == 0) { float* sc = (float*)(ws + WS_SCAL); sc[0] = expf(s1) - expf(s2) + LAM_INIT3; sc[1] = 1.0f - LAM_INIT3; }
        }
        if (tid < 256) ((float*)(ws + WS_SCAL + 1024))[tid] = a.in[I_DS][tid];
    }
    LAS float* scr = (LAS float*)(lds + 32768 + wave * 8448);
    const int gw = bx * 8 + wave, NGW = G * 8;
    constexpr int I_CI = 32 * 192, I_CO = 32 * 64;
    for (int it = gw; it < I_CI + I_CO; it += NGW) {
        int r = it;
        if (r < I_CI) {
            const int kb = r / 192, nb = r % 192, n = 32 * nb; int sc;
            if (n < 2048) sc = n; else { const int q = (n - 2048) >> 8, bj = ((n - 2048) >> 7) & 1, i = n & 127; sc = 2048 + bj * 2048 + 128 * q + i; }
            transpose_item(a.in[I_CIW], 3 * DM, sc, (bf16_t*)(ws + WS_WCI), DM, n, 64 * kb, scr, lane); continue; }
        r -= I_CI;
        tr_plain(a.in[I_COW], DM, DM, (bf16_t*)(ws + WS_WCO), r, scr, lane);
    }
    (void)0;
}

template <int NR>
__device__ __forceinline__ void init_rows(const Args& a, int r0, int rstride, int which) {
    const int lane = lane_id_fresh(); const unsigned lo16 = (unsigned)lane * 16u, lo8 = (unsigned)lane * 8u;
    bf16_t* H = (bf16_t*)(a.ws + WS_H);
    const float* mv = (const float*)(a.ws + WS_MODV) + (size_t)which * NMOD;
    const float* src = which ? a.in[I_CTX] : a.in[I_X] - (size_t)NCTX * DM;
    f32x4 v[NR][8];
#pragma unroll
    for (int k = 0; k < NR; ++k)
#pragma unroll
        for (int j = 0; j < 8; ++j) v[k][j] = ULD4(src, (size_t)(r0 + k * rstride) * (DM * 4) + j * 1024, lo16);
#pragma unroll
    for (int j = 0; j < 8; ++j) { const f32x4 sh = ULD4(mv, j * 1024, lo16), sc = ULD4(mv, DM * 4 + j * 1024, lo16) + 1.0f;
#pragma unroll
        for (int k = 0; k < NR; ++k) { const size_t rb = (size_t)(r0 + k * rstride) * (DM * 4) + j * 1024;
            const f32x4 h = v[k][j] * sc + sh;
            u32x2 w; w.x = cvt_pk_bf16(h[0], h[1]); w.y = cvt_pk_bf16(h[2], h[3]); *(u32x2*)((char*)H + (rb >> 1) + lo8) = w; } }
}
__device__ __forceinline__ void ph_init(const Args& a, int G, int bx, int wave) {
    const int gw = bx * 8 + wave, NGW = G * 8, gwT = wave * G + bx;
    int r = NCTX + gw;
    for (; r + 3 * NGW < MTOT; r += 4 * NGW) init_rows<4>(a, r, NGW, 0);
    for (; r < MTOT; r += NGW) init_rows<1>(a, r, NGW, 0);
    for (int rc = gwT; rc < NCTX; rc += NGW) init_rows<1>(a, rc, NGW, 1);
}

__device__ __forceinline__ void ph_conv(const Args& a, int gw, int NGW, int lane) {
    const bf16_t* GB = (const bf16_t*)(a.ws + WS_MIX); const bf16_t* PP = GB + (size_t)33 * MiB / 2; bf16_t* Y = (bf16_t*)(a.ws + WS_MIX + 66 * MiB);
    const float* cw = a.in[I_CW];
#pragma unroll 1
    for (int tk = gw; tk < MTOT; tk += NGW) {
        const int t0 = (tk >> 2) * 4;
        { const int j = tk & 3;
            const int c = 8 * lane + 512 * j;
            float w0[8], w1[8], w2[8];
#pragma unroll
            for (int i = 0; i < 8; i += 4) { const f32x4 x0 = *(const f32x4*)(cw + c + i), x1 = *(const f32x4*)(cw + DM + c + i), x2 = *(const f32x4*)(cw + 2 * DM + c + i);
                for (int q = 0; q < 4; ++q) { w0[i + q] = x0[q]; w1[i + q] = x1[q]; w2[i + q] = x2[q]; } }
            u32x4 prev = {0u, 0u, 0u, 0u}, cur, nxt;
            if (t0 != 0 && t0 != NCTX) prev = *(const u32x4*)(PP + (size_t)(t0 - 1) * DM + c);
            cur = *(const u32x4*)(PP + (size_t)t0 * DM + c);
#pragma unroll
            for (int i = 0; i < 4; ++i) { const int t = t0 + i;
                nxt = (u32x4){0u, 0u, 0u, 0u}; if (t + 1 != NCTX && t + 1 != MTOT) nxt = *(const u32x4*)(PP + (size_t)(t + 1) * DM + c);
                const u32x4 gb = *(const u32x4*)(GB + (size_t)t * DM + c);
                float y[8];
#pragma unroll
                for (int q = 0; q < 4; ++q) {
                    y[2 * q] = bf_lo(gb[q]) * (w0[2 * q] * bf_lo(prev[q]) + w1[2 * q] * bf_lo(cur[q]) + w2[2 * q] * bf_lo(nxt[q]));
                    y[2 * q + 1] = bf_hi(gb[q]) * (w0[2 * q + 1] * bf_hi(prev[q]) + w1[2 * q + 1] * bf_hi(cur[q]) + w2[2 * q + 1] * bf_hi(nxt[q])); }
                u32x4 o; o.x = cvt_pk_bf16(y[0], y[1]); o.y = cvt_pk_bf16(y[2], y[3]); o.z = cvt_pk_bf16(y[4], y[5]); o.w = cvt_pk_bf16(y[6], y[7]);
                *(u32x4*)(Y + (size_t)t * DM + c) = o; prev = cur; cur = nxt; }
        }
    }
}

template <int GI>
__device__ __forceinline__ void pool_task(const Args& a, int t0, int jj) {
    constexpr int HW = 1 << GI, NRW = 8 + 2 * HW;
    const int lane = lane_id_fresh(); const unsigned lo16 = (unsigned)lane * 16u, lo8 = (unsigned)lane * 8u;
    const float* X = (const float*)(a.ws + WS_X); bf16_t* PO = (bf16_t*)(a.ws + WS_MIX);
    const int which = t0 < NCTX, slo = which ? 0 : NCTX, shi = which ? NCTX : MTOT;
    const float* mv = (const float*)(a.ws + WS_MODV) + (size_t)(2 + which) * NMOD + DM;
    const size_t cb = (size_t)(GI * 512 + 256 * jj) * 4;
    f32x4 xr[NRW];
#pragma unroll
    for (int i = 0; i < NRW; ++i) { const int r = t0 - HW + i; xr[i] = (f32x4){0.f, 0.f, 0.f, 0.f}; if (r >= slo && r < shi) xr[i] = ULD4(X, (size_t)r * (DM * 4) + cb, lo16); }
    const f32x4 sc = ULD4(mv, cb, lo16) + 1.0f;
    f32x4 s = {0.f, 0.f, 0.f, 0.f};
#pragma unroll
    for (int i = 0; i < 2 * HW; ++i) s += xr[i];
#pragma unroll
    for (int o = 0; o < 8; ++o) { const int t = t0 + o; const int lo = (t - HW) > slo ? (t - HW) : slo, hi = (t + HW) < shi ? (t + HW) : shi;
        const f32x4 p = (s * (1.0f / (float)(hi - lo)) - xr[o + HW]) * sc;
        u32x2 w; w.x = cvt_pk_bf16(p[0], p[1]); w.y = cvt_pk_bf16(p[2], p[3]);
        *(u32x2*)((char*)PO + ((size_t)GI * MTOT + t) * 1024 + jj * 512 + lo8) = w;
        if (o < 7) s += xr[o + 2 * HW] - xr[o]; }
}
__device__ __forceinline__ void ph_pool(const Args& a, int gw, int NGW, int  ) {
    int k = 0;
    for (int T = gw; T < MTOT; T += NGW, ++k) { const int strip = T >> 3, sub = ((T & 7) + k) & 7, g = sub >> 1, jj = sub & 1, t0 = strip * 8;
        if (g == 0) pool_task<0>(a, t0, jj); else if (g == 1) pool_task<1>(a, t0, jj); else if (g == 2) pool_task<2>(a, t0, jj); else pool_task<3>(a, t0, jj); }
}

template <bool NORM>
__device__ __forceinline__ void head_pass(bf16_t* p, const float* gain, int quarter, int row, const float* rope, bf16_t* po) {
    u32x4 raw[4], par[4];
#pragma unroll
    for (int k = 0; k < 4; ++k) raw[k] = *(const u32x4*)(p + 8 * k);
    float rstd = 1.0f;
    if (NORM) { float ss = 0.f;
#pragma unroll
        for (int k = 0; k < 4; ++k)
#pragma unroll
            for (int q = 0; q < 4; ++q) { const float lo = bf_lo(raw[k][q]), hi = bf_hi(raw[k][q]); ss += lo * lo + hi * hi; }
        ss += __shfl_xor(ss, 1); ss += __shfl_xor(ss, 2);
        rstd = 1.0f / sqrtf(ss * (1.0f / 128.0f) + RMS_EPS); }
#pragma unroll
    for (int k = 0; k < 4; ++k)
#pragma unroll
        for (int q = 0; q < 4; ++q) par[k][q] = (unsigned)__shfl_xor((int)raw[k][q], 1);
    const bool do_rope = row >= NCTX; const int t = row - NCTX;
    const int pos = (quarter < 2) ? (t >> 6) : (t & 63);
    const float* cs = rope + ((quarter < 2) ? 0 : 8192) + pos * 32; const float* sn = cs + ((quarter < 2) ? 4096 : 2048);
    const float sgn = (quarter & 1) ? 1.0f : -1.0f;
#pragma unroll
    for (int k = 0; k < 4; ++k) {
        float a_[8], b_[8];
#pragma unroll
        for (int q = 0; q < 4; ++q) { a_[2 * q] = bf_lo(raw[k][q]) * rstd; a_[2 * q + 1] = bf_hi(raw[k][q]) * rstd; b_[2 * q] = bf_lo(par[k][q]) * rstd; b_[2 * q + 1] = bf_hi(par[k][q]) * rstd; }
        if (NORM) {
#pragma unroll
            for (int i = 0; i < 8; i += 4) { const f32x4 go = *(const f32x4*)(gain + 32 * quarter + 8 * k + i), gp = *(const f32x4*)(gain + 32 * (quarter ^ 1) + 8 * k + i);
                for (int q = 0; q < 4; ++q) { a_[i + q] *= go[q]; b_[i + q] *= gp[q]; } } }
        float o_[8];
        if (do_rope) {
#pragma unroll
            for (int i = 0; i < 8; i += 4) { const f32x4 c4 = *(const f32x4*)(cs + 8 * k + i), s4 = *(const f32x4*)(sn + 8 * k + i);
                for (int q = 0; q < 4; ++q) o_[i + q] = a_[i + q] * c4[q] + sgn * b_[i + q] * s4[q]; }
        } else {
#pragma unroll
            for (int i = 0; i < 8; ++i) o_[i] = a_[i];
        }
        u32x4 o; o.x = cvt_pk_bf16(o_[0], o_[1]); o.y = cvt_pk_bf16(o_[2], o_[3]); o.z = cvt_pk_bf16(o_[4], o_[5]); o.w = cvt_pk_bf16(o_[6], o_[7]);
        *(u32x4*)(po + 8 * k) = o;
    }
}

#define LLD4(off, lo) (*(const LAS f32x4*)(lds + (off) + (lo)))
__device__ __forceinline__ void ln1_stage(const Args& a, int L, LAS unsigned char* lds, int tid) {
    const float* mv = (const float*)(a.ws + WS_MODV) + (size_t)(L * 2) * NMOD;
    const float* lg_ = a.in[I_LNG] + (size_t)(L * 2 + 0) * DM; const float* lb_ = a.in[I_LNB] + (size_t)(L * 2 + 0) * DM;
    const float* wg = a.in[I_RGW] + (size_t)L * DM * 4; const float* ps = a.in[I_PS];
    LAS f32x4* d = (LAS f32x4*)lds; const int t = tid;
    __syncthreads();
    d[t] = ((const f32x4*)lg_)[t]; d[512 + t] = ((const f32x4*)lb_)[t];
    const f32x4 psv = (L == 1) ? ((const f32x4*)ps)[t] : (f32x4){1.f, 1.f, 1.f, 1.f};
#pragma unroll
    for (int w = 0; w < 2; ++w) { const float* m = mv + (size_t)w * NMOD;
        d[1024 + w * 1536 + t] = ((const f32x4*)(m + 3 * DM))[t]; d[1536 + w * 1536 + t] = ((const f32x4*)(m + 4 * DM))[t] + 1.0f; d[2048 + w * 1536 + t] = ((const f32x4*)(m + 2 * DM))[t] * psv; }
#pragma unroll
    for (int q = 0; q < 4; ++q) d[4096 + q * 512 + t] = ((const f32x4*)wg)[q * 512 + t];
    __syncthreads();
}
struct Ln1Row { f32x4 v[8]; u32x2 dw[8]; };
__device__ __forceinline__ void ln1_load(const Args& a, int L, Ln1Row& R, int r, int which, unsigned lo16, unsigned lo8) {
    const float* X = (L == 0) ? (which ? a.in[I_CTX] : a.in[I_X] - (size_t)NCTX * DM) : (const float*)(a.ws + WS_X);
    const bf16_t* Dm = (const bf16_t*)(a.ws + WS_D);
#pragma unroll
    for (int j = 0; j < 8; ++j) { R.v[j] = ULD4N(X, (size_t)r * (DM * 4) + j * 1024, lo16); R.dw[j] = __builtin_nontemporal_load((const u32x2*)((const char*)Dm + (size_t)r * (DM * 2) + j * 512 + lo8)); }
}
__device__ __forceinline__ void ln1_compute(const Args& a, int L, Ln1Row& R, int r, int which, LAS unsigned char* lds, bool dup, int lane, unsigned lo16, unsigned lo8) {
    bf16_t* HS = (bf16_t*)(a.ws + WS_MOE); bf16_t* XB = (bf16_t*)(a.ws + (dup ? WS_DUMH : WS_H));
    const float* wet = (const float*)(a.ws + WS_WET) + (size_t)L * 4 * DM * 4;
    const float* bg = a.in[I_RGB] + L * 4; const float* be = a.in[I_REB] + L * 16;
    unsigned* cnt = (unsigned*)(a.ws + WS_CTL) + CW_CNT + (dup ? 4 : L) * 16 * 64;
    int* route = (int*)(a.ws + WS_ROUTE + (dup ? 512 * 1024 : 0));
    const unsigned lo64 = (unsigned)lane * 64u, pw = which ? 24576u : 0u;
    asm volatile("" ::: "memory");
#pragma unroll
    for (int j = 0; j < 8; ++j) { const f32x4 g2 = LLD4(32768 + pw + j * 1024, lo16);
        const f32x4 dv = {bf_lo(R.dw[j].x), bf_hi(R.dw[j].x), bf_lo(R.dw[j].y), bf_hi(R.dw[j].y)};
        R.v[j] = R.v[j] * ALPHA + g2 * dv; }
    float s1_[1], q1_[1]; s1_[0] = 0.f;
#pragma unroll
    for (int j = 0; j < 8; ++j) s1_[0] += (R.v[j][0] + R.v[j][1]) + (R.v[j][2] + R.v[j][3]);
    wave_sum_n(s1_, lane);
    const float mean = s1_[0] * (1.f / DM); q1_[0] = 0.f;
#pragma unroll
    for (int j = 0; j < 8; ++j) { const f32x4 d = R.v[j] - mean; q1_[0] += (d[0] * d[0] + d[1] * d[1]) + (d[2] * d[2] + d[3] * d[3]); }
    wave_sum_n(q1_, lane);
    const float rstd = 1.f / sqrtf(q1_[0] * (1.f / DM) + LN_EPS);
    float lg[4] = {0.f, 0.f, 0.f, 0.f};
#pragma unroll
    for (int j = 0; j < 8; ++j) {
        const f32x4 gm = LLD4(j * 1024, lo16), bt = LLD4(8192 + j * 1024, lo16), sh = LLD4(16384 + pw + j * 1024, lo16), sc = LLD4(24576 + pw + j * 1024, lo16);
        f32x4 w4[4];
#pragma unroll
        for (int i = 0; i < 4; ++i) w4[i] = LLD4(65536 + j * 4096 + i * 16, lo64);
        const f32x4 xn = (R.v[j] - mean) * rstd * gm + bt;
        { u32x2 xw_; xw_.x = cvt_pk_bf16(xn[0], xn[1]); xw_.y = cvt_pk_bf16(xn[2], xn[3]); *(u32x2*)((char*)XB + (size_t)r * (DM * 2) + j * 512 + lo8) = xw_; }
        const f32x4 hm = xn * sc + sh; R.v[j] = hm;
#pragma unroll
        for (int i = 0; i < 4; ++i) { lg[0] += hm[i] * w4[i][0]; lg[1] += hm[i] * w4[i][1]; lg[2] += hm[i] * w4[i][2]; lg[3] += hm[i] * w4[i][3]; }
        if (j & 1) asm volatile("" ::: "memory"); }
    wave_sum_n(lg, lane);
    int g_ = 0; float best = lg[0] + bg[0];
#pragma unroll
    for (int q = 1; q < 4; ++q) { const float x = lg[q] + bg[q]; if (x > best) { best = x; g_ = q; } }
    float den = 0.f;
#pragma unroll
    for (int q = 0; q < 4; ++q) den += __expf(lg[q] + bg[q] - best);
    const float pg = 1.0f / den; const int gs = __builtin_amdgcn_readfirstlane(g_);
    float le[4] = {0.f, 0.f, 0.f, 0.f};
#pragma unroll
    for (int j = 0; j < 8; ++j) {
#pragma unroll
        for (int i = 0; i < 4; ++i) { const f32x4 w = ULD4(wet, (size_t)gs * (DM * 16) + j * 4096 + i * 16, lo64); le[0] += R.v[j][i] * w[0]; le[1] += R.v[j][i] * w[1]; le[2] += R.v[j][i] * w[2]; le[3] += R.v[j][i] * w[3]; }
        if ((j & 3) == 3) asm volatile("" ::: "memory"); }
    wave_sum_n(le, lane);
    float l4[4];
#pragma unroll
    for (int q = 0; q < 4; ++q) l4[q] = le[q] + be[gs * 4 + q];
    int i0 = 0; float b0 = l4[0];
#pragma unroll
    for (int q = 1; q < 4; ++q) if (l4[q] > b0) { b0 = l4[q]; i0 = q; }
    int i1 = -1; float b1 = -3.0e38f;
#pragma unroll
    for (int q = 0; q < 4; ++q) if (q != i0 && l4[q] > b1) { b1 = l4[q]; i1 = q; }
    const float tv0 = 1.0f / (1.0f + __expf(b1 - b0));
    const int me0 = gs * 4 + i0, me1 = gs * 4 + i1;
    unsigned p0 = 0u, p1 = 0u;
    if (lane == 0) {
        p0 = __hip_atomic_fetch_add(cnt + me0 * 64, 1u, __ATOMIC_RELAXED, __HIP_MEMORY_SCOPE_AGENT);
        p1 = __hip_atomic_fetch_add(cnt + me1 * 64, 1u, __ATOMIC_RELAXED, __HIP_MEMORY_SCOPE_AGENT);
        int* rp = route + (size_t)r * 8;
        *(u32x4*)rp = (u32x4){(unsigned)me0, (unsigned)me1, p0, p1};
        *(u32x4*)(rp + 4) = (u32x4){__float_as_uint(pg * tv0), __float_as_uint(pg * (1.0f - tv0)), 0u, 0u};
    }
    if (!dup) {
        const size_t d0 = ((size_t)__builtin_amdgcn_readfirstlane(me0) * MTOT + (unsigned)__builtin_amdgcn_readfirstlane((int)p0)) * (DM * 2);
        const size_t d1 = ((size_t)__builtin_amdgcn_readfirstlane(me1) * MTOT + (unsigned)__builtin_amdgcn_readfirstlane((int)p1)) * (DM * 2);
#pragma unroll
        for (int j = 0; j < 8; ++j) { u32x2 w; w.x = cvt_pk_bf16(R.v[j][0], R.v[j][1]); w.y = cvt_pk_bf16(R.v[j][2], R.v[j][3]);
            *(u32x2*)((char*)HS + d0 + j * 512 + lo8) = w; *(u32x2*)((char*)HS + d1 + j * 512 + lo8) = w; }
    }
}
__device__ __forceinline__ void ph_ln1(const Args& a, int L, int rowlo, LAS unsigned char* lds, int tid, int G, int bx, int wave, bool dup = false) {
    const int gw = bx * 8 + wave, NGW = G * 8, gwT = wave * G + bx;
    ln1_stage(a, L, lds, tid);
    int rbase = NCTX + gw;
    for (; rbase + 3 * NGW < MTOT; rbase += 4 * NGW) {
        const int lane = lane_id_fresh(); const unsigned lo16 = (unsigned)lane * 16u, lo8 = (unsigned)lane * 8u;
        Ln1Row A, B;
        ln1_load(a, L, A, rbase, 0, lo16, lo8);
        ln1_load(a, L, B, rbase + NGW, 0, lo16, lo8);
        ln1_compute(a, L, A, rbase, 0, lds, dup, lane, lo16, lo8);
        ln1_load(a, L, A, rbase + 2 * NGW, 0, lo16, lo8);
        ln1_compute(a, L, B, rbase + NGW, 0, lds, dup, lane, lo16, lo8);
        ln1_load(a, L, B, rbase + 3 * NGW, 0, lo16, lo8);
        ln1_compute(a, L, A, rbase + 2 * NGW, 0, lds, dup, lane, lo16, lo8);
        ln1_compute(a, L, B, rbase + 3 * NGW, 0, lds, dup, lane, lo16, lo8);
    }
    for (; rbase < MTOT; rbase += NGW) { const int lane = lane_id_fresh(); const unsigned lo16 = (unsigned)lane * 16u, lo8 = (unsigned)lane * 8u;
        Ln1Row A; ln1_load(a, L, A, rbase, 0, lo16, lo8); ln1_compute(a, L, A, rbase, 0, lds, dup, lane, lo16, lo8); }
    if (rowlo == 0) for (int rc = gwT; rc < NCTX; rc += NGW) { const int lane = lane_id_fresh(); const unsigned lo16 = (unsigned)lane * 16u, lo8 = (unsigned)lane * 8u;
        Ln1Row A; ln1_load(a, L, A, rc, 1, lo16, lo8); ln1_compute(a, L, A, rc, 1, lds, dup, lane, lo16, lo8); }
}

__device__ __forceinline__ void moe_table(const Args& a, int L, LAS unsigned char* lds, int tid) {
    volatile LAS int* tb = (volatile LAS int*)(lds + MISC_OFF + 64); volatile LAS int* t2e = (volatile LAS int*)(lds + MISC_OFF + 192);
    unsigned* cnt = (unsigned*)(a.ws + WS_CTL) + CW_CNT + L * 16 * 64;
    __syncthreads();
    if (tid < 64) {
        int nt = 0;
        if (tid < 16) nt = ((int)__hip_atomic_load(cnt + tid * 64, __ATOMIC_RELAXED, __HIP_MEMORY_SCOPE_AGENT) + 255) >> 8;
        int inc = nt;
#pragma unroll
        for (int o = 1; o < 16; o <<= 1) { const int up = __shfl_up(inc, o); if ((tid & 63) >= o) inc += up; }
        if (tid < 16) { const int ex = inc - nt; tb[tid] = ex < MAXT ? ex : MAXT; if (tid == 15) tb[16] = inc < MAXT ? inc : MAXT; }
    }
    __syncthreads();
    if (tid < 96) { int e = 0;
#pragma unroll
        for (int k = 1; k < 16; ++k) e += (tb[k] <= tid) ? 1 : 0;
        t2e[tid] = e; }
    __syncthreads();
}

__device__ __forceinline__ void ph_gather(const Args& a, int rowlo, LAS unsigned char* lds, int gw, int NGW, int lane) {
    const LAS int* tb = (const LAS int*)(lds + MISC_OFF + 64);
    const bf16_t* H = (const bf16_t*)(a.ws + WS_H); bf16_t* HS = (bf16_t*)(a.ws + WS_MOE);
    const int* route = (const int*)(a.ws + WS_ROUTE);
    for (int r = rowlo + gw; r < MTOT; r += NGW) {
        const u32x4 rt = *(const u32x4*)(route + (size_t)r * 8);
        const size_t s0 = (size_t)tb[rt[0]] * 256 + rt[2], s1 = (size_t)tb[rt[1]] * 256 + rt[3];
        const u32x4* src = (const u32x4*)(H + (size_t)r * DM); u32x4* d0 = (u32x4*)(HS + s0 * DM); u32x4* d1 = (u32x4*)(HS + s1 * DM);
#pragma unroll
        for (int j = 0; j < 4; ++j) { const u32x4 x = src[lane + 64 * j]; d0[lane + 64 * j] = x; d1[lane + 64 * j] = x; }
    }
}

__device__ __forceinline__ void ln2_stage(const Args& a, int L, bool last, LAS unsigned char* lds, int tid) {
    const float* mv = (const float*)(a.ws + WS_MODV) + (size_t)(L * 2) * NMOD;
    const float* mn = (const float*)(a.ws + WS_MODV) + (size_t)((last ? L : L + 1) * 2) * NMOD;
    const float* lg_ = a.in[I_LNG] + (size_t)(L * 2 + 1) * DM; const float* lb_ = a.in[I_LNB] + (size_t)(L * 2 + 1) * DM;
    LAS f32x4* d = (LAS f32x4*)lds; const int t = tid;
    __syncthreads();
    d[t] = ((const f32x4*)lg_)[t]; d[512 + t] = ((const f32x4*)lb_)[t];
#pragma unroll
    for (int w = 0; w < 2; ++w) { const float* m = mv + (size_t)w * NMOD; const float* n = mn + (size_t)w * NMOD;
        d[1024 + w * 1536 + t] = ((const f32x4*)(m + 5 * DM))[t]; d[1536 + w * 1536 + t] = ((const f32x4*)n)[t]; d[2048 + w * 1536 + t] = ((const f32x4*)(n + DM))[t] + 1.0f; }
    __syncthreads();
}
struct Ln2Row { u32x2 xw[8], ya[8], yb[8]; };
__device__ __forceinline__ void ln2_load(const Args& a, Ln2Row& R, int r, int s0, int s1, unsigned lo16, unsigned lo8) {
    const bf16_t* XB = (const bf16_t*)(a.ws + WS_H); const bf16_t* Y2 = (const bf16_t*)(a.ws + WS_MOE + MOE_Y2);
#pragma unroll
    for (int j = 0; j < 8; ++j) { R.xw[j] = __builtin_nontemporal_load((const u32x2*)((const char*)XB + (size_t)r * (DM * 2) + j * 512 + lo8));
        R.ya[j] = __builtin_nontemporal_load((const u32x2*)((const char*)Y2 + (size_t)s0 * (DM * 2) + j * 512 + lo8)); R.yb[j] = __builtin_nontemporal_load((const u32x2*)((const char*)Y2 + (size_t)s1 * (DM * 2) + j * 512 + lo8)); }
}
__device__ __forceinline__ void ln2_compute(const Args& a, int L, Ln2Row& R, int r, float w0, float w1, int which, bool last, LAS unsigned char* lds, bool dup, int lane, unsigned lo16, unsigned lo8) {
    bf16_t* H = (bf16_t*)(a.ws + (dup ? WS_DUMH : WS_H)); float* XO = (float*)(a.ws + (dup ? WS_DUMX : WS_X)); float* OUT = dup ? (float*)(a.ws + WS_DUMX) : a.out;
    const unsigned pw = which ? 24576u : 0u;
    asm volatile("" ::: "memory");
    f32x4 v[8];
#pragma unroll
    for (int j = 0; j < 8; ++j) { const f32x4 g5 = LLD4(16384 + pw + j * 1024, lo16);
        const f32x4 y0 = {bf_lo(R.ya[j].x), bf_hi(R.ya[j].x), bf_lo(R.ya[j].y), bf_hi(R.ya[j].y)}, y1 = {bf_lo(R.yb[j].x), bf_hi(R.yb[j].x), bf_lo(R.yb[j].y), bf_hi(R.yb[j].y)};
        const f32x4 x1 = {bf_lo(R.xw[j].x), bf_hi(R.xw[j].x), bf_lo(R.xw[j].y), bf_hi(R.xw[j].y)};
        v[j] = x1 * ALPHA + g5 * (y0 * w0 + y1 * w1); }
    float s1_[1], q1_[1]; s1_[0] = 0.f;
#pragma unroll
    for (int j = 0; j < 8; ++j) s1_[0] += (v[j][0] + v[j][1]) + (v[j][2] + v[j][3]);
    wave_sum_n(s1_, lane);
    const float mean = s1_[0] * (1.f / DM); q1_[0] = 0.f;
#pragma unroll
    for (int j = 0; j < 8; ++j) { const f32x4 d = v[j] - mean; q1_[0] += (d[0] * d[0] + d[1] * d[1]) + (d[2] * d[2] + d[3] * d[3]); }
    wave_sum_n(q1_, lane);
    const float rstd = 1.f / sqrtf(q1_[0] * (1.f / DM) + LN_EPS);
#pragma unroll
    for (int j = 0; j < 8; ++j) {
        const f32x4 gm = LLD4(j * 1024, lo16), bt = LLD4(8192 + j * 1024, lo16), sh = LLD4(24576 + pw + j * 1024, lo16), sc = LLD4(32768 + pw + j * 1024, lo16);
        const f32x4 xn = (v[j] - mean) * rstd * gm + bt;
        if (last) { UST4(OUT, (size_t)(r - NCTX) * (DM * 4) + j * 1024, lo16, xn); }
        else { UST4N(XO, (size_t)r * (DM * 4) + j * 1024, lo16, xn);
               if (L != 0) { const f32x4 hm = xn * sc + sh;
                   u32x2 w; w.x = cvt_pk_bf16(hm[0], hm[1]); w.y = cvt_pk_bf16(hm[2], hm[3]); *(u32x2*)((char*)H + (size_t)r * (DM * 2) + j * 512 + lo8) = w; } }
        if (j & 1) asm volatile("" ::: "memory"); }
}
__device__ __forceinline__ void ph_ln2(const Args& a, int L, int rowlo, bool last, LAS unsigned char* lds, int tid, int G, int bx, int wave, bool dup = false) {
    const int gw = bx * 8 + wave, NGW = G * 8, gwT = wave * G + bx;
    ln2_stage(a, L, last, lds, tid);
    const LAS int* tb = (const LAS int*)(lds + MISC_OFF + 64);
    const int* route = (const int*)(a.ws + WS_ROUTE);
    int rbase = NCTX + gw;
    for (; rbase + 3 * NGW < MTOT; rbase += 4 * NGW) {
        const int lane = lane_id_fresh(); const unsigned lo16 = (unsigned)lane * 16u, lo8 = (unsigned)lane * 8u;
        int s0[4], s1[4]; float w0[4], w1[4];
#pragma unroll
        for (int i = 0; i < 4; ++i) { const int* rp = route + (size_t)(rbase + i * NGW) * 8; const u32x4 rt = *(const u32x4*)rp; const u32x4 rw = *(const u32x4*)(rp + 4);
            s0[i] = __builtin_amdgcn_readfirstlane(tb[rt[0]] * 256 + (int)rt[2]); s1[i] = __builtin_amdgcn_readfirstlane(tb[rt[1]] * 256 + (int)rt[3]);
            w0[i] = __uint_as_float(__builtin_amdgcn_readfirstlane(rw[0])); w1[i] = __uint_as_float(__builtin_amdgcn_readfirstlane(rw[1])); }
        Ln2Row A, B;
        ln2_load(a, A, rbase, s0[0], s1[0], lo16, lo8);
        ln2_load(a, B, rbase + NGW, s0[1], s1[1], lo16, lo8);
        ln2_compute(a, L, A, rbase, w0[0], w1[0], 0, last, lds, dup, lane, lo16, lo8);
        ln2_load(a, A, rbase + 2 * NGW, s0[2], s1[2], lo16, lo8);
        ln2_compute(a, L, B, rbase + NGW, w0[1], w1[1], 0, last, lds, dup, lane, lo16, lo8);
        ln2_load(a, B, rbase + 3 * NGW, s0[3], s1[3], lo16, lo8);
        ln2_compute(a, L, A, rbase + 2 * NGW, w0[2], w1[2], 0, last, lds, dup, lane, lo16, lo8);
        ln2_compute(a, L, B, rbase + 3 * NGW, w0[3], w1[3], 0, last, lds, dup, lane, lo16, lo8);
    }
    for (; rbase < MTOT; rbase += NGW) {
        const int lane = lane_id_fresh(); const unsigned lo16 = (unsigned)lane * 16u, lo8 = (unsigned)lane * 8u;
        const int* rp = route + (size_t)rbase * 8; const u32x4 rt = *(const u32x4*)rp; const u32x4 rw = *(const u32x4*)(rp + 4);
        const int s0 = __builtin_amdgcn_readfirstlane(tb[rt[0]] * 256 + (int)rt[2]), s1 = __builtin_amdgcn_readfirstlane(tb[rt[1]] * 256 + (int)rt[3]);
        Ln2Row A; ln2_load(a, A, rbase, s0, s1, lo16, lo8);
        ln2_compute(a, L, A, rbase, __uint_as_float(__builtin_amdgcn_readfirstlane(rw[0])), __uint_as_float(__builtin_amdgcn_readfirstlane(rw[1])), 0, last, lds, dup, lane, lo16, lo8);
    }
    if (rowlo == 0) for (int rc = gwT; rc < NCTX; rc += NGW) {
        const int lane = lane_id_fresh(); const unsigned lo16 = (unsigned)lane * 16u, lo8 = (unsigned)lane * 8u;
        const int* rp = route + (size_t)rc * 8; const u32x4 rt = *(const u32x4*)rp; const u32x4 rw = *(const u32x4*)(rp + 4);
        const int s0 = __builtin_amdgcn_readfirstlane(tb[rt[0]] * 256 + (int)rt[2]), s1 = __builtin_amdgcn_readfirstlane(tb[rt[1]] * 256 + (int)rt[3]);
        Ln2Row A; ln2_load(a, A, rc, s0, s1, lo16, lo8);
        ln2_compute(a, L, A, rc, __uint_as_float(__builtin_amdgcn_readfirstlane(rw[0])), __uint_as_float(__builtin_amdgcn_readfirstlane(rw[1])), 1, last, lds, dup, lane, lo16, lo8);
    }
}

constexpr int NPH = 36;
__global__ void __launch_bounds__(512, 2) mega(Args a) {
    extern __shared__ __attribute__((aligned(16))) unsigned char lds_raw[];
    LAS unsigned char* lds = (LAS unsigned char*)lds_raw;
    const int wave = __builtin_amdgcn_readfirstlane((int)threadIdx.x >> 6);
    const int G = gridDim.x, bx = blockIdx.x;
    const int gw = bx * 8 + wave, NGW = G * 8;
    unsigned char* ws = a.ws;
    unsigned* ctl = (unsigned*)(ws + WS_CTL);
#if MK_ONE_LAUNCH
#define PDUP (rp_ != 0)
#else
#define PDUP (a.probe_dup != 0)
#endif
#define FRESH() const int lane = lane_id_fresh(); const int tid = wave * 64 + lane; (void)tid; (void)lane
    { FRESH(); for (int u = tid; u < (LDS_BYTES - MISC_OFF) / 4; u += 512) ((LAS unsigned*)(lds + MISC_OFF))[u] = 0u; }
    __syncthreads();
    const int lo = a.ph_lo, hi = a.ph_hi;
    XcdBarrier bar; bar.bar = ctl + CW_BAR; bar.x = 0; bar.st = (volatile LAS unsigned*)(lds + MISC_OFF);
    if (hi - lo > 1) { FRESH(); bar = xcd_barrier_post(ctl + CW_BAR, (volatile LAS unsigned*)(lds + MISC_OFF), tid); }
#define IN(k) (lo <= (k) && (k) < hi)
#define SEAM(k) do { if (IN(k) && IN((k) + 1)) { FRESH(); xcd_barrier(bar, tid); } } while (0)

    float* X = (float*)(ws + WS_X); bf16_t* H = (bf16_t*)(ws + WS_H);
    const float* modv = (const float*)(ws + WS_MODV);
    unsigned char* mix = ws + WS_MIX; unsigned char* moe = ws + WS_MOE;

#define MOE_TAIL(L, p0, rowlo, last) do { \
    if (IN((p0))) for (int rp_ = 0; rp_ <= REPC((p0)); ++rp_) { FRESH(); cvt_catchup(a, (L) == 0 ? cq::E0 : (L) == 1 ? cq::E2 : (L) == 2 ? cq::E5 : cq::E8, lds, tid, wave, lane); ph_ln1(a, (L), (rowlo), lds, tid, G, bx, wave, PDUP); } SEAM((p0)); \
      \
    if (IN((p0) + 2)) for (int rp_ = 0; rp_ <= REPC((p0) + 2); ++rp_) { FRESH(); moe_table(a, (L), lds, tid); const int T = ((const LAS int*)(lds + MISC_OFF + 64))[16]; \
        pg8::Gemm g{(const bf16_t*)moe, (const bf16_t*)(ws + WS_WGU) + (size_t)(L) * 16 * 1536 * DM, DM, (size_t)1536 * DM}; \
        pg8::MoeOrder S; S.init(T, 6, G, bx); S.t2e = (const LAS int*)(lds + MISC_OFF + 192); S.tb = (const LAS int*)(lds + MISC_OFF + 64); S.sparse_a = true; pg8::EpiMoeA E{(bf16_t*)(moe + MOE_ACT)}; \
        pg8::gemm_phase<pg8::EpiMoeA, pg8::MoeOrder, true, true>(lds, g, S, E, tid); cvt_opportunistic(a, 20 * idle_units(T * 6, G, bx), lds, tid, wave, lane); } SEAM((p0) + 2); \
    if (IN((p0) + 3)) for (int rp_ = 0; rp_ <= REPC((p0) + 3); ++rp_) { FRESH(); moe_table(a, (L), lds, tid); const int T = ((const LAS int*)(lds + MISC_OFF + 64))[16]; \
        pg8::Gemm g{(const bf16_t*)(moe + MOE_ACT), (const bf16_t*)(ws + WS_WDN) + (size_t)(L) * 16 * DM * EFF, EFF, (size_t)DM * EFF}; \
        pg8::MoeOrder S; S.init(T, 8, G, bx); S.t2e = (const LAS int*)(lds + MISC_OFF + 192); S.tb = (const LAS int*)(lds + MISC_OFF + 64); S.sparse_a = false; pg8::EpiQKV E{(bf16_t*)(moe + MOE_Y2), DM, 1 << 20, nullptr, 1 << 20, nullptr, 0}; \
        pg8::gemm_phase<pg8::EpiQKV, pg8::MoeOrder, true, true>(lds, g, S, E, tid); cvt_opportunistic(a, 6 * idle_units(T * 8, G, bx), lds, tid, wave, lane); } SEAM((p0) + 3); \
    if (IN((p0) + 4)) for (int rp_ = 0; rp_ <= REPC((p0) + 4); ++rp_) { FRESH(); if ((L) == 1) cvt_catchup(a, cq::E3, lds, tid, wave, lane); if ((L) == 2) cvt_catchup(a, cq::E6, lds, tid, wave, lane); moe_table(a, (L), lds, tid); ph_ln2(a, (L), (rowlo), (last), lds, tid, G, bx, wave, PDUP); } \
    } while (0)

    if (IN(0)) for (int rp_ = 0; rp_ <= REPC(0); ++rp_) { FRESH(); ph_prologue(a, lds, G, wave, lane, tid); } SEAM(0);
    if (IN(1)) for (int rp_ = 0; rp_ <= REPC(1); ++rp_) { FRESH(); ph_init(a, G, bx, wave); } SEAM(1);
    if (IN(2)) for (int rp_ = 0; rp_ <= REPC(2); ++rp_) { FRESH(); pg8::Gemm g{H, (const bf16_t*)(ws + WS_WCI), DM, 0}; pg8::GridOrder S; S.init(NMT, 24, G, bx);
        pg8::EpiConv1 E{(bf16_t*)mix, (bf16_t*)(mix + 33 * MiB)};
        pg8::gemm_phase<pg8::EpiConv1, pg8::GridOrder, true, true>(lds, g, S, E, tid); cvt_opportunistic(a, 12 * idle_units(NMT * 24, G, bx), lds, tid, wave, lane); } SEAM(2);
    if (IN(3)) for (int rp_ = 0; rp_ <= REPC(3); ++rp_) { FRESH(); ph_conv(a, gw, NGW, lane); } SEAM(3);
    if (IN(4)) for (int rp_ = 0; rp_ <= REPC(4); ++rp_) { FRESH(); pg8::Gemm g{(const bf16_t*)(mix + 66 * MiB), (const bf16_t*)(ws + WS_WCO), DM, 0}; pg8::GridOrder S; S.init(NMT, 8, G, bx);
        pg8::EpiDelta E{(bf16_t*)(ws + WS_D), 0, 1 << 20, 0};
        pg8::gemm_phase<pg8::EpiDelta, pg8::GridOrder, true, true>(lds, g, S, E, tid); cvt_opportunistic(a, 12 * idle_units(NMT * 8, G, bx), lds, tid, wave, lane); } SEAM(4);
    MOE_TAIL(0, 5, 0, false); SEAM(9);
    if (IN(10)) for (int rp_ = 0; rp_ <= REPC(10); ++rp_) { FRESH(); cvt_catchup(a, cq::E1, lds, tid, wave, lane); ph_pool(a, gw, NGW, lane); } SEAM(10);
    if (IN(11)) for (int rp_ = 0; rp_ <= REPC(11); ++rp_) { FRESH(); pg8::Gemm g{(const bf16_t*)mix, (const bf16_t*)(ws + WS_WPL), 512, (size_t)512 * 512}; pg8::PoolOrder S; S.init(4 * NMT, 2, G, bx);
        pg8::EpiDelta E{(bf16_t*)(ws + WS_D), 0, NMT, 512};
        pg8::gemm_phase<pg8::EpiDelta, pg8::PoolOrder, true, true>(lds, g, S, E, tid); cvt_opportunistic(a, 3 * idle_units(4 * NMT * 2, G, bx), lds, tid, wave, lane); } SEAM(11);
    MOE_TAIL(1, 12, 0, false); SEAM(16);
    if (IN(17)) for (int rp_ = 0; rp_ <= REPC(17); ++rp_) { FRESH(); pg8::Gemm g{H, (const bf16_t*)(ws + WS_WGQ), DM, 0}; pg8::GridOrder S; S.init(NMT, 12, G, bx);
        pg8::EpiQKV E{(bf16_t*)mix, DM, 8, (bf16_t*)(mix + 33 * MiB), 10, (bf16_t*)(mix + 42 * MiB), KVHS};
        pg8::gemm_phase<pg8::EpiQKV, pg8::GridOrder, true, true>(lds, g, S, E, tid); cvt_opportunistic(a, 12 * idle_units(NMT * 12, G, bx), lds, tid, wave, lane); } SEAM(17);
    if (IN(18)) for (int rp_ = 0; rp_ <= REPC(18); ++rp_) { FRESH(); cvt_catchup(a, cq::E4, lds, tid, wave, lane);
        bf16_t* Q = (bf16_t*)mix; bf16_t* Kb = (bf16_t*)(mix + 33 * MiB); const float* rope = (const float*)(ws + WS_ROPE);
        const float* gq = a.in[I_GQN]; const float* gk = gq + 128;
        for (int task = gw; task < MTOT / 4; task += NGW) {
            const int r = task * 4 + (lane >> 4); bf16_t* pp = Kb + (size_t)((lane >> 2) & 3) * KVHS + (size_t)r * 128 + (lane & 3) * 32;
            head_pass<true>(pp, gk, lane & 3, r, rope, PDUP ? (bf16_t*)(ws + WS_DUMQ) + (size_t)r * 512 + (lane & 15) * 32 : pp); }
    } SEAM(18);
    if (IN(19)) for (int rp_ = 0; rp_ <= REPC(19); ++rp_) { FRESH();
        const bf16_t* Q = (const bf16_t*)mix; const bf16_t* Kb = (const bf16_t*)(mix + 33 * MiB); const bf16_t* Vb = (const bf16_t*)(mix + 42 * MiB); bf16_t* O = (bf16_t*)(mix + 51 * MiB);
        for (int i = 0;; ++i) { const int idx = i * G + bx; if (idx >= 528) break;
            int h, kvh, row0, seq;
            if (idx < 512) { const int ii = idx >> 8, c = idx & 255, x = c & 7, wl = c >> 3, j = (x >> 2) * 64 + wl * 2 + ii; kvh = x & 3; h = kvh * 4 + (j >> 5); row0 = NCTX + (j & 31) * 256; seq = MTOT; }
            else { h = idx - 512; kvh = h >> 2; row0 = 0; seq = NCTX; }
            att::attn_unit<DM, 128, 128, DM>(Q + (size_t)row0 * DM + h * 128, Kb + (size_t)kvh * KVHS, Vb + (size_t)kvh * KVHS, O + (size_t)row0 * DM + h * 128, seq, (char*)lds_raw, wave, a.in[I_GQN], (const float*)(ws + WS_ROPE), row0 - NCTX);
        }
    } SEAM(19);
    if (IN(20)) for (int rp_ = 0; rp_ <= REPC(20); ++rp_) { FRESH(); pg8::Gemm g{(const bf16_t*)(mix + 51 * MiB), (const bf16_t*)(ws + WS_WGO), DM, 0}; pg8::GridOrder S; S.init(NMT, 8, G, bx);
        pg8::EpiDelta E{(bf16_t*)(ws + WS_D), 0, 1 << 20, 0};
        pg8::gemm_phase<pg8::EpiDelta, pg8::GridOrder, true, true>(lds, g, S, E, tid); cvt_opportunistic(a, 12 * idle_units(NMT * 8, G, bx), lds, tid, wave, lane); } SEAM(20);
    MOE_TAIL(2, 21, 0, false); SEAM(25);
    if (IN(26)) for (int rp_ = 0; rp_ <= REPC(26); ++rp_) { FRESH(); pg8::Gemm g{H, (const bf16_t*)(ws + WS_WDQ), DM, 0}; pg8::GridOrder S; S.init(NMT, 24, G, bx);
        pg8::EpiQKVRope E{(bf16_t*)mix, (bf16_t*)(mix + 33 * MiB), (bf16_t*)(mix + 66 * MiB), KVHS, (const float*)(ws + WS_ROPE)};
        pg8::gemm_phase<pg8::EpiQKVRope, pg8::GridOrder, true, true>(lds, g, S, E, tid); cvt_opportunistic(a, 12 * idle_units(NMT * 24, G, bx), lds, tid, wave, lane); } SEAM(26);
    if (IN(28)) for (int rp_ = 0; rp_ <= REPC(28); ++rp_) { FRESH();
        const bf16_t* Q = (const bf16_t*)mix; const bf16_t* Kb = (const bf16_t*)(mix + 33 * MiB); const bf16_t* Vb = (const bf16_t*)(mix + 66 * MiB);
#pragma unroll 1
        for (int i = 0;; ++i) { const int u = bx + (i >> 1) * G; if (u >= 256) break;
            { const int m = i & 1, h = u & 7, qb = u >> 3;
                auto epi = [&](f32x16 (&o)[8], float (&rli)[16], const int wid, const int le) __attribute__((always_inline)) {
                    int i2 = i; asm volatile("" : "+s"(i2)); const int u2 = bx + (i2 >> 1) * G, m2 = i2 & 1;
                    const int r32e = le & 31, hie = le >> 5;
                    char* st = (char*)a.ws + WS_MIX + 99 * MiB + (size_t)u2 * 131072 + (unsigned)(wid * 16384) + (unsigned)le * 16u;
                    if (m2 == 0) {
#pragma unroll
                        for (int r = 0; r < 16; ++r) { const float s_ = rli[r]; u32x4 w; w.x = cvt_pk_bf16(o[0][r] * s_, o[1][r] * s_); w.y = cvt_pk_bf16(o[2][r] * s_, o[3][r] * s_); w.z = cvt_pk_bf16(o[4][r] * s_, o[5][r] * s_); w.w = cvt_pk_bf16(o[6][r] * s_, o[7][r] * s_);
                            *(u32x4*)(st + r * 1024) = w; }
                    } else {
                        const float lam = __uint_as_float(__hip_atomic_load((unsigned*)(a.ws + WS_SCAL), __ATOMIC_RELAXED, __HIP_MEMORY_SCOPE_AGENT));
                        const float oml = __uint_as_float(__hip_atomic_load((unsigned*)(a.ws + WS_SCAL) + 1, __ATOMIC_RELAXED, __HIP_MEMORY_SCOPE_AGENT));
                        const float* sub = (const float*)(a.ws + WS_SCAL + 1024); char* A2b = (char*)a.ws + WS_MIX + 163 * MiB + ((size_t)((u2 >> 3) * 256) * DM + (u2 & 7) * 256) * 2;
                        float gl[8];
#pragma unroll
                        for (int d0 = 0; d0 < 8; ++d0) gl[d0] = sub[d0 * 32 + r32e];
#pragma unroll
                        for (int r = 0; r < 16; ++r) { if ((r & 3) == 0) asm volatile("" ::: "memory");
                            const unsigned offA = (unsigned)((wid * 32 + att::crow(r, hie)) * DM + r32e) * 2u;
                            const u32x4 w = *(const u32x4*)(st + r * 1024);
                            float d[8]; float ss = 0.f; const float s_ = rli[r] * lam;
                            d[0] = bf_lo(w.x) - o[0][r] * s_; d[1] = bf_hi(w.x) - o[1][r] * s_; d[2] = bf_lo(w.y) - o[2][r] * s_; d[3] = bf_hi(w.y) - o[3][r] * s_;
                            d[4] = bf_lo(w.z) - o[4][r] * s_; d[5] = bf_hi(w.z) - o[5][r] * s_; d[6] = bf_lo(w.w) - o[6][r] * s_; d[7] = bf_hi(w.w) - o[7][r] * s_;
#pragma unroll
                            for (int d0 = 0; d0 < 8; ++d0) ss += d[d0] * d[d0];
#pragma unroll
                            for (int mk = 1; mk < 32; mk <<= 1) ss += __int_as_float(__builtin_amdgcn_ds_bpermute((le ^ mk) << 2, __float_as_int(ss)));
                            const float rs = oml / sqrtf(ss * (1.0f / 256.0f) + RMS_EPS);
#pragma unroll
                            for (int d0 = 0; d0 < 8; ++d0) { const float v = d[d0] * rs * gl[d0]; *(bf16_t*)(A2b + offA + d0 * 64) = (bf16_t)(cvt_pk_bf16(v, v) & 0xffffu); } }
                    }
                };
                att::attn_unit2<DM, 128, 128>(Q + (size_t)(NCTX + qb * 256) * DM + (h * 2 + m) * 128, Kb + (size_t)(h * 2 + m) * KVHS, Vb + (size_t)(h * 2) * KVHS, Vb + (size_t)(h * 2 + 1) * KVHS, MTOT, (char*)lds_raw, wave, epi);
            }
        }
    } SEAM(28);
    if (IN(30)) for (int rp_ = 0; rp_ <= REPC(30); ++rp_) { FRESH(); cvt_catchup(a, cq::E7, lds, tid, wave, lane); pg8::Gemm g{(const bf16_t*)(mix + 163 * MiB), (const bf16_t*)(ws + WS_WDO), DM, 0}; pg8::GridOrder S; S.init(NLAT / 256, 8, G, bx);
        pg8::EpiDelta E{(bf16_t*)(ws + WS_D), NCTX, 1 << 20, 0};
        pg8::gemm_phase<pg8::EpiDelta, pg8::GridOrder, true, true>(lds, g, S, E, tid); } SEAM(30);
    MOE_TAIL(3, 31, NCTX, true);
#undef IN
#undef FRESH
#undef SEAM
#undef MOE_TAIL
}

extern "C" void kernel_launch(void* const* d_in, const int* in_sizes, int n_in, void* d_out, int out_size, void* d_ws, size_t ws_size, hipStream_t stream) {
    static int grid = 0;
    if (grid == 0) {
        if (n_in != 27 || out_size != NLAT * DM || ws_size < WS_END) { fprintf(stderr, "kernel_launch: unexpected shapes (n_in %d out %d ws %zu)\n", n_in, out_size, ws_size); grid = -1; return; }
        int dev = 0, cus = 0, per_cu = 0;
        if (hipGetDevice(&dev) != hipSuccess || hipDeviceGetAttribute(&cus, hipDeviceAttributeMultiprocessorCount, dev) != hipSuccess) { grid = -1; return; }
        if (hipFuncSetAttribute((const void*)mega, hipFuncAttributeMaxDynamicSharedMemorySize, LDS_BYTES) != hipSuccess) { fprintf(stderr, "kernel_launch: hipFuncSetAttribute failed\n"); grid = -1; return; }
        if (hipOccupancyMaxActiveBlocksPerMultiprocessor(&per_cu, (const void*)mega, 512, LDS_BYTES) != hipSuccess || per_cu < 1) fprintf(stderr, "kernel_launch: occupancy query says %d\n", per_cu);
        (void)hipGetLastError();
        grid = cus;
    }
    if (grid < 0) return;
    (void)hipMemsetAsync((char*)d_ws + WS_CTL, 0, CTL_ZERO_BYTES, stream);
    Args a{};
    for (int i = 0; i < 27; ++i) a.in[i] = (const float*)d_in[i];
    a.out = (float*)d_out; a.ws = (unsigned char*)d_ws;
#if MK_ONE_LAUNCH
    a.ph_lo = 0; a.ph_hi = NPH;
    hipLaunchKernelGGL(mega, dim3(grid), dim3(512), LDS_BYTES, stream, a);
#else
    for (int p = 0; p < NPH; ++p) { a.ph_lo = p; a.ph_hi = p + 1; const int reps = 1 + (int)((PROBE_REP_MASK >> p) & 1ull);
        for (int r = 0; r < reps; ++r) { a.probe_dup = r; hipLaunchKernelGGL(mega, dim3(grid), dim3(512), LDS_BYTES, stream, a); } }
#endif
}
```

```cpp
#include <hip/hip_runtime.h>
#include <hip/hip_bf16.h>
#include <cstdio>
#include <cstdint>

#ifndef MK_ONE_LAUNCH
#define MK_ONE_LAUNCH 1
#endif
#ifndef PROBE_REP_MASK
#define PROBE_REP_MASK 0ull
#endif
#if MK_ONE_LAUNCH
#define REPC(k) ((int)((PROBE_REP_MASK >> (k)) & 1ull))
#else
#define REPC(k) 0
#endif

#define LAS __attribute__((address_space(3)))
#define GAS __attribute__((address_space(1)))
typedef unsigned short bf16_t;
typedef short bf16x8 __attribute__((ext_vector_type(8)));
typedef short s16x4 __attribute__((ext_vector_type(4)));
typedef float f32x4 __attribute__((ext_vector_type(4)));
typedef float f32x16 __attribute__((ext_vector_type(16)));
typedef unsigned u32x4 __attribute__((ext_vector_type(4)));
typedef unsigned u32x2 __attribute__((ext_vector_type(2)));

constexpr int DM = 2048, NLAT = 8192, NCTX = 256, MTOT = NLAT + NCTX, NMT = MTOT / 256;
constexpr int NMOD = 6 * DM;
constexpr int EFF = 768, NEXP = 16;
constexpr float ALPHA = 1.6817928305074290f;
constexpr float LN_EPS = 1e-6f, RMS_EPS = 1e-6f;
constexpr float LAM_INIT3 = 0.55605820415f;
constexpr int MAXT = 82;
constexpr size_t KVHS = (size_t)MTOT * 128;

constexpr size_t MiB = 1ull << 20;
constexpr size_t WS_CTL = 0, CTL_ZERO_BYTES = 1 * MiB;
constexpr size_t WS_MODV = 1 * MiB;
constexpr size_t WS_ROPE = 1 * MiB + 512 * 1024;
constexpr size_t WS_SCAL = WS_ROPE + 64 * 1024;
constexpr size_t WS_ROUTE = 2 * MiB;
constexpr size_t WS_WET = 3 * MiB;
constexpr size_t WS_WCI = 4 * MiB, WS_WCO = 28 * MiB, WS_WPL = 36 * MiB, WS_WGQ = 38 * MiB, WS_WGO = 50 * MiB, WS_WDQ = 58 * MiB, WS_WDO = 82 * MiB;
constexpr size_t WS_WGU = 90 * MiB, WS_WDN = 474 * MiB;
constexpr size_t WS_X = 666 * MiB, WS_H = 732 * MiB;
constexpr size_t WS_MIX = 765 * MiB;
constexpr size_t WS_MOE = 965 * MiB;
constexpr size_t MOE_ACT = 528 * MiB, MOE_Y2 = 559 * MiB;
constexpr size_t WS_D = 1606 * MiB;
constexpr size_t WS_END = 1639 * MiB;
constexpr size_t WS_DUMX = 1640 * MiB, WS_DUMH = 1707 * MiB, WS_DUMQ = 1741 * MiB;
constexpr int CW_BAR = 4096;
constexpr int CW_CNT = 8192;

__device__ __forceinline__ unsigned cvt_pk_bf16(float lo, float hi) { unsigned r; asm volatile("v_cvt_pk_bf16_f32 %0, %1, %2" : "=v"(r) : "v"(lo), "v"(hi)); return r; }
__device__ __forceinline__ float bf_lo(unsigned w) { return __uint_as_float(w << 16); }
__device__ __forceinline__ float bf_hi(unsigned w) { return __uint_as_float(w & 0xffff0000u); }
__device__ __forceinline__ float wave_sum(float v) {
#pragma unroll
    for (int o = 1; o < 64; o <<= 1) v += __shfl_xor(v, o);
    return v;
}
template <int N> __device__ __forceinline__ void wave_sum_n(float (&x)[N], const int lane) {
#pragma unroll
    for (int o = 1; o < 64; o <<= 1) { const int idx = (lane ^ o) << 2;
#pragma unroll
        for (int i = 0; i < N; ++i) x[i] += __builtin_bit_cast(float, __builtin_amdgcn_ds_bpermute(idx, __builtin_bit_cast(int, x[i])));
    }
}
__device__ __forceinline__ int lane_id_fresh() { int l; asm volatile("v_mbcnt_lo_u32_b32 %0, -1, 0\n\tv_mbcnt_hi_u32_b32 %0, -1, %0" : "=v"(l)); return l; }
#define ULD4(base, cb, lo) (*(const f32x4*)((const char*)(base) + (size_t)(cb) + (lo)))
#define UST4(base, cb, lo, val) (*(f32x4*)((char*)(base) + (size_t)(cb) + (lo)) = (val))
#define ULD4N(base, cb, lo) __builtin_nontemporal_load((const f32x4*)((const char*)(base) + (size_t)(cb) + (lo)))
#define UST4N(base, cb, lo, val) __builtin_nontemporal_store((val), (f32x4*)((char*)(base) + (size_t)(cb) + (lo)))
#define LDS_WAIT() asm volatile("s_waitcnt lgkmcnt(0)" ::: "memory")
#define VM_WAIT() asm volatile("s_waitcnt vmcnt(0)" ::: "memory")

namespace pg8 {
constexpr int BM = 256, BK = 64, HALF = 128, HTB = HALF * BK * 2, STAGE_BYTES = 8 * HTB, NXCD = 8, WGM = 8;
__host__ __device__ __forceinline__ int lds_byte(int r, int c) { const int st = (r >> 4) * 2 + (c >> 5), rr = r & 15, cc = c & 31, ob = rr * 64 + cc * 2; return st * 1024 + (ob ^ (((ob >> 9) & 1) << 5)); }
__host__ __device__ __forceinline__ void stage_rc(int b, int& R, int& C) { const int st = b / 1024, sb = b % 1024, swz = sb ^ (((sb >> 9) & 1) << 5); R = (st >> 1) * 16 + swz / 64; C = (st & 1) * 32 + (swz % 64) / 2; }
__host__ __device__ __forceinline__ int perm32(int rho) { const int n = rho >> 4, i = rho & 15; return 8 * (i >> 2) + 4 * n + (i & 3); }

struct Unit { int pm, pn, bsel, pa; };
struct Gemm { const bf16_t* A; const bf16_t* Bt; int K; size_t bstride; };

struct GridOrder {
    int nM, nN, nwg, G, c;
    __device__ void init(int nM_, int nN_, int G_, int c_) { nM = nM_; nN = nN_; nwg = nM * nN; G = G_; c = c_; }
    __device__ bool base_next(int i, Unit& u) const {
        const long L = (long)i * G + c; if (L >= nwg) return false;
        int wgid = (int)L; { const int q = nwg / NXCD, r = nwg % NXCD, xcd = wgid % NXCD, off = wgid / NXCD; wgid = (xcd < r ? xcd * (q + 1) : r * (q + 1) + (xcd - r) * q) + off; }
        const int nig = WGM * nN, gid = wgid / nig, fm = gid * WGM, gsz = (nM - fm) < WGM ? (nM - fm) : WGM;
        u.pm = fm + ((wgid % nig) % gsz); u.pn = (wgid % nig) / gsz; u.bsel = 0; u.pa = u.pm; return true;
    }
    __device__ bool next(int i, Unit& u) const { return base_next(i, u); }
};
struct PoolOrder : GridOrder {
    __device__ bool next(int i, Unit& u) const { if (!base_next(i, u)) return false; u.bsel = u.pm / NMT; return true; }
};
struct MoeOrder : GridOrder {
    const LAS int* t2e; const LAS int* tb; bool sparse_a;
    __device__ bool next(int i, Unit& u) const { if (!base_next(i, u)) return false; const int e = __builtin_amdgcn_readfirstlane(t2e[u.pm]); u.bsel = e;
        if (sparse_a) u.pa = e * NMT + (u.pm - __builtin_amdgcn_readfirstlane(tb[e])); return true; }
};

__device__ __forceinline__ u32x4 pack8(const f32x4 v0, const f32x4 v1) { u32x4 w; w.x = cvt_pk_bf16(v0[0], v0[1]); w.y = cvt_pk_bf16(v0[2], v0[3]); w.z = cvt_pk_bf16(v1[0], v1[1]); w.w = cvt_pk_bf16(v1[2], v1[3]); return w; }

struct EpiQKV {
    static constexpr bool PERM = true;
    bf16_t* P0; int ld0; int pn1; bf16_t* P1; int pn2; bf16_t* P2; size_t hs;
    __device__ __forceinline__ void operator()(const f32x4 (&acc)[2][2][4][2], const Unit& u, int wr, int wc, int fr, int fq) const {
        const int row0 = u.pm * BM + wr * 64 + fr;
        if (u.pn < pn1) {
            bf16_t* base = P0 + u.pn * BM + wc * 32 + 8 * fq;
#pragma unroll
            for (int ai = 0; ai < 2; ++ai)
#pragma unroll
                for (int m = 0; m < 4; ++m) { bf16_t* rowp = base + (size_t)(row0 + ai * HALF + m * 16) * ld0;
#pragma unroll
                    for (int bj = 0; bj < 2; ++bj) *(u32x4*)(rowp + bj * HALF) = pack8(acc[ai][bj][m][0], acc[ai][bj][m][1]); }
        } else {
            const bool s1 = u.pn < pn2; bf16_t* base = (s1 ? P1 : P2) + (size_t)(2 * (u.pn - (s1 ? pn1 : pn2))) * hs + wc * 32 + 8 * fq;
#pragma unroll
            for (int ai = 0; ai < 2; ++ai)
#pragma unroll
                for (int m = 0; m < 4; ++m) { bf16_t* rowp = base + (size_t)(row0 + ai * HALF + m * 16) * 128;
#pragma unroll
                    for (int bj = 0; bj < 2; ++bj) *(u32x4*)(rowp + bj * hs) = pack8(acc[ai][bj][m][0], acc[ai][bj][m][1]); }
        }
    }
};
struct EpiQKVRope {
    static constexpr bool PERM = true;
    bf16_t* Q; bf16_t* Kb; bf16_t* Vb; size_t hs; const float* rope;
    __device__ __forceinline__ void operator()(const f32x4 (&acc)[2][2][4][2], const Unit& u, int wr, int wc, int fr, int fq) const {
        const int row0 = u.pm * BM + wr * 64 + fr;
        if (u.pn >= 16) {
            bf16_t* base = Vb + (size_t)(2 * (u.pn - 16)) * hs + wc * 32 + 8 * fq;
#pragma unroll
            for (int ai = 0; ai < 2; ++ai)
#pragma unroll
                for (int m = 0; m < 4; ++m) { bf16_t* rowp = base + (size_t)(row0 + ai * HALF + m * 16) * 128;
#pragma unroll
                    for (int bj = 0; bj < 2; ++bj) *(u32x4*)(rowp + bj * hs) = pack8(acc[ai][bj][m][0], acc[ai][bj][m][1]); }
        } else {
            const bool isk = u.pn >= 8; const int head = (u.pn - (isk ? 8 : 0)) * 2 + (wc >> 1), qp = wc & 1;
            const bool dorope = u.pm != 0;
            const float* tab = rope + (qp ? 8192 : 0) + 8 * fq; const int sno = qp ? 2048 : 4096;
#pragma unroll
            for (int ai = 0; ai < 2; ++ai)
#pragma unroll
                for (int m = 0; m < 4; ++m) { const int row = row0 + ai * HALF + m * 16;
                    f32x4 a0 = acc[ai][0][m][0], a1 = acc[ai][0][m][1], b0 = acc[ai][1][m][0], b1 = acc[ai][1][m][1];
                    if (dorope) { const int t = row - NCTX, pos = qp ? (t & 63) : (t >> 6); const float* cs = tab + pos * 32;
                        const f32x4 c0 = *(const f32x4*)cs, c1 = *(const f32x4*)(cs + 4), s0 = *(const f32x4*)(cs + sno), s1 = *(const f32x4*)(cs + sno + 4);
                        const f32x4 na0 = a0 * c0 - b0 * s0, na1 = a1 * c1 - b1 * s1, nb0 = b0 * c0 + a0 * s0, nb1 = b1 * c1 + a1 * s1;
                        a0 = na0; a1 = na1; b0 = nb0; b1 = nb1; }
                    bf16_t* dst = isk ? Kb + (size_t)head * hs + (size_t)row * 128 : Q + (size_t)row * DM + head * 128;
                    *(u32x4*)(dst + (2 * qp) * 32 + 8 * fq) = pack8(a0, a1); *(u32x4*)(dst + (2 * qp + 1) * 32 + 8 * fq) = pack8(b0, b1); }
        }
    }
};
struct EpiConv1 {
    static constexpr bool PERM = true;
    bf16_t* GB; bf16_t* PP;
    __device__ __forceinline__ void operator()(const f32x4 (&acc)[2][2][4][2], const Unit& u, int wr, int wc, int fr, int fq) const {
        const int row0 = u.pm * BM + wr * 64 + fr;
        if (u.pn < 8) {
            const int col0 = u.pn * BM + wc * 32 + 8 * fq;
#pragma unroll
            for (int ai = 0; ai < 2; ++ai)
#pragma unroll
                for (int m = 0; m < 4; ++m) { bf16_t* rowp = GB + (size_t)(row0 + ai * HALF + m * 16) * DM + col0;
#pragma unroll
                    for (int bj = 0; bj < 2; ++bj) *(u32x4*)(rowp + bj * HALF) = pack8(acc[ai][bj][m][0], acc[ai][bj][m][1]); }
        } else {
            const int col0 = (u.pn - 8) * HALF + wc * 32 + 8 * fq;
#pragma unroll
            for (int ai = 0; ai < 2; ++ai)
#pragma unroll
                for (int m = 0; m < 4; ++m) { bf16_t* rowp = PP + (size_t)(row0 + ai * HALF + m * 16) * DM + col0;
                    *(u32x4*)rowp = pack8(acc[ai][0][m][0] * acc[ai][1][m][0], acc[ai][0][m][1] * acc[ai][1][m][1]); }
        }
    }
};
struct EpiMoeA {
    static constexpr bool PERM = true;
    bf16_t* ACT;
    __device__ __forceinline__ f32x4 act(const f32x4 g, const f32x4 u) const { f32x4 r;
#pragma unroll
        for (int j = 0; j < 4; ++j) r[j] = g[j] * __builtin_amdgcn_rcpf(1.0f + __expf(-g[j])) * u[j];
        return r; }
    __device__ __forceinline__ void operator()(const f32x4 (&acc)[2][2][4][2], const Unit& u, int wr, int wc, int fr, int fq) const {
        const int row0 = u.pm * BM + wr * 64 + fr, col0 = u.pn * HALF + wc * 32 + 8 * fq;
#pragma unroll
        for (int ai = 0; ai < 2; ++ai)
#pragma unroll
            for (int m = 0; m < 4; ++m) { bf16_t* rowp = ACT + (size_t)(row0 + ai * HALF + m * 16) * EFF + col0;
                *(u32x4*)rowp = pack8(act(acc[ai][0][m][0], acc[ai][1][m][0]), act(acc[ai][0][m][1], acc[ai][1][m][1])); }
    }
};
struct EpiDelta {
    static constexpr bool PERM = true;
    bf16_t* D; int rowbase; int mper; int gcols;
    __device__ __forceinline__ void operator()(const f32x4 (&acc)[2][2][4][2], const Unit& u, int wr, int wc, int fr, int fq) const {
        const int g = u.pm / mper, rt = u.pm - g * mper;
        const int row0 = rowbase + rt * BM + wr * 64 + fr, col0 = g * gcols + u.pn * BM + wc * 32 + 8 * fq;
#pragma unroll
        for (int ai = 0; ai < 2; ++ai)
#pragma unroll
            for (int m = 0; m < 4; ++m) { bf16_t* rowp = D + (size_t)(row0 + ai * HALF + m * 16) * DM + col0;
#pragma unroll
                for (int bj = 0; bj < 2; ++bj) *(u32x4*)(rowp + bj * HALF) = pack8(acc[ai][bj][m][0], acc[ai][bj][m][1]); }
    }
};
struct EpiResid {
    static constexpr bool PERM = false;
    float* X; const float* gate_lat; const float* gate_ctx; const float* colscale; int rowbase; int mper; int gcols;
    __device__ __forceinline__ void operator()(const f32x4 (&acc)[2][2][4][2], const Unit& u, int wr, int wc, int fr, int fq) const {
        const int g = u.pm / mper, rt = u.pm - g * mper;
        const int rowt = rowbase + rt * BM, row0 = rowt + wr * 64 + fr, col0 = g * gcols + u.pn * BM + wc * 32 + 4 * fq;
        const float* gate = (rowt < NCTX) ? gate_ctx : gate_lat;
        f32x4 gv[2][2];
#pragma unroll
        for (int bj = 0; bj < 2; ++bj)
#pragma unroll
            for (int n = 0; n < 2; ++n) { gv[bj][n] = *(const f32x4*)(gate + col0 + bj * HALF + n * 16); if (colscale) gv[bj][n] = gv[bj][n] * *(const f32x4*)(colscale + col0 + bj * HALF + n * 16); }
#pragma unroll
        for (int ai = 0; ai < 2; ++ai)
#pragma unroll
            for (int m = 0; m < 4; ++m) { float* rowp = X + (size_t)(row0 + ai * HALF + m * 16) * DM + col0;
#pragma unroll
                for (int bj = 0; bj < 2; ++bj)
#pragma unroll
                    for (int n = 0; n < 2; ++n) { float* p = rowp + bj * HALF + n * 16; const f32x4 xv = *(const f32x4*)p; *(f32x4*)p = xv * ALPHA + gv[bj][n] * acc[ai][bj][m][n]; }
                asm volatile("" ::: "memory"); }
    }
};

template <class Epi, class Sched, bool ALIGN_EPI, bool SP2>
__device__ __forceinline__ void gemm_phase(LAS unsigned char* lds, const Gemm g, const Sched& S, const Epi& E, const int tid) {
    const int wid = __builtin_amdgcn_readfirstlane(tid >> 6), lane = tid & 63, wr = wid >> 2, wc = wid & 3, fr = lane & 15, fq = lane >> 4;
    const int K = g.K, nt = K / BK;
    unsigned voffA[2], voffB[2];
#pragma unroll
    for (int i = 0; i < 2; ++i) { int R, C; stage_rc(tid * 16 + i * 8192, R, C); const int Rb = Epi::PERM ? ((R & ~31) + perm32(R & 31)) : R;
        voffA[i] = (unsigned)(R * K + C) * 2u; voffB[i] = (unsigned)(Rb * K + C) * 2u; }
    const size_t kstep = (size_t)(BK * 2);
    const size_t hstep = (size_t)HALF * K * 2;
    const size_t tstep = 2 * hstep;
    const size_t bstep = g.bstride * 2;
    const unsigned ldsw = (unsigned)wid * 1024u;
    const int aoff = lds_byte(wr * 64 + fr, fq * 8), boff = lds_byte(wc * 32 + fr, fq * 8);
#define PG8_SA(b, h) (((b) * 2 + (h)) * HTB)
#define PG8_SB(b, h) ((4 + (b) * 2 + (h)) * HTB)
#define PG8_STAGE(bufoff, gbase, voff) do { _Pragma("unroll") for (int _i = 0; _i < 2; ++_i) \
        __builtin_amdgcn_global_load_lds((const unsigned*)((const char*)(gbase) + (voff)[_i]), (LAS unsigned*)(lds + (bufoff) + ldsw + _i * 8192), 16, 0, 0); } while (0)
#define PG8_LDA(dst, b, h) do { _Pragma("unroll") for (int m = 0; m < 4; ++m) _Pragma("unroll") for (int k = 0; k < 2; ++k) dst[m][k] = *(const LAS bf16x8*)(lds + PG8_SA(b, h) + aoff + m * 2048 + k * 1024); } while (0)
#define PG8_LDB(dst, b, h) do { _Pragma("unroll") for (int n = 0; n < 2; ++n) _Pragma("unroll") for (int k = 0; k < 2; ++k) dst[n][k] = *(const LAS bf16x8*)(lds + PG8_SB(b, h) + boff + n * 2048 + k * 1024); } while (0)
#define PG8_MMA(ai, bj, At, Bt) do { __builtin_amdgcn_s_setprio(1); _Pragma("unroll") for (int m = 0; m < 4; ++m) _Pragma("unroll") for (int n = 0; n < 2; ++n) _Pragma("unroll") for (int k = 0; k < 2; ++k) \
        acc[ai][bj][m][n] = __builtin_amdgcn_mfma_f32_16x16x32_bf16(Bt[n][k], At[m][k], acc[ai][bj][m][n], 0, 0, 0); __builtin_amdgcn_s_setprio(0); } while (0)
#define PG8_WAIT_V(n) asm volatile("s_waitcnt vmcnt(" #n ")" ::: "memory")
#define PG8_WAIT_L(n) asm volatile("s_waitcnt lgkmcnt(" #n ")" ::: "memory")
#define PG8_BAR __builtin_amdgcn_s_barrier()
#define PG8_SCHED __builtin_amdgcn_sched_barrier(0)
    Unit cur, nxt; int ui = 0;
    if (!S.next(0, cur)) return;
    f32x4 acc[2][2][4][2];
#pragma unroll
    for (int a = 0; a < 2; ++a)
#pragma unroll
        for (int b = 0; b < 2; ++b)
#pragma unroll
            for (int m = 0; m < 4; ++m)
#pragma unroll
                for (int n = 0; n < 2; ++n) acc[a][b][m][n] = (f32x4){0.f, 0.f, 0.f, 0.f};
    bf16x8 At[4][2], B0[2][2], B1[2][2];
    const char* cA = (const char*)g.A + (size_t)cur.pa * tstep; const char* cB = (const char*)g.Bt + (size_t)cur.bsel * bstep + (size_t)cur.pn * tstep;
    if constexpr (SP2) {
        PG8_STAGE(PG8_SB(0, 0), cB, voffB); PG8_STAGE(PG8_SB(0, 1), cB + hstep, voffB); PG8_STAGE(PG8_SA(0, 0), cA, voffA); PG8_STAGE(PG8_SA(0, 1), cA + hstep, voffA);
        if (wr == 1) PG8_BAR;
        PG8_WAIT_V(2); PG8_BAR;
        PG8_STAGE(PG8_SB(1, 0), cB + kstep, voffB); PG8_STAGE(PG8_SA(1, 0), cA + kstep, voffA); PG8_STAGE(PG8_SB(1, 1), cB + hstep + kstep, voffB);
        PG8_WAIT_V(6); PG8_BAR;
    } else {
        PG8_STAGE(PG8_SB(0, 0), cB, voffB); PG8_STAGE(PG8_SA(0, 0), cA, voffA); PG8_STAGE(PG8_SB(0, 1), cB + hstep, voffB); PG8_STAGE(PG8_SA(0, 1), cA + hstep, voffA);
        if (wr == 1) PG8_BAR;
        PG8_WAIT_V(4); PG8_BAR;
        PG8_STAGE(PG8_SB(1, 0), cB + kstep, voffB); PG8_STAGE(PG8_SA(1, 0), cA + kstep, voffA); PG8_STAGE(PG8_SB(1, 1), cB + hstep + kstep, voffB);
        PG8_WAIT_V(6); PG8_BAR;
    }
    for (;;) {
        const bool has_next = S.next(ui + 1, nxt);
        const char* nA = has_next ? (const char*)g.A + (size_t)nxt.pa * tstep : cA; const char* nB = has_next ? (const char*)g.Bt + (size_t)nxt.bsel * bstep + (size_t)nxt.pn * tstep : cB;
        for (int t = 0; t < nt; t += 2) {
            const bool last = (t == nt - 2);
            const char* a1 = cA + (size_t)(t + 1) * kstep;
            const char* a2 = last ? nA : cA + (size_t)(t + 2) * kstep; const char* b2 = last ? nB : cB + (size_t)(t + 2) * kstep;
            const char* a3 = a2 + kstep; const char* b3 = b2 + kstep;
            if constexpr (SP2) {
            PG8_LDB(B0, 0, 0); PG8_LDB(B1, 0, 1); PG8_SCHED; PG8_LDA(At, 0, 0); PG8_STAGE(PG8_SA(1, 1), a1 + hstep, voffA);
            PG8_WAIT_V(8); PG8_WAIT_L(0); PG8_BAR; PG8_MMA(0, 0, At, B0); PG8_MMA(0, 1, At, B1); PG8_BAR; PG8_SCHED;
            PG8_LDA(At, 0, 1); PG8_STAGE(PG8_SB(0, 0), b2, voffB); PG8_STAGE(PG8_SB(0, 1), b2 + hstep, voffB); PG8_STAGE(PG8_SA(0, 0), a2, voffA);
            PG8_WAIT_V(8); PG8_WAIT_L(0); PG8_BAR; PG8_MMA(1, 0, At, B0); PG8_MMA(1, 1, At, B1); PG8_BAR; PG8_SCHED;
            PG8_LDB(B0, 1, 0); PG8_LDB(B1, 1, 1); PG8_SCHED; PG8_LDA(At, 1, 0); PG8_STAGE(PG8_SA(0, 1), a2 + hstep, voffA);
            PG8_WAIT_V(8); PG8_WAIT_L(0); PG8_BAR; PG8_MMA(0, 0, At, B0); PG8_MMA(0, 1, At, B1); PG8_BAR; PG8_SCHED;
            PG8_LDA(At, 1, 1); PG8_STAGE(PG8_SB(1, 0), b3, voffB); PG8_STAGE(PG8_SB(1, 1), b3 + hstep, voffB); PG8_STAGE(PG8_SA(1, 0), a3, voffA);
            PG8_WAIT_V(8); PG8_WAIT_L(0); PG8_BAR; PG8_MMA(1, 0, At, B0); PG8_MMA(1, 1, At, B1); PG8_BAR; PG8_SCHED;
            } else {
            PG8_LDB(B0, 0, 0); PG8_SCHED; PG8_LDA(At, 0, 0); PG8_STAGE(PG8_SA(1, 1), a1 + hstep, voffA);
            PG8_WAIT_L(8); PG8_BAR; PG8_WAIT_L(0); PG8_MMA(0, 0, At, B0); PG8_BAR; PG8_SCHED;
            PG8_LDB(B1, 0, 1); PG8_STAGE(PG8_SB(0, 0), b2, voffB);
            PG8_BAR; PG8_WAIT_L(0); PG8_MMA(0, 1, At, B1); PG8_BAR;
            PG8_LDA(At, 0, 1); PG8_STAGE(PG8_SA(0, 0), a2, voffA);
            PG8_BAR; PG8_WAIT_L(0); PG8_MMA(1, 0, At, B0); PG8_BAR; PG8_SCHED;
            PG8_STAGE(PG8_SB(0, 1), b2 + hstep, voffB);
            PG8_WAIT_V(6); PG8_BAR; PG8_MMA(1, 1, At, B1); PG8_BAR;
            PG8_LDB(B0, 1, 0); PG8_SCHED; PG8_LDA(At, 1, 0); PG8_STAGE(PG8_SA(0, 1), a2 + hstep, voffA);
            PG8_WAIT_L(8); PG8_BAR; PG8_WAIT_L(0); PG8_MMA(0, 0, At, B0); PG8_BAR; PG8_SCHED;
            PG8_LDB(B1, 1, 1); PG8_STAGE(PG8_SB(1, 0), b3, voffB);
            PG8_BAR; PG8_WAIT_L(0); PG8_MMA(0, 1, At, B1); PG8_BAR;
            PG8_LDA(At, 1, 1); PG8_STAGE(PG8_SA(1, 0), a3, voffA);
            PG8_BAR; PG8_WAIT_L(0); PG8_MMA(1, 0, At, B0); PG8_BAR; PG8_SCHED;
            PG8_STAGE(PG8_SB(1, 1), b3 + hstep, voffB);
            PG8_WAIT_V(6); PG8_BAR; PG8_MMA(1, 1, At, B1); PG8_BAR;
            }
        }
        if constexpr (ALIGN_EPI) { if (wr == 0) PG8_BAR; }
        E(acc, cur, wr, wc, fr, fq);
        if (!has_next) break;
#pragma unroll
        for (int a = 0; a < 2; ++a)
#pragma unroll
            for (int b = 0; b < 2; ++b)
#pragma unroll
                for (int m = 0; m < 4; ++m)
#pragma unroll
                    for (int n = 0; n < 2; ++n) acc[a][b][m][n] = (f32x4){0.f, 0.f, 0.f, 0.f};
        cur = nxt; cA = nA; cB = nB; ++ui;
        if constexpr (ALIGN_EPI) { if (wr == 1) PG8_BAR; }
    }
    PG8_WAIT_V(0);
    if constexpr (!ALIGN_EPI) { if (wr == 0) PG8_BAR; }
    PG8_BAR;
#undef PG8_SA
#undef PG8_SB
#undef PG8_STAGE
#undef PG8_LDA
#undef PG8_LDB
#undef PG8_MMA
#undef PG8_WAIT_V
#undef PG8_WAIT_L
#undef PG8_BAR
#undef PG8_SCHED
}
}

namespace att {
constexpr int D = 128, NW = 8, QBLK = 32, KVBLK = 64;
constexpr float SCALE = 0.088388347648318440f;
constexpr float THR = 8.f;
constexpr size_t SHM_V = KVBLK * D * 2, SHM_K = KVBLK * D * 2, SHM_ATTN = 2 * SHM_V + 2 * SHM_K + NW * 64 * 4;
#define KSWZ(row, colB) ((row) * 256 + ((colB) ^ (((row) & 7) << 4)))
#define SBAR() __builtin_amdgcn_sched_barrier(0)
__device__ __forceinline__ int crow(int r, int hi) { return (r & 3) + 8 * (r >> 2) + 4 * hi; }
__device__ __forceinline__ unsigned cvtpk(float lo, float hi) { unsigned r; asm volatile("v_cvt_pk_bf16_f32 %0, %1, %2" : "=v"(r) : "v"(lo), "v"(hi)); return r; }
__device__ __forceinline__ void partialSM(f32x16& p0, f32x16& p1, float& m_reg, float& mn, float& alpha) {
  constexpr float C = SCALE * 1.4426950408889634f;
  float pmax = p0[0]; for (int r = 1; r < 16; ++r) pmax = fmaxf(pmax, p0[r]); for (int r = 0; r < 16; ++r) pmax = fmaxf(pmax, p1[r]);
  { auto rr = __builtin_amdgcn_permlane32_swap(__float_as_uint(pmax), __float_as_uint(pmax), false, false);
    pmax = fmaxf(__uint_as_float(rr[0]), __uint_as_float(rr[1])); }
  if (__builtin_expect(__all(pmax - m_reg <= THR / SCALE), 1)) { mn = m_reg; alpha = 1.f; }
  else { mn = fmaxf(m_reg, pmax); alpha = __builtin_amdgcn_exp2f((m_reg - mn) * C); m_reg = mn; }
  float mnC = -mn * C;
  for (int r = 0; r < 16; ++r) p0[r] = fmaf(p0[r], C, mnC); for (int r = 0; r < 16; ++r) p1[r] = fmaf(p1[r], C, mnC);
  for (int r = 0; r < 16; ++r) p0[r] = __builtin_amdgcn_exp2f(p0[r]);
}
__device__ __forceinline__ void finishSM(f32x16& p0, f32x16& p1, float alpha, float& l_reg, bf16x8& pa0, bf16x8& pa1, bf16x8& pa2, bf16x8& pa3) {
  for (int r = 0; r < 16; ++r) p1[r] = __builtin_amdgcn_exp2f(p1[r]);
  float ps = 0; for (int r = 0; r < 16; ++r) ps += p0[r]; for (int r = 0; r < 16; ++r) ps += p1[r];
  { auto rr = __builtin_amdgcn_permlane32_swap(__float_as_uint(ps), __float_as_uint(ps), false, false);
    ps = __uint_as_float(rr[0]) + __uint_as_float(rr[1]); }
  l_reg = l_reg * alpha + ps;
#define PK4(P, BASE, OUT) do { unsigned a0 = cvtpk(P[BASE + 0], P[BASE + 1]), a1 = cvtpk(P[BASE + 2], P[BASE + 3]);   \
    unsigned b0 = cvtpk(P[BASE + 4], P[BASE + 5]), b1 = cvtpk(P[BASE + 6], P[BASE + 7]);                              \
    auto r0 = __builtin_amdgcn_permlane32_swap(a0, b0, false, false); auto r1 = __builtin_amdgcn_permlane32_swap(a1, b1, false, false); \
    u32x4 w = {r0[0], r1[0], r0[1], r1[1]}; OUT = *reinterpret_cast<bf16x8*>(&w); } while (0)
  PK4(p0, 0, pa0); PK4(p0, 8, pa1); PK4(p1, 0, pa2); PK4(p1, 8, pa3);
#undef PK4
}
__device__ __forceinline__ void qkt(f32x16& p0, f32x16& p1, const bf16_t* Ks, const bf16x8* qr, int r32, int hi) {
  p0 = f32x16{}; p1 = f32x16{};
  for (int d0 = 0; d0 < 8; ++d0) { int cb = (d0 * 16 + hi * 8) * 2;
    bf16x8 b0 = *reinterpret_cast<const bf16x8*>((const char*)Ks + KSWZ(r32, cb));
    bf16x8 b1 = *reinterpret_cast<const bf16x8*>((const char*)Ks + KSWZ(32 + r32, cb));
    p0 = __builtin_amdgcn_mfma_f32_32x32x16_bf16(b0, qr[d0], p0, 0, 0, 0);
    p1 = __builtin_amdgcn_mfma_f32_32x32x16_bf16(b1, qr[d0], p1, 0, 0, 0); }
}
__device__ __forceinline__ int v_st(int k, int c) { const int kk = (k & ~0xC) | ((k & 4) << 1) | ((k & 8) >> 1); return ((kk >> 3) * 4 + (c >> 5)) * 512 + ((kk & 7) * 32 + (c & 31)) * 2; }
__device__ __forceinline__ int v_rd_base(int lane) { return ((lane & 3) << 3) | (((lane >> 2) & 3) << 6) | (((lane >> 4) & 1) << 5) | (((lane >> 5) & 1) << 8); }
constexpr int v_rd_off(int d0, int ks, int half) { return d0 * 512 + ks * 4096 + half * 2048; }
template <int OFF> __device__ __forceinline__ s16x4 tr_read(int vb) {
  s16x4 r; asm volatile("ds_read_b64_tr_b16 %0, %1 offset:%2" : "=&v"(r) : "v"(vb), "i"(OFF) : "memory"); return r;
}
template <int D0> __device__ __forceinline__ void pv_one(f32x16& od, int vb, bf16x8 pa0, bf16x8 pa1, bf16x8 pa2, bf16x8 pa3) {
  const s16x4 l0 = tr_read<v_rd_off(D0, 0, 0)>(vb), h0 = tr_read<v_rd_off(D0, 0, 1)>(vb), l1 = tr_read<v_rd_off(D0, 1, 0)>(vb), h1 = tr_read<v_rd_off(D0, 1, 1)>(vb);
  const s16x4 l2 = tr_read<v_rd_off(D0, 2, 0)>(vb), h2 = tr_read<v_rd_off(D0, 2, 1)>(vb), l3 = tr_read<v_rd_off(D0, 3, 0)>(vb), h3 = tr_read<v_rd_off(D0, 3, 1)>(vb);
  asm volatile("s_waitcnt lgkmcnt(0)" ::: "memory"); SBAR();
#define PK(L, H) (bf16x8){L[0], L[1], L[2], L[3], H[0], H[1], H[2], H[3]}
  od = __builtin_amdgcn_mfma_f32_32x32x16_bf16(pa0, PK(l0, h0), od, 0, 0, 0);
  od = __builtin_amdgcn_mfma_f32_32x32x16_bf16(pa1, PK(l1, h1), od, 0, 0, 0);
  od = __builtin_amdgcn_mfma_f32_32x32x16_bf16(pa2, PK(l2, h2), od, 0, 0, 0);
  od = __builtin_amdgcn_mfma_f32_32x32x16_bf16(pa3, PK(l3, h3), od, 0, 0, 0);
#undef PK
}
__device__ __forceinline__ void pv_d0(f32x16* o, int vb, bf16x8 pa0, bf16x8 pa1, bf16x8 pa2, bf16x8 pa3) {
  pv_one<0>(o[0], vb, pa0, pa1, pa2, pa3); pv_one<1>(o[1], vb, pa0, pa1, pa2, pa3); pv_one<2>(o[2], vb, pa0, pa1, pa2, pa3); pv_one<3>(o[3], vb, pa0, pa1, pa2, pa3);
}
template <int LDQ, int LDK, int LDV, int LDO>
__device__ __forceinline__ void attn_unit(const bf16_t* __restrict__ Qb, const bf16_t* __restrict__ Kh, const bf16_t* __restrict__ Vh, bf16_t* __restrict__ Ob, int seq, char* lds, const int wid,
                                          const float* qgain = nullptr, const float* rope = nullptr, int qpos0 = -1) {
  const int lane = lane_id_fresh(), tid = wid * 64 + lane, r32 = lane & 31, hi = lane >> 5;
  bf16_t* V_lds = (bf16_t*)lds; bf16_t* K_lds = (bf16_t*)(lds + 2 * SHM_V);
  float* ws = (float*)(lds + 2 * SHM_V + 2 * SHM_K) + wid * 64; float* li_l = ws; float* al_l = ws + 32;
  float m_reg = -1e30f, l_reg = 0; f32x16 o[4] = {}; bf16x8 qr[8];
  { const unsigned offQ = (unsigned)((wid * QBLK + r32) * LDQ + hi * 8) * 2u;
#pragma unroll
  for (int d0 = 0; d0 < 8; ++d0) qr[d0] = *reinterpret_cast<const bf16x8*>((const char*)Qb + offQ + d0 * 32); }
  if (qgain) {
    float x[8][8]; float ss = 0.f;
#pragma unroll
    for (int d0 = 0; d0 < 8; ++d0) { const u32x4 w = *reinterpret_cast<const u32x4*>(&qr[d0]);
#pragma unroll
      for (int q = 0; q < 4; ++q) { x[d0][2 * q] = bf_lo(w[q]); x[d0][2 * q + 1] = bf_hi(w[q]); ss += x[d0][2 * q] * x[d0][2 * q] + x[d0][2 * q + 1] * x[d0][2 * q + 1]; } }
    { auto rr = __builtin_amdgcn_permlane32_swap(__float_as_uint(ss), __float_as_uint(ss), false, false); ss = __uint_as_float(rr[0]) + __uint_as_float(rr[1]); }
    const float rstd = 1.0f / sqrtf(ss * (1.0f / 128.0f) + RMS_EPS);
#pragma unroll
    for (int d0 = 0; d0 < 8; ++d0) { const f32x4 g0 = *(const f32x4*)(qgain + d0 * 16 + hi * 8), g1 = *(const f32x4*)(qgain + d0 * 16 + hi * 8 + 4);
#pragma unroll
      for (int j = 0; j < 4; ++j) { x[d0][j] *= rstd * g0[j]; x[d0][4 + j] *= rstd * g1[j]; } }
    if (qpos0 >= 0) { const int t = qpos0 + wid * QBLK + r32;
#pragma unroll
      for (int pr = 0; pr < 4; ++pr) { const int da = (pr >> 1) * 4 + (pr & 1), db = da + 2;
        const int pos = (pr < 2) ? (t >> 6) : (t & 63); const float* cs = rope + ((pr < 2) ? 0 : 8192) + pos * 32 + (pr & 1) * 16 + hi * 8; const float* sn = cs + ((pr < 2) ? 4096 : 2048);
        const f32x4 c0 = *(const f32x4*)cs, c1 = *(const f32x4*)(cs + 4), s0 = *(const f32x4*)sn, s1 = *(const f32x4*)(sn + 4);
#pragma unroll
        for (int j = 0; j < 8; ++j) { const float c = j < 4 ? c0[j & 3] : c1[j & 3], sv = j < 4 ? s0[j & 3] : s1[j & 3]; const float xa = x[da][j], xb = x[db][j];
          x[da][j] = xa * c - xb * sv; x[db][j] = xb * c + xa * sv; } } }
#pragma unroll
    for (int d0 = 0; d0 < 8; ++d0) { u32x4 w; w.x = cvtpk(x[d0][0], x[d0][1]); w.y = cvtpk(x[d0][2], x[d0][3]); w.z = cvtpk(x[d0][4], x[d0][5]); w.w = cvtpk(x[d0][6], x[d0][7]); qr[d0] = *reinterpret_cast<bf16x8*>(&w); }
  }
  const int sr = tid >> 4, sc = (tid & 15) * 8, vst0 = v_st(sr, sc), vst1 = v_st(32 + sr, sc);
  const int vb0 = (int)(uintptr_t)V_lds + v_rd_base(lane);
  struct { bf16x8 vs0, vs1, ks0, ks1; } sr_[2];
  const int offV = (sr * LDV + sc) * 2, offK = (sr * LDK + sc) * 2;
  const __amdgpu_buffer_rsrc_t rV = __builtin_amdgcn_make_buffer_rsrc((void*)Vh, 0, 0x7ffffff0, 0x00020000);
  const __amdgpu_buffer_rsrc_t rK = __builtin_amdgcn_make_buffer_rsrc((void*)Kh, 0, 0x7ffffff0, 0x00020000);
#define SLOAD(i, k0) do { const int sv_ = (k0) * (LDV * 2), sk_ = (k0) * (LDK * 2); \
    { u32x4 t_ = __builtin_amdgcn_raw_buffer_load_b128(rV, offV, sv_, 0); sr_[i].vs0 = *reinterpret_cast<bf16x8*>(&t_); } \
    { u32x4 t_ = __builtin_amdgcn_raw_buffer_load_b128(rV, offV, sv_ + 32 * LDV * 2, 0); sr_[i].vs1 = *reinterpret_cast<bf16x8*>(&t_); } \
    { u32x4 t_ = __builtin_amdgcn_raw_buffer_load_b128(rK, offK, sk_, 0); sr_[i].ks0 = *reinterpret_cast<bf16x8*>(&t_); } \
    { u32x4 t_ = __builtin_amdgcn_raw_buffer_load_b128(rK, offK, sk_ + 32 * LDK * 2, 0); sr_[i].ks1 = *reinterpret_cast<bf16x8*>(&t_); } } while (0)
#define SWRITE(b, i) do { *(bf16x8*)((char*)V_lds + (b) * SHM_V + vst0) = sr_[i].vs0;          \
    *(bf16x8*)((char*)V_lds + (b) * SHM_V + vst1) = sr_[i].vs1; int kc = sc * 2;               \
    *(bf16x8*)((char*)K_lds + (b) * SHM_K + KSWZ(sr, kc)) = sr_[i].ks0;                       \
    *(bf16x8*)((char*)K_lds + (b) * SHM_K + KSWZ(32 + sr, kc)) = sr_[i].ks1; } while (0)
#define SWAIT() asm volatile("s_waitcnt vmcnt(4)" ::: "memory")
#define RESC(a) do { if (__any((a) < 1.f)) { if (hi == 0) al_l[r32] = (a); asm volatile("s_waitcnt lgkmcnt(0)" ::: "memory"); \
    for (int d = 0; d < 4; ++d) for (int r = 0; r < 16; ++r) o[d][r] *= al_l[crow(r, hi)]; } } while (0)
  f32x16 pA0, pA1, pB0, pB1; float mnA, mnB, alA, alB; bf16x8 pa0, pa1, pa2, pa3; const int NT = seq / KVBLK;
  constexpr int SE = 0, SO = 1;
  SLOAD(SE, 0); asm volatile("s_waitcnt vmcnt(0)" ::: "memory"); SWRITE(0, SE); __syncthreads();
  qkt(pA0, pA1, K_lds, qr, r32, hi); partialSM(pA0, pA1, m_reg, mnA, alA);
  SLOAD(SO, KVBLK); if (2 < NT) SLOAD(SE, 2 * KVBLK);
  SWAIT(); SWRITE(1, SO); __syncthreads();
  for (int j = 1; j + 1 < NT; j += 2) {
    SBAR(); qkt(pB0, pB1, (bf16_t*)((char*)K_lds + SHM_K), qr, r32, hi);
    finishSM(pA0, pA1, alA, l_reg, pa0, pa1, pa2, pa3); SBAR();
    SLOAD(SO, (j + 2) * KVBLK); SBAR();
    pv_d0(o, vb0, pa0, pa1, pa2, pa3); partialSM(pB0, pB1, m_reg, mnB, alB);
    __syncthreads(); SWAIT(); SWRITE(0, SE);
    RESC(alB); __syncthreads();
    SBAR(); qkt(pA0, pA1, K_lds, qr, r32, hi);
    finishSM(pB0, pB1, alB, l_reg, pa0, pa1, pa2, pa3); SBAR();
    if (j + 3 < NT) SLOAD(SE, (j + 3) * KVBLK); SBAR();
    pv_d0(o, vb0 + (int)SHM_V, pa0, pa1, pa2, pa3); partialSM(pA0, pA1, m_reg, mnA, alA);
    __syncthreads(); SWAIT(); SWRITE(1, SO);
    RESC(alA); __syncthreads();
  }
  SBAR(); qkt(pB0, pB1, (bf16_t*)((char*)K_lds + SHM_K), qr, r32, hi);
  finishSM(pA0, pA1, alA, l_reg, pa0, pa1, pa2, pa3); SBAR();
  pv_d0(o, vb0, pa0, pa1, pa2, pa3); partialSM(pB0, pB1, m_reg, mnB, alB);
  __syncthreads(); RESC(alB);
  finishSM(pB0, pB1, alB, l_reg, pa0, pa1, pa2, pa3); SBAR();
  pv_d0(o, vb0 + (int)SHM_V, pa0, pa1, pa2, pa3);
  if (hi == 0) li_l[r32] = l_reg; asm volatile("s_waitcnt lgkmcnt(0)" ::: "memory");
  float rli[16];
#pragma unroll
  for (int r = 0; r < 16; ++r) rli[r] = __builtin_amdgcn_rcpf(li_l[crow(r, hi)]);
#pragma unroll
  for (int r = 0; r < 16; ++r) { const unsigned offO = (unsigned)((wid * QBLK + crow(r, hi)) * LDO + r32) * 2u;
    for (int d0 = 0; d0 < 4; ++d0) { const float v = o[d0][r] * rli[r]; *(bf16_t*)((char*)Ob + offO + d0 * 64) = (bf16_t)(cvtpk(v, v) & 0xffffu); } }
  asm volatile("s_waitcnt vmcnt(0) lgkmcnt(0)" ::: "memory"); __syncthreads();
#undef SLOAD
#undef SWRITE
#undef SWAIT
#undef RESC
}
constexpr size_t SHM_V2 = 2 * SHM_V;
template <int LDQ, int LDK, int LDV, class EPI>
__device__ __forceinline__ void attn_unit2(const bf16_t* __restrict__ Qb, const bf16_t* __restrict__ Kh, const bf16_t* __restrict__ Vh0, const bf16_t* __restrict__ Vh1, int seq, char* lds, const int wid, EPI&& epi) {
  const int lane = lane_id_fresh(), tid = wid * 64 + lane, r32 = lane & 31, hi = lane >> 5;
  bf16_t* V_lds = (bf16_t*)lds; bf16_t* K_lds = (bf16_t*)(lds + 2 * SHM_V2);
  float* ws = (float*)(lds + 2 * SHM_V2 + 2 * SHM_K) + wid * 64; float* li_l = ws; float* al_l = ws + 32;
  float m_reg = -1e30f, l_reg = 0; f32x16 o[8] = {}; bf16x8 qr[8];
  { const unsigned offQ = (unsigned)((wid * QBLK + r32) * LDQ + hi * 8) * 2u;
#pragma unroll
  for (int d0 = 0; d0 < 8; ++d0) qr[d0] = *reinterpret_cast<const bf16x8*>((const char*)Qb + offQ + d0 * 32); }
  const int sr = tid >> 4, sc = (tid & 15) * 8, vst0 = v_st(sr, sc), vst1 = v_st(32 + sr, sc);
  const int vb0 = (int)(uintptr_t)V_lds + v_rd_base(lane);
  const int offV = (sr * LDV + sc) * 2, offK = (sr * LDK + sc) * 2;
  const __amdgpu_buffer_rsrc_t rV0 = __builtin_amdgcn_make_buffer_rsrc((void*)Vh0, 0, 0x7ffffff0, 0x00020000);
  const __amdgpu_buffer_rsrc_t rV1 = __builtin_amdgcn_make_buffer_rsrc((void*)Vh1, 0, 0x7ffffff0, 0x00020000);
  const __amdgpu_buffer_rsrc_t rK = __builtin_amdgcn_make_buffer_rsrc((void*)Kh, 0, 0x7ffffff0, 0x00020000);
  u32x4 sv0, sv1, sv2, sv3, sk0, sk1;
#define SLOAD2(k0) do { const int sv_ = (k0) * (LDV * 2), sk_ = (k0) * (LDK * 2); \
    sv0 = __builtin_amdgcn_raw_buffer_load_b128(rV0, offV, sv_, 0); sv1 = __builtin_amdgcn_raw_buffer_load_b128(rV0, offV, sv_ + 32 * LDV * 2, 0); \
    sv2 = __builtin_amdgcn_raw_buffer_load_b128(rV1, offV, sv_, 0); sv3 = __builtin_amdgcn_raw_buffer_load_b128(rV1, offV, sv_ + 32 * LDV * 2, 0); \
    sk0 = __builtin_amdgcn_raw_buffer_load_b128(rK, offK, sk_, 0); sk1 = __builtin_amdgcn_raw_buffer_load_b128(rK, offK, sk_ + 32 * LDK * 2, 0); } while (0)
#define SWRITE2(b) do { char* vb_ = (char*)V_lds + (b) * SHM_V2; const int kc = sc * 2; \
    *(u32x4*)(vb_ + vst0) = sv0; *(u32x4*)(vb_ + vst1) = sv1; *(u32x4*)(vb_ + SHM_V + vst0) = sv2; *(u32x4*)(vb_ + SHM_V + vst1) = sv3; \
    *(u32x4*)((char*)K_lds + (b) * SHM_K + KSWZ(sr, kc)) = sk0; *(u32x4*)((char*)K_lds + (b) * SHM_K + KSWZ(32 + sr, kc)) = sk1; } while (0)
#define RESC2(a) do { if (__any((a) < 1.f)) { if (hi == 0) al_l[r32] = (a); asm volatile("s_waitcnt lgkmcnt(0)" ::: "memory"); \
    for (int d = 0; d < 8; ++d) for (int r = 0; r < 16; ++r) o[d][r] *= al_l[crow(r, hi)]; } } while (0)
  f32x16 p0, p1; float mn, al; bf16x8 pa0, pa1, pa2, pa3; const int NT = seq / KVBLK;
  SLOAD2(0); SWRITE2(0); __syncthreads();
  for (int j = 0; j < NT; ++j) { const int b = j & 1;
    if (j + 1 < NT) SLOAD2((j + 1) * KVBLK);
    SBAR(); qkt(p0, p1, (bf16_t*)((char*)K_lds + b * SHM_K), qr, r32, hi);
    partialSM(p0, p1, m_reg, mn, al); RESC2(al);
    finishSM(p0, p1, al, l_reg, pa0, pa1, pa2, pa3); SBAR();
    pv_d0(o, vb0 + b * (int)SHM_V2, pa0, pa1, pa2, pa3);
    pv_d0(o + 4, vb0 + b * (int)SHM_V2 + (int)SHM_V, pa0, pa1, pa2, pa3);
    __syncthreads();
    if (j + 1 < NT) SWRITE2(b ^ 1);
    __syncthreads();
  }
  const int le = lane_id_fresh(), r32e = le & 31, hie = le >> 5;
  if (hie == 0) li_l[r32e] = l_reg; asm volatile("s_waitcnt lgkmcnt(0)" ::: "memory");
  float rli[16];
#pragma unroll
  for (int r = 0; r < 16; ++r) rli[r] = __builtin_amdgcn_rcpf(li_l[crow(r, hie)]);
  epi(o, rli, wid, le);
  asm volatile("s_waitcnt vmcnt(0) lgkmcnt(0)" ::: "memory"); __syncthreads();
#undef SLOAD2
#undef SWRITE2
#undef RESC2
}
#undef KSWZ
#undef SBAR
}

#define XB_TMO      128
#define XB_XCNT(j)  (256  + 64 * (j))
#define XB_XSUB(j)  (1280 + 64 * (j))
#define XB_XGEN(j)  (2304 + 64 * (j))
#define XB_TOP      3328
#define XB_TOPGEN   3392
#define XCD_BAR_WORDS 3456
#define XB_SPIN_CAP (1u << 18)
__device__ __forceinline__ unsigned xb_ld(unsigned* p)              { return __hip_atomic_load(p, __ATOMIC_RELAXED, __HIP_MEMORY_SCOPE_AGENT); }
__device__ __forceinline__ unsigned xb_add(unsigned* p, unsigned v) { return __hip_atomic_fetch_add(p, v, __ATOMIC_RELAXED, __HIP_MEMORY_SCOPE_AGENT); }
__device__ __forceinline__ unsigned xb_xcc_id() { return (unsigned)__builtin_amdgcn_s_getreg((3 << 11) | 20) & 0xFu; }
#define XB_SPIN(cond, bar) do { unsigned _sp = 0; while (cond) { __builtin_amdgcn_s_sleep(1); \
    if ((++_sp & 255u) == 0u) { if (xb_ld(&(bar)[XB_TMO])) break; if (_sp > XB_SPIN_CAP) { atomicAdd(&(bar)[XB_TMO], 1u); break; } } } } while (0)
struct XcdBarrier { unsigned* bar; unsigned x; volatile LAS unsigned* st; };
__device__ __forceinline__ XcdBarrier xcd_barrier_post(unsigned* bar, volatile LAS unsigned* st, const int tid) {
    XcdBarrier b; b.bar = bar; b.x = xb_xcc_id(); b.st = st;
    if (tid == 0) (void)xb_add(&bar[XB_XCNT(b.x)], 1u);
    return b;
}
__device__ __forceinline__ void xcd_barrier_complete(unsigned* bar, unsigned x, unsigned& nloc, unsigned& nx) {
    const unsigned G = gridDim.x * gridDim.y * gridDim.z;
    unsigned sum, cnt, mine, sp = 0u;
    for (;;) {
        sum = 0u; cnt = 0u; mine = 0u;
#pragma unroll
        for (unsigned j = 0; j < 16; ++j) { const unsigned c = xb_ld(&bar[XB_XCNT(j)]); sum += c; cnt += (c > 0u) ? 1u : 0u; mine = (j == x) ? c : mine; }
        if (sum == G) break;
        __builtin_amdgcn_s_sleep(1);
        if ((++sp & 255u) == 0u) { if (xb_ld(&bar[XB_TMO])) break; if (sp > XB_SPIN_CAP) { atomicAdd(&bar[XB_TMO], 1u); break; } }
    }
    nloc = mine > 0u ? mine : 1u; nx = cnt > 0u ? cnt : 1u;
}
__device__ __forceinline__ void xcd_barrier(const XcdBarrier& b, const int tid) {
    asm volatile("s_waitcnt vmcnt(0)" ::: "memory");
    __syncthreads();
    if (tid == 0) {
        unsigned* bar = b.bar;
        __builtin_amdgcn_s_waitcnt(0);
        unsigned nloc = b.st[0], nx = b.st[1];
        if (nloc == 0u) { xcd_barrier_complete(bar, b.x, nloc, nx); b.st[0] = nloc; b.st[1] = nx; }
        const unsigned old = xb_add(&bar[XB_XSUB(b.x)], 1u);
        const unsigned gen = old / nloc;
        if (old + 1u == (gen + 1u) * nloc) {
            __builtin_amdgcn_fence(__ATOMIC_RELEASE, "agent");
            asm volatile("s_waitcnt vmcnt(0)" ::: "memory");
            const unsigned og = xb_add(&bar[XB_TOP], 1u);
            const unsigned tg = og / nx;
            if (og + 1u == (tg + 1u) * nx) xb_add(&bar[XB_TOPGEN], 1u);
            else XB_SPIN(xb_ld(&bar[XB_TOPGEN]) == tg, bar);
            __builtin_amdgcn_fence(__ATOMIC_ACQUIRE, "agent");
            xb_add(&bar[XB_XGEN(b.x)], 1u);
            asm volatile("s_waitcnt vmcnt(0)" ::: "memory");
        } else {
            XB_SPIN(xb_ld(&bar[XB_XGEN(b.x)]) == gen, bar);
            __builtin_amdgcn_fence(__ATOMIC_ACQUIRE, "agent");
            asm volatile("s_waitcnt vmcnt(0)" ::: "memory");
        }
    }
    __syncthreads();
}

constexpr int RING_BYTES = 131072;
constexpr int MISC_OFF = RING_BYTES;
constexpr int LDS_BYTES = 147456;

struct RowStats { float mean, rstd; };
__device__ __forceinline__ RowStats ln_stats(const f32x4 (&v)[8]) {
    float s = 0.f;
#pragma unroll
    for (int j = 0; j < 8; ++j) s += (v[j][0] + v[j][1]) + (v[j][2] + v[j][3]);
    const float mean = wave_sum(s) * (1.f / DM); float q = 0.f;
#pragma unroll
    for (int j = 0; j < 8; ++j) { const f32x4 d = v[j] - mean; q += (d[0] * d[0] + d[1] * d[1]) + (d[2] * d[2] + d[3] * d[3]); }
    RowStats r; r.mean = mean; r.rstd = 1.f / sqrtf(wave_sum(q) * (1.f / DM) + LN_EPS); return r;
}
__device__ __forceinline__ void store_bf16x4(bf16_t* p, const f32x4 v) { u32x2 w; w.x = cvt_pk_bf16(v[0], v[1]); w.y = cvt_pk_bf16(v[2], v[3]); *(u32x2*)p = w; }
__device__ __forceinline__ f32x4 load_bf16x4(const bf16_t* p) { const u32x2 w = *(const u32x2*)p; return (f32x4){bf_lo(w.x), bf_hi(w.x), bf_lo(w.y), bf_hi(w.y)}; }

__device__ __forceinline__ void transpose_item(const float* W, int ldw, int scol0, bf16_t* WT, int K, int drow0, int k0, LAS float*  , int lane) {
    const int kr = lane >> 3, n4 = (lane & 7) * 4;
    const float* src = W + (size_t)(k0 + 8 * kr) * ldw + scol0 + n4;
    f32x4 v[8];
#pragma unroll
    for (int i = 0; i < 8; ++i) v[i] = __builtin_nontemporal_load((const f32x4*)(src + (size_t)i * ldw));
    bf16_t* dst = WT + (size_t)(drow0 + n4) * K + k0 + 8 * kr;
#pragma unroll
    for (int q = 0; q < 4; ++q) { u32x4 o; o.x = cvt_pk_bf16(v[0][q], v[1][q]); o.y = cvt_pk_bf16(v[2][q], v[3][q]); o.z = cvt_pk_bf16(v[4][q], v[5][q]); o.w = cvt_pk_bf16(v[6][q], v[7][q]);
        *(u32x4*)(dst + (size_t)q * K) = o; }
}
__device__ __forceinline__ void tr_plain(const float* W, int K, int N, bf16_t* WT, int it, LAS float* scr, int lane) {
    const int nnb = N / 32, kb = it / nnb, nb = it % nnb;
    transpose_item(W, N, 32 * nb, WT, K, 32 * nb, 64 * kb, scr, lane);
}

struct Args { const float* in[27]; float* out; unsigned char* ws; int ph_lo, ph_hi; int probe_dup, pad; };
enum { I_X = 0, I_C, I_CTX, I_CCTX, I_MODW, I_MODB, I_LNG, I_LNB, I_RGW, I_RGB, I_REW, I_REB, I_EG, I_EU, I_ED, I_CIW, I_CW, I_COW, I_PW, I_PS, I_GQW, I_GQN, I_GOW, I_DQW, I_DL, I_DS, I_DOW };

namespace cq {
constexpr int I_GU = 32 * 48, I_DN = 12 * 64, I_EXP = I_GU + I_DN, I_LEXP = 16 * I_EXP;
constexpr int I_PL = 4 * 8 * 16, I_GQ = 32 * 96, I_GO = 32 * 64, I_DQ = 32 * 192, I_DO = 32 * 64;
constexpr int E0 = I_LEXP, E1 = E0 + I_PL, E2 = E1 + I_LEXP, E3 = E2 + I_GQ, E4 = E3 + I_GO, E5 = E4 + I_LEXP, E6 = E5 + I_DQ, E7 = E6 + I_DO, E8 = E7 + I_LEXP;
constexpr int NQ = E8;
}
constexpr int CW_Q = 16384;
struct __attribute__((packed, aligned(4))) F3 { float x, y, z; };
typedef float f32x3u __attribute__((ext_vector_type(3), aligned(4)));
struct TrDesc { const float* W; int ldw, sc; bf16_t* WT; int K, drow, k0; };
__device__ __forceinline__ TrDesc tr_plain_desc(const float* W, int K, int N, bf16_t* WT, int it) { const int nnb = N / 32, kb = it / nnb, nb = it % nnb; return TrDesc{W, N, 32 * nb, WT, K, 32 * nb, 64 * kb}; }
__device__ __forceinline__ TrDesc tr_expert_desc(const Args& a, int L, int r) {
    const int e = r / cq::I_EXP; r -= e * cq::I_EXP; const int le = L * 16 + e;
    if (r < cq::I_GU) {
        const int kb = r / 48, nb = r % 48, n = 32 * nb, pn = n >> 8, bj = (n >> 7) & 1, i = n & 127;
        const float* src = (bj ? a.in[I_EU] : a.in[I_EG]) + (size_t)le * DM * EFF;
        return TrDesc{src, EFF, 128 * pn + i, (bf16_t*)(a.ws + WS_WGU) + (size_t)le * 1536 * DM, DM, n, 64 * kb}; }
    return tr_plain_desc(a.in[I_ED] + (size_t)le * EFF * DM, EFF, DM, (bf16_t*)(a.ws + WS_WDN) + (size_t)le * DM * EFF, r - cq::I_GU);
}
__device__ __forceinline__ TrDesc cvt_queue_desc(const Args& a, int qi) {
    using namespace cq; TrDesc d;
    if (qi < E0) d = tr_expert_desc(a, 0, qi);
    else if (qi < E1) { const int r = qi - E0, g = r / 128; d = tr_plain_desc(a.in[I_PW] + (size_t)g * 512 * 512, 512, 512, (bf16_t*)(a.ws + WS_WPL) + (size_t)g * 512 * 512, r % 128); }
    else if (qi < E2) d = tr_expert_desc(a, 1, qi - E1);
    else if (qi < E3) d = tr_plain_desc(a.in[I_GQW], DM, 3072, (bf16_t*)(a.ws + WS_WGQ), qi - E2);
    else if (qi < E4) d = tr_plain_desc(a.in[I_GOW], DM, DM, (bf16_t*)(a.ws + WS_WGO), qi - E3);
    else if (qi < E5) d = tr_expert_desc(a, 2, qi - E4);
    else if (qi < E6) {
        const int it = qi - E5, kb = it / 192, nb = it % 192, n = 32 * nb; int sc = n;
        if (n < 4096) { const int pn = n >> 8, wi = n & 255, bj = wi >> 7, wc = (wi >> 5) & 3; sc = pn * 256 + (wc >> 1) * 128 + (2 * (wc & 1) + bj) * 32; }
        d = TrDesc{a.in[I_DQW], 3 * DM, sc, (bf16_t*)(a.ws + WS_WDQ), DM, n, 64 * kb}; }
    else if (qi < E7) d = tr_plain_desc(a.in[I_DOW], DM, DM, (bf16_t*)(a.ws + WS_WDO), qi - E6);
    else d = tr_expert_desc(a, 3, qi - E7);
    return d;
}
__device__ __forceinline__ void transpose_pair(const TrDesc& d0, const TrDesc& d1, int lane) {
    const int kr = lane >> 3, n4 = (lane & 7) * 4;
    const float* s0 = d0.W + (size_t)(d0.k0 + 8 * kr) * d0.ldw + d0.sc + n4; const float* s1 = d1.W + (size_t)(d1.k0 + 8 * kr) * d1.ldw + d1.sc + n4;
    f32x4 v0[8], v1[8];
#pragma unroll
    for (int i = 0; i < 8; ++i) v0[i] = *(const f32x4*)(s0 + (size_t)i * d0.ldw);
#pragma unroll
    for (int i = 0; i < 8; ++i) v1[i] = *(const f32x4*)(s1 + (size_t)i * d1.ldw);
    bf16_t* t0 = d0.WT + (size_t)(d0.drow + n4) * d0.K + d0.k0 + 8 * kr; bf16_t* t1 = d1.WT + (size_t)(d1.drow + n4) * d1.K + d1.k0 + 8 * kr;
#pragma unroll
    for (int q = 0; q < 4; ++q) { u32x4 o; o.x = cvt_pk_bf16(v0[0][q], v0[1][q]); o.y = cvt_pk_bf16(v0[2][q], v0[3][q]); o.z = cvt_pk_bf16(v0[4][q], v0[5][q]); o.w = cvt_pk_bf16(v0[6][q], v0[7][q]);
        *(u32x4*)(t0 + (size_t)q * d0.K) = o; }
#pragma unroll
    for (int q = 0; q < 4; ++q) { u32x4 o; o.x = cvt_pk_bf16(v1[0][q], v1[1][q]); o.y = cvt_pk_bf16(v1[2][q], v1[3][q]); o.z = cvt_pk_bf16(v1[4][q], v1[5][q]); o.w = cvt_pk_bf16(v1[6][q], v1[7][q]);
        *(u32x4*)(t1 + (size_t)q * d1.K) = o; }
}
__device__ __forceinline__ void cvt_run(const Args& a, int it, int n, int lane) {
    int k = 0;
    for (; k + 1 < n && it + k + 1 < cq::NQ; k += 2) { const TrDesc d0 = cvt_queue_desc(a, it + k), d1 = cvt_queue_desc(a, it + k + 1); transpose_pair(d0, d1, lane); }
    for (; k < n && it + k < cq::NQ; ++k) { const TrDesc d = cvt_queue_desc(a, it + k); transpose_item(d.W, d.ldw, d.sc, d.WT, d.K, d.drow, d.k0, nullptr, lane); }
}
__device__ __forceinline__ void cvt_opportunistic(const Args& a, int n, LAS unsigned char* lds, int tid, int wave, int lane) {
    if (n <= 0) return;
    unsigned* q = (unsigned*)(a.ws + WS_CTL) + CW_Q; volatile LAS int* qs = (volatile LAS int*)(lds + MISC_OFF + 768);
    __syncthreads();
    if (tid == 0) qs[0] = (int)__hip_atomic_fetch_add(q, (unsigned)(8 * n), __ATOMIC_RELAXED, __HIP_MEMORY_SCOPE_AGENT);
    __syncthreads();
    const int it = __builtin_amdgcn_readfirstlane(qs[0]) + wave * n;
    cvt_run(a, it, n, lane);
}
__device__ __forceinline__ void cvt_catchup(const Args& a, int target, LAS unsigned char* lds, int tid, int wave, int lane) {
    unsigned* q = (unsigned*)(a.ws + WS_CTL) + CW_Q; volatile LAS int* qs = (volatile LAS int*)(lds + MISC_OFF + 768);
    for (;;) {
        __syncthreads();
        if (tid == 0) { int h = (int)__hip_atomic_load(q, __ATOMIC_RELAXED, __HIP_MEMORY_SCOPE_AGENT);
            if (h < target) h = (int)__hip_atomic_fetch_add(q, 64u, __ATOMIC_RELAXED, __HIP_MEMORY_SCOPE_AGENT); else h = 0x7fffffff;
            qs[0] = h; }
        __syncthreads();
        const int base = __builtin_amdgcn_readfirstlane(qs[0]);
        if (base == 0x7fffffff) break;
        const int it = base + wave * 8;
        cvt_run(a, it, 8, lane);
    }
}
__device__ __forceinline__ int idle_units(int nwg, int G, int c) { const int mx = (nwg + G - 1) / G, mine = c < nwg ? (nwg - c + G - 1) / G : 0; return mx - mine; }

__device__ __forceinline__ void ph_prologue(const Args& a, LAS unsigned char* lds, int G, int wave, int lane, int tid) {
    unsigned char* ws = a.ws;
    const int bx = blockIdx.x;
    for (int t = bx; t < 256; t += G) {
        const int L = t >> 6, col0 = (t & 63) * 192;
        LAS float* sl = (LAS float*)lds; LAS float* sx = sl + DM; LAS float* red = sx + DM;
        for (int k = tid; k < DM; k += 512) { const float c = a.in[I_C][k], cc = a.in[I_CCTX][k];
            sl[k] = c / (1.f + __expf(-c)); sx[k] = cc / (1.f + __expf(-cc)); }
        __syncthreads();
        const float* W = a.in[I_MODW] + (size_t)L * DM * NMOD + col0 + 3 * lane;
        float al0 = 0.f, al1 = 0.f, al2 = 0.f, ac0 = 0.f, ac1 = 0.f, ac2 = 0.f;
        const int kb = wave * 256;
#pragma unroll 16
        for (int k = 0; k < 256; ++k) { const f32x3u w = __builtin_nontemporal_load((const f32x3u*)(W + (size_t)(kb + k) * NMOD));     const float s1 = sl[kb + k], s2 = sx[kb + k];
            al0 += w.x * s1; al1 += w.y * s1; al2 += w.z * s1; ac0 += w.x * s2; ac1 += w.y * s2; ac2 += w.z * s2; }
        LAS float* rp = red + (wave * 64 + lane) * 6;
        rp[0] = al0; rp[1] = al1; rp[2] = al2; rp[3] = ac0; rp[4] = ac1; rp[5] = ac2;
        __syncthreads();
        if (tid < 384) { const int which = tid / 192, col = tid % 192; float s_ = 0.f;
#pragma unroll
          for (int w = 0; w < 8; ++w) s_ += red[(w * 64 + col / 3) * 6 + which * 3 + col % 3];
          float* modv = (float*)(ws + WS_MODV);
          modv[(size_t)(L * 2 + which) * NMOD + col0 + col] = s_ + a.in[I_MODB][L * NMOD + col0 + col]; }
        __syncthreads();
    }
    if (bx == 0) {
        float* rope = (float*)(ws + WS_ROPE);
        for (int idx = tid; idx < 6144; idx += 512) {
            const int isc = idx >= 4096, e = isc ? idx - 4096 : idx, pos = e >> 5, i = e & 31;
            const float inv = powf(10000.0f, -(float)(2 * i) / 64.0f), ang = (float)pos * inv;
            float* cs = rope + (isc ? 8192 : 0); const int half = isc ? 2048 : 4096;
            cs[e] = cosf(ang); cs[half + e] = sinf(ang);
        }
    } else if (bx >= 2 && bx < 6) {
        const int L = bx - 2; const float* w = a.in[I_REW] + (size_t)L * DM * 16; float* wt = (float*)(ws + WS_WET) + (size_t)L * 4 * DM * 4;
        for (int idx = tid; idx < DM * 16; idx += 512) { const int c = idx >> 4, e = idx & 15; wt[((size_t)(e >> 2) * DM + c) * 4 + (e & 3)] = w[idx]; }
    } else if (bx == 1) {
        if (wave == 0) {
            const float* lv = a.in[I_DL];
            float s1 = lv[lane] * lv[128 + lane] + lv[64 + lane] * lv[192 + lane];
            float s2 = lv[256 + lane] * lv[384 + lane] + lv[320 + lane] * lv[448 + lane];
            s1 = wave_sum(s1); s2 = wave_sum(s2);
            if (lane == 0) { float* sc = (float*)(ws + WS_SCAL); sc[0] = expf(s1) - expf(s2) + LAM_INIT3; sc[1] = 1.0f - LAM_INIT3; }
        }
        if (tid < 256) ((float*)(ws + WS_SCAL + 1024))[tid] = a.in[I_DS][tid];
    }
    LAS float* scr = (LAS float*)(lds + 32768 + wave * 8448);
    const int gw = bx * 8 + wave, NGW = G * 8;
    constexpr int I_CI = 32 * 192, I_CO = 32 * 64;
    for (int it = gw; it < I_CI + I_CO; it += NGW) {
        int r = it;
        if (r < I_CI) {
            const int kb = r / 192, nb = r % 192, n = 32 * nb; int sc;
            if (n < 2048) sc = n; else { const int q = (n - 2048) >> 8, bj = ((n - 2048) >> 7) & 1, i = n & 127; sc = 2048 + bj * 2048 + 128 * q + i; }
            transpose_item(a.in[I_CIW], 3 * DM, sc, (bf16_t*)(ws + WS_WCI), DM, n, 64 * kb, scr, lane); continue; }
        r -= I_CI;
        tr_plain(a.in[I_COW], DM, DM, (bf16_t*)(ws + WS_WCO), r, scr, lane);
    }
    (void)0;
}

template <int NR>
__device__ __forceinline__ void init_rows(const Args& a, int r0, int rstride, int which) {
    const int lane = lane_id_fresh(); const unsigned lo16 = (unsigned)lane * 16u, lo8 = (unsigned)lane * 8u;
    bf16_t* H = (bf16_t*)(a.ws + WS_H);
    const float* mv = (const float*)(a.ws + WS_MODV) + (size_t)which * NMOD;
    const float* src = which ? a.in[I_CTX] : a.in[I_X] - (size_t)NCTX * DM;
    f32x4 v[NR][8];
#pragma unroll
    for (int k = 0; k < NR; ++k)
#pragma unroll
        for (int j = 0; j < 8; ++j) v[k][j] = ULD4(src, (size_t)(r0 + k * rstride) * (DM * 4) + j * 1024, lo16);
#pragma unroll
    for (int j = 0; j < 8; ++j) { const f32x4 sh = ULD4(mv, j * 1024, lo16), sc = ULD4(mv, DM * 4 + j * 1024, lo16) + 1.0f;
#pragma unroll
        for (int k = 0; k < NR; ++k) { const size_t rb = (size_t)(r0 + k * rstride) * (DM * 4) + j * 1024;
            const f32x4 h = v[k][j] * sc + sh;
            u32x2 w; w.x = cvt_pk_bf16(h[0], h[1]); w.y = cvt_pk_bf16(h[2], h[3]); *(u32x2*)((char*)H + (rb >> 1) + lo8) = w; } }
}
__device__ __forceinline__ void ph_init(const Args& a, int G, int bx, int wave) {
    const int gw = bx * 8 + wave, NGW = G * 8, gwT = wave * G + bx;
    int r = NCTX + gw;
    for (; r + 3 * NGW < MTOT; r += 4 * NGW) init_rows<4>(a, r, NGW, 0);
    for (; r < MTOT; r += NGW) init_rows<1>(a, r, NGW, 0);
    for (int rc = gwT; rc < NCTX; rc += NGW) init_rows<1>(a, rc, NGW, 1);
}

__device__ __forceinline__ void conv_tasks(const bf16_t* __restrict__ GB, const bf16_t* __restrict__ PP, bf16_t* __restrict__ Y, const float* __restrict__ cw, int gw, int NGW, int lane) {
#pragma unroll 2
    for (int tk = gw; tk < MTOT; tk += NGW) {
        const int t0 = (tk >> 2) * 4;
        { const int j = tk & 3;
            const int c = 8 * lane + 512 * j;
            float w0[8], w1[8], w2[8];
#pragma unroll
            for (int i = 0; i < 8; i += 4) { const f32x4 x0 = *(const f32x4*)(cw + c + i), x1 = *(const f32x4*)(cw + DM + c + i), x2 = *(const f32x4*)(cw + 2 * DM + c + i);
                for (int q = 0; q < 4; ++q) { w0[i + q] = x0[q]; w1[i + q] = x1[q]; w2[i + q] = x2[q]; } }
            u32x4 prev = {0u, 0u, 0u, 0u}, cur, nxt;
            if (t0 != 0 && t0 != NCTX) prev = *(const u32x4*)(PP + (size_t)(t0 - 1) * DM + c);
            cur = *(const u32x4*)(PP + (size_t)t0 * DM + c);
#pragma unroll
            for (int i = 0; i < 4; ++i) { const int t = t0 + i;
                nxt = (u32x4){0u, 0u, 0u, 0u}; if (t + 1 != NCTX && t + 1 != MTOT) nxt = *(const u32x4*)(PP + (size_t)(t + 1) * DM + c);
                const u32x4 gb = *(const u32x4*)(GB + (size_t)t * DM + c);
                float y[8];
#pragma unroll
                for (int q = 0; q < 4; ++q) {
                    y[2 * q] = bf_lo(gb[q]) * (w0[2 * q] * bf_lo(prev[q]) + w1[2 * q] * bf_lo(cur[q]) + w2[2 * q] * bf_lo(nxt[q]));
                    y[2 * q + 1] = bf_hi(gb[q]) * (w0[2 * q + 1] * bf_hi(prev[q]) + w1[2 * q + 1] * bf_hi(cur[q]) + w2[2 * q + 1] * bf_hi(nxt[q])); }
                u32x4 o; o.x = cvt_pk_bf16(y[0], y[1]); o.y = cvt_pk_bf16(y[2], y[3]); o.z = cvt_pk_bf16(y[4], y[5]); o.w = cvt_pk_bf16(y[6], y[7]);
                *(u32x4*)(Y + (size_t)t * DM + c) = o; prev = cur; cur = nxt; }
        }
    }
}
__device__ __forceinline__ void ph_conv(const Args& a, int gw, int NGW, int lane) {
    const bf16_t* GB = (const bf16_t*)(a.ws + WS_MIX);
    conv_tasks(GB, GB + (size_t)33 * MiB / 2, (bf16_t*)(a.ws + WS_MIX + 66 * MiB), a.in[I_CW], gw, NGW, lane);
}

template <int GI>
__device__ __forceinline__ void pool_task(const Args& a, int t0, int jj) {
    constexpr int HW = 1 << GI, NRW = 8 + 2 * HW;
    const int lane = lane_id_fresh(); const unsigned lo16 = (unsigned)lane * 16u, lo8 = (unsigned)lane * 8u;
    const float* X = (const float*)(a.ws + WS_X); bf16_t* PO = (bf16_t*)(a.ws + WS_MIX);
    const int which = t0 < NCTX, slo = which ? 0 : NCTX, shi = which ? NCTX : MTOT;
    const float* mv = (const float*)(a.ws + WS_MODV) + (size_t)(2 + which) * NMOD + DM;
    const size_t cb = (size_t)(GI * 512 + 256 * jj) * 4;
    f32x4 xr[NRW];
#pragma unroll
    for (int i = 0; i < NRW; ++i) { const int r = t0 - HW + i; xr[i] = (f32x4){0.f, 0.f, 0.f, 0.f}; if (r >= slo && r < shi) xr[i] = ULD4(X, (size_t)r * (DM * 4) + cb, lo16); }
    const f32x4 sc = ULD4(mv, cb, lo16) + 1.0f;
    f32x4 s = {0.f, 0.f, 0.f, 0.f};
#pragma unroll
    for (int i = 0; i < 2 * HW; ++i) s += xr[i];
#pragma unroll
    for (int o = 0; o < 8; ++o) { const int t = t0 + o; const int lo = (t - HW) > slo ? (t - HW) : slo, hi = (t + HW) < shi ? (t + HW) : shi;
        const f32x4 p = (s * (1.0f / (float)(hi - lo)) - xr[o + HW]) * sc;
        u32x2 w; w.x = cvt_pk_bf16(p[0], p[1]); w.y = cvt_pk_bf16(p[2], p[3]);
        *(u32x2*)((char*)PO + ((size_t)GI * MTOT + t) * 1024 + jj * 512 + lo8) = w;
        if (o < 7) s += xr[o + 2 * HW] - xr[o]; }
}
__device__ __forceinline__ void ph_pool(const Args& a, int gw, int NGW, int  ) {
    int k = 0;
    for (int T = gw; T < MTOT; T += NGW, ++k) { const int strip = T >> 3, sub = ((T & 7) + k) & 7, g = sub >> 1, jj = sub & 1, t0 = strip * 8;
        if (g == 0) pool_task<0>(a, t0, jj); else if (g == 1) pool_task<1>(a, t0, jj); else if (g == 2) pool_task<2>(a, t0, jj); else pool_task<3>(a, t0, jj); }
}

template <bool NORM>
__device__ __forceinline__ void head_pass(bf16_t* p, const float* gain, int quarter, int row, const float* rope, bf16_t* po) {
    u32x4 raw[4], par[4];
#pragma unroll
    for (int k = 0; k < 4; ++k) raw[k] = *(const u32x4*)(p + 8 * k);
    float rstd = 1.0f;
    if (NORM) { float ss = 0.f;
#pragma unroll
        for (int k = 0; k < 4; ++k)
#pragma unroll
            for (int q = 0; q < 4; ++q) { const float lo = bf_lo(raw[k][q]), hi = bf_hi(raw[k][q]); ss += lo * lo + hi * hi; }
        ss += __shfl_xor(ss, 1); ss += __shfl_xor(ss, 2);
        rstd = 1.0f / sqrtf(ss * (1.0f / 128.0f) + RMS_EPS); }
#pragma unroll
    for (int k = 0; k < 4; ++k)
#pragma unroll
        for (int q = 0; q < 4; ++q) par[k][q] = (unsigned)__shfl_xor((int)raw[k][q], 1);
    const bool do_rope = row >= NCTX; const int t = row - NCTX;
    const int pos = (quarter < 2) ? (t >> 6) : (t & 63);
    const float* cs = rope + ((quarter < 2) ? 0 : 8192) + pos * 32; const float* sn = cs + ((quarter < 2) ? 4096 : 2048);
    const float sgn = (quarter & 1) ? 1.0f : -1.0f;
#pragma unroll
    for (int k = 0; k < 4; ++k) {
        float a_[8], b_[8];
#pragma unroll
        for (int q = 0; q < 4; ++q) { a_[2 * q] = bf_lo(raw[k][q]) * rstd; a_[2 * q + 1] = bf_hi(raw[k][q]) * rstd; b_[2 * q] = bf_lo(par[k][q]) * rstd; b_[2 * q + 1] = bf_hi(par[k][q]) * rstd; }
        if (NORM) {
#pragma unroll
            for (int i = 0; i < 8; i += 4) { const f32x4 go = *(const f32x4*)(gain + 32 * quarter + 8 * k + i), gp = *(const f32x4*)(gain + 32 * (quarter ^ 1) + 8 * k + i);
                for (int q = 0; q < 4; ++q) { a_[i + q] *= go[q]; b_[i + q] *= gp[q]; } } }
        float o_[8];
        if (do_rope) {
#pragma unroll
            for (int i = 0; i < 8; i += 4) { const f32x4 c4 = *(const f32x4*)(cs + 8 * k + i), s4 = *(const f32x4*)(sn + 8 * k + i);
                for (int q = 0; q < 4; ++q) o_[i + q] = a_[i + q] * c4[q] + sgn * b_[i + q] * s4[q]; }
        } else {
#pragma unroll
            for (int i = 0; i < 8; ++i) o_[i] = a_[i];
        }
        u32x4 o; o.x = cvt_pk_bf16(o_[0], o_[1]); o.y = cvt_pk_bf16(o_[2], o_[3]); o.z = cvt_pk_bf16(o_[4], o_[5]); o.w = cvt_pk_bf16(o_[6], o_[7]);
        *(u32x4*)(po + 8 * k) = o;
    }
}

#define LLD4(off, lo) (*(const LAS f32x4*)(lds + (off) + (lo)))
__device__ __forceinline__ void ln1_stage(const Args& a, int L, LAS unsigned char* lds, int tid) {
    const float* mv = (const float*)(a.ws + WS_MODV) + (size_t)(L * 2) * NMOD;
    const float* lg_ = a.in[I_LNG] + (size_t)(L * 2 + 0) * DM; const float* lb_ = a.in[I_LNB] + (size_t)(L * 2 + 0) * DM;
    const float* wg = a.in[I_RGW] + (size_t)L * DM * 4; const float* ps = a.in[I_PS];
    LAS f32x4* d = (LAS f32x4*)lds; const int t = tid;
    __syncthreads();
    d[t] = ((const f32x4*)lg_)[t]; d[512 + t] = ((const f32x4*)lb_)[t];
    const f32x4 psv = (L == 1) ? ((const f32x4*)ps)[t] : (f32x4){1.f, 1.f, 1.f, 1.f};
#pragma unroll
    for (int w = 0; w < 2; ++w) { const float* m = mv + (size_t)w * NMOD;
        d[1024 + w * 1536 + t] = ((const f32x4*)(m + 3 * DM))[t]; d[1536 + w * 1536 + t] = ((const f32x4*)(m + 4 * DM))[t] + 1.0f; d[2048 + w * 1536 + t] = ((const f32x4*)(m + 2 * DM))[t] * psv; }
#pragma unroll
    for (int q = 0; q < 4; ++q) d[4096 + q * 512 + t] = ((const f32x4*)wg)[q * 512 + t];
    __syncthreads();
}
struct Ln1Row { f32x4 v[8]; u32x2 dw[8]; };
__device__ __forceinline__ void ln1_load(const Args& a, int L, Ln1Row& R, int r, int which, unsigned lo16, unsigned lo8) {
    const float* X = (L == 0) ? (which ? a.in[I_CTX] : a.in[I_X] - (size_t)NCTX * DM) : (const float*)(a.ws + WS_X);
    const bf16_t* Dm = (const bf16_t*)(a.ws + WS_D);
#pragma unroll
    for (int j = 0; j < 8; ++j) { R.v[j] = ULD4N(X, (size_t)r * (DM * 4) + j * 1024, lo16); R.dw[j] = __builtin_nontemporal_load((const u32x2*)((const char*)Dm + (size_t)r * (DM * 2) + j * 512 + lo8)); }
}
__device__ __forceinline__ void ln1_compute(const Args& a, int L, Ln1Row& R, int r, int which, LAS unsigned char* lds, bool dup, int lane, unsigned lo16, unsigned lo8) {
    bf16_t* HS = (bf16_t*)(a.ws + WS_MOE); bf16_t* XB = (bf16_t*)(a.ws + (dup ? WS_DUMH : WS_H));
    const float* wet = (const float*)(a.ws + WS_WET) + (size_t)L * 4 * DM * 4;
    const float* bg = a.in[I_RGB] + L * 4; const float* be = a.in[I_REB] + L * 16;
    unsigned* cnt = (unsigned*)(a.ws + WS_CTL) + CW_CNT + (dup ? 4 : L) * 16 * 64;
    int* route = (int*)(a.ws + WS_ROUTE + (dup ? 512 * 1024 : 0));
    const unsigned lo64 = (unsigned)lane * 64u, pw = which ? 24576u : 0u;
    asm volatile("" ::: "memory");
#pragma unroll
    for (int j = 0; j < 8; ++j) { const f32x4 g2 = LLD4(32768 + pw + j * 1024, lo16);
        const f32x4 dv = {bf_lo(R.dw[j].x), bf_hi(R.dw[j].x), bf_lo(R.dw[j].y), bf_hi(R.dw[j].y)};
        R.v[j] = R.v[j] * ALPHA + g2 * dv; }
    float s1_[1], q1_[1]; s1_[0] = 0.f;
#pragma unroll
    for (int j = 0; j < 8; ++j) s1_[0] += (R.v[j][0] + R.v[j][1]) + (R.v[j][2] + R.v[j][3]);
    wave_sum_n(s1_, lane);
    const float mean = s1_[0] * (1.f / DM); q1_[0] = 0.f;
#pragma unroll
    for (int j = 0; j < 8; ++j) { const f32x4 d = R.v[j] - mean; q1_[0] += (d[0] * d[0] + d[1] * d[1]) + (d[2] * d[2] + d[3] * d[3]); }
    wave_sum_n(q1_, lane);
    const float rstd = 1.f / sqrtf(q1_[0] * (1.f / DM) + LN_EPS);
    float lg[4] = {0.f, 0.f, 0.f, 0.f};
#pragma unroll
    for (int j = 0; j < 8; ++j) {
        const f32x4 gm = LLD4(j * 1024, lo16), bt = LLD4(8192 + j * 1024, lo16), sh = LLD4(16384 + pw + j * 1024, lo16), sc = LLD4(24576 + pw + j * 1024, lo16);
        f32x4 w4[4];
#pragma unroll
        for (int i = 0; i < 4; ++i) w4[i] = LLD4(65536 + j * 4096 + i * 16, lo64);
        const f32x4 xn = (R.v[j] - mean) * rstd * gm + bt;
        { u32x2 xw_; xw_.x = cvt_pk_bf16(xn[0], xn[1]); xw_.y = cvt_pk_bf16(xn[2], xn[3]); *(u32x2*)((char*)XB + (size_t)r * (DM * 2) + j * 512 + lo8) = xw_; }
        const f32x4 hm = xn * sc + sh; R.v[j] = hm;
#pragma unroll
        for (int i = 0; i < 4; ++i) { lg[0] += hm[i] * w4[i][0]; lg[1] += hm[i] * w4[i][1]; lg[2] += hm[i] * w4[i][2]; lg[3] += hm[i] * w4[i][3]; }
        if (j & 1) asm volatile("" ::: "memory"); }
    wave_sum_n(lg, lane);
    int g_ = 0; float best = lg[0] + bg[0];
#pragma unroll
    for (int q = 1; q < 4; ++q) { const float x = lg[q] + bg[q]; if (x > best) { best = x; g_ = q; } }
    float den = 0.f;
#pragma unroll
    for (int q = 0; q < 4; ++q) den += __expf(lg[q] + bg[q] - best);
    const float pg = 1.0f / den; const int gs = __builtin_amdgcn_readfirstlane(g_);
    float le[4] = {0.f, 0.f, 0.f, 0.f};
#pragma unroll
    for (int j = 0; j < 8; ++j) {
#pragma unroll
        for (int i = 0; i < 4; ++i) { const f32x4 w = ULD4(wet, (size_t)gs * (DM * 16) + j * 4096 + i * 16, lo64); le[0] += R.v[j][i] * w[0]; le[1] += R.v[j][i] * w[1]; le[2] += R.v[j][i] * w[2]; le[3] += R.v[j][i] * w[3]; }
        if ((j & 3) == 3) asm volatile("" ::: "memory"); }
    wave_sum_n(le, lane);
    float l4[4];
#pragma unroll
    for (int q = 0; q < 4; ++q) l4[q] = le[q] + be[gs * 4 + q];
    int i0 = 0; float b0 = l4[0];
#pragma unroll
    for (int q = 1; q < 4; ++q) if (l4[q] > b0) { b0 = l4[q]; i0 = q; }
    int i1 = -1; float b1 = -3.0e38f;
#pragma unroll
    for (int q = 0; q < 4; ++q) if (q != i0 && l4[q] > b1) { b1 = l4[q]; i1 = q; }
    const float tv0 = 1.0f / (1.0f + __expf(b1 - b0));
    const int me0 = gs * 4 + i0, me1 = gs * 4 + i1;
    unsigned p0 = 0u, p1 = 0u;
    if (lane == 0) {
        p0 = __hip_atomic_fetch_add(cnt + me0 * 64, 1u, __ATOMIC_RELAXED, __HIP_MEMORY_SCOPE_AGENT);
        p1 = __hip_atomic_fetch_add(cnt + me1 * 64, 1u, __ATOMIC_RELAXED, __HIP_MEMORY_SCOPE_AGENT);
        int* rp = route + (size_t)r * 8;
        *(u32x4*)rp = (u32x4){(unsigned)me0, (unsigned)me1, p0, p1};
        *(u32x4*)(rp + 4) = (u32x4){__float_as_uint(pg * tv0), __float_as_uint(pg * (1.0f - tv0)), 0u, 0u};
    }
    if (!dup) {
        const size_t d0 = ((size_t)__builtin_amdgcn_readfirstlane(me0) * MTOT + (unsigned)__builtin_amdgcn_readfirstlane((int)p0)) * (DM * 2);
        const size_t d1 = ((size_t)__builtin_amdgcn_readfirstlane(me1) * MTOT + (unsigned)__builtin_amdgcn_readfirstlane((int)p1)) * (DM * 2);
#pragma unroll
        for (int j = 0; j < 8; ++j) { u32x2 w; w.x = cvt_pk_bf16(R.v[j][0], R.v[j][1]); w.y = cvt_pk_bf16(R.v[j][2], R.v[j][3]);
            *(u32x2*)((char*)HS + d0 + j * 512 + lo8) = w; *(u32x2*)((char*)HS + d1 + j * 512 + lo8) = w; }
    }
}
__device__ __forceinline__ void ph_ln1(const Args& a, int L, int rowlo, LAS unsigned char* lds, int tid, int G, int bx, int wave, bool dup = false) {
    const int gw = bx * 8 + wave, NGW = G * 8, gwT = wave * G + bx;
    ln1_stage(a, L, lds, tid);
    int rbase = NCTX + gw;
    for (; rbase + 3 * NGW < MTOT; rbase += 4 * NGW) {
        const int lane = lane_id_fresh(); const unsigned lo16 = (unsigned)lane * 16u, lo8 = (unsigned)lane * 8u;
        Ln1Row A, B;
        ln1_load(a, L, A, rbase, 0, lo16, lo8);
        ln1_load(a, L, B, rbase + NGW, 0, lo16, lo8);
        ln1_compute(a, L, A, rbase, 0, lds, dup, lane, lo16, lo8);
        ln1_load(a, L, A, rbase + 2 * NGW, 0, lo16, lo8);
        ln1_compute(a, L, B, rbase + NGW, 0, lds, dup, lane, lo16, lo8);
        ln1_load(a, L, B, rbase + 3 * NGW, 0, lo16, lo8);
        ln1_compute(a, L, A, rbase + 2 * NGW, 0, lds, dup, lane, lo16, lo8);
        ln1_compute(a, L, B, rbase + 3 * NGW, 0, lds, dup, lane, lo16, lo8);
    }
    for (; rbase < MTOT; rbase += NGW) { const int lane = lane_id_fresh(); const unsigned lo16 = (unsigned)lane * 16u, lo8 = (unsigned)lane * 8u;
        Ln1Row A; ln1_load(a, L, A, rbase, 0, lo16, lo8); ln1_compute(a, L, A, rbase, 0, lds, dup, lane, lo16, lo8); }
    if (rowlo == 0) for (int rc = gwT; rc < NCTX; rc += NGW) { const int lane = lane_id_fresh(); const unsigned lo16 = (unsigned)lane * 16u, lo8 = (unsigned)lane * 8u;
        Ln1Row A; ln1_load(a, L, A, rc, 1, lo16, lo8); ln1_compute(a, L, A, rc, 1, lds, dup, lane, lo16, lo8); }
}

__device__ __forceinline__ void moe_table(const Args& a, int L, LAS unsigned char* lds, int tid) {
    volatile LAS int* tb = (volatile LAS int*)(lds + MISC_OFF + 64); volatile LAS int* t2e = (volatile LAS int*)(lds + MISC_OFF + 192);
    unsigned* cnt = (unsigned*)(a.ws + WS_CTL) + CW_CNT + L * 16 * 64;
    __syncthreads();
    if (tid < 64) {
        int nt = 0;
        if (tid < 16) nt = ((int)__hip_atomic_load(cnt + tid * 64, __ATOMIC_RELAXED, __HIP_MEMORY_SCOPE_AGENT) + 255) >> 8;
        int inc = nt;
#pragma unroll
        for (int o = 1; o < 16; o <<= 1) { const int up = __shfl_up(inc, o); if ((tid & 63) >= o) inc += up; }
        if (tid < 16) { const int ex = inc - nt; tb[tid] = ex < MAXT ? ex : MAXT; if (tid == 15) tb[16] = inc < MAXT ? inc : MAXT; }
    }
    __syncthreads();
    if (tid < 96) { int e = 0;
#pragma unroll
        for (int k = 1; k < 16; ++k) e += (tb[k] <= tid) ? 1 : 0;
        t2e[tid] = e; }
    __syncthreads();
}

__device__ __forceinline__ void ph_gather(const Args& a, int rowlo, LAS unsigned char* lds, int gw, int NGW, int lane) {
    const LAS int* tb = (const LAS int*)(lds + MISC_OFF + 64);
    const bf16_t* H = (const bf16_t*)(a.ws + WS_H); bf16_t* HS = (bf16_t*)(a.ws + WS_MOE);
    const int* route = (const int*)(a.ws + WS_ROUTE);
    for (int r = rowlo + gw; r < MTOT; r += NGW) {
        const u32x4 rt = *(const u32x4*)(route + (size_t)r * 8);
        const size_t s0 = (size_t)tb[rt[0]] * 256 + rt[2], s1 = (size_t)tb[rt[1]] * 256 + rt[3];
        const u32x4* src = (const u32x4*)(H + (size_t)r * DM); u32x4* d0 = (u32x4*)(HS + s0 * DM); u32x4* d1 = (u32x4*)(HS + s1 * DM);
#pragma unroll
        for (int j = 0; j < 4; ++j) { const u32x4 x = src[lane + 64 * j]; d0[lane + 64 * j] = x; d1[lane + 64 * j] = x; }
    }
}

__device__ __forceinline__ void ln2_stage(const Args& a, int L, bool last, LAS unsigned char* lds, int tid) {
    const float* mv = (const float*)(a.ws + WS_MODV) + (size_t)(L * 2) * NMOD;
    const float* mn = (const float*)(a.ws + WS_MODV) + (size_t)((last ? L : L + 1) * 2) * NMOD;
    const float* lg_ = a.in[I_LNG] + (size_t)(L * 2 + 1) * DM; const float* lb_ = a.in[I_LNB] + (size_t)(L * 2 + 1) * DM;
    LAS f32x4* d = (LAS f32x4*)lds; const int t = tid;
    __syncthreads();
    d[t] = ((const f32x4*)lg_)[t]; d[512 + t] = ((const f32x4*)lb_)[t];
#pragma unroll
    for (int w = 0; w < 2; ++w) { const float* m = mv + (size_t)w * NMOD; const float* n = mn + (size_t)w * NMOD;
        d[1024 + w * 1536 + t] = ((const f32x4*)(m + 5 * DM))[t]; d[1536 + w * 1536 + t] = ((const f32x4*)n)[t]; d[2048 + w * 1536 + t] = ((const f32x4*)(n + DM))[t] + 1.0f; }
    __syncthreads();
}
struct Ln2Row { u32x2 xw[8], ya[8], yb[8]; };
__device__ __forceinline__ void ln2_load(const Args& a, Ln2Row& R, int r, int s0, int s1, unsigned lo16, unsigned lo8) {
    const bf16_t* XB = (const bf16_t*)(a.ws + WS_H); const bf16_t* Y2 = (const bf16_t*)(a.ws + WS_MOE + MOE_Y2);
#pragma unroll
    for (int j = 0; j < 8; ++j) { R.xw[j] = __builtin_nontemporal_load((const u32x2*)((const char*)XB + (size_t)r * (DM * 2) + j * 512 + lo8));
        R.ya[j] = __builtin_nontemporal_load((const u32x2*)((const char*)Y2 + (size_t)s0 * (DM * 2) + j * 512 + lo8)); R.yb[j] = __builtin_nontemporal_load((const u32x2*)((const char*)Y2 + (size_t)s1 * (DM * 2) + j * 512 + lo8)); }
}
__device__ __forceinline__ void ln2_compute(const Args& a, int L, Ln2Row& R, int r, float w0, float w1, int which, bool last, LAS unsigned char* lds, bool dup, int lane, unsigned lo16, unsigned lo8) {
    bf16_t* H = (bf16_t*)(a.ws + (dup ? WS_DUMH : WS_H)); float* XO = (float*)(a.ws + (dup ? WS_DUMX : WS_X)); float* OUT = dup ? (float*)(a.ws + WS_DUMX) : a.out;
    const unsigned pw = which ? 24576u : 0u;
    asm volatile("" ::: "memory");
    f32x4 v[8];
#pragma unroll
    for (int j = 0; j < 8; ++j) { const f32x4 g5 = LLD4(16384 + pw + j * 1024, lo16);
        const f32x4 y0 = {bf_lo(R.ya[j].x), bf_hi(R.ya[j].x), bf_lo(R.ya[j].y), bf_hi(R.ya[j].y)}, y1 = {bf_lo(R.yb[j].x), bf_hi(R.yb[j].x), bf_lo(R.yb[j].y), bf_hi(R.yb[j].y)};
        const f32x4 x1 = {bf_lo(R.xw[j].x), bf_hi(R.xw[j].x), bf_lo(R.xw[j].y), bf_hi(R.xw[j].y)};
        v[j] = x1 * ALPHA + g5 * (y0 * w0 + y1 * w1); }
    float s1_[1], q1_[1]; s1_[0] = 0.f;
#pragma unroll
    for (int j = 0; j < 8; ++j) s1_[0] += (v[j][0] + v[j][1]) + (v[j][2] + v[j][3]);
    wave_sum_n(s1_, lane);
    const float mean = s1_[0] * (1.f / DM); q1_[0] = 0.f;
#pragma unroll
    for (int j = 0; j < 8; ++j) { const f32x4 d = v[j] - mean; q1_[0] += (d[0] * d[0] + d[1] * d[1]) + (d[2] * d[2] + d[3] * d[3]); }
    wave_sum_n(q1_, lane);
    const float rstd = 1.f / sqrtf(q1_[0] * (1.f / DM) + LN_EPS);
#pragma unroll
    for (int j = 0; j < 8; ++j) {
        const f32x4 gm = LLD4(j * 1024, lo16), bt = LLD4(8192 + j * 1024, lo16), sh = LLD4(24576 + pw + j * 1024, lo16), sc = LLD4(32768 + pw + j * 1024, lo16);
        const f32x4 xn = (v[j] - mean) * rstd * gm + bt;
        if (last) { UST4(OUT, (size_t)(r - NCTX) * (DM * 4) + j * 1024, lo16, xn); }
        else { UST4N(XO, (size_t)r * (DM * 4) + j * 1024, lo16, xn);
               if (L != 0) { const f32x4 hm = xn * sc + sh;
                   u32x2 w; w.x = cvt_pk_bf16(hm[0], hm[1]); w.y = cvt_pk_bf16(hm[2], hm[3]); *(u32x2*)((char*)H + (size_t)r * (DM * 2) + j * 512 + lo8) = w; } }
        if (j & 1) asm volatile("" ::: "memory"); }
}
__device__ __forceinline__ void ph_ln2(const Args& a, int L, int rowlo, bool last, LAS unsigned char* lds, int tid, int G, int bx, int wave, bool dup = false) {
    const int gw = bx * 8 + wave, NGW = G * 8, gwT = wave * G + bx;
    ln2_stage(a, L, last, lds, tid);
    const LAS int* tb = (const LAS int*)(lds + MISC_OFF + 64);
    const int* route = (const int*)(a.ws + WS_ROUTE);
    int rbase = NCTX + gw;
    for (; rbase + 3 * NGW < MTOT; rbase += 4 * NGW) {
        const int lane = lane_id_fresh(); const unsigned lo16 = (unsigned)lane * 16u, lo8 = (unsigned)lane * 8u;
        int s0[4], s1[4]; float w0[4], w1[4];
#pragma unroll
        for (int i = 0; i < 4; ++i) { const int* rp = route + (size_t)(rbase + i * NGW) * 8; const u32x4 rt = *(const u32x4*)rp; const u32x4 rw = *(const u32x4*)(rp + 4);
            s0[i] = __builtin_amdgcn_readfirstlane(tb[rt[0]] * 256 + (int)rt[2]); s1[i] = __builtin_amdgcn_readfirstlane(tb[rt[1]] * 256 + (int)rt[3]);
            w0[i] = __uint_as_float(__builtin_amdgcn_readfirstlane(rw[0])); w1[i] = __uint_as_float(__builtin_amdgcn_readfirstlane(rw[1])); }
        Ln2Row A, B;
        ln2_load(a, A, rbase, s0[0], s1[0], lo16, lo8);
        ln2_load(a, B, rbase + NGW, s0[1], s1[1], lo16, lo8);
        ln2_compute(a, L, A, rbase, w0[0], w1[0], 0, last, lds, dup, lane, lo16, lo8);
        ln2_load(a, A, rbase + 2 * NGW, s0[2], s1[2], lo16, lo8);
        ln2_compute(a, L, B, rbase + NGW, w0[1], w1[1], 0, last, lds, dup, lane, lo16, lo8);
        ln2_load(a, B, rbase + 3 * NGW, s0[3], s1[3], lo16, lo8);
        ln2_compute(a, L, A, rbase + 2 * NGW, w0[2], w1[2], 0, last, lds, dup, lane, lo16, lo8);
        ln2_compute(a, L, B, rbase + 3 * NGW, w0[3], w1[3], 0, last, lds, dup, lane, lo16, lo8);
    }
    for (; rbase < MTOT; rbase += NGW) {
        const int lane = lane_id_fresh(); const unsigned lo16 = (unsigned)lane * 16u, lo8 = (unsigned)lane * 8u;
        const int* rp = route + (size_t)rbase * 8; const u32x4 rt = *(const u32x4*)rp; const u32x4 rw = *(const u32x4*)(rp + 4);
        const int s0 = __builtin_amdgcn_readfirstlane(tb[rt[0]] * 256 + (int)rt[2]), s1 = __builtin_amdgcn_readfirstlane(tb[rt[1]] * 256 + (int)rt[3]);
        Ln2Row A; ln2_load(a, A, rbase, s0, s1, lo16, lo8);
        ln2_compute(a, L, A, rbase, __uint_as_float(__builtin_amdgcn_readfirstlane(rw[0])), __uint_as_float(__builtin_amdgcn_readfirstlane(rw[1])), 0, last, lds, dup, lane, lo16, lo8);
    }
    if (rowlo == 0) for (int rc = gwT; rc < NCTX; rc += NGW) {
        const int lane = lane_id_fresh(); const unsigned lo16 = (unsigned)lane * 16u, lo8 = (unsigned)lane * 8u;
        const int* rp = route + (size_t)rc * 8; const u32x4 rt = *(const u32x4*)rp; const u32x4 rw = *(const u32x4*)(rp + 4);
        const int s0 = __builtin_amdgcn_readfirstlane(tb[rt[0]] * 256 + (int)rt[2]), s1 = __builtin_amdgcn_readfirstlane(tb[rt[1]] * 256 + (int)rt[3]);
        Ln2Row A; ln2_load(a, A, rc, s0, s1, lo16, lo8);
        ln2_compute(a, L, A, rc, __uint_as_float(__builtin_amdgcn_readfirstlane(rw[0])), __uint_as_float(__builtin_amdgcn_readfirstlane(rw[1])), 1, last, lds, dup, lane, lo16, lo8);
    }
}

constexpr int NPH = 36;
__global__ void __launch_bounds__(512, 2) mega(Args a) {
    extern __shared__ __attribute__((aligned(16))) unsigned char lds_raw[];
    LAS unsigned char* lds = (LAS unsigned char*)lds_raw;
    const int wave = __builtin_amdgcn_readfirstlane((int)threadIdx.x >> 6);
    const int G = gridDim.x, bx = blockIdx.x;
    const int gw = bx * 8 + wave, NGW = G * 8;
    unsigned char* ws = a.ws;
    unsigned* ctl = (unsigned*)(ws + WS_CTL);
#if MK_ONE_LAUNCH
#define PDUP (rp_ != 0)
#else
#define PDUP (a.probe_dup != 0)
#endif
#define FRESH() const int lane = lane_id_fresh(); const int tid = wave * 64 + lane; (void)tid; (void)lane
    { FRESH(); for (int u = tid; u < (LDS_BYTES - MISC_OFF) / 4; u += 512) ((LAS unsigned*)(lds + MISC_OFF))[u] = 0u; }
    __syncthreads();
    const int lo = a.ph_lo, hi = a.ph_hi;
    XcdBarrier bar; bar.bar = ctl + CW_BAR; bar.x = 0; bar.st = (volatile LAS unsigned*)(lds + MISC_OFF);
    if (hi - lo > 1) { FRESH(); bar = xcd_barrier_post(ctl + CW_BAR, (volatile LAS unsigned*)(lds + MISC_OFF), tid); }
#define IN(k) (lo <= (k) && (k) < hi)
#define SEAM(k) do { if (IN(k) && IN((k) + 1)) { FRESH(); xcd_barrier(bar, tid); } } while (0)

    float* X = (float*)(ws + WS_X); bf16_t* H = (bf16_t*)(ws + WS_H);
    const float* modv = (const float*)(ws + WS_MODV);
    unsigned char* mix = ws + WS_MIX; unsigned char* moe = ws + WS_MOE;

#define MOE_TAIL(L, p0, rowlo, last) do { \
    if (IN((p0))) for (int rp_ = 0; rp_ <= REPC((p0)); ++rp_) { FRESH(); cvt_catchup(a, (L) == 0 ? cq::E0 : (L) == 1 ? cq::E2 : (L) == 2 ? cq::E5 : cq::E8, lds, tid, wave, lane); ph_ln1(a, (L), (rowlo), lds, tid, G, bx, wave, PDUP); } SEAM((p0)); \
      \
    if (IN((p0) + 2)) for (int rp_ = 0; rp_ <= REPC((p0) + 2); ++rp_) { FRESH(); moe_table(a, (L), lds, tid); const int T = ((const LAS int*)(lds + MISC_OFF + 64))[16]; \
        pg8::Gemm g{(const bf16_t*)moe, (const bf16_t*)(ws + WS_WGU) + (size_t)(L) * 16 * 1536 * DM, DM, (size_t)1536 * DM}; \
        pg8::MoeOrder S; S.init(T, 6, G, bx); S.t2e = (const LAS int*)(lds + MISC_OFF + 192); S.tb = (const LAS int*)(lds + MISC_OFF + 64); S.sparse_a = true; pg8::EpiMoeA E{(bf16_t*)(moe + MOE_ACT)}; \
        pg8::gemm_phase<pg8::EpiMoeA, pg8::MoeOrder, true, true>(lds, g, S, E, tid); cvt_opportunistic(a, 20 * idle_units(T * 6, G, bx), lds, tid, wave, lane); } SEAM((p0) + 2); \
    if (IN((p0) + 3)) for (int rp_ = 0; rp_ <= REPC((p0) + 3); ++rp_) { FRESH(); moe_table(a, (L), lds, tid); const int T = ((const LAS int*)(lds + MISC_OFF + 64))[16]; \
        pg8::Gemm g{(const bf16_t*)(moe + MOE_ACT), (const bf16_t*)(ws + WS_WDN) + (size_t)(L) * 16 * DM * EFF, EFF, (size_t)DM * EFF}; \
        pg8::MoeOrder S; S.init(T, 8, G, bx); S.t2e = (const LAS int*)(lds + MISC_OFF + 192); S.tb = (const LAS int*)(lds + MISC_OFF + 64); S.sparse_a = false; pg8::EpiQKV E{(bf16_t*)(moe + MOE_Y2), DM, 1 << 20, nullptr, 1 << 20, nullptr, 0}; \
        pg8::gemm_phase<pg8::EpiQKV, pg8::MoeOrder, true, true>(lds, g, S, E, tid); cvt_opportunistic(a, 6 * idle_units(T * 8, G, bx), lds, tid, wave, lane); } SEAM((p0) + 3); \
    if (IN((p0) + 4)) for (int rp_ = 0; rp_ <= REPC((p0) + 4); ++rp_) { FRESH(); if ((L) == 1) cvt_catchup(a, cq::E3, lds, tid, wave, lane); if ((L) == 2) cvt_catchup(a, cq::E6, lds, tid, wave, lane); moe_table(a, (L), lds, tid); ph_ln2(a, (L), (rowlo), (last), lds, tid, G, bx, wave, PDUP); } \
    } while (0)

    if (IN(0)) for (int rp_ = 0; rp_ <= REPC(0); ++rp_) { FRESH(); ph_prologue(a, lds, G, wave, lane, tid); } SEAM(0);
    if (IN(1)) for (int rp_ = 0; rp_ <= REPC(1); ++rp_) { FRESH(); ph_init(a, G, bx, wave); } SEAM(1);
    if (IN(2)) for (int rp_ = 0; rp_ <= REPC(2); ++rp_) { FRESH(); pg8::Gemm g{H, (const bf16_t*)(ws + WS_WCI), DM, 0}; pg8::GridOrder S; S.init(NMT, 24, G, bx);
        pg8::EpiConv1 E{(bf16_t*)mix, (bf16_t*)(mix + 33 * MiB)};
        pg8::gemm_phase<pg8::EpiConv1, pg8::GridOrder, true, true>(lds, g, S, E, tid); cvt_opportunistic(a, 12 * idle_units(NMT * 24, G, bx), lds, tid, wave, lane); } SEAM(2);
    if (IN(3)) for (int rp_ = 0; rp_ <= REPC(3); ++rp_) { FRESH(); ph_conv(a, gw, NGW, lane); } SEAM(3);
    if (IN(4)) for (int rp_ = 0; rp_ <= REPC(4); ++rp_) { FRESH(); pg8::Gemm g{(const bf16_t*)(mix + 66 * MiB), (const bf16_t*)(ws + WS_WCO), DM, 0}; pg8::GridOrder S; S.init(NMT, 8, G, bx);
        pg8::EpiDelta E{(bf16_t*)(ws + WS_D), 0, 1 << 20, 0};
        pg8::gemm_phase<pg8::EpiDelta, pg8::GridOrder, true, true>(lds, g, S, E, tid); cvt_opportunistic(a, 12 * idle_units(NMT * 8, G, bx), lds, tid, wave, lane); } SEAM(4);
    MOE_TAIL(0, 5, 0, false); SEAM(9);
    if (IN(10)) for (int rp_ = 0; rp_ <= REPC(10); ++rp_) { FRESH(); cvt_catchup(a, cq::E1, lds, tid, wave, lane); ph_pool(a, gw, NGW, lane); } SEAM(10);
    if (IN(11)) for (int rp_ = 0; rp_ <= REPC(11); ++rp_) { FRESH(); pg8::Gemm g{(const bf16_t*)mix, (const bf16_t*)(ws + WS_WPL), 512, (size_t)512 * 512}; pg8::PoolOrder S; S.init(4 * NMT, 2, G, bx);
        pg8::EpiDelta E{(bf16_t*)(ws + WS_D), 0, NMT, 512};
        pg8::gemm_phase<pg8::EpiDelta, pg8::PoolOrder, true, true>(lds, g, S, E, tid); cvt_opportunistic(a, 3 * idle_units(4 * NMT * 2, G, bx), lds, tid, wave, lane); } SEAM(11);
    MOE_TAIL(1, 12, 0, false); SEAM(16);
    if (IN(17)) for (int rp_ = 0; rp_ <= REPC(17); ++rp_) { FRESH(); pg8::Gemm g{H, (const bf16_t*)(ws + WS_WGQ), DM, 0}; pg8::GridOrder S; S.init(NMT, 12, G, bx);
        pg8::EpiQKV E{(bf16_t*)mix, DM, 8, (bf16_t*)(mix + 33 * MiB), 10, (bf16_t*)(mix + 42 * MiB), KVHS};
        pg8::gemm_phase<pg8::EpiQKV, pg8::GridOrder, true, true>(lds, g, S, E, tid); cvt_opportunistic(a, 12 * idle_units(NMT * 12, G, bx), lds, tid, wave, lane); } SEAM(17);
    if (IN(18)) for (int rp_ = 0; rp_ <= REPC(18); ++rp_) { FRESH(); cvt_catchup(a, cq::E4, lds, tid, wave, lane);
        bf16_t* Q = (bf16_t*)mix; bf16_t* Kb = (bf16_t*)(mix + 33 * MiB); const float* rope = (const float*)(ws + WS_ROPE);
        const float* gq = a.in[I_GQN]; const float* gk = gq + 128;
        for (int task = gw; task < MTOT / 4; task += NGW) {
            const int r = task * 4 + (lane >> 4); bf16_t* pp = Kb + (size_t)((lane >> 2) & 3) * KVHS + (size_t)r * 128 + (lane & 3) * 32;
            head_pass<true>(pp, gk, lane & 3, r, rope, PDUP ? (bf16_t*)(ws + WS_DUMQ) + (size_t)r * 512 + (lane & 15) * 32 : pp); }
    } SEAM(18);
    if (IN(19)) for (int rp_ = 0; rp_ <= REPC(19); ++rp_) { FRESH();
        const bf16_t* Q = (const bf16_t*)mix; const bf16_t* Kb = (const bf16_t*)(mix + 33 * MiB); const bf16_t* Vb = (const bf16_t*)(mix + 42 * MiB); bf16_t* O = (bf16_t*)(mix + 51 * MiB);
        for (int i = 0;; ++i) { const int idx = i * G + bx; if (idx >= 528) break;
            int h, kvh, row0, seq;
            if (idx < 512) { const int ii = idx >> 8, c = idx & 255, x = c & 7, wl = c >> 3, j = (x >> 2) * 64 + wl * 2 + ii; kvh = x & 3; h = kvh * 4 + (j >> 5); row0 = NCTX + (j & 31) * 256; seq = MTOT; }
            else { h = idx - 512; kvh = h >> 2; row0 = 0; seq = NCTX; }
            att::attn_unit<DM, 128, 128, DM>(Q + (size_t)row0 * DM + h * 128, Kb + (size_t)kvh * KVHS, Vb + (size_t)kvh * KVHS, O + (size_t)row0 * DM + h * 128, seq, (char*)lds_raw, wave, a.in[I_GQN], (const float*)(ws + WS_ROPE), row0 - NCTX);
        }
    } SEAM(19);
    if (IN(20)) for (int rp_ = 0; rp_ <= REPC(20); ++rp_) { FRESH(); pg8::Gemm g{(const bf16_t*)(mix + 51 * MiB), (const bf16_t*)(ws + WS_WGO), DM, 0}; pg8::GridOrder S; S.init(NMT, 8, G, bx);
        pg8::EpiDelta E{(bf16_t*)(ws + WS_D), 0, 1 << 20, 0};
        pg8::gemm_phase<pg8::EpiDelta, pg8::GridOrder, true, true>(lds, g, S, E, tid); cvt_opportunistic(a, 12 * idle_units(NMT * 8, G, bx), lds, tid, wave, lane); } SEAM(20);
    MOE_TAIL(2, 21, 0, false); SEAM(25);
    if (IN(26)) for (int rp_ = 0; rp_ <= REPC(26); ++rp_) { FRESH(); pg8::Gemm g{H, (const bf16_t*)(ws + WS_WDQ), DM, 0}; pg8::GridOrder S; S.init(NMT, 24, G, bx);
        pg8::EpiQKVRope E{(bf16_t*)mix, (bf16_t*)(mix + 33 * MiB), (bf16_t*)(mix + 66 * MiB), KVHS, (const float*)(ws + WS_ROPE)};
        pg8::gemm_phase<pg8::EpiQKVRope, pg8::GridOrder, true, true>(lds, g, S, E, tid); cvt_opportunistic(a, 12 * idle_units(NMT * 24, G, bx), lds, tid, wave, lane); } SEAM(26);
    if (IN(28)) for (int rp_ = 0; rp_ <= REPC(28); ++rp_) { FRESH();
        const bf16_t* Q = (const bf16_t*)mix; const bf16_t* Kb = (const bf16_t*)(mix + 33 * MiB); const bf16_t* Vb = (const bf16_t*)(mix + 66 * MiB);
#pragma unroll 1
        for (int i = 0;; ++i) { const int u = bx + (i >> 1) * G; if (u >= 256) break;
            { const int m = i & 1, h = u & 7, qb = u >> 3;
                auto epi = [&](f32x16 (&o)[8], float (&rli)[16], const int wid, const int le) __attribute__((always_inline)) {
                    int i2 = i; asm volatile("" : "+s"(i2)); const int u2 = bx + (i2 >> 1) * G, m2 = i2 & 1;
                    const int r32e = le & 31, hie = le >> 5;
                    char* st = (char*)a.ws + WS_MIX + 99 * MiB + (size_t)u2 * 131072 + (unsigned)(wid * 16384) + (unsigned)le * 16u;
                    if (m2 == 0) {
#pragma unroll
                        for (int r = 0; r < 16; ++r) { const float s_ = rli[r]; u32x4 w; w.x = cvt_pk_bf16(o[0][r] * s_, o[1][r] * s_); w.y = cvt_pk_bf16(o[2][r] * s_, o[3][r] * s_); w.z = cvt_pk_bf16(o[4][r] * s_, o[5][r] * s_); w.w = cvt_pk_bf16(o[6][r] * s_, o[7][r] * s_);
                            *(u32x4*)(st + r * 1024) = w; }
                    } else {
                        const float lam = __uint_as_float(__hip_atomic_load((unsigned*)(a.ws + WS_SCAL), __ATOMIC_RELAXED, __HIP_MEMORY_SCOPE_AGENT));
                        const float oml = __uint_as_float(__hip_atomic_load((unsigned*)(a.ws + WS_SCAL) + 1, __ATOMIC_RELAXED, __HIP_MEMORY_SCOPE_AGENT));
                        const float* sub = (const float*)(a.ws + WS_SCAL + 1024); char* A2b = (char*)a.ws + WS_MIX + 163 * MiB + ((size_t)((u2 >> 3) * 256) * DM + (u2 & 7) * 256) * 2;
                        float gl[8];
#pragma unroll
                        for (int d0 = 0; d0 < 8; ++d0) gl[d0] = sub[d0 * 32 + r32e];
#pragma unroll
                        for (int r = 0; r < 16; ++r) { if ((r & 3) == 0) asm volatile("" ::: "memory");
                            const unsigned offA = (unsigned)((wid * 32 + att::crow(r, hie)) * DM + r32e) * 2u;
                            const u32x4 w = *(const u32x4*)(st + r * 1024);
                            float d[8]; float ss = 0.f; const float s_ = rli[r] * lam;
                            d[0] = bf_lo(w.x) - o[0][r] * s_; d[1] = bf_hi(w.x) - o[1][r] * s_; d[2] = bf_lo(w.y) - o[2][r] * s_; d[3] = bf_hi(w.y) - o[3][r] * s_;
                            d[4] = bf_lo(w.z) - o[4][r] * s_; d[5] = bf_hi(w.z) - o[5][r] * s_; d[6] = bf_lo(w.w) - o[6][r] * s_; d[7] = bf_hi(w.w) - o[7][r] * s_;
#pragma unroll
                            for (int d0 = 0; d0 < 8; ++d0) ss += d[d0] * d[d0];
#pragma unroll
                            for (int mk = 1; mk < 32; mk <<= 1) ss += __int_as_float(__builtin_amdgcn_ds_bpermute((le ^ mk) << 2, __float_as_int(ss)));
                            const float rs = oml / sqrtf(ss * (1.0f / 256.0f) + RMS_EPS);
#pragma unroll
                            for (int d0 = 0; d0 < 8; ++d0) { const float v = d[d0] * rs * gl[d0]; *(bf16_t*)(A2b + offA + d0 * 64) = (bf16_t)(cvt_pk_bf16(v, v) & 0xffffu); } }
                    }
                };
                att::attn_unit2<DM, 128, 128>(Q + (size_t)(NCTX + qb * 256) * DM + (h * 2 + m) * 128, Kb + (size_t)(h * 2 + m) * KVHS, Vb + (size_t)(h * 2) * KVHS, Vb + (size_t)(h * 2 + 1) * KVHS, MTOT, (char*)lds_raw, wave, epi);
            }
        }
    } SEAM(28);
    if (IN(30)) for (int rp_ = 0; rp_ <= REPC(30); ++rp_) { FRESH(); cvt_catchup(a, cq::E7, lds, tid, wave, lane); pg8::Gemm g{(const bf16_t*)(mix + 163 * MiB), (const bf16_t*)(ws + WS_WDO), DM, 0}; pg8::GridOrder S; S.init(NLAT / 256, 8, G, bx);
        pg8::EpiDelta E{(bf16_t*)(ws + WS_D), NCTX, 1 << 20, 0};
        pg8::gemm_phase<pg8::EpiDelta, pg8::GridOrder, true, true>(lds, g, S, E, tid); } SEAM(30);
    MOE_TAIL(3, 31, NCTX, true);
#undef IN
#undef FRESH
#undef SEAM
#undef MOE_TAIL
}

extern "C" void kernel_launch(void* const* d_in, const int* in_sizes, int n_in, void* d_out, int out_size, void* d_ws, size_t ws_size, hipStream_t stream) {
    static int grid = 0;
    if (grid == 0) {
        if (n_in != 27 || out_size != NLAT * DM || ws_size < WS_END) { fprintf(stderr, "kernel_launch: unexpected shapes (n_in %d out %d ws %zu)\n", n_in, out_size, ws_size); grid = -1; return; }
        int dev = 0, cus = 0, per_cu = 0;
        if (hipGetDevice(&dev) != hipSuccess || hipDeviceGetAttribute(&cus, hipDeviceAttributeMultiprocessorCount, dev) != hipSuccess) { grid = -1; return; }
        if (hipFuncSetAttribute((const void*)mega, hipFuncAttributeMaxDynamicSharedMemorySize, LDS_BYTES) != hipSuccess) { fprintf(stderr, "kernel_launch: hipFuncSetAttribute failed\n"); grid = -1; return; }
        if (hipOccupancyMaxActiveBlocksPerMultiprocessor(&per_cu, (const void*)mega, 512, LDS_BYTES) != hipSuccess || per_cu < 1) fprintf(stderr, "kernel_launch: occupancy query says %d\n", per_cu);
        (void)hipGetLastError();
        grid = cus;
    }
    if (grid < 0) return;
    (void)hipMemsetAsync((char*)d_ws + WS_CTL, 0, CTL_ZERO_BYTES, stream);
    Args a{};
    for (int i = 0; i < 27; ++i) a.in[i] = (const float*)d_in[i];
    a.out = (float*)d_out; a.ws = (unsigned char*)d_ws;
#if MK_ONE_LAUNCH
    a.ph_lo = 0; a.ph_hi = NPH;
    hipLaunchKernelGGL(mega, dim3(grid), dim3(512), LDS_BYTES, stream, a);
#else
    for (int p = 0; p < NPH; ++p) { a.ph_lo = p; a.ph_hi = p + 1; const int reps = 1 + (int)((PROBE_REP_MASK >> p) & 1ull);
        for (int r = 0; r < reps; ++r) { a.probe_dup = r; hipLaunchKernelGGL(mega, dim3(grid), dim3(512), LDS_BYTES, stream, a); } }
#endif
}
```

```cpp
#include <hip/hip_runtime.h>
#include <hip/hip_bf16.h>
#include <cstdio>
#include <cstdint>

#ifndef MK_ONE_LAUNCH
#define MK_ONE_LAUNCH 1
#endif
#ifndef PROBE_REP_MASK
#define PROBE_REP_MASK 0ull
#endif
#if MK_ONE_LAUNCH
#define REPC(k) ((int)((PROBE_REP_MASK >> (k)) & 1ull))
#else
#define REPC(k) 0
#endif

#define LAS __attribute__((address_space(3)))
#define GAS __attribute__((address_space(1)))
typedef unsigned short bf16_t;
typedef short bf16x8 __attribute__((ext_vector_type(8)));
typedef short s16x4 __attribute__((ext_vector_type(4)));
typedef float f32x4 __attribute__((ext_vector_type(4)));
typedef float f32x16 __attribute__((ext_vector_type(16)));
typedef unsigned u32x4 __attribute__((ext_vector_type(4)));
typedef unsigned u32x2 __attribute__((ext_vector_type(2)));

constexpr int DM = 2048, NLAT = 8192, NCTX = 256, MTOT = NLAT + NCTX, NMT = MTOT / 256;
constexpr int NMOD = 6 * DM;
constexpr int EFF = 768, NEXP = 16;
constexpr float ALPHA = 1.6817928305074290f;
constexpr float LN_EPS = 1e-6f, RMS_EPS = 1e-6f;
constexpr float LAM_INIT3 = 0.55605820415f;
constexpr int MAXT = 82;
constexpr size_t KVHS = (size_t)MTOT * 128;

constexpr size_t MiB = 1ull << 20;
constexpr size_t WS_CTL = 0, CTL_ZERO_BYTES = 1 * MiB;
constexpr size_t WS_MODV = 1 * MiB;
constexpr size_t WS_ROPE = 1 * MiB + 512 * 1024;
constexpr size_t WS_SCAL = WS_ROPE + 64 * 1024;
constexpr size_t WS_ROUTE = 2 * MiB;
constexpr size_t WS_WET = 3 * MiB;
constexpr size_t WS_WCI = 4 * MiB, WS_WCO = 28 * MiB, WS_WPL = 36 * MiB, WS_WGQ = 38 * MiB, WS_WGO = 50 * MiB, WS_WDQ = 58 * MiB, WS_WDO = 82 * MiB;
constexpr size_t WS_WGU = 90 * MiB, WS_WDN = 474 * MiB;
constexpr size_t WS_X = 666 * MiB, WS_H = 732 * MiB;
constexpr size_t WS_MIX = 765 * MiB;
constexpr size_t WS_MOE = 965 * MiB;
constexpr size_t MOE_ACT = 528 * MiB, MOE_Y2 = 559 * MiB;
constexpr size_t WS_D = 1606 * MiB;
constexpr size_t WS_END = 1639 * MiB;
constexpr size_t WS_DUMX = 1640 * MiB, WS_DUMH = 1707 * MiB, WS_DUMQ = 1741 * MiB;
constexpr int CW_BAR = 4096;
constexpr int CW_CNT = 8192;

__device__ __forceinline__ unsigned cvt_pk_bf16(float lo, float hi) { unsigned r; asm volatile("v_cvt_pk_bf16_f32 %0, %1, %2" : "=v"(r) : "v"(lo), "v"(hi)); return r; }
__device__ __forceinline__ float bf_lo(unsigned w) { return __uint_as_float(w << 16); }
__device__ __forceinline__ float bf_hi(unsigned w) { return __uint_as_float(w & 0xffff0000u); }
__device__ __forceinline__ float wave_sum(float v) {
#pragma unroll
    for (int o = 1; o < 64; o <<= 1) v += __shfl_xor(v, o);
    return v;
}
template <int N> __device__ __forceinline__ void wave_sum_n(float (&x)[N], const int lane) {
#pragma unroll
    for (int o = 1; o < 64; o <<= 1) { const int idx = (lane ^ o) << 2;
#pragma unroll
        for (int i = 0; i < N; ++i) x[i] += __builtin_bit_cast(float, __builtin_amdgcn_ds_bpermute(idx, __builtin_bit_cast(int, x[i])));
    }
}
__device__ __forceinline__ int lane_id_fresh() { int l; asm volatile("v_mbcnt_lo_u32_b32 %0, -1, 0\n\tv_mbcnt_hi_u32_b32 %0, -1, %0" : "=v"(l)); return l; }
#define ULD4(base, cb, lo) (*(const f32x4*)((const char*)(base) + (size_t)(cb) + (lo)))
#define UST4(base, cb, lo, val) (*(f32x4*)((char*)(base) + (size_t)(cb) + (lo)) = (val))
#define ULD4N(base, cb, lo) __builtin_nontemporal_load((const f32x4*)((const char*)(base) + (size_t)(cb) + (lo)))
#define UST4N(base, cb, lo, val) __builtin_nontemporal_store((val), (f32x4*)((char*)(base) + (size_t)(cb) + (lo)))
#define LDS_WAIT() asm volatile("s_waitcnt lgkmcnt(0)" ::: "memory")
#define VM_WAIT() asm volatile("s_waitcnt vmcnt(0)" ::: "memory")

namespace pg8 {
constexpr int BM = 256, BK = 64, HALF = 128, HTB = HALF * BK * 2, STAGE_BYTES = 8 * HTB, NXCD = 8, WGM = 8;
__host__ __device__ __forceinline__ int lds_byte(int r, int c) { const int st = (r >> 4) * 2 + (c >> 5), rr = r & 15, cc = c & 31, ob = rr * 64 + cc * 2; return st * 1024 + (ob ^ (((ob >> 9) & 1) << 5)); }
__host__ __device__ __forceinline__ void stage_rc(int b, int& R, int& C) { const int st = b / 1024, sb = b % 1024, swz = sb ^ (((sb >> 9) & 1) << 5); R = (st >> 1) * 16 + swz / 64; C = (st & 1) * 32 + (swz % 64) / 2; }
__host__ __device__ __forceinline__ int perm32(int rho) { const int n = rho >> 4, i = rho & 15; return 8 * (i >> 2) + 4 * n + (i & 3); }

struct Unit { int pm, pn, bsel, pa; };
struct Gemm { const bf16_t* A; const bf16_t* Bt; int K; size_t bstride; };

struct GridOrder {
    int nM, nN, nwg, G, c;
    __device__ void init(int nM_, int nN_, int G_, int c_) { nM = nM_; nN = nN_; nwg = nM * nN; G = G_; c = c_; }
    __device__ bool base_next(int i, Unit& u) const {
        const long L = (long)i * G + c; if (L >= nwg) return false;
        int wgid = (int)L; { const int q = nwg / NXCD, r = nwg % NXCD, xcd = wgid % NXCD, off = wgid / NXCD; wgid = (xcd < r ? xcd * (q + 1) : r * (q + 1) + (xcd - r) * q) + off; }
        const int nig = WGM * nN, gid = wgid / nig, fm = gid * WGM, gsz = (nM - fm) < WGM ? (nM - fm) : WGM;
        u.pm = fm + ((wgid % nig) % gsz); u.pn = (wgid % nig) / gsz; u.bsel = 0; u.pa = u.pm; return true;
    }
    __device__ bool next(int i, Unit& u) const { return base_next(i, u); }
};
struct PoolOrder : GridOrder {
    __device__ bool next(int i, Unit& u) const { if (!base_next(i, u)) return false; u.bsel = u.pm / NMT; return true; }
};
struct MoeOrder : GridOrder {
    const LAS int* t2e; const LAS int* tb; bool sparse_a;
    __device__ bool next(int i, Unit& u) const { if (!base_next(i, u)) return false; const int e = __builtin_amdgcn_readfirstlane(t2e[u.pm]); u.bsel = e;
        if (sparse_a) u.pa = e * NMT + (u.pm - __builtin_amdgcn_readfirstlane(tb[e])); return true; }
};

__device__ __forceinline__ u32x4 pack8(const f32x4 v0, const f32x4 v1) { u32x4 w; w.x = cvt_pk_bf16(v0[0], v0[1]); w.y = cvt_pk_bf16(v0[2], v0[3]); w.z = cvt_pk_bf16(v1[0], v1[1]); w.w = cvt_pk_bf16(v1[2], v1[3]); return w; }

struct EpiQKV {
    static constexpr bool PERM = true;
    bf16_t* P0; int ld0; int pn1; bf16_t* P1; int pn2; bf16_t* P2; size_t hs;
    __device__ __forceinline__ void operator()(const f32x4 (&acc)[2][2][4][2], const Unit& u, int wr, int wc, int fr, int fq) const {
        const int row0 = u.pm * BM + wr * 64 + fr;
        if (u.pn < pn1) {
            bf16_t* base = P0 + u.pn * BM + wc * 32 + 8 * fq;
#pragma unroll
            for (int ai = 0; ai < 2; ++ai)
#pragma unroll
                for (int m = 0; m < 4; ++m) { bf16_t* rowp = base + (size_t)(row0 + ai * HALF + m * 16) * ld0;
#pragma unroll
                    for (int bj = 0; bj < 2; ++bj) *(u32x4*)(rowp + bj * HALF) = pack8(acc[ai][bj][m][0], acc[ai][bj][m][1]); }
        } else {
            const bool s1 = u.pn < pn2; bf16_t* base = (s1 ? P1 : P2) + (size_t)(2 * (u.pn - (s1 ? pn1 : pn2))) * hs + wc * 32 + 8 * fq;
#pragma unroll
            for (int ai = 0; ai < 2; ++ai)
#pragma unroll
                for (int m = 0; m < 4; ++m) { bf16_t* rowp = base + (size_t)(row0 + ai * HALF + m * 16) * 128;
#pragma unroll
                    for (int bj = 0; bj < 2; ++bj) *(u32x4*)(rowp + bj * hs) = pack8(acc[ai][bj][m][0], acc[ai][bj][m][1]); }
        }
    }
};
struct EpiQKVRope {
    static constexpr bool PERM = true;
    bf16_t* Q; bf16_t* Kb; bf16_t* Vb; size_t hs; const float* rope;
    __device__ __forceinline__ void operator()(const f32x4 (&acc)[2][2][4][2], const Unit& u, int wr, int wc, int fr, int fq) const {
        const int row0 = u.pm * BM + wr * 64 + fr;
        if (u.pn >= 16) {
            bf16_t* base = Vb + (size_t)(2 * (u.pn - 16)) * hs + wc * 32 + 8 * fq;
#pragma unroll
            for (int ai = 0; ai < 2; ++ai)
#pragma unroll
                for (int m = 0; m < 4; ++m) { bf16_t* rowp = base + (size_t)(row0 + ai * HALF + m * 16) * 128;
#pragma unroll
                    for (int bj = 0; bj < 2; ++bj) *(u32x4*)(rowp + bj * hs) = pack8(acc[ai][bj][m][0], acc[ai][bj][m][1]); }
        } else {
            const bool isk = u.pn >= 8; const int head = (u.pn - (isk ? 8 : 0)) * 2 + (wc >> 1), qp = wc & 1;
            const bool dorope = u.pm != 0;
            const float* tab = rope + (qp ? 8192 : 0) + 8 * fq; const int sno = qp ? 2048 : 4096;
#pragma unroll
            for (int ai = 0; ai < 2; ++ai)
#pragma unroll
                for (int m = 0; m < 4; ++m) { const int row = row0 + ai * HALF + m * 16;
                    f32x4 a0 = acc[ai][0][m][0], a1 = acc[ai][0][m][1], b0 = acc[ai][1][m][0], b1 = acc[ai][1][m][1];
                    if (dorope) { const int t = row - NCTX, pos = qp ? (t & 63) : (t >> 6); const float* cs = tab + pos * 32;
                        const f32x4 c0 = *(const f32x4*)cs, c1 = *(const f32x4*)(cs + 4), s0 = *(const f32x4*)(cs + sno), s1 = *(const f32x4*)(cs + sno + 4);
                        const f32x4 na0 = a0 * c0 - b0 * s0, na1 = a1 * c1 - b1 * s1, nb0 = b0 * c0 + a0 * s0, nb1 = b1 * c1 + a1 * s1;
                        a0 = na0; a1 = na1; b0 = nb0; b1 = nb1; }
                    bf16_t* dst = isk ? Kb + (size_t)head * hs + (size_t)row * 128 : Q + (size_t)row * DM + head * 128;
                    *(u32x4*)(dst + (2 * qp) * 32 + 8 * fq) = pack8(a0, a1); *(u32x4*)(dst + (2 * qp + 1) * 32 + 8 * fq) = pack8(b0, b1); }
        }
    }
};
struct EpiConv1 {
    static constexpr bool PERM = true;
    bf16_t* GB; bf16_t* PP;
    __device__ __forceinline__ void operator()(const f32x4 (&acc)[2][2][4][2], const Unit& u, int wr, int wc, int fr, int fq) const {
        const int row0 = u.pm * BM + wr * 64 + fr;
        if (u.pn < 8) {
            const int col0 = u.pn * BM + wc * 32 + 8 * fq;
#pragma unroll
            for (int ai = 0; ai < 2; ++ai)
#pragma unroll
                for (int m = 0; m < 4; ++m) { bf16_t* rowp = GB + (size_t)(row0 + ai * HALF + m * 16) * DM + col0;
#pragma unroll
                    for (int bj = 0; bj < 2; ++bj) *(u32x4*)(rowp + bj * HALF) = pack8(acc[ai][bj][m][0], acc[ai][bj][m][1]); }
        } else {
            const int col0 = (u.pn - 8) * HALF + wc * 32 + 8 * fq;
#pragma unroll
            for (int ai = 0; ai < 2; ++ai)
#pragma unroll
                for (int m = 0; m < 4; ++m) { bf16_t* rowp = PP + (size_t)(row0 + ai * HALF + m * 16) * DM + col0;
                    *(u32x4*)rowp = pack8(acc[ai][0][m][0] * acc[ai][1][m][0], acc[ai][0][m][1] * acc[ai][1][m][1]); }
        }
    }
};
struct EpiMoeA {
    static constexpr bool PERM = true;
    bf16_t* ACT;
    __device__ __forceinline__ f32x4 act(const f32x4 g, const f32x4 u) const { f32x4 r;
#pragma unroll
        for (int j = 0; j < 4; ++j) r[j] = g[j] * __builtin_amdgcn_rcpf(1.0f + __expf(-g[j])) * u[j];
        return r; }
    __device__ __forceinline__ void operator()(const f32x4 (&acc)[2][2][4][2], const Unit& u, int wr, int wc, int fr, int fq) const {
        const int row0 = u.pm * BM + wr * 64 + fr, col0 = u.pn * HALF + wc * 32 + 8 * fq;
#pragma unroll
        for (int ai = 0; ai < 2; ++ai)
#pragma unroll
            for (int m = 0; m < 4; ++m) { bf16_t* rowp = ACT + (size_t)(row0 + ai * HALF + m * 16) * EFF + col0;
                *(u32x4*)rowp = pack8(act(acc[ai][0][m][0], acc[ai][1][m][0]), act(acc[ai][0][m][1], acc[ai][1][m][1])); }
    }
};
struct EpiDelta {
    static constexpr bool PERM = true;
    bf16_t* D; int rowbase; int mper; int gcols;
    __device__ __forceinline__ void operator()(const f32x4 (&acc)[2][2][4][2], const Unit& u, int wr, int wc, int fr, int fq) const {
        const int g = u.pm / mper, rt = u.pm - g * mper;
        const int row0 = rowbase + rt * BM + wr * 64 + fr, col0 = g * gcols + u.pn * BM + wc * 32 + 8 * fq;
#pragma unroll
        for (int ai = 0; ai < 2; ++ai)
#pragma unroll
            for (int m = 0; m < 4; ++m) { bf16_t* rowp = D + (size_t)(row0 + ai * HALF + m * 16) * DM + col0;
#pragma unroll
                for (int bj = 0; bj < 2; ++bj) *(u32x4*)(rowp + bj * HALF) = pack8(acc[ai][bj][m][0], acc[ai][bj][m][1]); }
    }
};
struct EpiResid {
    static constexpr bool PERM = false;
    float* X; const float* gate_lat; const float* gate_ctx; const float* colscale; int rowbase; int mper; int gcols;
    __device__ __forceinline__ void operator()(const f32x4 (&acc)[2][2][4][2], const Unit& u, int wr, int wc, int fr, int fq) const {
        const int g = u.pm / mper, rt = u.pm - g * mper;
        const int rowt = rowbase + rt * BM, row0 = rowt + wr * 64 + fr, col0 = g * gcols + u.pn * BM + wc * 32 + 4 * fq;
        const float* gate = (rowt < NCTX) ? gate_ctx : gate_lat;
        f32x4 gv[2][2];
#pragma unroll
        for (int bj = 0; bj < 2; ++bj)
#pragma unroll
            for (int n = 0; n < 2; ++n) { gv[bj][n] = *(const f32x4*)(gate + col0 + bj * HALF + n * 16); if (colscale) gv[bj][n] = gv[bj][n] * *(const f32x4*)(colscale + col0 + bj * HALF + n * 16); }
#pragma unroll
        for (int ai = 0; ai < 2; ++ai)
#pragma unroll
            for (int m = 0; m < 4; ++m) { float* rowp = X + (size_t)(row0 + ai * HALF + m * 16) * DM + col0;
#pragma unroll
                for (int bj = 0; bj < 2; ++bj)
#pragma unroll
                    for (int n = 0; n < 2; ++n) { float* p = rowp + bj * HALF + n * 16; const f32x4 xv = *(const f32x4*)p; *(f32x4*)p = xv * ALPHA + gv[bj][n] * acc[ai][bj][m][n]; }
                asm volatile("" ::: "memory"); }
    }
};

template <class Epi, class Sched, bool ALIGN_EPI, bool SP2>
__device__ __forceinline__ void gemm_phase(LAS unsigned char* lds, const Gemm g, const Sched& S, const Epi& E, const int tid) {
    const int wid = __builtin_amdgcn_readfirstlane(tid >> 6), lane = tid & 63, wr = wid >> 2, wc = wid & 3, fr = lane & 15, fq = lane >> 4;
    const int K = g.K, nt = K / BK;
    unsigned voffA[2], voffB[2];
#pragma unroll
    for (int i = 0; i < 2; ++i) { int R, C; stage_rc(tid * 16 + i * 8192, R, C); const int Rb = Epi::PERM ? ((R & ~31) + perm32(R & 31)) : R;
        voffA[i] = (unsigned)(R * K + C) * 2u; voffB[i] = (unsigned)(Rb * K + C) * 2u; }
    const size_t kstep = (size_t)(BK * 2);
    const size_t hstep = (size_t)HALF * K * 2;
    const size_t tstep = 2 * hstep;
    const size_t bstep = g.bstride * 2;
    const unsigned ldsw = (unsigned)wid * 1024u;
    const int aoff = lds_byte(wr * 64 + fr, fq * 8), boff = lds_byte(wc * 32 + fr, fq * 8);
#define PG8_SA(b, h) (((b) * 2 + (h)) * HTB)
#define PG8_SB(b, h) ((4 + (b) * 2 + (h)) * HTB)
#define PG8_STAGE(bufoff, gbase, voff) do { _Pragma("unroll") for (int _i = 0; _i < 2; ++_i) \
        __builtin_amdgcn_global_load_lds((const unsigned*)((const char*)(gbase) + (voff)[_i]), (LAS unsigned*)(lds + (bufoff) + ldsw + _i * 8192), 16, 0, 0); } while (0)
#define PG8_LDA(dst, b, h) do { _Pragma("unroll") for (int m = 0; m < 4; ++m) _Pragma("unroll") for (int k = 0; k < 2; ++k) dst[m][k] = *(const LAS bf16x8*)(lds + PG8_SA(b, h) + aoff + m * 2048 + k * 1024); } while (0)
#define PG8_LDB(dst, b, h) do { _Pragma("unroll") for (int n = 0; n < 2; ++n) _Pragma("unroll") for (int k = 0; k < 2; ++k) dst[n][k] = *(const LAS bf16x8*)(lds + PG8_SB(b, h) + boff + n * 2048 + k * 1024); } while (0)
#define PG8_MMA(ai, bj, At, Bt) do { __builtin_amdgcn_s_setprio(1); _Pragma("unroll") for (int m = 0; m < 4; ++m) _Pragma("unroll") for (int n = 0; n < 2; ++n) _Pragma("unroll") for (int k = 0; k < 2; ++k) \
        acc[ai][bj][m][n] = __builtin_amdgcn_mfma_f32_16x16x32_bf16(Bt[n][k], At[m][k], acc[ai][bj][m][n], 0, 0, 0); __builtin_amdgcn_s_setprio(0); } while (0)
#define PG8_WAIT_V(n) asm volatile("s_waitcnt vmcnt(" #n ")" ::: "memory")
#define PG8_WAIT_L(n) asm volatile("s_waitcnt lgkmcnt(" #n ")" ::: "memory")
#define PG8_BAR __builtin_amdgcn_s_barrier()
#define PG8_SCHED __builtin_amdgcn_sched_barrier(0)
    Unit cur, nxt; int ui = 0;
    if (!S.next(0, cur)) return;
    f32x4 acc[2][2][4][2];
#pragma unroll
    for (int a = 0; a < 2; ++a)
#pragma unroll
        for (int b = 0; b < 2; ++b)
#pragma unroll
            for (int m = 0; m < 4; ++m)
#pragma unroll
                for (int n = 0; n < 2; ++n) acc[a][b][m][n] = (f32x4){0.f, 0.f, 0.f, 0.f};
    bf16x8 At[4][2], B0[2][2], B1[2][2];
    const char* cA = (const char*)g.A + (size_t)cur.pa * tstep; const char* cB = (const char*)g.Bt + (size_t)cur.bsel * bstep + (size_t)cur.pn * tstep;
    if constexpr (SP2) {
        PG8_STAGE(PG8_SB(0, 0), cB, voffB); PG8_STAGE(PG8_SB(0, 1), cB + hstep, voffB); PG8_STAGE(PG8_SA(0, 0), cA, voffA); PG8_STAGE(PG8_SA(0, 1), cA + hstep, voffA);
        if (wr == 1) PG8_BAR;
        PG8_WAIT_V(2); PG8_BAR;
        PG8_STAGE(PG8_SB(1, 0), cB + kstep, voffB); PG8_STAGE(PG8_SA(1, 0), cA + kstep, voffA); PG8_STAGE(PG8_SB(1, 1), cB + hstep + kstep, voffB);
        PG8_WAIT_V(6); PG8_BAR;
    } else {
        PG8_STAGE(PG8_SB(0, 0), cB, voffB); PG8_STAGE(PG8_SA(0, 0), cA, voffA); PG8_STAGE(PG8_SB(0, 1), cB + hstep, voffB); PG8_STAGE(PG8_SA(0, 1), cA + hstep, voffA);
        if (wr == 1) PG8_BAR;
        PG8_WAIT_V(4); PG8_BAR;
        PG8_STAGE(PG8_SB(1, 0), cB + kstep, voffB); PG8_STAGE(PG8_SA(1, 0), cA + kstep, voffA); PG8_STAGE(PG8_SB(1, 1), cB + hstep + kstep, voffB);
        PG8_WAIT_V(6); PG8_BAR;
    }
    for (;;) {
        const bool has_next = S.next(ui + 1, nxt);
        const char* nA = has_next ? (const char*)g.A + (size_t)nxt.pa * tstep : cA; const char* nB = has_next ? (const char*)g.Bt + (size_t)nxt.bsel * bstep + (size_t)nxt.pn * tstep : cB;
        for (int t = 0; t < nt; t += 2) {
            const bool last = (t == nt - 2);
            const char* a1 = cA + (size_t)(t + 1) * kstep;
            const char* a2 = last ? nA : cA + (size_t)(t + 2) * kstep; const char* b2 = last ? nB : cB + (size_t)(t + 2) * kstep;
            const char* a3 = a2 + kstep; const char* b3 = b2 + kstep;
            if constexpr (SP2) {
            PG8_LDB(B0, 0, 0); PG8_LDB(B1, 0, 1); PG8_SCHED; PG8_LDA(At, 0, 0); PG8_STAGE(PG8_SA(1, 1), a1 + hstep, voffA);
            PG8_WAIT_V(8); PG8_WAIT_L(0); PG8_BAR; PG8_MMA(0, 0, At, B0); PG8_MMA(0, 1, At, B1); PG8_BAR; PG8_SCHED;
            PG8_LDA(At, 0, 1); PG8_STAGE(PG8_SB(0, 0), b2, voffB); PG8_STAGE(PG8_SB(0, 1), b2 + hstep, voffB); PG8_STAGE(PG8_SA(0, 0), a2, voffA);
            PG8_WAIT_V(8); PG8_WAIT_L(0); PG8_BAR; PG8_MMA(1, 0, At, B0); PG8_MMA(1, 1, At, B1); PG8_BAR; PG8_SCHED;
            PG8_LDB(B0, 1, 0); PG8_LDB(B1, 1, 1); PG8_SCHED; PG8_LDA(At, 1, 0); PG8_STAGE(PG8_SA(0, 1), a2 + hstep, voffA);
            PG8_WAIT_V(8); PG8_WAIT_L(0); PG8_BAR; PG8_MMA(0, 0, At, B0); PG8_MMA(0, 1, At, B1); PG8_BAR; PG8_SCHED;
            PG8_LDA(At, 1, 1); PG8_STAGE(PG8_SB(1, 0), b3, voffB); PG8_STAGE(PG8_SB(1, 1), b3 + hstep, voffB); PG8_STAGE(PG8_SA(1, 0), a3, voffA);
            PG8_WAIT_V(8); PG8_WAIT_L(0); PG8_BAR; PG8_MMA(1, 0, At, B0); PG8_MMA(1, 1, At, B1); PG8_BAR; PG8_SCHED;
            } else {
            PG8_LDB(B0, 0, 0); PG8_SCHED; PG8_LDA(At, 0, 0); PG8_STAGE(PG8_SA(1, 1), a1 + hstep, voffA);
            PG8_WAIT_L(8); PG8_BAR; PG8_WAIT_L(0); PG8_MMA(0, 0, At, B0); PG8_BAR; PG8_SCHED;
            PG8_LDB(B1, 0, 1); PG8_STAGE(PG8_SB(0, 0), b2, voffB);
            PG8_BAR; PG8_WAIT_L(0); PG8_MMA(0, 1, At, B1); PG8_BAR;
            PG8_LDA(At, 0, 1); PG8_STAGE(PG8_SA(0, 0), a2, voffA);
            PG8_BAR; PG8_WAIT_L(0); PG8_MMA(1, 0, At, B0); PG8_BAR; PG8_SCHED;
            PG8_STAGE(PG8_SB(0, 1), b2 + hstep, voffB);
            PG8_WAIT_V(6); PG8_BAR; PG8_MMA(1, 1, At, B1); PG8_BAR;
            PG8_LDB(B0, 1, 0); PG8_SCHED; PG8_LDA(At, 1, 0); PG8_STAGE(PG8_SA(0, 1), a2 + hstep, voffA);
            PG8_WAIT_L(8); PG8_BAR; PG8_WAIT_L(0); PG8_MMA(0, 0, At, B0); PG8_BAR; PG8_SCHED;
            PG8_LDB(B1, 1, 1); PG8_STAGE(PG8_SB(1, 0), b3, voffB);
            PG8_BAR; PG8_WAIT_L(0); PG8_MMA(0, 1, At, B1); PG8_BAR;
            PG8_LDA(At, 1, 1); PG8_STAGE(PG8_SA(1, 0), a3, voffA);
            PG8_BAR; PG8_WAIT_L(0); PG8_MMA(1, 0, At, B0); PG8_BAR; PG8_SCHED;
            PG8_STAGE(PG8_SB(1, 1), b3 + hstep, voffB);
            PG8_WAIT_V(6); PG8_BAR; PG8_MMA(1, 1, At, B1); PG8_BAR;
            }
        }
        if constexpr (ALIGN_EPI) { if (wr == 0) PG8_BAR; }
        E(acc, cur, wr, wc, fr, fq);
        if (!has_next) break;
#pragma unroll
        for (int a = 0; a < 2; ++a)
#pragma unroll
            for (int b = 0; b < 2; ++b)
#pragma unroll
                for (int m = 0; m < 4; ++m)
#pragma unroll
                    for (int n = 0; n < 2; ++n) acc[a][b][m][n] = (f32x4){0.f, 0.f, 0.f, 0.f};
        cur = nxt; cA = nA; cB = nB; ++ui;
        if constexpr (ALIGN_EPI) { if (wr == 1) PG8_BAR; }
    }
    PG8_WAIT_V(0);
    if constexpr (!ALIGN_EPI) { if (wr == 0) PG8_BAR; }
    PG8_BAR;
#undef PG8_SA
#undef PG8_SB
#undef PG8_STAGE
#undef PG8_LDA
#undef PG8_LDB
#undef PG8_MMA
#undef PG8_WAIT_V
#undef PG8_WAIT_L
#undef PG8_BAR
#undef PG8_SCHED
}
}

namespace att {
constexpr int D = 128, NW = 8, QBLK = 32, KVBLK = 64;
constexpr float SCALE = 0.088388347648318440f;
constexpr float THR = 8.f;
constexpr size_t SHM_V = KVBLK * D * 2, SHM_K = KVBLK * D * 2, SHM_ATTN = 2 * SHM_V + 2 * SHM_K + NW * 64 * 4;
#define KSWZ(row, colB) ((row) * 256 + ((colB) ^ (((row) & 7) << 4)))
#define SBAR() __builtin_amdgcn_sched_barrier(0)
__device__ __forceinline__ int crow(int r, int hi) { return (r & 3) + 8 * (r >> 2) + 4 * hi; }
__device__ __forceinline__ unsigned cvtpk(float lo, float hi) { unsigned r; asm volatile("v_cvt_pk_bf16_f32 %0, %1, %2" : "=v"(r) : "v"(lo), "v"(hi)); return r; }
__device__ __forceinline__ void partialSM(f32x16& p0, f32x16& p1, float& m_reg, float& mn, float& alpha) {
  constexpr float C = SCALE * 1.4426950408889634f;
  float pmax = p0[0]; for (int r = 1; r < 16; ++r) pmax = fmaxf(pmax, p0[r]); for (int r = 0; r < 16; ++r) pmax = fmaxf(pmax, p1[r]);
  { auto rr = __builtin_amdgcn_permlane32_swap(__float_as_uint(pmax), __float_as_uint(pmax), false, false);
    pmax = fmaxf(__uint_as_float(rr[0]), __uint_as_float(rr[1])); }
  if (__builtin_expect(__all(pmax - m_reg <= THR / SCALE), 1)) { mn = m_reg; alpha = 1.f; }
  else { mn = fmaxf(m_reg, pmax); alpha = __builtin_amdgcn_exp2f((m_reg - mn) * C); m_reg = mn; }
  float mnC = -mn * C;
  for (int r = 0; r < 16; ++r) p0[r] = fmaf(p0[r], C, mnC); for (int r = 0; r < 16; ++r) p1[r] = fmaf(p1[r], C, mnC);
  for (int r = 0; r < 16; ++r) p0[r] = __builtin_amdgcn_exp2f(p0[r]);
}
__device__ __forceinline__ void finishSM(f32x16& p0, f32x16& p1, float alpha, float& l_reg, bf16x8& pa0, bf16x8& pa1, bf16x8& pa2, bf16x8& pa3) {
  for (int r = 0; r < 16; ++r) p1[r] = __builtin_amdgcn_exp2f(p1[r]);
  float ps = 0; for (int r = 0; r < 16; ++r) ps += p0[r]; for (int r = 0; r < 16; ++r) ps += p1[r];
  { auto rr = __builtin_amdgcn_permlane32_swap(__float_as_uint(ps), __float_as_uint(ps), false, false);
    ps = __uint_as_float(rr[0]) + __uint_as_float(rr[1]); }
  l_reg = l_reg * alpha + ps;
#define PK4(P, BASE, OUT) do { unsigned a0 = cvtpk(P[BASE + 0], P[BASE + 1]), a1 = cvtpk(P[BASE + 2], P[BASE + 3]);   \
    unsigned b0 = cvtpk(P[BASE + 4], P[BASE + 5]), b1 = cvtpk(P[BASE + 6], P[BASE + 7]);                              \
    auto r0 = __builtin_amdgcn_permlane32_swap(a0, b0, false, false); auto r1 = __builtin_amdgcn_permlane32_swap(a1, b1, false, false); \
    u32x4 w = {r0[0], r1[0], r0[1], r1[1]}; OUT = *reinterpret_cast<bf16x8*>(&w); } while (0)
  PK4(p0, 0, pa0); PK4(p0, 8, pa1); PK4(p1, 0, pa2); PK4(p1, 8, pa3);
#undef PK4
}
__device__ __forceinline__ void qkt(f32x16& p0, f32x16& p1, const bf16_t* Ks, const bf16x8* qr, int r32, int hi) {
  p0 = f32x16{}; p1 = f32x16{};
  for (int d0 = 0; d0 < 8; ++d0) { int cb = (d0 * 16 + hi * 8) * 2;
    bf16x8 b0 = *reinterpret_cast<const bf16x8*>((const char*)Ks + KSWZ(r32, cb));
    bf16x8 b1 = *reinterpret_cast<const bf16x8*>((const char*)Ks + KSWZ(32 + r32, cb));
    p0 = __builtin_amdgcn_mfma_f32_32x32x16_bf16(b0, qr[d0], p0, 0, 0, 0);
    p1 = __builtin_amdgcn_mfma_f32_32x32x16_bf16(b1, qr[d0], p1, 0, 0, 0); }
}
__device__ __forceinline__ int v_st(int k, int c) { const int kk = (k & ~0xC) | ((k & 4) << 1) | ((k & 8) >> 1); return ((kk >> 3) * 4 + (c >> 5)) * 512 + ((kk & 7) * 32 + (c & 31)) * 2; }
__device__ __forceinline__ int v_rd_base(int lane) { return ((lane & 3) << 3) | (((lane >> 2) & 3) << 6) | (((lane >> 4) & 1) << 5) | (((lane >> 5) & 1) << 8); }
constexpr int v_rd_off(int d0, int ks, int half) { return d0 * 512 + ks * 4096 + half * 2048; }
template <int OFF> __device__ __forceinline__ s16x4 tr_read(int vb) {
  s16x4 r; asm volatile("ds_read_b64_tr_b16 %0, %1 offset:%2" : "=&v"(r) : "v"(vb), "i"(OFF) : "memory"); return r;
}
template <int D0> __device__ __forceinline__ void pv_one(f32x16& od, int vb, bf16x8 pa0, bf16x8 pa1, bf16x8 pa2, bf16x8 pa3) {
  const s16x4 l0 = tr_read<v_rd_off(D0, 0, 0)>(vb), h0 = tr_read<v_rd_off(D0, 0, 1)>(vb), l1 = tr_read<v_rd_off(D0, 1, 0)>(vb), h1 = tr_read<v_rd_off(D0, 1, 1)>(vb);
  const s16x4 l2 = tr_read<v_rd_off(D0, 2, 0)>(vb), h2 = tr_read<v_rd_off(D0, 2, 1)>(vb), l3 = tr_read<v_rd_off(D0, 3, 0)>(vb), h3 = tr_read<v_rd_off(D0, 3, 1)>(vb);
  asm volatile("s_waitcnt lgkmcnt(0)" ::: "memory"); SBAR();
#define PK(L, H) (bf16x8){L[0], L[1], L[2], L[3], H[0], H[1], H[2], H[3]}
  od = __builtin_amdgcn_mfma_f32_32x32x16_bf16(pa0, PK(l0, h0), od, 0, 0, 0);
  od = __builtin_amdgcn_mfma_f32_32x32x16_bf16(pa1, PK(l1, h1), od, 0, 0, 0);
  od = __builtin_amdgcn_mfma_f32_32x32x16_bf16(pa2, PK(l2, h2), od, 0, 0, 0);
  od = __builtin_amdgcn_mfma_f32_32x32x16_bf16(pa3, PK(l3, h3), od, 0, 0, 0);
#undef PK
}
__device__ __forceinline__ void pv_d0(f32x16* o, int vb, bf16x8 pa0, bf16x8 pa1, bf16x8 pa2, bf16x8 pa3) {
  pv_one<0>(o[0], vb, pa0, pa1, pa2, pa3); pv_one<1>(o[1], vb, pa0, pa1, pa2, pa3); pv_one<2>(o[2], vb, pa0, pa1, pa2, pa3); pv_one<3>(o[3], vb, pa0, pa1, pa2, pa3);
}
template <int LDQ, int LDK, int LDV, int LDO>
__device__ __forceinline__ void attn_unit(const bf16_t* __restrict__ Qb, const bf16_t* __restrict__ Kh, const bf16_t* __restrict__ Vh, bf16_t* __restrict__ Ob, int seq, char* lds, const int wid,
                                          const float* qgain = nullptr, const float* rope = nullptr, int qpos0 = -1) {
  const int lane = lane_id_fresh(), tid = wid * 64 + lane, r32 = lane & 31, hi = lane >> 5;
  bf16_t* V_lds = (bf16_t*)lds; bf16_t* K_lds = (bf16_t*)(lds + 2 * SHM_V);
  float* ws = (float*)(lds + 2 * SHM_V + 2 * SHM_K) + wid * 64; float* li_l = ws; float* al_l = ws + 32;
  float m_reg = -1e30f, l_reg = 0; f32x16 o[4] = {}; bf16x8 qr[8];
  { const unsigned offQ = (unsigned)((wid * QBLK + r32) * LDQ + hi * 8) * 2u;
#pragma unroll
  for (int d0 = 0; d0 < 8; ++d0) qr[d0] = *reinterpret_cast<const bf16x8*>((const char*)Qb + offQ + d0 * 32); }
  if (qgain) {
    float x[8][8]; float ss = 0.f;
#pragma unroll
    for (int d0 = 0; d0 < 8; ++d0) { const u32x4 w = *reinterpret_cast<const u32x4*>(&qr[d0]);
#pragma unroll
      for (int q = 0; q < 4; ++q) { x[d0][2 * q] = bf_lo(w[q]); x[d0][2 * q + 1] = bf_hi(w[q]); ss += x[d0][2 * q] * x[d0][2 * q] + x[d0][2 * q + 1] * x[d0][2 * q + 1]; } }
    { auto rr = __builtin_amdgcn_permlane32_swap(__float_as_uint(ss), __float_as_uint(ss), false, false); ss = __uint_as_float(rr[0]) + __uint_as_float(rr[1]); }
    const float rstd = 1.0f / sqrtf(ss * (1.0f / 128.0f) + RMS_EPS);
#pragma unroll
    for (int d0 = 0; d0 < 8; ++d0) { const f32x4 g0 = *(const f32x4*)(qgain + d0 * 16 + hi * 8), g1 = *(const f32x4*)(qgain + d0 * 16 + hi * 8 + 4);
#pragma unroll
      for (int j = 0; j < 4; ++j) { x[d0][j] *= rstd * g0[j]; x[d0][4 + j] *= rstd * g1[j]; } }
    if (qpos0 >= 0) { const int t = qpos0 + wid * QBLK + r32;
#pragma unroll
      for (int pr = 0; pr < 4; ++pr) { const int da = (pr >> 1) * 4 + (pr & 1), db = da + 2;
        const int pos = (pr < 2) ? (t >> 6) : (t & 63); const float* cs = rope + ((pr < 2) ? 0 : 8192) + pos * 32 + (pr & 1) * 16 + hi * 8; const float* sn = cs + ((pr < 2) ? 4096 : 2048);
        const f32x4 c0 = *(const f32x4*)cs, c1 = *(const f32x4*)(cs + 4), s0 = *(const f32x4*)sn, s1 = *(const f32x4*)(sn + 4);
#pragma unroll
        for (int j = 0; j < 8; ++j) { const float c = j < 4 ? c0[j & 3] : c1[j & 3], sv = j < 4 ? s0[j & 3] : s1[j & 3]; const float xa = x[da][j], xb = x[db][j];
          x[da][j] = xa * c - xb * sv; x[db][j] = xb * c + xa * sv; } } }
#pragma unroll
    for (int d0 = 0; d0 < 8; ++d0) { u32x4 w; w.x = cvtpk(x[d0][0], x[d0][1]); w.y = cvtpk(x[d0][2], x[d0][3]); w.z = cvtpk(x[d0][4], x[d0][5]); w.w = cvtpk(x[d0][6], x[d0][7]); qr[d0] = *reinterpret_cast<bf16x8*>(&w); }
  }
  const int sr = tid >> 4, sc = (tid & 15) * 8, vst0 = v_st(sr, sc), vst1 = v_st(32 + sr, sc);
  const int vb0 = (int)(uintptr_t)V_lds + v_rd_base(lane);
  struct { bf16x8 vs0, vs1, ks0, ks1; } sr_[2];
  const int offV = (sr * LDV + sc) * 2, offK = (sr * LDK + sc) * 2;
  const __amdgpu_buffer_rsrc_t rV = __builtin_amdgcn_make_buffer_rsrc((void*)Vh, 0, 0x7ffffff0, 0x00020000);
  const __amdgpu_buffer_rsrc_t rK = __builtin_amdgcn_make_buffer_rsrc((void*)Kh, 0, 0x7ffffff0, 0x00020000);
#define SLOAD(i, k0) do { const int sv_ = (k0) * (LDV * 2), sk_ = (k0) * (LDK * 2); \
    { u32x4 t_ = __builtin_amdgcn_raw_buffer_load_b128(rV, offV, sv_, 0); sr_[i].vs0 = *reinterpret_cast<bf16x8*>(&t_); } \
    { u32x4 t_ = __builtin_amdgcn_raw_buffer_load_b128(rV, offV, sv_ + 32 * LDV * 2, 0); sr_[i].vs1 = *reinterpret_cast<bf16x8*>(&t_); } \
    { u32x4 t_ = __builtin_amdgcn_raw_buffer_load_b128(rK, offK, sk_, 0); sr_[i].ks0 = *reinterpret_cast<bf16x8*>(&t_); } \
    { u32x4 t_ = __builtin_amdgcn_raw_buffer_load_b128(rK, offK, sk_ + 32 * LDK * 2, 0); sr_[i].ks1 = *reinterpret_cast<bf16x8*>(&t_); } } while (0)
#define SWRITE(b, i) do { *(bf16x8*)((char*)V_lds + (b) * SHM_V + vst0) = sr_[i].vs0;          \
    *(bf16x8*)((char*)V_lds + (b) * SHM_V + vst1) = sr_[i].vs1; int kc = sc * 2;               \
    *(bf16x8*)((char*)K_lds + (b) * SHM_K + KSWZ(sr, kc)) = sr_[i].ks0;                       \
    *(bf16x8*)((char*)K_lds + (b) * SHM_K + KSWZ(32 + sr, kc)) = sr_[i].ks1; } while (0)
#define SWAIT() asm volatile("s_waitcnt vmcnt(4)" ::: "memory")
#define RESC(a) do { if (__any((a) < 1.f)) { if (hi == 0) al_l[r32] = (a); asm volatile("s_waitcnt lgkmcnt(0)" ::: "memory"); \
    for (int d = 0; d < 4; ++d) for (int r = 0; r < 16; ++r) o[d][r] *= al_l[crow(r, hi)]; } } while (0)
  f32x16 pA0, pA1, pB0, pB1; float mnA, mnB, alA, alB; bf16x8 pa0, pa1, pa2, pa3; const int NT = seq / KVBLK;
  constexpr int SE = 0, SO = 1;
  SLOAD(SE, 0); asm volatile("s_waitcnt vmcnt(0)" ::: "memory"); SWRITE(0, SE); __syncthreads();
  qkt(pA0, pA1, K_lds, qr, r32, hi); partialSM(pA0, pA1, m_reg, mnA, alA);
  SLOAD(SO, KVBLK); if (2 < NT) SLOAD(SE, 2 * KVBLK);
  SWAIT(); SWRITE(1, SO); __syncthreads();
  for (int j = 1; j + 1 < NT; j += 2) {
    SBAR(); qkt(pB0, pB1, (bf16_t*)((char*)K_lds + SHM_K), qr, r32, hi);
    finishSM(pA0, pA1, alA, l_reg, pa0, pa1, pa2, pa3); SBAR();
    SLOAD(SO, (j + 2) * KVBLK); SBAR();
    pv_d0(o, vb0, pa0, pa1, pa2, pa3); partialSM(pB0, pB1, m_reg, mnB, alB);
    __syncthreads(); SWAIT(); SWRITE(0, SE);
    RESC(alB); __syncthreads();
    SBAR(); qkt(pA0, pA1, K_lds, qr, r32, hi);
    finishSM(pB0, pB1, alB, l_reg, pa0, pa1, pa2, pa3); SBAR();
    if (j + 3 < NT) SLOAD(SE, (j + 3) * KVBLK); SBAR();
    pv_d0(o, vb0 + (int)SHM_V, pa0, pa1, pa2, pa3); partialSM(pA0, pA1, m_reg, mnA, alA);
    __syncthreads(); SWAIT(); SWRITE(1, SO);
    RESC(alA); __syncthreads();
  }
  SBAR(); qkt(pB0, pB1, (bf16_t*)((char*)K_lds + SHM_K), qr, r32, hi);
  finishSM(pA0, pA1, alA, l_reg, pa0, pa1, pa2, pa3); SBAR();
  pv_d0(o, vb0, pa0, pa1, pa2, pa3); partialSM(pB0, pB1, m_reg, mnB, alB);
  __syncthreads(); RESC(alB);
  finishSM(pB0, pB1, alB, l_reg, pa0, pa1, pa2, pa3); SBAR();
  pv_d0(o, vb0 + (int)SHM_V, pa0, pa1, pa2, pa3);
  if (hi == 0) li_l[r32] = l_reg; asm volatile("s_waitcnt lgkmcnt(0)" ::: "memory");
  float rli[16];
#pragma unroll
  for (int r = 0; r < 16; ++r) rli[r] = __builtin_amdgcn_rcpf(li_l[crow(r, hi)]);
#pragma unroll
  for (int r = 0; r < 16; ++r) { const unsigned offO = (unsigned)((wid * QBLK + crow(r, hi)) * LDO + r32) * 2u;
    for (int d0 = 0; d0 < 4; ++d0) { const float v = o[d0][r] * rli[r]; *(bf16_t*)((char*)Ob + offO + d0 * 64) = (bf16_t)(cvtpk(v, v) & 0xffffu); } }
  asm volatile("s_waitcnt vmcnt(0) lgkmcnt(0)" ::: "memory"); __syncthreads();
#undef SLOAD
#undef SWRITE
#undef SWAIT
#undef RESC
}
constexpr size_t SHM_V2 = 2 * SHM_V;
template <int LDQ, int LDK, int LDV, class EPI>
__device__ __forceinline__ void attn_unit2(const bf16_t* __restrict__ Qb, const bf16_t* __restrict__ Kh, const bf16_t* __restrict__ Vh0, const bf16_t* __restrict__ Vh1, int seq, char* lds, const int wid, EPI&& epi) {
  const int lane = lane_id_fresh(), tid = wid * 64 + lane, r32 = lane & 31, hi = lane >> 5;
  bf16_t* V_lds = (bf16_t*)lds; bf16_t* K_lds = (bf16_t*)(lds + 2 * SHM_V2);
  float* ws = (float*)(lds + 2 * SHM_V2 + 2 * SHM_K) + wid * 64; float* li_l = ws; float* al_l = ws + 32;
  float m_reg = -1e30f, l_reg = 0; f32x16 o[8] = {}; bf16x8 qr[8];
  { const unsigned offQ = (unsigned)((wid * QBLK + r32) * LDQ + hi * 8) * 2u;
#pragma unroll
  for (int d0 = 0; d0 < 8; ++d0) qr[d0] = *reinterpret_cast<const bf16x8*>((const char*)Qb + offQ + d0 * 32); }
  const int sr = tid >> 4, sc = (tid & 15) * 8, vst0 = v_st(sr, sc), vst1 = v_st(32 + sr, sc);
  const int vb0 = (int)(uintptr_t)V_lds + v_rd_base(lane);
  const int offV = (sr * LDV + sc) * 2, offK = (sr * LDK + sc) * 2;
  const __amdgpu_buffer_rsrc_t rV0 = __builtin_amdgcn_make_buffer_rsrc((void*)Vh0, 0, 0x7ffffff0, 0x00020000);
  const __amdgpu_buffer_rsrc_t rV1 = __builtin_amdgcn_make_buffer_rsrc((void*)Vh1, 0, 0x7ffffff0, 0x00020000);
  const __amdgpu_buffer_rsrc_t rK = __builtin_amdgcn_make_buffer_rsrc((void*)Kh, 0, 0x7ffffff0, 0x00020000);
  u32x4 sv0, sv1, sv2, sv3, sk0, sk1;
#define SLOAD2(k0) do { const int sv_ = (k0) * (LDV * 2), sk_ = (k0) * (LDK * 2); \
    sv0 = __builtin_amdgcn_raw_buffer_load_b128(rV0, offV, sv_, 0); sv1 = __builtin_amdgcn_raw_buffer_load_b128(rV0, offV, sv_ + 32 * LDV * 2, 0); \
    sv2 = __builtin_amdgcn_raw_buffer_load_b128(rV1, offV, sv_, 0); sv3 = __builtin_amdgcn_raw_buffer_load_b128(rV1, offV, sv_ + 32 * LDV * 2, 0); \
    sk0 = __builtin_amdgcn_raw_buffer_load_b128(rK, offK, sk_, 0); sk1 = __builtin_amdgcn_raw_buffer_load_b128(rK, offK, sk_ + 32 * LDK * 2, 0); } while (0)
#define SWRITE2(b) do { char* vb_ = (char*)V_lds + (b) * SHM_V2; const int kc = sc * 2; \
    *(u32x4*)(vb_ + vst0) = sv0; *(u32x4*)(vb_ + vst1) = sv1; *(u32x4*)(vb_ + SHM_V + vst0) = sv2; *(u32x4*)(vb_ + SHM_V + vst1) = sv3; \
    *(u32x4*)((char*)K_lds + (b) * SHM_K + KSWZ(sr, kc)) = sk0; *(u32x4*)((char*)K_lds + (b) * SHM_K + KSWZ(32 + sr, kc)) = sk1; } while (0)
#define RESC2(a) do { if (__any((a) < 1.f)) { if (hi == 0) al_l[r32] = (a); asm volatile("s_waitcnt lgkmcnt(0)" ::: "memory"); \
    for (int d = 0; d < 8; ++d) for (int r = 0; r < 16; ++r) o[d][r] *= al_l[crow(r, hi)]; } } while (0)
  f32x16 p0, p1; float mn, al; bf16x8 pa0, pa1, pa2, pa3; const int NT = seq / KVBLK;
  SLOAD2(0); SWRITE2(0); __syncthreads();
  for (int j = 0; j < NT; ++j) { const int b = j & 1;
    if (j + 1 < NT) SLOAD2((j + 1) * KVBLK);
    SBAR(); qkt(p0, p1, (bf16_t*)((char*)K_lds + b * SHM_K), qr, r32, hi);
    partialSM(p0, p1, m_reg, mn, al); RESC2(al);
    finishSM(p0, p1, al, l_reg, pa0, pa1, pa2, pa3); SBAR();
    pv_d0(o, vb0 + b * (int)SHM_V2, pa0, pa1, pa2, pa3);
    pv_d0(o + 4, vb0 + b * (int)SHM_V2 + (int)SHM_V, pa0, pa1, pa2, pa3);
    __syncthreads();
    if (j + 1 < NT) SWRITE2(b ^ 1);
    __syncthreads();
  }
  const int le = lane_id_fresh(), r32e = le & 31, hie = le >> 5;
  if (hie == 0) li_l[r32e] = l_reg; asm volatile("s_waitcnt lgkmcnt(0)" ::: "memory");
  float rli[16];
#pragma unroll
  for (int r = 0; r < 16; ++r) rli[r] = __builtin_amdgcn_rcpf(li_l[crow(r, hie)]);
  epi(o, rli, wid, le);
  asm volatile("s_waitcnt vmcnt(0) lgkmcnt(0)" ::: "memory"); __syncthreads();
#undef SLOAD2
#undef SWRITE2
#undef RESC2
}
#undef KSWZ
#undef SBAR
}

#define XB_TMO      128
#define XB_XCNT(j)  (256  + 64 * (j))
#define XB_XSUB(j)  (1280 + 64 * (j))
#define XB_XGEN(j)  (2304 + 64 * (j))
#define XB_TOP      3328
#define XB_TOPGEN   3392
#define XCD_BAR_WORDS 3456
#define XB_SPIN_CAP (1u << 18)
__device__ __forceinline__ unsigned xb_ld(unsigned* p)              { return __hip_atomic_load(p, __ATOMIC_RELAXED, __HIP_MEMORY_SCOPE_AGENT); }
__device__ __forceinline__ unsigned xb_add(unsigned* p, unsigned v) { return __hip_atomic_fetch_add(p, v, __ATOMIC_RELAXED, __HIP_MEMORY_SCOPE_AGENT); }
__device__ __forceinline__ unsigned xb_xcc_id() { return (unsigned)__builtin_amdgcn_s_getreg((3 << 11) | 20) & 0xFu; }
#define XB_SPIN(cond, bar) do { unsigned _sp = 0; while (cond) { __builtin_amdgcn_s_sleep(1); \
    if ((++_sp & 255u) == 0u) { if (xb_ld(&(bar)[XB_TMO])) break; if (_sp > XB_SPIN_CAP) { atomicAdd(&(bar)[XB_TMO], 1u); break; } } } } while (0)
struct XcdBarrier { unsigned* bar; unsigned x; volatile LAS unsigned* st; };
__device__ __forceinline__ XcdBarrier xcd_barrier_post(unsigned* bar, volatile LAS unsigned* st, const int tid) {
    XcdBarrier b; b.bar = bar; b.x = xb_xcc_id(); b.st = st;
    if (tid == 0) (void)xb_add(&bar[XB_XCNT(b.x)], 1u);
    return b;
}
__device__ __forceinline__ void xcd_barrier_complete(unsigned* bar, unsigned x, unsigned& nloc, unsigned& nx) {
    const unsigned G = gridDim.x * gridDim.y * gridDim.z;
    unsigned sum, cnt, mine, sp = 0u;
    for (;;) {
        sum = 0u; cnt = 0u; mine = 0u;
#pragma unroll
        for (unsigned j = 0; j < 16; ++j) { const unsigned c = xb_ld(&bar[XB_XCNT(j)]); sum += c; cnt += (c > 0u) ? 1u : 0u; mine = (j == x) ? c : mine; }
        if (sum == G) break;
        __builtin_amdgcn_s_sleep(1);
        if ((++sp & 255u) == 0u) { if (xb_ld(&bar[XB_TMO])) break; if (sp > XB_SPIN_CAP) { atomicAdd(&bar[XB_TMO], 1u); break; } }
    }
    nloc = mine > 0u ? mine : 1u; nx = cnt > 0u ? cnt : 1u;
}
__device__ __forceinline__ void xcd_barrier(const XcdBarrier& b, const int tid) {
    asm volatile("s_waitcnt vmcnt(0)" ::: "memory");
    __syncthreads();
    if (tid == 0) {
        unsigned* bar = b.bar;
        __builtin_amdgcn_s_waitcnt(0);
        unsigned nloc = b.st[0], nx = b.st[1];
        if (nloc == 0u) { xcd_barrier_complete(bar, b.x, nloc, nx); b.st[0] = nloc; b.st[1] = nx; }
        const unsigned old = xb_add(&bar[XB_XSUB(b.x)], 1u);
        const unsigned gen = old / nloc;
        if (old + 1u == (gen + 1u) * nloc) {
            __builtin_amdgcn_fence(__ATOMIC_RELEASE, "agent");
            asm volatile("s_waitcnt vmcnt(0)" ::: "memory");
            const unsigned og = xb_add(&bar[XB_TOP], 1u);
            const unsigned tg = og / nx;
            if (og + 1u == (tg + 1u) * nx) xb_add(&bar[XB_TOPGEN], 1u);
            else XB_SPIN(xb_ld(&bar[XB_TOPGEN]) == tg, bar);
            __builtin_amdgcn_fence(__ATOMIC_ACQUIRE, "agent");
            xb_add(&bar[XB_XGEN(b.x)], 1u);
            asm volatile("s_waitcnt vmcnt(0)" ::: "memory");
        } else {
            XB_SPIN(xb_ld(&bar[XB_XGEN(b.x)]) == gen, bar);
            __builtin_amdgcn_fence(__ATOMIC_ACQUIRE, "agent");
            asm volatile("s_waitcnt vmcnt(0)" ::: "memory");
        }
    }
    __syncthreads();
}

constexpr int RING_BYTES = 131072;
constexpr int MISC_OFF = RING_BYTES;
constexpr int LDS_BYTES = 147456;

struct RowStats { float mean, rstd; };
__device__ __forceinline__ RowStats ln_stats(const f32x4 (&v)[8]) {
    float s = 0.f;
#pragma unroll
    for (int j = 0; j < 8; ++j) s += (v[j][0] + v[j][1]) + (v[j][2] + v[j][3]);
    const float mean = wave_sum(s) * (1.f / DM); float q = 0.f;
#pragma unroll
    for (int j = 0; j < 8; ++j) { const f32x4 d = v[j] - mean; q += (d[0] * d[0] + d[1] * d[1]) + (d[2] * d[2] + d[3] * d[3]); }
    RowStats r; r.mean = mean; r.rstd = 1.f / sqrtf(wave_sum(q) * (1.f / DM) + LN_EPS); return r;
}
__device__ __forceinline__ void store_bf16x4(bf16_t* p, const f32x4 v) { u32x2 w; w.x = cvt_pk_bf16(v[0], v[1]); w.y = cvt_pk_bf16(v[2], v[3]); *(u32x2*)p = w; }
__device__ __forceinline__ f32x4 load_bf16x4(const bf16_t* p) { const u32x2 w = *(const u32x2*)p; return (f32x4){bf_lo(w.x), bf_hi(w.x), bf_lo(w.y), bf_hi(w.y)}; }

__device__ __forceinline__ void transpose_item(const float* W, int ldw, int scol0, bf16_t* WT, int K, int drow0, int k0, LAS float*  , int lane) {
    const int kr = lane >> 3, n4 = (lane & 7) * 4;
    const float* src = W + (size_t)(k0 + 8 * kr) * ldw + scol0 + n4;
    f32x4 v[8];
#pragma unroll
    for (int i = 0; i < 8; ++i) v[i] = __builtin_nontemporal_load((const f32x4*)(src + (size_t)i * ldw));
    bf16_t* dst = WT + (size_t)(drow0 + n4) * K + k0 + 8 * kr;
#pragma unroll
    for (int q = 0; q < 4; ++q) { u32x4 o; o.x = cvt_pk_bf16(v[0][q], v[1][q]); o.y = cvt_pk_bf16(v[2][q], v[3][q]); o.z = cvt_pk_bf16(v[4][q], v[5][q]); o.w = cvt_pk_bf16(v[6][q], v[7][q]);
        *(u32x4*)(dst + (size_t)q * K) = o; }
}
__device__ __forceinline__ void tr_plain(const float* W, int K, int N, bf16_t* WT, int it, LAS float* scr, int lane) {
    const int nnb = N / 32, kb = it / nnb, nb = it % nnb;
    transpose_item(W, N, 32 * nb, WT, K, 32 * nb, 64 * kb, scr, lane);
}

struct Args { const float* in[27]; float* out; unsigned char* ws; int ph_lo, ph_hi; int probe_dup, pad; };
enum { I_X = 0, I_C, I_CTX, I_CCTX, I_MODW, I_MODB, I_LNG, I_LNB, I_RGW, I_RGB, I_REW, I_REB, I_EG, I_EU, I_ED, I_CIW, I_CW, I_COW, I_PW, I_PS, I_GQW, I_GQN, I_GOW, I_DQW, I_DL, I_DS, I_DOW };

namespace cq {
constexpr int I_GU = 32 * 48, I_DN = 12 * 64, I_EXP = I_GU + I_DN, I_LEXP = 16 * I_EXP;
constexpr int I_PL = 4 * 8 * 16, I_GQ = 32 * 96, I_GO = 32 * 64, I_DQ = 32 * 192, I_DO = 32 * 64;
constexpr int E0 = I_LEXP, E1 = E0 + I_PL, E2 = E1 + I_LEXP, E3 = E2 + I_GQ, E4 = E3 + I_GO, E5 = E4 + I_LEXP, E6 = E5 + I_DQ, E7 = E6 + I_DO, E8 = E7 + I_LEXP;
constexpr int NQ = E8;
}
constexpr int CW_Q = 16384;
struct __attribute__((packed, aligned(4))) F3 { float x, y, z; };
typedef float f32x3u __attribute__((ext_vector_type(3), aligned(4)));
struct TrDesc { const float* W; int ldw, sc; bf16_t* WT; int K, drow, k0; };
__device__ __forceinline__ TrDesc tr_plain_desc(const float* W, int K, int N, bf16_t* WT, int it) { const int nnb = N / 32, kb = it / nnb, nb = it % nnb; return TrDesc{W, N, 32 * nb, WT, K, 32 * nb, 64 * kb}; }
__device__ __forceinline__ TrDesc tr_expert_desc(const Args& a, int L, int r) {
    const int e = r / cq::I_EXP; r -= e * cq::I_EXP; const int le = L * 16 + e;
    if (r < cq::I_GU) {
        const int kb = r / 48, nb = r % 48, n = 32 * nb, pn = n >> 8, bj = (n >> 7) & 1, i = n & 127;
        const float* src = (bj ? a.in[I_EU] : a.in[I_EG]) + (size_t)le * DM * EFF;
        return TrDesc{src, EFF, 128 * pn + i, (bf16_t*)(a.ws + WS_WGU) + (size_t)le * 1536 * DM, DM, n, 64 * kb}; }
    return tr_plain_desc(a.in[I_ED] + (size_t)le * EFF * DM, EFF, DM, (bf16_t*)(a.ws + WS_WDN) + (size_t)le * DM * EFF, r - cq::I_GU);
}
__device__ __forceinline__ TrDesc cvt_queue_desc(const Args& a, int qi) {
    using namespace cq; TrDesc d;
    if (qi < E0) d = tr_expert_desc(a, 0, qi);
    else if (qi < E1) { const int r = qi - E0, g = r / 128; d = tr_plain_desc(a.in[I_PW] + (size_t)g * 512 * 512, 512, 512, (bf16_t*)(a.ws + WS_WPL) + (size_t)g * 512 * 512, r % 128); }
    else if (qi < E2) d = tr_expert_desc(a, 1, qi - E1);
    else if (qi < E3) d = tr_plain_desc(a.in[I_GQW], DM, 3072, (bf16_t*)(a.ws + WS_WGQ), qi - E2);
    else if (qi < E4) d = tr_plain_desc(a.in[I_GOW], DM, DM, (bf16_t*)(a.ws + WS_WGO), qi - E3);
    else if (qi < E5) d = tr_expert_desc(a, 2, qi - E4);
    else if (qi < E6) {
        const int it = qi - E5, kb = it / 192, nb = it % 192, n = 32 * nb; int sc = n;
        if (n < 4096) { const int pn = n >> 8, wi = n & 255, bj = wi >> 7, wc = (wi >> 5) & 3; sc = pn * 256 + (wc >> 1) * 128 + (2 * (wc & 1) + bj) * 32; }
        d = TrDesc{a.in[I_DQW], 3 * DM, sc, (bf16_t*)(a.ws + WS_WDQ), DM, n, 64 * kb}; }
    else if (qi < E7) d = tr_plain_desc(a.in[I_DOW], DM, DM, (bf16_t*)(a.ws + WS_WDO), qi - E6);
    else d = tr_expert_desc(a, 3, qi - E7);
    return d;
}
__device__ __forceinline__ void transpose_pair(const TrDesc& d0, const TrDesc& d1, int lane) {
    const int kr = lane >> 3, n4 = (lane & 7) * 4;
    const float* s0 = d0.W + (size_t)(d0.k0 + 8 * kr) * d0.ldw + d0.sc + n4; const float* s1 = d1.W + (size_t)(d1.k0 + 8 * kr) * d1.ldw + d1.sc + n4;
    f32x4 v0[8], v1[8];
#pragma unroll
    for (int i = 0; i < 8; ++i) v0[i] = __builtin_nontemporal_load((const f32x4*)(s0 + (size_t)i * d0.ldw));
#pragma unroll
    for (int i = 0; i < 8; ++i) v1[i] = __builtin_nontemporal_load((const f32x4*)(s1 + (size_t)i * d1.ldw));
    bf16_t* t0 = d0.WT + (size_t)(d0.drow + n4) * d0.K + d0.k0 + 8 * kr; bf16_t* t1 = d1.WT + (size_t)(d1.drow + n4) * d1.K + d1.k0 + 8 * kr;
#pragma unroll
    for (int q = 0; q < 4; ++q) { u32x4 o; o.x = cvt_pk_bf16(v0[0][q], v0[1][q]); o.y = cvt_pk_bf16(v0[2][q], v0[3][q]); o.z = cvt_pk_bf16(v0[4][q], v0[5][q]); o.w = cvt_pk_bf16(v0[6][q], v0[7][q]);
        *(u32x4*)(t0 + (size_t)q * d0.K) = o; }
#pragma unroll
    for (int q = 0; q < 4; ++q) { u32x4 o; o.x = cvt_pk_bf16(v1[0][q], v1[1][q]); o.y = cvt_pk_bf16(v1[2][q], v1[3][q]); o.z = cvt_pk_bf16(v1[4][q], v1[5][q]); o.w = cvt_pk_bf16(v1[6][q], v1[7][q]);
        *(u32x4*)(t1 + (size_t)q * d1.K) = o; }
}
__device__ __forceinline__ void cvt_run(const Args& a, int it, int n, int lane) {
    int k = 0;
    for (; k + 1 < n && it + k + 1 < cq::NQ; k += 2) { const TrDesc d0 = cvt_queue_desc(a, it + k), d1 = cvt_queue_desc(a, it + k + 1); transpose_pair(d0, d1, lane); }
    for (; k < n && it + k < cq::NQ; ++k) { const TrDesc d = cvt_queue_desc(a, it + k); transpose_item(d.W, d.ldw, d.sc, d.WT, d.K, d.drow, d.k0, nullptr, lane); }
}
__device__ __forceinline__ void cvt_opportunistic(const Args& a, int n, LAS unsigned char* lds, int tid, int wave, int lane) {
    if (n <= 0) return;
    unsigned* q = (unsigned*)(a.ws + WS_CTL) + CW_Q; volatile LAS int* qs = (volatile LAS int*)(lds + MISC_OFF + 768);
    __syncthreads();
    if (tid == 0) qs[0] = (int)__hip_atomic_fetch_add(q, (unsigned)(8 * n), __ATOMIC_RELAXED, __HIP_MEMORY_SCOPE_AGENT);
    __syncthreads();
    const int it = __builtin_amdgcn_readfirstlane(qs[0]) + wave * n;
    cvt_run(a, it, n, lane);
}
__device__ __forceinline__ void cvt_catchup(const Args& a, int target, LAS unsigned char* lds, int tid, int wave, int lane) {
    unsigned* q = (unsigned*)(a.ws + WS_CTL) + CW_Q; volatile LAS int* qs = (volatile LAS int*)(lds + MISC_OFF + 768);
    for (;;) {
        __syncthreads();
        if (tid == 0) { int h = (int)__hip_atomic_load(q, __ATOMIC_RELAXED, __HIP_MEMORY_SCOPE_AGENT);
            if (h < target) h = (int)__hip_atomic_fetch_add(q, 64u, __ATOMIC_RELAXED, __HIP_MEMORY_SCOPE_AGENT); else h = 0x7fffffff;
            qs[0] = h; }
        __syncthreads();
        const int base = __builtin_amdgcn_readfirstlane(qs[0]);
        if (base == 0x7fffffff) break;
        const int it = base + wave * 8;
        cvt_run(a, it, 8, lane);
    }
}
__device__ __forceinline__ int idle_units(int nwg, int G, int c) { const int mx = (nwg + G - 1) / G, mine = c < nwg ? (nwg - c + G - 1) / G : 0; return mx - mine; }

__device__ __forceinline__ void ph_prologue(const Args& a, LAS unsigned char* lds, int G, int wave, int lane, int tid) {
    unsigned char* ws = a.ws;
    const int bx = blockIdx.x;
    for (int t = bx; t < 256; t += G) {
        const int L = t >> 6, col0 = (t & 63) * 192;
        LAS float* sl = (LAS float*)lds; LAS float* sx = sl + DM; LAS float* red = sx + DM;
        for (int k = tid; k < DM; k += 512) { const float c = a.in[I_C][k], cc = a.in[I_CCTX][k];
            sl[k] = c / (1.f + __expf(-c)); sx[k] = cc / (1.f + __expf(-cc)); }
        __syncthreads();
        const float* W = a.in[I_MODW] + (size_t)L * DM * NMOD + col0 + 3 * lane;
        float al0 = 0.f, al1 = 0.f, al2 = 0.f, ac0 = 0.f, ac1 = 0.f, ac2 = 0.f;
        const int kb = wave * 256;
#pragma unroll 16
        for (int k = 0; k < 256; ++k) { const f32x3u w = __builtin_nontemporal_load((const f32x3u*)(W + (size_t)(kb + k) * NMOD));     const float s1 = sl[kb + k], s2 = sx[kb + k];
            al0 += w.x * s1; al1 += w.y * s1; al2 += w.z * s1; ac0 += w.x * s2; ac1 += w.y * s2; ac2 += w.z * s2; }
        LAS float* rp = red + (wave * 64 + lane) * 6;
        rp[0] = al0; rp[1] = al1; rp[2] = al2; rp[3] = ac0; rp[4] = ac1; rp[5] = ac2;
        __syncthreads();
        if (tid < 384) { const int which = tid / 192, col = tid % 192; float s_ = 0.f;
#pragma unroll
          for (int w = 0; w < 8; ++w) s_ += red[(w * 64 + col / 3) * 6 + which * 3 + col % 3];
          float* modv = (float*)(ws + WS_MODV);
          modv[(size_t)(L * 2 + which) * NMOD + col0 + col] = s_ + a.in[I_MODB][L * NMOD + col0 + col]; }
        __syncthreads();
    }
    if (bx == 0) {
        float* rope = (float*)(ws + WS_ROPE);
        for (int idx = tid; idx < 6144; idx += 512) {
            const int isc = idx >= 4096, e = isc ? idx - 4096 : idx, pos = e >> 5, i = e & 31;
            const float inv = powf(10000.0f, -(float)(2 * i) / 64.0f), ang = (float)pos * inv;
            float* cs = rope + (isc ? 8192 : 0); const int half = isc ? 2048 : 4096;
            cs[e] = cosf(ang); cs[half + e] = sinf(ang);
        }
    } else if (bx >= 2 && bx < 6) {
        const int L = bx - 2; const float* w = a.in[I_REW] + (size_t)L * DM * 16; float* wt = (float*)(ws + WS_WET) + (size_t)L * 4 * DM * 4;
        for (int idx = tid; idx < DM * 16; idx += 512) { const int c = idx >> 4, e = idx & 15; wt[((size_t)(e >> 2) * DM + c) * 4 + (e & 3)] = w[idx]; }
    } else if (bx == 1) {
        if (wave == 0) {
            const float* lv = a.in[I_DL];
            float s1 = lv[lane] * lv[128 + lane] + lv[64 + lane] * lv[192 + lane];
            float s2 = lv[256 + lane] * lv[384 + lane] + lv[320 + lane] * lv[448 + lane];
            s1 = wave_sum(s1); s2 = wave_sum(s2);
            if (lane == 0) { float* sc = (float*)(ws + WS_SCAL); sc[0] = expf(s1) - expf(s2) + LAM_INIT3; sc[1] = 1.0f - LAM_INIT3; }
        }
        if (tid < 256) ((float*)(ws + WS_SCAL + 1024))[tid] = a.in[I_DS][tid];
    }
    LAS float* scr = (LAS float*)(lds + 32768 + wave * 8448);
    const int gw = bx * 8 + wave, NGW = G * 8;
    constexpr int I_CI = 32 * 192, I_CO = 32 * 64;
    for (int it = gw; it < I_CI + I_CO; it += NGW) {
        int r = it;
        if (r < I_CI) {
            const int kb = r / 192, nb = r % 192, n = 32 * nb; int sc;
            if (n < 2048) sc = n; else { const int q = (n - 2048) >> 8, bj = ((n - 2048) >> 7) & 1, i = n & 127; sc = 2048 + bj * 2048 + 128 * q + i; }
            transpose_item(a.in[I_CIW], 3 * DM, sc, (bf16_t*)(ws + WS_WCI), DM, n, 64 * kb, scr, lane); continue; }
        r -= I_CI;
        tr_plain(a.in[I_COW], DM, DM, (bf16_t*)(ws + WS_WCO), r, scr, lane);
    }
    (void)0;
}

template <int NR>
__device__ __forceinline__ void init_rows(const Args& a, int r0, int rstride, int which) {
    const int lane = lane_id_fresh(); const unsigned lo16 = (unsigned)lane * 16u, lo8 = (unsigned)lane * 8u;
    bf16_t* H = (bf16_t*)(a.ws + WS_H);
    const float* mv = (const float*)(a.ws + WS_MODV) + (size_t)which * NMOD;
    const float* src = which ? a.in[I_CTX] : a.in[I_X] - (size_t)NCTX * DM;
    f32x4 v[NR][8];
#pragma unroll
    for (int k = 0; k < NR; ++k)
#pragma unroll
        for (int j = 0; j < 8; ++j) v[k][j] = ULD4(src, (size_t)(r0 + k * rstride) * (DM * 4) + j * 1024, lo16);
#pragma unroll
    for (int j = 0; j < 8; ++j) { const f32x4 sh = ULD4(mv, j * 1024, lo16), sc = ULD4(mv, DM * 4 + j * 1024, lo16) + 1.0f;
#pragma unroll
        for (int k = 0; k < NR; ++k) { const size_t rb = (size_t)(r0 + k * rstride) * (DM * 4) + j * 1024;
            const f32x4 h = v[k][j] * sc + sh;
            u32x2 w; w.x = cvt_pk_bf16(h[0], h[1]); w.y = cvt_pk_bf16(h[2], h[3]); *(u32x2*)((char*)H + (rb >> 1) + lo8) = w; } }
}
__device__ __forceinline__ void ph_init(const Args& a, int G, int bx, int wave) {
    const int gw = bx * 8 + wave, NGW = G * 8, gwT = wave * G + bx;
    int r = NCTX + gw;
    for (; r + 3 * NGW < MTOT; r += 4 * NGW) init_rows<4>(a, r, NGW, 0);
    for (; r < MTOT; r += NGW) init_rows<1>(a, r, NGW, 0);
    for (int rc = gwT; rc < NCTX; rc += NGW) init_rows<1>(a, rc, NGW, 1);
}

__device__ __forceinline__ void conv_tasks(const bf16_t* __restrict__ GB, const bf16_t* __restrict__ PP, bf16_t* __restrict__ Y, const float* __restrict__ cw, int gw, int NGW, int lane) {
#pragma unroll 2
    for (int tk = gw; tk < MTOT; tk += NGW) {
        const int t0 = (tk >> 2) * 4;
        { const int j = tk & 3;
            const int c = 8 * lane + 512 * j;
            float w0[8], w1[8], w2[8];
#pragma unroll
            for (int i = 0; i < 8; i += 4) { const f32x4 x0 = *(const f32x4*)(cw + c + i), x1 = *(const f32x4*)(cw + DM + c + i), x2 = *(const f32x4*)(cw + 2 * DM + c + i);
                for (int q = 0; q < 4; ++q) { w0[i + q] = x0[q]; w1[i + q] = x1[q]; w2[i + q] = x2[q]; } }
            u32x4 prev = {0u, 0u, 0u, 0u}, cur, nxt;
            if (t0 != 0 && t0 != NCTX) prev = *(const u32x4*)(PP + (size_t)(t0 - 1) * DM + c);
            cur = *(const u32x4*)(PP + (size_t)t0 * DM + c);
#pragma unroll
            for (int i = 0; i < 4; ++i) { const int t = t0 + i;
                nxt = (u32x4){0u, 0u, 0u, 0u}; if (t + 1 != NCTX && t + 1 != MTOT) nxt = *(const u32x4*)(PP + (size_t)(t + 1) * DM + c);
                const u32x4 gb = *(const u32x4*)(GB + (size_t)t * DM + c);
                float y[8];
#pragma unroll
                for (int q = 0; q < 4; ++q) {
                    y[2 * q] = bf_lo(gb[q]) * (w0[2 * q] * bf_lo(prev[q]) + w1[2 * q] * bf_lo(cur[q]) + w2[2 * q] * bf_lo(nxt[q]));
                    y[2 * q + 1] = bf_hi(gb[q]) * (w0[2 * q + 1] * bf_hi(prev[q]) + w1[2 * q + 1] * bf_hi(cur[q]) + w2[2 * q + 1] * bf_hi(nxt[q])); }
                u32x4 o; o.x = cvt_pk_bf16(y[0], y[1]); o.y = cvt_pk_bf16(y[2], y[3]); o.z = cvt_pk_bf16(y[4], y[5]); o.w = cvt_pk_bf16(y[6], y[7]);
                *(u32x4*)(Y + (size_t)t * DM + c) = o; prev = cur; cur = nxt; }
        }
    }
}
__device__ __forceinline__ void ph_conv(const Args& a, int gw, int NGW, int lane) {
    const bf16_t* GB = (const bf16_t*)(a.ws + WS_MIX);
    conv_tasks(GB, GB + (size_t)33 * MiB / 2, (bf16_t*)(a.ws + WS_MIX + 66 * MiB), a.in[I_CW], gw, NGW, lane);
}

template <int GI>
__device__ __forceinline__ void pool_task(const Args& a, int t0, int jj) {
    constexpr int HW = 1 << GI, NRW = 8 + 2 * HW;
    const int lane = lane_id_fresh(); const unsigned lo16 = (unsigned)lane * 16u, lo8 = (unsigned)lane * 8u;
    const float* X = (const float*)(a.ws + WS_X); bf16_t* PO = (bf16_t*)(a.ws + WS_MIX);
    const int which = t0 < NCTX, slo = which ? 0 : NCTX, shi = which ? NCTX : MTOT;
    const float* mv = (const float*)(a.ws + WS_MODV) + (size_t)(2 + which) * NMOD + DM;
    const size_t cb = (size_t)(GI * 512 + 256 * jj) * 4;
    f32x4 xr[NRW];
#pragma unroll
    for (int i = 0; i < NRW; ++i) { const int r = t0 - HW + i; xr[i] = (f32x4){0.f, 0.f, 0.f, 0.f}; if (r >= slo && r < shi) xr[i] = ULD4(X, (size_t)r * (DM * 4) + cb, lo16); }
    const f32x4 sc = ULD4(mv, cb, lo16) + 1.0f;
    f32x4 s = {0.f, 0.f, 0.f, 0.f};
#pragma unroll
    for (int i = 0; i < 2 * HW; ++i) s += xr[i];
#pragma unroll
    for (int o = 0; o < 8; ++o) { const int t = t0 + o; const int lo = (t - HW) > slo ? (t - HW) : slo, hi = (t + HW) < shi ? (t + HW) : shi;
        const f32x4 p = (s * (1.0f / (float)(hi - lo)) - xr[o + HW]) * sc;
        u32x2 w; w.x = cvt_pk_bf16(p[0], p[1]); w.y = cvt_pk_bf16(p[2], p[3]);
        *(u32x2*)((char*)PO + ((size_t)GI * MTOT + t) * 1024 + jj * 512 + lo8) = w;
        if (o < 7) s += xr[o + 2 * HW] - xr[o]; }
}
__device__ __forceinline__ void ph_pool(const Args& a, int gw, int NGW, int  ) {
    int k = 0;
    for (int T = gw; T < MTOT; T += NGW, ++k) { const int strip = T >> 3, sub = ((T & 7) + k) & 7, g = sub >> 1, jj = sub & 1, t0 = strip * 8;
        if (g == 0) pool_task<0>(a, t0, jj); else if (g == 1) pool_task<1>(a, t0, jj); else if (g == 2) pool_task<2>(a, t0, jj); else pool_task<3>(a, t0, jj); }
}

template <bool NORM>
__device__ __forceinline__ void head_pass(bf16_t* p, const float* gain, int quarter, int row, const float* rope, bf16_t* po) {
    u32x4 raw[4], par[4];
#pragma unroll
    for (int k = 0; k < 4; ++k) raw[k] = *(const u32x4*)(p + 8 * k);
    float rstd = 1.0f;
    if (NORM) { float ss = 0.f;
#pragma unroll
        for (int k = 0; k < 4; ++k)
#pragma unroll
            for (int q = 0; q < 4; ++q) { const float lo = bf_lo(raw[k][q]), hi = bf_hi(raw[k][q]); ss += lo * lo + hi * hi; }
        ss += __shfl_xor(ss, 1); ss += __shfl_xor(ss, 2);
        rstd = 1.0f / sqrtf(ss * (1.0f / 128.0f) + RMS_EPS); }
#pragma unroll
    for (int k = 0; k < 4; ++k)
#pragma unroll
        for (int q = 0; q < 4; ++q) par[k][q] = (unsigned)__shfl_xor((int)raw[k][q], 1);
    const bool do_rope = row >= NCTX; const int t = row - NCTX;
    const int pos = (quarter < 2) ? (t >> 6) : (t & 63);
    const float* cs = rope + ((quarter < 2) ? 0 : 8192) + pos * 32; const float* sn = cs + ((quarter < 2) ? 4096 : 2048);
    const float sgn = (quarter & 1) ? 1.0f : -1.0f;
#pragma unroll
    for (int k = 0; k < 4; ++k) {
        float a_[8], b_[8];
#pragma unroll
        for (int q = 0; q < 4; ++q) { a_[2 * q] = bf_lo(raw[k][q]) * rstd; a_[2 * q + 1] = bf_hi(raw[k][q]) * rstd; b_[2 * q] = bf_lo(par[k][q]) * rstd; b_[2 * q + 1] = bf_hi(par[k][q]) * rstd; }
        if (NORM) {
#pragma unroll
            for (int i = 0; i < 8; i += 4) { const f32x4 go = *(const f32x4*)(gain + 32 * quarter + 8 * k + i), gp = *(const f32x4*)(gain + 32 * (quarter ^ 1) + 8 * k + i);
                for (int q = 0; q < 4; ++q) { a_[i + q] *= go[q]; b_[i + q] *= gp[q]; } } }
        float o_[8];
        if (do_rope) {
#pragma unroll
            for (int i = 0; i < 8; i += 4) { const f32x4 c4 = *(const f32x4*)(cs + 8 * k + i), s4 = *(const f32x4*)(sn + 8 * k + i);
                for (int q = 0; q < 4; ++q) o_[i + q] = a_[i + q] * c4[q] + sgn * b_[i + q] * s4[q]; }
        } else {
#pragma unroll
            for (int i = 0; i < 8; ++i) o_[i] = a_[i];
        }
        u32x4 o; o.x = cvt_pk_bf16(o_[0], o_[1]); o.y = cvt_pk_bf16(o_[2], o_[3]); o.z = cvt_pk_bf16(o_[4], o_[5]); o.w = cvt_pk_bf16(o_[6], o_[7]);
        *(u32x4*)(po + 8 * k) = o;
    }
}

#define LLD4(off, lo) (*(const LAS f32x4*)(lds + (off) + (lo)))
__device__ __forceinline__ void ln1_stage(const Args& a, int L, LAS unsigned char* lds, int tid) {
    const float* mv = (const float*)(a.ws + WS_MODV) + (size_t)(L * 2) * NMOD;
    const float* lg_ = a.in[I_LNG] + (size_t)(L * 2 + 0) * DM; const float* lb_ = a.in[I_LNB] + (size_t)(L * 2 + 0) * DM;
    const float* wg = a.in[I_RGW] + (size_t)L * DM * 4; const float* ps = a.in[I_PS];
    LAS f32x4* d = (LAS f32x4*)lds; const int t = tid;
    __syncthreads();
    d[t] = ((const f32x4*)lg_)[t]; d[512 + t] = ((const f32x4*)lb_)[t];
    const f32x4 psv = (L == 1) ? ((const f32x4*)ps)[t] : (f32x4){1.f, 1.f, 1.f, 1.f};
#pragma unroll
    for (int w = 0; w < 2; ++w) { const float* m = mv + (size_t)w * NMOD;
        d[1024 + w * 1536 + t] = ((const f32x4*)(m + 3 * DM))[t]; d[1536 + w * 1536 + t] = ((const f32x4*)(m + 4 * DM))[t] + 1.0f; d[2048 + w * 1536 + t] = ((const f32x4*)(m + 2 * DM))[t] * psv; }
#pragma unroll
    for (int q = 0; q < 4; ++q) d[4096 + q * 512 + t] = ((const f32x4*)wg)[q * 512 + t];
    __syncthreads();
}
struct Ln1Row { f32x4 v[8]; u32x2 dw[8]; };
__device__ __forceinline__ void ln1_load(const Args& a, int L, Ln1Row& R, int r, int which, unsigned lo16, unsigned lo8) {
    const float* X = (L == 0) ? (which ? a.in[I_CTX] : a.in[I_X] - (size_t)NCTX * DM) : (const float*)(a.ws + WS_X);
    const bf16_t* Dm = (const bf16_t*)(a.ws + WS_D);
#pragma unroll
    for (int j = 0; j < 8; ++j) { R.v[j] = ULD4N(X, (size_t)r * (DM * 4) + j * 1024, lo16); R.dw[j] = __builtin_nontemporal_load((const u32x2*)((const char*)Dm + (size_t)r * (DM * 2) + j * 512 + lo8)); }
}
__device__ __forceinline__ void ln1_compute(const Args& a, int L, Ln1Row& R, int r, int which, LAS unsigned char* lds, bool dup, int lane, unsigned lo16, unsigned lo8) {
    bf16_t* HS = (bf16_t*)(a.ws + WS_MOE); bf16_t* XB = (bf16_t*)(a.ws + (dup ? WS_DUMH : WS_H));
    const float* wet = (const float*)(a.ws + WS_WET) + (size_t)L * 4 * DM * 4;
    const float* bg = a.in[I_RGB] + L * 4; const float* be = a.in[I_REB] + L * 16;
    unsigned* cnt = (unsigned*)(a.ws + WS_CTL) + CW_CNT + (dup ? 4 : L) * 16 * 64;
    int* route = (int*)(a.ws + WS_ROUTE + (dup ? 512 * 1024 : 0));
    const unsigned lo64 = (unsigned)lane * 64u, pw = which ? 24576u : 0u;
    asm volatile("" ::: "memory");
#pragma unroll
    for (int j = 0; j < 8; ++j) { const f32x4 g2 = LLD4(32768 + pw + j * 1024, lo16);
        const f32x4 dv = {bf_lo(R.dw[j].x), bf_hi(R.dw[j].x), bf_lo(R.dw[j].y), bf_hi(R.dw[j].y)};
        R.v[j] = R.v[j] * ALPHA + g2 * dv; }
    float s1_[1], q1_[1]; s1_[0] = 0.f;
#pragma unroll
    for (int j = 0; j < 8; ++j) s1_[0] += (R.v[j][0] + R.v[j][1]) + (R.v[j][2] + R.v[j][3]);
    wave_sum_n(s1_, lane);
    const float mean = s1_[0] * (1.f / DM); q1_[0] = 0.f;
#pragma unroll
    for (int j = 0; j < 8; ++j) { const f32x4 d = R.v[j] - mean; q1_[0] += (d[0] * d[0] + d[1] * d[1]) + (d[2] * d[2] + d[3] * d[3]); }
    wave_sum_n(q1_, lane);
    const float rstd = 1.f / sqrtf(q1_[0] * (1.f / DM) + LN_EPS);
    float lg[4] = {0.f, 0.f, 0.f, 0.f};
#pragma unroll
    for (int j = 0; j < 8; ++j) {
        const f32x4 gm = LLD4(j * 1024, lo16), bt = LLD4(8192 + j * 1024, lo16), sh = LLD4(16384 + pw + j * 1024, lo16), sc = LLD4(24576 + pw + j * 1024, lo16);
        f32x4 w4[4];
#pragma unroll
        for (int i = 0; i < 4; ++i) w4[i] = LLD4(65536 + j * 4096 + i * 16, lo64);
        const f32x4 xn = (R.v[j] - mean) * rstd * gm + bt;
        { u32x2 xw_; xw_.x = cvt_pk_bf16(xn[0], xn[1]); xw_.y = cvt_pk_bf16(xn[2], xn[3]); *(u32x2*)((char*)XB + (size_t)r * (DM * 2) + j * 512 + lo8) = xw_; }
        const f32x4 hm = xn * sc + sh; R.v[j] = hm;
#pragma unroll
        for (int i = 0; i < 4; ++i) { lg[0] += hm[i] * w4[i][0]; lg[1] += hm[i] * w4[i][1]; lg[2] += hm[i] * w4[i][2]; lg[3] += hm[i] * w4[i][3]; }
        if (j & 1) asm volatile("" ::: "memory"); }
    wave_sum_n(lg, lane);
    int g_ = 0; float best = lg[0] + bg[0];
#pragma unroll
    for (int q = 1; q < 4; ++q) { const float x = lg[q] + bg[q]; if (x > best) { best = x; g_ = q; } }
    float den = 0.f;
#pragma unroll
    for (int q = 0; q < 4; ++q) den += __expf(lg[q] + bg[q] - best);
    const float pg = 1.0f / den; const int gs = __builtin_amdgcn_readfirstlane(g_);
    float le[4] = {0.f, 0.f, 0.f, 0.f};
#pragma unroll
    for (int j = 0; j < 8; ++j) {
#pragma unroll
        for (int i = 0; i < 4; ++i) { const f32x4 w = ULD4(wet, (size_t)gs * (DM * 16) + j * 4096 + i * 16, lo64); le[0] += R.v[j][i] * w[0]; le[1] += R.v[j][i] * w[1]; le[2] += R.v[j][i] * w[2]; le[3] += R.v[j][i] * w[3]; }
        if ((j & 3) == 3) asm volatile("" ::: "memory"); }
    wave_sum_n(le, lane);
    float l4[4];
#pragma unroll
    for (int q = 0; q < 4; ++q) l4[q] = le[q] + be[gs * 4 + q];
    int i0 = 0; float b0 = l4[0];
#pragma unroll
    for (int q = 1; q < 4; ++q) if (l4[q] > b0) { b0 = l4[q]; i0 = q; }
    int i1 = -1; float b1 = -3.0e38f;
#pragma unroll
    for (int q = 0; q < 4; ++q) if (q != i0 && l4[q] > b1) { b1 = l4[q]; i1 = q; }
    const float tv0 = 1.0f / (1.0f + __expf(b1 - b0));
    const int me0 = gs * 4 + i0, me1 = gs * 4 + i1;
    unsigned p0 = 0u, p1 = 0u;
    if (lane == 0) {
        p0 = __hip_atomic_fetch_add(cnt + me0 * 64, 1u, __ATOMIC_RELAXED, __HIP_MEMORY_SCOPE_AGENT);
        p1 = __hip_atomic_fetch_add(cnt + me1 * 64, 1u, __ATOMIC_RELAXED, __HIP_MEMORY_SCOPE_AGENT);
        int* rp = route + (size_t)r * 8;
        *(u32x4*)rp = (u32x4){(unsigned)me0, (unsigned)me1, p0, p1};
        *(u32x4*)(rp + 4) = (u32x4){__float_as_uint(pg * tv0), __float_as_uint(pg * (1.0f - tv0)), 0u, 0u};
    }
    if (!dup) {
        const size_t d0 = ((size_t)__builtin_amdgcn_readfirstlane(me0) * MTOT + (unsigned)__builtin_amdgcn_readfirstlane((int)p0)) * (DM * 2);
        const size_t d1 = ((size_t)__builtin_amdgcn_readfirstlane(me1) * MTOT + (unsigned)__builtin_amdgcn_readfirstlane((int)p1)) * (DM * 2);
#pragma unroll
        for (int j = 0; j < 8; ++j) { u32x2 w; w.x = cvt_pk_bf16(R.v[j][0], R.v[j][1]); w.y = cvt_pk_bf16(R.v[j][2], R.v[j][3]);
            *(u32x2*)((char*)HS + d0 + j * 512 + lo8) = w; *(u32x2*)((char*)HS + d1 + j * 512 + lo8) = w; }
    }
}
__device__ __forceinline__ void ph_ln1(const Args& a, int L, int rowlo, LAS unsigned char* lds, int tid, int G, int bx, int wave, bool dup = false) {
    const int gw = bx * 8 + wave, NGW = G * 8, gwT = wave * G + bx;
    ln1_stage(a, L, lds, tid);
    int rbase = NCTX + gw;
    for (; rbase + 3 * NGW < MTOT; rbase += 4 * NGW) {
        const int lane = lane_id_fresh(); const unsigned lo16 = (unsigned)lane * 16u, lo8 = (unsigned)lane * 8u;
        Ln1Row A, B;
        ln1_load(a, L, A, rbase, 0, lo16, lo8);
        ln1_load(a, L, B, rbase + NGW, 0, lo16, lo8);
        ln1_compute(a, L, A, rbase, 0, lds, dup, lane, lo16, lo8);
        ln1_load(a, L, A, rbase + 2 * NGW, 0, lo16, lo8);
        ln1_compute(a, L, B, rbase + NGW, 0, lds, dup, lane, lo16, lo8);
        ln1_load(a, L, B, rbase + 3 * NGW, 0, lo16, lo8);
        ln1_compute(a, L, A, rbase + 2 * NGW, 0, lds, dup, lane, lo16, lo8);
        ln1_compute(a, L, B, rbase + 3 * NGW, 0, lds, dup, lane, lo16, lo8);
    }
    for (; rbase < MTOT; rbase += NGW) { const int lane = lane_id_fresh(); const unsigned lo16 = (unsigned)lane * 16u, lo8 = (unsigned)lane * 8u;
        Ln1Row A; ln1_load(a, L, A, rbase, 0, lo16, lo8); ln1_compute(a, L, A, rbase, 0, lds, dup, lane, lo16, lo8); }
    if (rowlo == 0) for (int rc = gwT; rc < NCTX; rc += NGW) { const int lane = lane_id_fresh(); const unsigned lo16 = (unsigned)lane * 16u, lo8 = (unsigned)lane * 8u;
        Ln1Row A; ln1_load(a, L, A, rc, 1, lo16, lo8); ln1_compute(a, L, A, rc, 1, lds, dup, lane, lo16, lo8); }
}

__device__ __forceinline__ void moe_table(const Args& a, int L, LAS unsigned char* lds, int tid) {
    volatile LAS int* tb = (volatile LAS int*)(lds + MISC_OFF + 64); volatile LAS int* t2e = (volatile LAS int*)(lds + MISC_OFF + 192);
    unsigned* cnt = (unsigned*)(a.ws + WS_CTL) + CW_CNT + L * 16 * 64;
    __syncthreads();
    if (tid < 64) {
        int nt = 0;
        if (tid < 16) nt = ((int)__hip_atomic_load(cnt + tid * 64, __ATOMIC_RELAXED, __HIP_MEMORY_SCOPE_AGENT) + 255) >> 8;
        int inc = nt;
#pragma unroll
        for (int o = 1; o < 16; o <<= 1) { const int up = __shfl_up(inc, o); if ((tid & 63) >= o) inc += up; }
        if (tid < 16) { const int ex = inc - nt; tb[tid] = ex < MAXT ? ex : MAXT; if (tid == 15) tb[16] = inc < MAXT ? inc : MAXT; }
    }
    __syncthreads();
    if (tid < 96) { int e = 0;
#pragma unroll
        for (int k = 1; k < 16; ++k) e += (tb[k] <= tid) ? 1 : 0;
        t2e[tid] = e; }
    __syncthreads();
}

__device__ __forceinline__ void ph_gather(const Args& a, int rowlo, LAS unsigned char* lds, int gw, int NGW, int lane) {
    const LAS int* tb = (const LAS int*)(lds + MISC_OFF + 64);
    const bf16_t* H = (const bf16_t*)(a.ws + WS_H); bf16_t* HS = (bf16_t*)(a.ws + WS_MOE);
    const int* route = (const int*)(a.ws + WS_ROUTE);
    for (int r = rowlo + gw; r < MTOT; r += NGW) {
        const u32x4 rt = *(const u32x4*)(route + (size_t)r * 8);
        const size_t s0 = (size_t)tb[rt[0]] * 256 + rt[2], s1 = (size_t)tb[rt[1]] * 256 + rt[3];
        const u32x4* src = (const u32x4*)(H + (size_t)r * DM); u32x4* d0 = (u32x4*)(HS + s0 * DM); u32x4* d1 = (u32x4*)(HS + s1 * DM);
#pragma unroll
        for (int j = 0; j < 4; ++j) { const u32x4 x = src[lane + 64 * j]; d0[lane + 64 * j] = x; d1[lane + 64 * j] = x; }
    }
}

__device__ __forceinline__ void ln2_stage(const Args& a, int L, bool last, LAS unsigned char* lds, int tid) {
    const float* mv = (const float*)(a.ws + WS_MODV) + (size_t)(L * 2) * NMOD;
    const float* mn = (const float*)(a.ws + WS_MODV) + (size_t)((last ? L : L + 1) * 2) * NMOD;
    const float* lg_ = a.in[I_LNG] + (size_t)(L * 2 + 1) * DM; const float* lb_ = a.in[I_LNB] + (size_t)(L * 2 + 1) * DM;
    LAS f32x4* d = (LAS f32x4*)lds; const int t = tid;
    __syncthreads();
    d[t] = ((const f32x4*)lg_)[t]; d[512 + t] = ((const f32x4*)lb_)[t];
#pragma unroll
    for (int w = 0; w < 2; ++w) { const float* m = mv + (size_t)w * NMOD; const float* n = mn + (size_t)w * NMOD;
        d[1024 + w * 1536 + t] = ((const f32x4*)(m + 5 * DM))[t]; d[1536 + w * 1536 + t] = ((const f32x4*)n)[t]; d[2048 + w * 1536 + t] = ((const f32x4*)(n + DM))[t] + 1.0f; }
    __syncthreads();
}
struct Ln2Row { u32x2 xw[8], ya[8], yb[8]; };
__device__ __forceinline__ void ln2_load(const Args& a, Ln2Row& R, int r, int s0, int s1, unsigned lo16, unsigned lo8) {
    const bf16_t* XB = (const bf16_t*)(a.ws + WS_H); const bf16_t* Y2 = (const bf16_t*)(a.ws + WS_MOE + MOE_Y2);
#pragma unroll
    for (int j = 0; j < 8; ++j) { R.xw[j] = __builtin_nontemporal_load((const u32x2*)((const char*)XB + (size_t)r * (DM * 2) + j * 512 + lo8));
        R.ya[j] = __builtin_nontemporal_load((const u32x2*)((const char*)Y2 + (size_t)s0 * (DM * 2) + j * 512 + lo8)); R.yb[j] = __builtin_nontemporal_load((const u32x2*)((const char*)Y2 + (size_t)s1 * (DM * 2) + j * 512 + lo8)); }
}
__device__ __forceinline__ void ln2_compute(const Args& a, int L, Ln2Row& R, int r, float w0, float w1, int which, bool last, LAS unsigned char* lds, bool dup, int lane, unsigned lo16, unsigned lo8) {
    bf16_t* H = (bf16_t*)(a.ws + (dup ? WS_DUMH : WS_H)); float* XO = (float*)(a.ws + (dup ? WS_DUMX : WS_X)); float* OUT = dup ? (float*)(a.ws + WS_DUMX) : a.out;
    const unsigned pw = which ? 24576u : 0u;
    asm volatile("" ::: "memory");
    f32x4 v[8];
#pragma unroll
    for (int j = 0; j < 8; ++j) { const f32x4 g5 = LLD4(16384 + pw + j * 1024, lo16);
        const f32x4 y0 = {bf_lo(R.ya[j].x), bf_hi(R.ya[j].x), bf_lo(R.ya[j].y), bf_hi(R.ya[j].y)}, y1 = {bf_lo(R.yb[j].x), bf_hi(R.yb[j].x), bf_lo(R.yb[j].y), bf_hi(R.yb[j].y)};
        const f32x4 x1 = {bf_lo(R.xw[j].x), bf_hi(R.xw[j].x), bf_lo(R.xw[j].y), bf_hi(R.xw[j].y)};
        v[j] = x1 * ALPHA + g5 * (y0 * w0 + y1 * w1); }
    float s1_[1], q1_[1]; s1_[0] = 0.f;
#pragma unroll
    for (int j = 0; j < 8; ++j) s1_[0] += (v[j][0] + v[j][1]) + (v[j][2] + v[j][3]);
    wave_sum_n(s1_, lane);
    const float mean = s1_[0] * (1.f / DM); q1_[0] = 0.f;
#pragma unroll
    for (int j = 0; j < 8; ++j) { const f32x4 d = v[j] - mean; q1_[0] += (d[0] * d[0] + d[1] * d[1]) + (d[2] * d[2] + d[3] * d[3]); }
    wave_sum_n(q1_, lane);
    const float rstd = 1.f / sqrtf(q1_[0] * (1.f / DM) + LN_EPS);
#pragma unroll
    for (int j = 0; j < 8; ++j) {
        const f32x4 gm = LLD4(j * 1024, lo16), bt = LLD4(8192 + j * 1024, lo16), sh = LLD4(24576 + pw + j * 1024, lo16), sc = LLD4(32768 + pw + j * 1024, lo16);
        const f32x4 xn = (v[j] - mean) * rstd * gm + bt;
        if (last) { UST4(OUT, (size_t)(r - NCTX) * (DM * 4) + j * 1024, lo16, xn); }
        else { UST4N(XO, (size_t)r * (DM * 4) + j * 1024, lo16, xn);
               if (L != 0) { const f32x4 hm = xn * sc + sh;
                   u32x2 w; w.x = cvt_pk_bf16(hm[0], hm[1]); w.y = cvt_pk_bf16(hm[2], hm[3]); *(u32x2*)((char*)H + (size_t)r * (DM * 2) + j * 512 + lo8) = w; } }
        if (j & 1) asm volatile("" ::: "memory"); }
}
__device__ __forceinline__ void ph_ln2(const Args& a, int L, int rowlo, bool last, LAS unsigned char* lds, int tid, int G, int bx, int wave, bool dup = false) {
    const int gw = bx * 8 + wave, NGW = G * 8, gwT = wave * G + bx;
    ln2_stage(a, L, last, lds, tid);
    const LAS int* tb = (const LAS int*)(lds + MISC_OFF + 64);
    const int* route = (const int*)(a.ws + WS_ROUTE);
    int rbase = NCTX + gw;
    for (; rbase + 3 * NGW < MTOT; rbase += 4 * NGW) {
        const int lane = lane_id_fresh(); const unsigned lo16 = (unsigned)lane * 16u, lo8 = (unsigned)lane * 8u;
        int s0[4], s1[4]; float w0[4], w1[4];
#pragma unroll
        for (int i = 0; i < 4; ++i) { const int* rp = route + (size_t)(rbase + i * NGW) * 8; const u32x4 rt = *(const u32x4*)rp; const u32x4 rw = *(const u32x4*)(rp + 4);
            s0[i] = __builtin_amdgcn_readfirstlane(tb[rt[0]] * 256 + (int)rt[2]); s1[i] = __builtin_amdgcn_readfirstlane(tb[rt[1]] * 256 + (int)rt[3]);
            w0[i] = __uint_as_float(__builtin_amdgcn_readfirstlane(rw[0])); w1[i] = __uint_as_float(__builtin_amdgcn_readfirstlane(rw[1])); }
        Ln2Row A, B;
        ln2_load(a, A, rbase, s0[0], s1[0], lo16, lo8);
        ln2_load(a, B, rbase + NGW, s0[1], s1[1], lo16, lo8);
        ln2_compute(a, L, A, rbase, w0[0], w1[0], 0, last, lds, dup, lane, lo16, lo8);
        ln2_load(a, A, rbase + 2 * NGW, s0[2], s1[2], lo16, lo8);
        ln2_compute(a, L, B, rbase + NGW, w0[1], w1[1], 0, last, lds, dup, lane, lo16, lo8);
        ln2_load(a, B, rbase + 3 * NGW, s0[3], s1[3], lo16, lo8);
        ln2_compute(a, L, A, rbase + 2 * NGW, w0[2], w1[2], 0, last, lds, dup, lane, lo16, lo8);
        ln2_compute(a, L, B, rbase + 3 * NGW, w0[3], w1[3], 0, last, lds, dup, lane, lo16, lo8);
    }
    for (; rbase < MTOT; rbase += NGW) {
        const int lane = lane_id_fresh(); const unsigned lo16 = (unsigned)lane * 16u, lo8 = (unsigned)lane * 8u;
        const int* rp = route + (size_t)rbase * 8; const u32x4 rt = *(const u32x4*)rp; const u32x4 rw = *(const u32x4*)(rp + 4);
        const int s0 = __builtin_amdgcn_readfirstlane(tb[rt[0]] * 256 + (int)rt[2]), s1 = __builtin_amdgcn_readfirstlane(tb[rt[1]] * 256 + (int)rt[3]);
        Ln2Row A; ln2_load(a, A, rbase, s0, s1, lo16, lo8);
        ln2_compute(a, L, A, rbase, __uint_as_float(__builtin_amdgcn_readfirstlane(rw[0])), __uint_as_float(__builtin_amdgcn_readfirstlane(rw[1])), 0, last, lds, dup, lane, lo16, lo8);
    }
    if (rowlo == 0) for (int rc = gwT; rc < NCTX; rc += NGW) {
        const int lane = lane_id_fresh(); const unsigned lo16 = (unsigned)lane * 16u, lo8 = (unsigned)lane * 8u;
        const int* rp = route + (size_t)rc * 8; const u32x4 rt = *(const u32x4*)rp; const u32x4 rw = *(const u32x4*)(rp + 4);
        const int s0 = __builtin_amdgcn_readfirstlane(tb[rt[0]] * 256 + (int)rt[2]), s1 = __builtin_amdgcn_readfirstlane(tb[rt[1]] * 256 + (int)rt[3]);
        Ln2Row A; ln2_load(a, A, rc, s0, s1, lo16, lo8);
        ln2_compute(a, L, A, rc, __uint_as_float(__builtin_amdgcn_readfirstlane(rw[0])), __uint_as_float(__builtin_amdgcn_readfirstlane(rw[1])), 1, last, lds, dup, lane, lo16, lo8);
    }
}

constexpr int NPH = 36;
__global__ void __launch_bounds__(512, 2) mega(Args a) {
    extern __shared__ __attribute__((aligned(16))) unsigned char lds_raw[];
    LAS unsigned char* lds = (LAS unsigned char*)lds_raw;
    const int wave = __builtin_amdgcn_readfirstlane((int)threadIdx.x >> 6);
    const int G = gridDim.x, bx = blockIdx.x;
    const int gw = bx * 8 + wave, NGW = G * 8;
    unsigned char* ws = a.ws;
    unsigned* ctl = (unsigned*)(ws + WS_CTL);
#if MK_ONE_LAUNCH
#define PDUP (rp_ != 0)
#else
#define PDUP (a.probe_dup != 0)
#endif
#define FRESH() const int lane = lane_id_fresh(); const int tid = wave * 64 + lane; (void)tid; (void)lane
    { FRESH(); for (int u = tid; u < (LDS_BYTES - MISC_OFF) / 4; u += 512) ((LAS unsigned*)(lds + MISC_OFF))[u] = 0u; }
    __syncthreads();
    const int lo = a.ph_lo, hi = a.ph_hi;
    XcdBarrier bar; bar.bar = ctl + CW_BAR; bar.x = 0; bar.st = (volatile LAS unsigned*)(lds + MISC_OFF);
    if (hi - lo > 1) { FRESH(); bar = xcd_barrier_post(ctl + CW_BAR, (volatile LAS unsigned*)(lds + MISC_OFF), tid); }
#define IN(k) (lo <= (k) && (k) < hi)
#define SEAM(k) do { if (IN(k) && IN((k) + 1)) { FRESH(); xcd_barrier(bar, tid); } } while (0)

    float* X = (float*)(ws + WS_X); bf16_t* H = (bf16_t*)(ws + WS_H);
    const float* modv = (const float*)(ws + WS_MODV);
    unsigned char* mix = ws + WS_MIX; unsigned char* moe = ws + WS_MOE;

#define MOE_TAIL(L, p0, rowlo, last) do { \
    if (IN((p0))) for (int rp_ = 0; rp_ <= REPC((p0)); ++rp_) { FRESH(); cvt_catchup(a, (L) == 0 ? cq::E0 : (L) == 1 ? cq::E2 : (L) == 2 ? cq::E5 : cq::E8, lds, tid, wave, lane); ph_ln1(a, (L), (rowlo), lds, tid, G, bx, wave, PDUP); } SEAM((p0)); \
      \
    if (IN((p0) + 2)) for (int rp_ = 0; rp_ <= REPC((p0) + 2); ++rp_) { FRESH(); moe_table(a, (L), lds, tid); const int T = ((const LAS int*)(lds + MISC_OFF + 64))[16]; \
        pg8::Gemm g{(const bf16_t*)moe, (const bf16_t*)(ws + WS_WGU) + (size_t)(L) * 16 * 1536 * DM, DM, (size_t)1536 * DM}; \
        pg8::MoeOrder S; S.init(T, 6, G, bx); S.t2e = (const LAS int*)(lds + MISC_OFF + 192); S.tb = (const LAS int*)(lds + MISC_OFF + 64); S.sparse_a = true; pg8::EpiMoeA E{(bf16_t*)(moe + MOE_ACT)}; \
        pg8::gemm_phase<pg8::EpiMoeA, pg8::MoeOrder, true, true>(lds, g, S, E, tid); cvt_opportunistic(a, 20 * idle_units(T * 6, G, bx), lds, tid, wave, lane); } SEAM((p0) + 2); \
    if (IN((p0) + 3)) for (int rp_ = 0; rp_ <= REPC((p0) + 3); ++rp_) { FRESH(); moe_table(a, (L), lds, tid); const int T = ((const LAS int*)(lds + MISC_OFF + 64))[16]; \
        pg8::Gemm g{(const bf16_t*)(moe + MOE_ACT), (const bf16_t*)(ws + WS_WDN) + (size_t)(L) * 16 * DM * EFF, EFF, (size_t)DM * EFF}; \
        pg8::MoeOrder S; S.init(T, 8, G, bx); S.t2e = (const LAS int*)(lds + MISC_OFF + 192); S.tb = (const LAS int*)(lds + MISC_OFF + 64); S.sparse_a = false; pg8::EpiQKV E{(bf16_t*)(moe + MOE_Y2), DM, 1 << 20, nullptr, 1 << 20, nullptr, 0}; \
        pg8::gemm_phase<pg8::EpiQKV, pg8::MoeOrder, true, true>(lds, g, S, E, tid); cvt_opportunistic(a, 6 * idle_units(T * 8, G, bx), lds, tid, wave, lane); } SEAM((p0) + 3); \
    if (IN((p0) + 4)) for (int rp_ = 0; rp_ <= REPC((p0) + 4); ++rp_) { FRESH(); if ((L) == 1) cvt_catchup(a, cq::E3, lds, tid, wave, lane); if ((L) == 2) cvt_catchup(a, cq::E6, lds, tid, wave, lane); moe_table(a, (L), lds, tid); ph_ln2(a, (L), (rowlo), (last), lds, tid, G, bx, wave, PDUP); } \
    } while (0)

    if (IN(0)) for (int rp_ = 0; rp_ <= REPC(0); ++rp_) { FRESH(); ph_prologue(a, lds, G, wave, lane, tid); } SEAM(0);
    if (IN(1)) for (int rp_ = 0; rp_ <= REPC(1); ++rp_) { FRESH(); ph_init(a, G, bx, wave); } SEAM(1);
    if (IN(2)) for (int rp_ = 0; rp_ <= REPC(2); ++rp_) { FRESH(); pg8::Gemm g{H, (const bf16_t*)(ws + WS_WCI), DM, 0}; pg8::GridOrder S; S.init(NMT, 24, G, bx);
        pg8::EpiConv1 E{(bf16_t*)mix, (bf16_t*)(mix + 33 * MiB)};
        pg8::gemm_phase<pg8::EpiConv1, pg8::GridOrder, true, true>(lds, g, S, E, tid); cvt_opportunistic(a, 12 * idle_units(NMT * 24, G, bx), lds, tid, wave, lane); } SEAM(2);
    if (IN(3)) for (int rp_ = 0; rp_ <= REPC(3); ++rp_) { FRESH(); ph_conv(a, gw, NGW, lane); } SEAM(3);
    if (IN(4)) for (int rp_ = 0; rp_ <= REPC(4); ++rp_) { FRESH(); pg8::Gemm g{(const bf16_t*)(mix + 66 * MiB), (const bf16_t*)(ws + WS_WCO), DM, 0}; pg8::GridOrder S; S.init(NMT, 8, G, bx);
        pg8::EpiDelta E{(bf16_t*)(ws + WS_D), 0, 1 << 20, 0};
        pg8::gemm_phase<pg8::EpiDelta, pg8::GridOrder, true, true>(lds, g, S, E, tid); cvt_opportunistic(a, 12 * idle_units(NMT * 8, G, bx), lds, tid, wave, lane); } SEAM(4);
    MOE_TAIL(0, 5, 0, false); SEAM(9);
    if (IN(10)) for (int rp_ = 0; rp_ <= REPC(10); ++rp_) { FRESH(); cvt_catchup(a, cq::E1, lds, tid, wave, lane); ph_pool(a, gw, NGW, lane); } SEAM(10);
    if (IN(11)) for (int rp_ = 0; rp_ <= REPC(11); ++rp_) { FRESH(); pg8::Gemm g{(const bf16_t*)mix, (const bf16_t*)(ws + WS_WPL), 512, (size_t)512 * 512}; pg8::PoolOrder S; S.init(4 * NMT, 2, G, bx);
        pg8::EpiDelta E{(bf16_t*)(ws + WS_D), 0, NMT, 512};
        pg8::gemm_phase<pg8::EpiDelta, pg8::PoolOrder, true, true>(lds, g, S, E, tid); cvt_opportunistic(a, 3 * idle_units(4 * NMT * 2, G, bx), lds, tid, wave, lane); } SEAM(11);
    MOE_TAIL(1, 12, 0, false); SEAM(16);
    if (IN(17)) for (int rp_ = 0; rp_ <= REPC(17); ++rp_) { FRESH(); pg8::Gemm g{H, (const bf16_t*)(ws + WS_WGQ), DM, 0}; pg8::GridOrder S; S.init(NMT, 12, G, bx);
        pg8::EpiQKV E{(bf16_t*)mix, DM, 8, (bf16_t*)(mix + 33 * MiB), 10, (bf16_t*)(mix + 42 * MiB), KVHS};
        pg8::gemm_phase<pg8::EpiQKV, pg8::GridOrder, true, true>(lds, g, S, E, tid); cvt_opportunistic(a, 12 * idle_units(NMT * 12, G, bx), lds, tid, wave, lane); } SEAM(17);
    if (IN(18)) for (int rp_ = 0; rp_ <= REPC(18); ++rp_) { FRESH(); cvt_catchup(a, cq::E4, lds, tid, wave, lane);
        bf16_t* Q = (bf16_t*)mix; bf16_t* Kb = (bf16_t*)(mix + 33 * MiB); const float* rope = (const float*)(ws + WS_ROPE);
        const float* gq = a.in[I_GQN]; const float* gk = gq + 128;
        for (int task = gw; task < MTOT / 4; task += NGW) {
            const int r = task * 4 + (lane >> 4); bf16_t* pp = Kb + (size_t)((lane >> 2) & 3) * KVHS + (size_t)r * 128 + (lane & 3) * 32;
            head_pass<true>(pp, gk, lane & 3, r, rope, PDUP ? (bf16_t*)(ws + WS_DUMQ) + (size_t)r * 512 + (lane & 15) * 32 : pp); }
    } SEAM(18);
    if (IN(19)) for (int rp_ = 0; rp_ <= REPC(19); ++rp_) { FRESH();
        const bf16_t* Q = (const bf16_t*)mix; const bf16_t* Kb = (const bf16_t*)(mix + 33 * MiB); const bf16_t* Vb = (const bf16_t*)(mix + 42 * MiB); bf16_t* O = (bf16_t*)(mix + 51 * MiB);
        for (int i = 0;; ++i) { const int idx = i * G + bx; if (idx >= 528) break;
            int h, kvh, row0, seq;
            if (idx < 512) { const int ii = idx >> 8, c = idx & 255, x = c & 7, wl = c >> 3, j = (x >> 2) * 64 + wl * 2 + ii; kvh = x & 3; h = kvh * 4 + (j >> 5); row0 = NCTX + (j & 31) * 256; seq = MTOT; }
            else { h = idx - 512; kvh = h >> 2; row0 = 0; seq = NCTX; }
            att::attn_unit<DM, 128, 128, DM>(Q + (size_t)row0 * DM + h * 128, Kb + (size_t)kvh * KVHS, Vb + (size_t)kvh * KVHS, O + (size_t)row0 * DM + h * 128, seq, (char*)lds_raw, wave, a.in[I_GQN], (const float*)(ws + WS_ROPE), row0 - NCTX);
        }
    } SEAM(19);
    if (IN(20)) for (int rp_ = 0; rp_ <= REPC(20); ++rp_) { FRESH(); pg8::Gemm g{(const bf16_t*)(mix + 51 * MiB), (const bf16_t*)(ws + WS_WGO), DM, 0}; pg8::GridOrder S; S.init(NMT, 8, G, bx);
        pg8::EpiDelta E{(bf16_t*)(ws + WS_D), 0, 1 << 20, 0};
        pg8::gemm_phase<pg8::EpiDelta, pg8::GridOrder, true, true>(lds, g, S, E, tid); cvt_opportunistic(a, 12 * idle_units(NMT * 8, G, bx), lds, tid, wave, lane); } SEAM(20);
    MOE_TAIL(2, 21, 0, false); SEAM(25);
    if (IN(26)) for (int rp_ = 0; rp_ <= REPC(26); ++rp_) { FRESH(); pg8::Gemm g{H, (const bf16_t*)(ws + WS_WDQ), DM, 0}; pg8::GridOrder S; S.init(NMT, 24, G, bx);
        pg8::EpiQKVRope E{(bf16_t*)mix, (bf16_t*)(mix + 33 * MiB), (bf16_t*)(mix + 66 * MiB), KVHS, (const float*)(ws + WS_ROPE)};
        pg8::gemm_phase<pg8::EpiQKVRope, pg8::GridOrder, true, true>(lds, g, S, E, tid); cvt_opportunistic(a, 12 * idle_units(NMT * 24, G, bx), lds, tid, wave, lane); } SEAM(26);
    if (IN(28)) for (int rp_ = 0; rp_ <= REPC(28); ++rp_) { FRESH();
        const bf16_t* Q = (const bf16_t*)mix; const bf16_t* Kb = (const bf16_t*)(mix + 33 * MiB); const bf16_t* Vb = (const bf16_t*)(mix + 66 * MiB);
#pragma unroll 1
        for (int i = 0;; ++i) { const int u = bx + (i >> 1) * G; if (u >= 256) break;
            { const int m = i & 1, h = u & 7, qb = u >> 3;
                auto epi = [&](f32x16 (&o)[8], float (&rli)[16], const int wid, const int le) __attribute__((always_inline)) {
                    int i2 = i; asm volatile("" : "+s"(i2)); const int u2 = bx + (i2 >> 1) * G, m2 = i2 & 1;
                    const int r32e = le & 31, hie = le >> 5;
                    char* st = (char*)a.ws + WS_MIX + 99 * MiB + (size_t)u2 * 131072 + (unsigned)(wid * 16384) + (unsigned)le * 16u;
                    if (m2 == 0) {
#pragma unroll
                        for (int r = 0; r < 16; ++r) { const float s_ = rli[r]; u32x4 w; w.x = cvt_pk_bf16(o[0][r] * s_, o[1][r] * s_); w.y = cvt_pk_bf16(o[2][r] * s_, o[3][r] * s_); w.z = cvt_pk_bf16(o[4][r] * s_, o[5][r] * s_); w.w = cvt_pk_bf16(o[6][r] * s_, o[7][r] * s_);
                            *(u32x4*)(st + r * 1024) = w; }
                    } else {
                        const float lam = __uint_as_float(__hip_atomic_load((unsigned*)(a.ws + WS_SCAL), __ATOMIC_RELAXED, __HIP_MEMORY_SCOPE_AGENT));
                        const float oml = __uint_as_float(__hip_atomic_load((unsigned*)(a.ws + WS_SCAL) + 1, __ATOMIC_RELAXED, __HIP_MEMORY_SCOPE_AGENT));
                        const float* sub = (const float*)(a.ws + WS_SCAL + 1024); char* A2b = (char*)a.ws + WS_MIX + 163 * MiB + ((size_t)((u2 >> 3) * 256) * DM + (u2 & 7) * 256) * 2;
                        float gl[8];
#pragma unroll
                        for (int d0 = 0; d0 < 8; ++d0) gl[d0] = sub[d0 * 32 + r32e];
#pragma unroll
                        for (int r = 0; r < 16; ++r) { if ((r & 3) == 0) asm volatile("" ::: "memory");
                            const unsigned offA = (unsigned)((wid * 32 + att::crow(r, hie)) * DM + r32e) * 2u;
                            const u32x4 w = *(const u32x4*)(st + r * 1024);
                            float d[8]; float ss = 0.f; const float s_ = rli[r] * lam;
                            d[0] = bf_lo(w.x) - o[0][r] * s_; d[1] = bf_hi(w.x) - o[1][r] * s_; d[2] = bf_lo(w.y) - o[2][r] * s_; d[3] = bf_hi(w.y) - o[3][r] * s_;
                            d[4] = bf_lo(w.z) - o[4][r] * s_; d[5] = bf_hi(w.z) - o[5][r] * s_; d[6] = bf_lo(w.w) - o[6][r] * s_; d[7] = bf_hi(w.w) - o[7][r] * s_;
#pragma unroll
                            for (int d0 = 0; d0 < 8; ++d0) ss += d[d0] * d[d0];
#pragma unroll
                            for (int mk = 1; mk < 32; mk <<= 1) ss += __int_as_float(__builtin_amdgcn_ds_bpermute((le ^ mk) << 2, __float_as_int(ss)));
                            const float rs = oml / sqrtf(ss * (1.0f / 256.0f) + RMS_EPS);
#pragma unroll
                            for (int d0 = 0; d0 < 8; ++d0) { const float v = d[d0] * rs * gl[d0]; *(bf16_t*)(A2b + offA + d0 * 64) = (bf16_t)(cvt_pk_bf16(v, v) & 0xffffu); } }
                    }
                };
                att::attn_unit2<DM, 128, 128>(Q + (size_t)(NCTX + qb * 256) * DM + (h * 2 + m) * 128, Kb + (size_t)(h * 2 + m) * KVHS, Vb + (size_t)(h * 2) * KVHS, Vb + (size_t)(h * 2 + 1) * KVHS, MTOT, (char*)lds_raw, wave, epi);
            }
        }
    } SEAM(28);
    if (IN(30)) for (int rp_ = 0; rp_ <= REPC(30); ++rp_) { FRESH(); cvt_catchup(a, cq::E7, lds, tid, wave, lane); pg8::Gemm g{(const bf16_t*)(mix + 163 * MiB), (const bf16_t*)(ws + WS_WDO), DM, 0}; pg8::GridOrder S; S.init(NLAT / 256, 8, G, bx);
        pg8::EpiDelta E{(bf16_t*)(ws + WS_D), NCTX, 1 << 20, 0};
        pg8::gemm_phase<pg8::EpiDelta, pg8::GridOrder, true, true>(lds, g, S, E, tid); } SEAM(30);
    MOE_TAIL(3, 31, NCTX, true);
#undef IN
#undef FRESH
#undef SEAM
#undef MOE_TAIL
}

extern "C" void kernel_launch(void* const* d_in, const int* in_sizes, int n_in, void* d_out, int out_size, void* d_ws, size_t ws_size, hipStream_t stream) {
    static int grid = 0;
    if (grid == 0) {
        if (n_in != 27 || out_size != NLAT * DM || ws_size < WS_END) { fprintf(stderr, "kernel_launch: unexpected shapes (n_in %d out %d ws %zu)\n", n_in, out_size, ws_size); grid = -1; return; }
        int dev = 0, cus = 0, per_cu = 0;
        if (hipGetDevice(&dev) != hipSuccess || hipDeviceGetAttribute(&cus, hipDeviceAttributeMultiprocessorCount, dev) != hipSuccess) { grid = -1; return; }
        if (hipFuncSetAttribute((const void*)mega, hipFuncAttributeMaxDynamicSharedMemorySize, LDS_BYTES) != hipSuccess) { fprintf(stderr, "kernel_launch: hipFuncSetAttribute failed\n"); grid = -1; return; }
        if (hipOccupancyMaxActiveBlocksPerMultiprocessor(&per_cu, (const void*)mega, 512, LDS_BYTES) != hipSuccess || per_cu < 1) fprintf(stderr, "kernel_launch: occupancy query says %d\n", per_cu);
        (void)hipGetLastError();
        grid = cus;
    }
    if (grid < 0) return;
    (void)hipMemsetAsync((char*)d_ws + WS_CTL, 0, CTL_ZERO_BYTES, stream);
    Args a{};
    for (int i = 0; i < 27; ++i) a.in[i] = (const float*)d_in[i];
    a.out = (float*)d_out; a.ws = (unsigned char*)d_ws;
#if MK_ONE_LAUNCH
    a.ph_lo = 0; a.ph_hi = NPH;
    hipLaunchKernelGGL(mega, dim3(grid), dim3(512), LDS_BYTES, stream, a);
#else
    for (int p = 0; p < NPH; ++p) { a.ph_lo = p; a.ph_hi = p + 1; const int reps = 1 + (int)((PROBE_REP_MASK >> p) & 1ull);
        for (int r = 0; r < reps; ++r) { a.probe_dup = r; hipLaunchKernelGGL(mega, dim3(grid), dim3(512), LDS_BYTES, stream, a); } }
#endif
}
```

```cpp
#include <hip/hip_runtime.h>
#include <hip/hip_bf16.h>
#include <cstdio>
#include <cstdint>

#ifndef MK_ONE_LAUNCH
#define MK_ONE_LAUNCH 1
#endif
#ifndef PROBE_REP_MASK
#define PROBE_REP_MASK 0ull
#endif
#if MK_ONE_LAUNCH
#define REPC(k) ((int)((PROBE_REP_MASK >> (k)) & 1ull))
#else
#define REPC(k) 0
#endif

#define LAS __attribute__((address_space(3)))
#define GAS __attribute__((address_space(1)))
typedef unsigned short bf16_t;
typedef short bf16x8 __attribute__((ext_vector_type(8)));
typedef short s16x4 __attribute__((ext_vector_type(4)));
typedef float f32x4 __attribute__((ext_vector_type(4)));
typedef float f32x16 __attribute__((ext_vector_type(16)));
typedef unsigned u32x4 __attribute__((ext_vector_type(4)));
typedef unsigned u32x2 __attribute__((ext_vector_type(2)));

constexpr int DM = 2048, NLAT = 8192, NCTX = 256, MTOT = NLAT + NCTX, NMT = MTOT / 256;
constexpr int NMOD = 6 * DM;
constexpr int EFF = 768, NEXP = 16;
constexpr float ALPHA = 1.6817928305074290f;
constexpr float LN_EPS = 1e-6f, RMS_EPS = 1e-6f;
constexpr float LAM_INIT3 = 0.55605820415f;
constexpr int MAXT = 82;
constexpr size_t KVHS = (size_t)MTOT * 128;

constexpr size_t MiB = 1ull << 20;
constexpr size_t WS_CTL = 0, CTL_ZERO_BYTES = 1 * MiB;
constexpr size_t WS_MODV = 1 * MiB;
constexpr size_t WS_ROPE = 1 * MiB + 512 * 1024;
constexpr size_t WS_SCAL = WS_ROPE + 64 * 1024;
constexpr size_t WS_ROUTE = 2 * MiB;
constexpr size_t WS_WET = 3 * MiB;
constexpr size_t WS_WCI = 4 * MiB, WS_WCO = 28 * MiB, WS_WPL = 36 * MiB, WS_WGQ = 38 * MiB, WS_WGO = 50 * MiB, WS_WDQ = 58 * MiB, WS_WDO = 82 * MiB;
constexpr size_t WS_WGU = 90 * MiB, WS_WDN = 474 * MiB;
constexpr size_t WS_X = 666 * MiB, WS_H = 732 * MiB;
constexpr size_t WS_MIX = 765 * MiB;
constexpr size_t WS_MOE = 965 * MiB;
constexpr size_t MOE_ACT = 528 * MiB, MOE_Y2 = 559 * MiB;
constexpr size_t WS_D = 1606 * MiB;
constexpr size_t WS_END = 1639 * MiB;
constexpr size_t WS_DUMX = 1640 * MiB, WS_DUMH = 1707 * MiB, WS_DUMQ = 1741 * MiB;
constexpr int CW_BAR = 4096;
constexpr int CW_CNT = 8192;

__device__ __forceinline__ unsigned cvt_pk_bf16(float lo, float hi) { unsigned r; asm volatile("v_cvt_pk_bf16_f32 %0, %1, %2" : "=v"(r) : "v"(lo), "v"(hi)); return r; }
__device__ __forceinline__ float bf_lo(unsigned w) { return __uint_as_float(w << 16); }
__device__ __forceinline__ float bf_hi(unsigned w) { return __uint_as_float(w & 0xffff0000u); }
__device__ __forceinline__ float wave_sum(float v) {
#pragma unroll
    for (int o = 1; o < 64; o <<= 1) v += __shfl_xor(v, o);
    return v;
}
template <int N> __device__ __forceinline__ void wave_sum_n(float (&x)[N], const int lane) {
#pragma unroll
    for (int o = 1; o < 64; o <<= 1) { const int idx = (lane ^ o) << 2;
#pragma unroll
        for (int i = 0; i < N; ++i) x[i] += __builtin_bit_cast(float, __builtin_amdgcn_ds_bpermute(idx, __builtin_bit_cast(int, x[i])));
    }
}
__device__ __forceinline__ int lane_id_fresh() { int l; asm volatile("v_mbcnt_lo_u32_b32 %0, -1, 0\n\tv_mbcnt_hi_u32_b32 %0, -1, %0" : "=v"(l)); return l; }
#define ULD4(base, cb, lo) (*(const f32x4*)((const char*)(base) + (size_t)(cb) + (lo)))
#define UST4(base, cb, lo, val) (*(f32x4*)((char*)(base) + (size_t)(cb) + (lo)) = (val))
#define ULD4N(base, cb, lo) __builtin_nontemporal_load((const f32x4*)((const char*)(base) + (size_t)(cb) + (lo)))
#define UST4N(base, cb, lo, val) __builtin_nontemporal_store((val), (f32x4*)((char*)(base) + (size_t)(cb) + (lo)))
#define LDS_WAIT() asm volatile("s_waitcnt lgkmcnt(0)" ::: "memory")
#define VM_WAIT() asm volatile("s_waitcnt vmcnt(0)" ::: "memory")

namespace pg8 {
constexpr int BM = 256, BK = 64, HALF = 128, HTB = HALF * BK * 2, STAGE_BYTES = 8 * HTB, NXCD = 8, WGM = 8;
__host__ __device__ __forceinline__ int lds_byte(int r, int c) { const int st = (r >> 4) * 2 + (c >> 5), rr = r & 15, cc = c & 31, ob = rr * 64 + cc * 2; return st * 1024 + (ob ^ (((ob >> 9) & 1) << 5)); }
__host__ __device__ __forceinline__ void stage_rc(int b, int& R, int& C) { const int st = b / 1024, sb = b % 1024, swz = sb ^ (((sb >> 9) & 1) << 5); R = (st >> 1) * 16 + swz / 64; C = (st & 1) * 32 + (swz % 64) / 2; }
__host__ __device__ __forceinline__ int perm32(int rho) { const int n = rho >> 4, i = rho & 15; return 8 * (i >> 2) + 4 * n + (i & 3); }

struct Unit { int pm, pn, bsel, pa; };
struct Gemm { const bf16_t* A; const bf16_t* Bt; int K; size_t bstride; };

struct GridOrder {
    int nM, nN, nwg, G, c;
    __device__ void init(int nM_, int nN_, int G_, int c_) { nM = nM_; nN = nN_; nwg = nM * nN; G = G_; c = c_; }
    __device__ bool base_next(int i, Unit& u) const {
        const long L = (long)i * G + c; if (L >= nwg) return false;
        int wgid = (int)L; { const int q = nwg / NXCD, r = nwg % NXCD, xcd = wgid % NXCD, off = wgid / NXCD; wgid = (xcd < r ? xcd * (q + 1) : r * (q + 1) + (xcd - r) * q) + off; }
        const int nig = WGM * nN, gid = wgid / nig, fm = gid * WGM, gsz = (nM - fm) < WGM ? (nM - fm) : WGM;
        u.pm = fm + ((wgid % nig) % gsz); u.pn = (wgid % nig) / gsz; u.bsel = 0; u.pa = u.pm; return true;
    }
    __device__ bool next(int i, Unit& u) const { return base_next(i, u); }
};
struct PoolOrder : GridOrder {
    __device__ bool next(int i, Unit& u) const { if (!base_next(i, u)) return false; u.bsel = u.pm / NMT; return true; }
};
struct MoeOrder : GridOrder {
    const LAS int* t2e; const LAS int* tb; bool sparse_a;
    __device__ bool next(int i, Unit& u) const { if (!base_next(i, u)) return false; const int e = __builtin_amdgcn_readfirstlane(t2e[u.pm]); u.bsel = e;
        if (sparse_a) u.pa = e * NMT + (u.pm - __builtin_amdgcn_readfirstlane(tb[e])); return true; }
};

__device__ __forceinline__ u32x4 pack8(const f32x4 v0, const f32x4 v1) { u32x4 w; w.x = cvt_pk_bf16(v0[0], v0[1]); w.y = cvt_pk_bf16(v0[2], v0[3]); w.z = cvt_pk_bf16(v1[0], v1[1]); w.w = cvt_pk_bf16(v1[2], v1[3]); return w; }

struct EpiQKV {
    static constexpr bool PERM = true;
    bf16_t* P0; int ld0; int pn1; bf16_t* P1; int pn2; bf16_t* P2; size_t hs;
    __device__ __forceinline__ void operator()(const f32x4 (&acc)[2][2][4][2], const Unit& u, int wr, int wc, int fr, int fq) const {
        const int row0 = u.pm * BM + wr * 64 + fr;
        if (u.pn < pn1) {
            bf16_t* base = P0 + u.pn * BM + wc * 32 + 8 * fq;
#pragma unroll
            for (int ai = 0; ai < 2; ++ai)
#pragma unroll
                for (int m = 0; m < 4; ++m) { bf16_t* rowp = base + (size_t)(row0 + ai * HALF + m * 16) * ld0;
#pragma unroll
                    for (int bj = 0; bj < 2; ++bj) *(u32x4*)(rowp + bj * HALF) = pack8(acc[ai][bj][m][0], acc[ai][bj][m][1]); }
        } else {
            const bool s1 = u.pn < pn2; bf16_t* base = (s1 ? P1 : P2) + (size_t)(2 * (u.pn - (s1 ? pn1 : pn2))) * hs + wc * 32 + 8 * fq;
#pragma unroll
            for (int ai = 0; ai < 2; ++ai)
#pragma unroll
                for (int m = 0; m < 4; ++m) { bf16_t* rowp = base + (size_t)(row0 + ai * HALF + m * 16) * 128;
#pragma unroll
                    for (int bj = 0; bj < 2; ++bj) *(u32x4*)(rowp + bj * hs) = pack8(acc[ai][bj][m][0], acc[ai][bj][m][1]); }
        }
    }
};
struct EpiQKVRope {
    static constexpr bool PERM = true;
    bf16_t* Q; bf16_t* Kb; bf16_t* Vb; size_t hs; const float* rope;
    __device__ __forceinline__ void operator()(const f32x4 (&acc)[2][2][4][2], const Unit& u, int wr, int wc, int fr, int fq) const {
        const int row0 = u.pm * BM + wr * 64 + fr;
        if (u.pn >= 16) {
            bf16_t* base = Vb + (size_t)(2 * (u.pn - 16)) * hs + wc * 32 + 8 * fq;
#pragma unroll
            for (int ai = 0; ai < 2; ++ai)
#pragma unroll
                for (int m = 0; m < 4; ++m) { bf16_t* rowp = base + (size_t)(row0 + ai * HALF + m * 16) * 128;
#pragma unroll
                    for (int bj = 0; bj < 2; ++bj) *(u32x4*)(rowp + bj * hs) = pack8(acc[ai][bj][m][0], acc[ai][bj][m][1]); }
        } else {
            const bool isk = u.pn >= 8; const int head = (u.pn - (isk ? 8 : 0)) * 2 + (wc >> 1), qp = wc & 1;
            const bool dorope = u.pm != 0;
            const float* tab = rope + (qp ? 8192 : 0) + 8 * fq; const int sno = qp ? 2048 : 4096;
#pragma unroll
            for (int ai = 0; ai < 2; ++ai)
#pragma unroll
                for (int m = 0; m < 4; ++m) { const int row = row0 + ai * HALF + m * 16;
                    f32x4 a0 = acc[ai][0][m][0], a1 = acc[ai][0][m][1], b0 = acc[ai][1][m][0], b1 = acc[ai][1][m][1];
                    if (dorope) { const int t = row - NCTX, pos = qp ? (t & 63) : (t >> 6); const float* cs = tab + pos * 32;
                        const f32x4 c0 = *(const f32x4*)cs, c1 = *(const f32x4*)(cs + 4), s0 = *(const f32x4*)(cs + sno), s1 = *(const f32x4*)(cs + sno + 4);
                        const f32x4 na0 = a0 * c0 - b0 * s0, na1 = a1 * c1 - b1 * s1, nb0 = b0 * c0 + a0 * s0, nb1 = b1 * c1 + a1 * s1;
                        a0 = na0; a1 = na1; b0 = nb0; b1 = nb1; }
                    bf16_t* dst = isk ? Kb + (size_t)head * hs + (size_t)row * 128 : Q + (size_t)row * DM + head * 128;
                    *(u32x4*)(dst + (2 * qp) * 32 + 8 * fq) = pack8(a0, a1); *(u32x4*)(dst + (2 * qp + 1) * 32 + 8 * fq) = pack8(b0, b1); }
        }
    }
};
struct EpiConv1 {
    static constexpr bool PERM = true;
    bf16_t* GB; bf16_t* PP;
    __device__ __forceinline__ void operator()(const f32x4 (&acc)[2][2][4][2], const Unit& u, int wr, int wc, int fr, int fq) const {
        const int row0 = u.pm * BM + wr * 64 + fr;
        if (u.pn < 8) {
            const int col0 = u.pn * BM + wc * 32 + 8 * fq;
#pragma unroll
            for (int ai = 0; ai < 2; ++ai)
#pragma unroll
                for (int m = 0; m < 4; ++m) { bf16_t* rowp = GB + (size_t)(row0 + ai * HALF + m * 16) * DM + col0;
#pragma unroll
                    for (int bj = 0; bj < 2; ++bj) *(u32x4*)(rowp + bj * HALF) = pack8(acc[ai][bj][m][0], acc[ai][bj][m][1]); }
        } else {
            const int col0 = (u.pn - 8) * HALF + wc * 32 + 8 * fq;
#pragma unroll
            for (int ai = 0; ai < 2; ++ai)
#pragma unroll
                for (int m = 0; m < 4; ++m) { bf16_t* rowp = PP + (size_t)(row0 + ai * HALF + m * 16) * DM + col0;
                    *(u32x4*)rowp = pack8(acc[ai][0][m][0] * acc[ai][1][m][0], acc[ai][0][m][1] * acc[ai][1][m][1]); }
        }
    }
};
struct EpiMoeA {
    static constexpr bool PERM = true;
    bf16_t* ACT;
    __device__ __forceinline__ f32x4 act(const f32x4 g, const f32x4 u) const { f32x4 r;
#pragma unroll
        for (int j = 0; j < 4; ++j) r[j] = g[j] * __builtin_amdgcn_rcpf(1.0f + __expf(-g[j])) * u[j];
        return r; }
    __device__ __forceinline__ void operator()(const f32x4 (&acc)[2][2][4][2], const Unit& u, int wr, int wc, int fr, int fq) const {
        const int row0 = u.pm * BM + wr * 64 + fr, col0 = u.pn * HALF + wc * 32 + 8 * fq;
#pragma unroll
        for (int ai = 0; ai < 2; ++ai)
#pragma unroll
            for (int m = 0; m < 4; ++m) { bf16_t* rowp = ACT + (size_t)(row0 + ai * HALF + m * 16) * EFF + col0;
                *(u32x4*)rowp = pack8(act(acc[ai][0][m][0], acc[ai][1][m][0]), act(acc[ai][0][m][1], acc[ai][1][m][1])); }
    }
};
struct EpiDelta {
    static constexpr bool PERM = true;
    bf16_t* D; int rowbase; int mper; int gcols;
    __device__ __forceinline__ void operator()(const f32x4 (&acc)[2][2][4][2], const Unit& u, int wr, int wc, int fr, int fq) const {
        const int g = u.pm / mper, rt = u.pm - g * mper;
        const int row0 = rowbase + rt * BM + wr * 64 + fr, col0 = g * gcols + u.pn * BM + wc * 32 + 8 * fq;
#pragma unroll
        for (int ai = 0; ai < 2; ++ai)
#pragma unroll
            for (int m = 0; m < 4; ++m) { bf16_t* rowp = D + (size_t)(row0 + ai * HALF + m * 16) * DM + col0;
#pragma unroll
                for (int bj = 0; bj < 2; ++bj) *(u32x4*)(rowp + bj * HALF) = pack8(acc[ai][bj][m][0], acc[ai][bj][m][1]); }
    }
};
struct EpiResid {
    static constexpr bool PERM = false;
    float* X; const float* gate_lat; const float* gate_ctx; const float* colscale; int rowbase; int mper; int gcols;
    __device__ __forceinline__ void operator()(const f32x4 (&acc)[2][2][4][2], const Unit& u, int wr, int wc, int fr, int fq) const {
        const int g = u.pm / mper, rt = u.pm - g * mper;
        const int rowt = rowbase + rt * BM, row0 = rowt + wr * 64 + fr, col0 = g * gcols + u.pn * BM + wc * 32 + 4 * fq;
        const float* gate = (rowt < NCTX) ? gate_ctx : gate_lat;
        f32x4 gv[2][2];
#pragma unroll
        for (int bj = 0; bj < 2; ++bj)
#pragma unroll
            for (int n = 0; n < 2; ++n) { gv[bj][n] = *(const f32x4*)(gate + col0 + bj * HALF + n * 16); if (colscale) gv[bj][n] = gv[bj][n] * *(const f32x4*)(colscale + col0 + bj * HALF + n * 16); }
#pragma unroll
        for (int ai = 0; ai < 2; ++ai)
#pragma unroll
            for (int m = 0; m < 4; ++m) { float* rowp = X + (size_t)(row0 + ai * HALF + m * 16) * DM + col0;
#pragma unroll
                for (int bj = 0; bj < 2; ++bj)
#pragma unroll
                    for (int n = 0; n < 2; ++n) { float* p = rowp + bj * HALF + n * 16; const f32x4 xv = *(const f32x4*)p; *(f32x4*)p = xv * ALPHA + gv[bj][n] * acc[ai][bj][m][n]; }
                asm volatile("" ::: "memory"); }
    }
};

template <class Epi, class Sched, bool ALIGN_EPI, bool SP2>
__device__ __forceinline__ void gemm_phase(LAS unsigned char* lds, const Gemm g, const Sched& S, const Epi& E, const int tid) {
    const int wid = __builtin_amdgcn_readfirstlane(tid >> 6), lane = tid & 63, wr = wid >> 2, wc = wid & 3, fr = lane & 15, fq = lane >> 4;
    const int K = g.K, nt = K / BK;
    unsigned voffA[2], voffB[2];
#pragma unroll
    for (int i = 0; i < 2; ++i) { int R, C; stage_rc(tid * 16 + i * 8192, R, C); const int Rb = Epi::PERM ? ((R & ~31) + perm32(R & 31)) : R;
        voffA[i] = (unsigned)(R * K + C) * 2u; voffB[i] = (unsigned)(Rb * K + C) * 2u; }
    const size_t kstep = (size_t)(BK * 2);
    const size_t hstep = (size_t)HALF * K * 2;
    const size_t tstep = 2 * hstep;
    const size_t bstep = g.bstride * 2;
    const unsigned ldsw = (unsigned)wid * 1024u;
    const int aoff = lds_byte(wr * 64 + fr, fq * 8), boff = lds_byte(wc * 32 + fr, fq * 8);
#define PG8_SA(b, h) (((b) * 2 + (h)) * HTB)
#define PG8_SB(b, h) ((4 + (b) * 2 + (h)) * HTB)
#define PG8_STAGE(bufoff, gbase, voff) do { _Pragma("unroll") for (int _i = 0; _i < 2; ++_i) \
        __builtin_amdgcn_global_load_lds((const unsigned*)((const char*)(gbase) + (voff)[_i]), (LAS unsigned*)(lds + (bufoff) + ldsw + _i * 8192), 16, 0, 0); } while (0)
#define PG8_LDA(dst, b, h) do { _Pragma("unroll") for (int m = 0; m < 4; ++m) _Pragma("unroll") for (int k = 0; k < 2; ++k) dst[m][k] = *(const LAS bf16x8*)(lds + PG8_SA(b, h) + aoff + m * 2048 + k * 1024); } while (0)
#define PG8_LDB(dst, b, h) do { _Pragma("unroll") for (int n = 0; n < 2; ++n) _Pragma("unroll") for (int k = 0; k < 2; ++k) dst[n][k] = *(const LAS bf16x8*)(lds + PG8_SB(b, h) + boff + n * 2048 + k * 1024); } while (0)
#define PG8_MMA(ai, bj, At, Bt) do { __builtin_amdgcn_s_setprio(1); _Pragma("unroll") for (int m = 0; m < 4; ++m) _Pragma("unroll") for (int n = 0; n < 2; ++n) _Pragma("unroll") for (int k = 0; k < 2; ++k) \
        acc[ai][bj][m][n] = __builtin_amdgcn_mfma_f32_16x16x32_bf16(Bt[n][k], At[m][k], acc[ai][bj][m][n], 0, 0, 0); __builtin_amdgcn_s_setprio(0); } while (0)
#define PG8_WAIT_V(n) asm volatile("s_waitcnt vmcnt(" #n ")" ::: "memory")
#define PG8_WAIT_L(n) asm volatile("s_waitcnt lgkmcnt(" #n ")" ::: "memory")
#define PG8_BAR __builtin_amdgcn_s_barrier()
#define PG8_SCHED __builtin_amdgcn_sched_barrier(0)
    Unit cur, nxt; int ui = 0;
    if (!S.next(0, cur)) return;
    f32x4 acc[2][2][4][2];
#pragma unroll
    for (int a = 0; a < 2; ++a)
#pragma unroll
        for (int b = 0; b < 2; ++b)
#pragma unroll
            for (int m = 0; m < 4; ++m)
#pragma unroll
                for (int n = 0; n < 2; ++n) acc[a][b][m][n] = (f32x4){0.f, 0.f, 0.f, 0.f};
    bf16x8 At[4][2], B0[2][2], B1[2][2];
    const char* cA = (const char*)g.A + (size_t)cur.pa * tstep; const char* cB = (const char*)g.Bt + (size_t)cur.bsel * bstep + (size_t)cur.pn * tstep;
    if constexpr (SP2) {
        PG8_STAGE(PG8_SB(0, 0), cB, voffB); PG8_STAGE(PG8_SB(0, 1), cB + hstep, voffB); PG8_STAGE(PG8_SA(0, 0), cA, voffA); PG8_STAGE(PG8_SA(0, 1), cA + hstep, voffA);
        if (wr == 1) PG8_BAR;
        PG8_WAIT_V(2); PG8_BAR;
        PG8_STAGE(PG8_SB(1, 0), cB + kstep, voffB); PG8_STAGE(PG8_SA(1, 0), cA + kstep, voffA); PG8_STAGE(PG8_SB(1, 1), cB + hstep + kstep, voffB);
        PG8_WAIT_V(6); PG8_BAR;
    } else {
        PG8_STAGE(PG8_SB(0, 0), cB, voffB); PG8_STAGE(PG8_SA(0, 0), cA, voffA); PG8_STAGE(PG8_SB(0, 1), cB + hstep, voffB); PG8_STAGE(PG8_SA(0, 1), cA + hstep, voffA);
        if (wr == 1) PG8_BAR;
        PG8_WAIT_V(4); PG8_BAR;
        PG8_STAGE(PG8_SB(1, 0), cB + kstep, voffB); PG8_STAGE(PG8_SA(1, 0), cA + kstep, voffA); PG8_STAGE(PG8_SB(1, 1), cB + hstep + kstep, voffB);
        PG8_WAIT_V(6); PG8_BAR;
    }
    for (;;) {
        const bool has_next = S.next(ui + 1, nxt);
        const char* nA = has_next ? (const char*)g.A + (size_t)nxt.pa * tstep : cA; const char* nB = has_next ? (const char*)g.Bt + (size_t)nxt.bsel * bstep + (size_t)nxt.pn * tstep : cB;
        for (int t = 0; t < nt; t += 2) {
            const bool last = (t == nt - 2);
            const char* a1 = cA + (size_t)(t + 1) * kstep;
            const char* a2 = last ? nA : cA + (size_t)(t + 2) * kstep; const char* b2 = last ? nB : cB + (size_t)(t + 2) * kstep;
            const char* a3 = a2 + kstep; const char* b3 = b2 + kstep;
            if constexpr (SP2) {
            PG8_LDB(B0, 0, 0); PG8_LDB(B1, 0, 1); PG8_SCHED; PG8_LDA(At, 0, 0); PG8_STAGE(PG8_SA(1, 1), a1 + hstep, voffA);
            PG8_WAIT_V(8); PG8_WAIT_L(0); PG8_BAR; PG8_MMA(0, 0, At, B0); PG8_MMA(0, 1, At, B1); PG8_BAR; PG8_SCHED;
            PG8_LDA(At, 0, 1); PG8_STAGE(PG8_SB(0, 0), b2, voffB); PG8_STAGE(PG8_SB(0, 1), b2 + hstep, voffB); PG8_STAGE(PG8_SA(0, 0), a2, voffA);
            PG8_WAIT_V(8); PG8_WAIT_L(0); PG8_BAR; PG8_MMA(1, 0, At, B0); PG8_MMA(1, 1, At, B1); PG8_BAR; PG8_SCHED;
            PG8_LDB(B0, 1, 0); PG8_LDB(B1, 1, 1); PG8_SCHED; PG8_LDA(At, 1, 0); PG8_STAGE(PG8_SA(0, 1), a2 + hstep, voffA);
            PG8_WAIT_V(8); PG8_WAIT_L(0); PG8_BAR; PG8_MMA(0, 0, At, B0); PG8_MMA(0, 1, At, B1); PG8_BAR; PG8_SCHED;
            PG8_LDA(At, 1, 1); PG8_STAGE(PG8_SB(1, 0), b3, voffB); PG8_STAGE(PG8_SB(1, 1), b3 + hstep, voffB); PG8_STAGE(PG8_SA(1, 0), a3, voffA);
            PG8_WAIT_V(8); PG8_WAIT_L(0); PG8_BAR; PG8_MMA(1, 0, At, B0); PG8_MMA(1, 1, At, B1); PG8_BAR; PG8_SCHED;
            } else {
            PG8_LDB(B0, 0, 0); PG8_SCHED; PG8_LDA(At, 0, 0); PG8_STAGE(PG8_SA(1, 1), a1 + hstep, voffA);
            PG8_WAIT_L(8); PG8_BAR; PG8_WAIT_L(0); PG8_MMA(0, 0, At, B0); PG8_BAR; PG8_SCHED;
            PG8_LDB(B1, 0, 1); PG8_STAGE(PG8_SB(0, 0), b2, voffB);
            PG8_BAR; PG8_WAIT_L(0); PG8_MMA(0, 1, At, B1); PG8_BAR;
            PG8_LDA(At, 0, 1); PG8_STAGE(PG8_SA(0, 0), a2, voffA);
            PG8_BAR; PG8_WAIT_L(0); PG8_MMA(1, 0, At, B0); PG8_BAR; PG8_SCHED;
            PG8_STAGE(PG8_SB(0, 1), b2 + hstep, voffB);
            PG8_WAIT_V(6); PG8_BAR; PG8_MMA(1, 1, At, B1); PG8_BAR;
            PG8_LDB(B0, 1, 0); PG8_SCHED; PG8_LDA(At, 1, 0); PG8_STAGE(PG8_SA(0, 1), a2 + hstep, voffA);
            PG8_WAIT_L(8); PG8_BAR; PG8_WAIT_L(0); PG8_MMA(0, 0, At, B0); PG8_BAR; PG8_SCHED;
            PG8_LDB(B1, 1, 1); PG8_STAGE(PG8_SB(1, 0), b3, voffB);
            PG8_BAR; PG8_WAIT_L(0); PG8_MMA(0, 1, At, B1); PG8_BAR;
            PG8_LDA(At, 1, 1); PG8_STAGE(PG8_SA(1, 0), a3, voffA);
            PG8_BAR; PG8_WAIT_L(0); PG8_MMA(1, 0, At, B0); PG8_BAR; PG8_SCHED;
            PG8_STAGE(PG8_SB(1, 1), b3 + hstep, voffB);
            PG8_WAIT_V(6); PG8_BAR; PG8_MMA(1, 1, At, B1); PG8_BAR;
            }
        }
        if constexpr (ALIGN_EPI) { if (wr == 0) PG8_BAR; }
        E(acc, cur, wr, wc, fr, fq);
        if (!has_next) break;
#pragma unroll
        for (int a = 0; a < 2; ++a)
#pragma unroll
            for (int b = 0; b < 2; ++b)
#pragma unroll
                for (int m = 0; m < 4; ++m)
#pragma unroll
                    for (int n = 0; n < 2; ++n) acc[a][b][m][n] = (f32x4){0.f, 0.f, 0.f, 0.f};
        cur = nxt; cA = nA; cB = nB; ++ui;
        if constexpr (ALIGN_EPI) { if (wr == 1) PG8_BAR; }
    }
    PG8_WAIT_V(0);
    if constexpr (!ALIGN_EPI) { if (wr == 0) PG8_BAR; }
    PG8_BAR;
#undef PG8_SA
#undef PG8_SB
#undef PG8_STAGE
#undef PG8_LDA
#undef PG8_LDB
#undef PG8_MMA
#undef PG8_WAIT_V
#undef PG8_WAIT_L
#undef PG8_BAR
#undef PG8_SCHED
}
}

namespace att {
constexpr int D = 128, NW = 8, QBLK = 32, KVBLK = 64;
constexpr float SCALE = 0.088388347648318440f;
constexpr float THR = 8.f;
constexpr size_t SHM_V = KVBLK * D * 2, SHM_K = KVBLK * D * 2, SHM_ATTN = 2 * SHM_V + 2 * SHM_K + NW * 64 * 4;
#define KSWZ(row, colB) ((row) * 256 + ((colB) ^ (((row) & 7) << 4)))
#define SBAR() __builtin_amdgcn_sched_barrier(0)
__device__ __forceinline__ int crow(int r, int hi) { return (r & 3) + 8 * (r >> 2) + 4 * hi; }
__device__ __forceinline__ unsigned cvtpk(float lo, float hi) { unsigned r; asm volatile("v_cvt_pk_bf16_f32 %0, %1, %2" : "=v"(r) : "v"(lo), "v"(hi)); return r; }
__device__ __forceinline__ void partialSM(f32x16& p0, f32x16& p1, float& m_reg, float& mn, float& alpha) {
  constexpr float C = SCALE * 1.4426950408889634f;
  float pmax = p0[0]; for (int r = 1; r < 16; ++r) pmax = fmaxf(pmax, p0[r]); for (int r = 0; r < 16; ++r) pmax = fmaxf(pmax, p1[r]);
  { auto rr = __builtin_amdgcn_permlane32_swap(__float_as_uint(pmax), __float_as_uint(pmax), false, false);
    pmax = fmaxf(__uint_as_float(rr[0]), __uint_as_float(rr[1])); }
  if (__builtin_expect(__all(pmax - m_reg <= THR / SCALE), 1)) { mn = m_reg; alpha = 1.f; }
  else { mn = fmaxf(m_reg, pmax); alpha = __builtin_amdgcn_exp2f((m_reg - mn) * C); m_reg = mn; }
  float mnC = -mn * C;
  for (int r = 0; r < 16; ++r) p0[r] = fmaf(p0[r], C, mnC); for (int r = 0; r < 16; ++r) p1[r] = fmaf(p1[r], C, mnC);
  for (int r = 0; r < 16; ++r) p0[r] = __builtin_amdgcn_exp2f(p0[r]);
}
__device__ __forceinline__ void finishSM(f32x16& p0, f32x16& p1, float alpha, float& l_reg, bf16x8& pa0, bf16x8& pa1, bf16x8& pa2, bf16x8& pa3) {
  for (int r = 0; r < 16; ++r) p1[r] = __builtin_amdgcn_exp2f(p1[r]);
  float ps = 0; for (int r = 0; r < 16; ++r) ps += p0[r]; for (int r = 0; r < 16; ++r) ps += p1[r];
  { auto rr = __builtin_amdgcn_permlane32_swap(__float_as_uint(ps), __float_as_uint(ps), false, false);
    ps = __uint_as_float(rr[0]) + __uint_as_float(rr[1]); }
  l_reg = l_reg * alpha + ps;
#define PK4(P, BASE, OUT) do { unsigned a0 = cvtpk(P[BASE + 0], P[BASE + 1]), a1 = cvtpk(P[BASE + 2], P[BASE + 3]);   \
    unsigned b0 = cvtpk(P[BASE + 4], P[BASE + 5]), b1 = cvtpk(P[BASE + 6], P[BASE + 7]);                              \
    auto r0 = __builtin_amdgcn_permlane32_swap(a0, b0, false, false); auto r1 = __builtin_amdgcn_permlane32_swap(a1, b1, false, false); \
    u32x4 w = {r0[0], r1[0], r0[1], r1[1]}; OUT = *reinterpret_cast<bf16x8*>(&w); } while (0)
  PK4(p0, 0, pa0); PK4(p0, 8, pa1); PK4(p1, 0, pa2); PK4(p1, 8, pa3);
#undef PK4
}
__device__ __forceinline__ void qkt(f32x16& p0, f32x16& p1, const bf16_t* Ks, const bf16x8* qr, int r32, int hi) {
  p0 = f32x16{}; p1 = f32x16{};
  for (int d0 = 0; d0 < 8; ++d0) { int cb = (d0 * 16 + hi * 8) * 2;
    bf16x8 b0 = *reinterpret_cast<const bf16x8*>((const char*)Ks + KSWZ(r32, cb));
    bf16x8 b1 = *reinterpret_cast<const bf16x8*>((const char*)Ks + KSWZ(32 + r32, cb));
    p0 = __builtin_amdgcn_mfma_f32_32x32x16_bf16(b0, qr[d0], p0, 0, 0, 0);
    p1 = __builtin_amdgcn_mfma_f32_32x32x16_bf16(b1, qr[d0], p1, 0, 0, 0); }
}
__device__ __forceinline__ int v_st(int k, int c) { const int kk = (k & ~0xC) | ((k & 4) << 1) | ((k & 8) >> 1); return ((kk >> 3) * 4 + (c >> 5)) * 512 + ((kk & 7) * 32 + (c & 31)) * 2; }
__device__ __forceinline__ int v_rd_base(int lane) { return ((lane & 3) << 3) | (((lane >> 2) & 3) << 6) | (((lane >> 4) & 1) << 5) | (((lane >> 5) & 1) << 8); }
constexpr int v_rd_off(int d0, int ks, int half) { return d0 * 512 + ks * 4096 + half * 2048; }
template <int OFF> __device__ __forceinline__ s16x4 tr_read(int vb) {
  s16x4 r; asm volatile("ds_read_b64_tr_b16 %0, %1 offset:%2" : "=&v"(r) : "v"(vb), "i"(OFF) : "memory"); return r;
}
template <int D0> __device__ __forceinline__ void pv_one(f32x16& od, int vb, bf16x8 pa0, bf16x8 pa1, bf16x8 pa2, bf16x8 pa3) {
  const s16x4 l0 = tr_read<v_rd_off(D0, 0, 0)>(vb), h0 = tr_read<v_rd_off(D0, 0, 1)>(vb), l1 = tr_read<v_rd_off(D0, 1, 0)>(vb), h1 = tr_read<v_rd_off(D0, 1, 1)>(vb);
  const s16x4 l2 = tr_read<v_rd_off(D0, 2, 0)>(vb), h2 = tr_read<v_rd_off(D0, 2, 1)>(vb), l3 = tr_read<v_rd_off(D0, 3, 0)>(vb), h3 = tr_read<v_rd_off(D0, 3, 1)>(vb);
  asm volatile("s_waitcnt lgkmcnt(0)" ::: "memory"); SBAR();
#define PK(L, H) (bf16x8){L[0], L[1], L[2], L[3], H[0], H[1], H[2], H[3]}
  od = __builtin_amdgcn_mfma_f32_32x32x16_bf16(pa0, PK(l0, h0), od, 0, 0, 0);
  od = __builtin_amdgcn_mfma_f32_32x32x16_bf16(pa1, PK(l1, h1), od, 0, 0, 0);
  od = __builtin_amdgcn_mfma_f32_32x32x16_bf16(pa2, PK(l2, h2), od, 0, 0, 0);
  od = __builtin_amdgcn_mfma_f32_32x32x16_bf16(pa3, PK(l3, h3), od, 0, 0, 0);
#undef PK
}
__device__ __forceinline__ void pv_d0(f32x16* o, int vb, bf16x8 pa0, bf16x8 pa1, bf16x8 pa2, bf16x8 pa3) {
  pv_one<0>(o[0], vb, pa0, pa1, pa2, pa3); pv_one<1>(o[1], vb, pa0, pa1, pa2, pa3); pv_one<2>(o[2], vb, pa0, pa1, pa2, pa3); pv_one<3>(o[3], vb, pa0, pa1, pa2, pa3);
}
template <int LDQ, int LDK, int LDV, int LDO>
__device__ __forceinline__ void attn_unit(const bf16_t* __restrict__ Qb, const bf16_t* __restrict__ Kh, const bf16_t* __restrict__ Vh, bf16_t* __restrict__ Ob, int seq, char* lds, const int wid,
                                          const float* qgain = nullptr, const float* rope = nullptr, int qpos0 = -1) {
  const int lane = lane_id_fresh(), tid = wid * 64 + lane, r32 = lane & 31, hi = lane >> 5;
  bf16_t* V_lds = (bf16_t*)lds; bf16_t* K_lds = (bf16_t*)(lds + 2 * SHM_V);
  float* ws = (float*)(lds + 2 * SHM_V + 2 * SHM_K) + wid * 64; float* li_l = ws; float* al_l = ws + 32;
  float m_reg = -1e30f, l_reg = 0; f32x16 o[4] = {}; bf16x8 qr[8];
  { const unsigned offQ = (unsigned)((wid * QBLK + r32) * LDQ + hi * 8) * 2u;
#pragma unroll
  for (int d0 = 0; d0 < 8; ++d0) qr[d0] = *reinterpret_cast<const bf16x8*>((const char*)Qb + offQ + d0 * 32); }
  if (qgain) {
    float x[8][8]; float ss = 0.f;
#pragma unroll
    for (int d0 = 0; d0 < 8; ++d0) { const u32x4 w = *reinterpret_cast<const u32x4*>(&qr[d0]);
#pragma unroll
      for (int q = 0; q < 4; ++q) { x[d0][2 * q] = bf_lo(w[q]); x[d0][2 * q + 1] = bf_hi(w[q]); ss += x[d0][2 * q] * x[d0][2 * q] + x[d0][2 * q + 1] * x[d0][2 * q + 1]; } }
    { auto rr = __builtin_amdgcn_permlane32_swap(__float_as_uint(ss), __float_as_uint(ss), false, false); ss = __uint_as_float(rr[0]) + __uint_as_float(rr[1]); }
    const float rstd = 1.0f / sqrtf(ss * (1.0f / 128.0f) + RMS_EPS);
#pragma unroll
    for (int d0 = 0; d0 < 8; ++d0) { const f32x4 g0 = *(const f32x4*)(qgain + d0 * 16 + hi * 8), g1 = *(const f32x4*)(qgain + d0 * 16 + hi * 8 + 4);
#pragma unroll
      for (int j = 0; j < 4; ++j) { x[d0][j] *= rstd * g0[j]; x[d0][4 + j] *= rstd * g1[j]; } }
    if (qpos0 >= 0) { const int t = qpos0 + wid * QBLK + r32;
#pragma unroll
      for (int pr = 0; pr < 4; ++pr) { const int da = (pr >> 1) * 4 + (pr & 1), db = da + 2;
        const int pos = (pr < 2) ? (t >> 6) : (t & 63); const float* cs = rope + ((pr < 2) ? 0 : 8192) + pos * 32 + (pr & 1) * 16 + hi * 8; const float* sn = cs + ((pr < 2) ? 4096 : 2048);
        const f32x4 c0 = *(const f32x4*)cs, c1 = *(const f32x4*)(cs + 4), s0 = *(const f32x4*)sn, s1 = *(const f32x4*)(sn + 4);
#pragma unroll
        for (int j = 0; j < 8; ++j) { const float c = j < 4 ? c0[j & 3] : c1[j & 3], sv = j < 4 ? s0[j & 3] : s1[j & 3]; const float xa = x[da][j], xb = x[db][j];
          x[da][j] = xa * c - xb * sv; x[db][j] = xb * c + xa * sv; } } }
#pragma unroll
    for (int d0 = 0; d0 < 8; ++d0) { u32x4 w; w.x = cvtpk(x[d0][0], x[d0][1]); w.y = cvtpk(x[d0][2], x[d0][3]); w.z = cvtpk(x[d0][4], x[d0][5]); w.w = cvtpk(x[d0][6], x[d0][7]); qr[d0] = *reinterpret_cast<bf16x8*>(&w); }
  }
  const int sr = tid >> 4, sc = (tid & 15) * 8, vst0 = v_st(sr, sc), vst1 = v_st(32 + sr, sc);
  const int vb0 = (int)(uintptr_t)V_lds + v_rd_base(lane);
  struct { bf16x8 vs0, vs1, ks0, ks1; } sr_[2];
  const int offV = (sr * LDV + sc) * 2, offK = (sr * LDK + sc) * 2;
  const __amdgpu_buffer_rsrc_t rV = __builtin_amdgcn_make_buffer_rsrc((void*)Vh, 0, 0x7ffffff0, 0x00020000);
  const __amdgpu_buffer_rsrc_t rK = __builtin_amdgcn_make_buffer_rsrc((void*)Kh, 0, 0x7ffffff0, 0x00020000);
#define SLOAD(i, k0) do { const int sv_ = (k0) * (LDV * 2), sk_ = (k0) * (LDK * 2); \
    { u32x4 t_ = __builtin_amdgcn_raw_buffer_load_b128(rV, offV, sv_, 0); sr_[i].vs0 = *reinterpret_cast<bf16x8*>(&t_); } \
    { u32x4 t_ = __builtin_amdgcn_raw_buffer_load_b128(rV, offV, sv_ + 32 * LDV * 2, 0); sr_[i].vs1 = *reinterpret_cast<bf16x8*>(&t_); } \
    { u32x4 t_ = __builtin_amdgcn_raw_buffer_load_b128(rK, offK, sk_, 0); sr_[i].ks0 = *reinterpret_cast<bf16x8*>(&t_); } \
    { u32x4 t_ = __builtin_amdgcn_raw_buffer_load_b128(rK, offK, sk_ + 32 * LDK * 2, 0); sr_[i].ks1 = *reinterpret_cast<bf16x8*>(&t_); } } while (0)
#define SWRITE(b, i) do { *(bf16x8*)((char*)V_lds + (b) * SHM_V + vst0) = sr_[i].vs0;          \
    *(bf16x8*)((char*)V_lds + (b) * SHM_V + vst1) = sr_[i].vs1; int kc = sc * 2;               \
    *(bf16x8*)((char*)K_lds + (b) * SHM_K + KSWZ(sr, kc)) = sr_[i].ks0;                       \
    *(bf16x8*)((char*)K_lds + (b) * SHM_K + KSWZ(32 + sr, kc)) = sr_[i].ks1; } while (0)
#define SWAIT() asm volatile("s_waitcnt vmcnt(4)" ::: "memory")
#define RESC(a) do { if (__any((a) < 1.f)) { if (hi == 0) al_l[r32] = (a); asm volatile("s_waitcnt lgkmcnt(0)" ::: "memory"); \
    for (int d = 0; d < 4; ++d) for (int r = 0; r < 16; ++r) o[d][r] *= al_l[crow(r, hi)]; } } while (0)
  f32x16 pA0, pA1, pB0, pB1; float mnA, mnB, alA, alB; bf16x8 pa0, pa1, pa2, pa3; const int NT = seq / KVBLK;
  constexpr int SE = 0, SO = 1;
  SLOAD(SE, 0); asm volatile("s_waitcnt vmcnt(0)" ::: "memory"); SWRITE(0, SE); __syncthreads();
  qkt(pA0, pA1, K_lds, qr, r32, hi); partialSM(pA0, pA1, m_reg, mnA, alA);
  SLOAD(SO, KVBLK); if (2 < NT) SLOAD(SE, 2 * KVBLK);
  SWAIT(); SWRITE(1, SO); __syncthreads();
  for (int j = 1; j + 1 < NT; j += 2) {
    SBAR(); qkt(pB0, pB1, (bf16_t*)((char*)K_lds + SHM_K), qr, r32, hi);
    finishSM(pA0, pA1, alA, l_reg, pa0, pa1, pa2, pa3); SBAR();
    SLOAD(SO, (j + 2) * KVBLK); SBAR();
    pv_d0(o, vb0, pa0, pa1, pa2, pa3); partialSM(pB0, pB1, m_reg, mnB, alB);
    __syncthreads(); SWAIT(); SWRITE(0, SE);
    RESC(alB); __syncthreads();
    SBAR(); qkt(pA0, pA1, K_lds, qr, r32, hi);
    finishSM(pB0, pB1, alB, l_reg, pa0, pa1, pa2, pa3); SBAR();
    if (j + 3 < NT) SLOAD(SE, (j + 3) * KVBLK); SBAR();
    pv_d0(o, vb0 + (int)SHM_V, pa0, pa1, pa2, pa3); partialSM(pA0, pA1, m_reg, mnA, alA);
    __syncthreads(); SWAIT(); SWRITE(1, SO);
    RESC(alA); __syncthreads();
  }
  SBAR(); qkt(pB0, pB1, (bf16_t*)((char*)K_lds + SHM_K), qr, r32, hi);
  finishSM(pA0, pA1, alA, l_reg, pa0, pa1, pa2, pa3); SBAR();
  pv_d0(o, vb0, pa0, pa1, pa2, pa3); partialSM(pB0, pB1, m_reg, mnB, alB);
  __syncthreads(); RESC(alB);
  finishSM(pB0, pB1, alB, l_reg, pa0, pa1, pa2, pa3); SBAR();
  pv_d0(o, vb0 + (int)SHM_V, pa0, pa1, pa2, pa3);
  if (hi == 0) li_l[r32] = l_reg; asm volatile("s_waitcnt lgkmcnt(0)" ::: "memory");
  float rli[16];
#pragma unroll
  for (int r = 0; r < 16; ++r) rli[r] = __builtin_amdgcn_rcpf(li_l[crow(r, hi)]);
#pragma unroll
  for (int r = 0; r < 16; ++r) { const unsigned offO = (unsigned)((wid * QBLK + crow(r, hi)) * LDO + r32) * 2u;
    for (int d0 = 0; d0 < 4; ++d0) { const float v = o[d0][r] * rli[r]; *(bf16_t*)((char*)Ob + offO + d0 * 64) = (bf16_t)(cvtpk(v, v) & 0xffffu); } }
  asm volatile("s_waitcnt vmcnt(0) lgkmcnt(0)" ::: "memory"); __syncthreads();
#undef SLOAD
#undef SWRITE
#undef SWAIT
#undef RESC
}
constexpr size_t SHM_V2 = 2 * SHM_V;
template <int LDQ, int LDK, int LDV, class EPI>
__device__ __forceinline__ void attn_unit2(const bf16_t* __restrict__ Qb, const bf16_t* __restrict__ Kh, const bf16_t* __restrict__ Vh0, const bf16_t* __restrict__ Vh1, int seq, char* lds, const int wid, EPI&& epi) {
  const int lane = lane_id_fresh(), tid = wid * 64 + lane, r32 = lane & 31, hi = lane >> 5;
  bf16_t* V_lds = (bf16_t*)lds; bf16_t* K_lds = (bf16_t*)(lds + 2 * SHM_V2);
  float* ws = (float*)(lds + 2 * SHM_V2 + 2 * SHM_K) + wid * 64; float* li_l = ws; float* al_l = ws + 32;
  float m_reg = -1e30f, l_reg = 0; f32x16 o[8] = {}; bf16x8 qr[8];
  { const unsigned offQ = (unsigned)((wid * QBLK + r32) * LDQ + hi * 8) * 2u;
#pragma unroll
  for (int d0 = 0; d0 < 8; ++d0) qr[d0] = *reinterpret_cast<const bf16x8*>((const char*)Qb + offQ + d0 * 32); }
  const int sr = tid >> 4, sc = (tid & 15) * 8, vst0 = v_st(sr, sc), vst1 = v_st(32 + sr, sc);
  const int vb0 = (int)(uintptr_t)V_lds + v_rd_base(lane);
  const int offV = (sr * LDV + sc) * 2, offK = (sr * LDK + sc) * 2;
  const __amdgpu_buffer_rsrc_t rV0 = __builtin_amdgcn_make_buffer_rsrc((void*)Vh0, 0, 0x7ffffff0, 0x00020000);
  const __amdgpu_buffer_rsrc_t rV1 = __builtin_amdgcn_make_buffer_rsrc((void*)Vh1, 0, 0x7ffffff0, 0x00020000);
  const __amdgpu_buffer_rsrc_t rK = __builtin_amdgcn_make_buffer_rsrc((void*)Kh, 0, 0x7ffffff0, 0x00020000);
  u32x4 sv0, sv1, sv2, sv3, sk0, sk1;
#define SLOAD2(k0) do { const int sv_ = (k0) * (LDV * 2), sk_ = (k0) * (LDK * 2); \
    sv0 = __builtin_amdgcn_raw_buffer_load_b128(rV0, offV, sv_, 0); sv1 = __builtin_amdgcn_raw_buffer_load_b128(rV0, offV, sv_ + 32 * LDV * 2, 0); \
    sv2 = __builtin_amdgcn_raw_buffer_load_b128(rV1, offV, sv_, 0); sv3 = __builtin_amdgcn_raw_buffer_load_b128(rV1, offV, sv_ + 32 * LDV * 2, 0); \
    sk0 = __builtin_amdgcn_raw_buffer_load_b128(rK, offK, sk_, 0); sk1 = __builtin_amdgcn_raw_buffer_load_b128(rK, offK, sk_ + 32 * LDK * 2, 0); } while (0)
#define SWRITE2(b) do { char* vb_ = (char*)V_lds + (b) * SHM_V2; const int kc = sc * 2; \
    *(u32x4*)(vb_ + vst0) = sv0; *(u32x4*)(vb_ + vst1) = sv1; *(u32x4*)(vb_ + SHM_V + vst0) = sv2; *(u32x4*)(vb_ + SHM_V + vst1) = sv3; \
    *(u32x4*)((char*)K_lds + (b) * SHM_K + KSWZ(sr, kc)) = sk0; *(u32x4*)((char*)K_lds + (b) * SHM_K + KSWZ(32 + sr, kc)) = sk1; } while (0)
#define RESC2(a) do { if (__any((a) < 1.f)) { if (hi == 0) al_l[r32] = (a); asm volatile("s_waitcnt lgkmcnt(0)" ::: "memory"); \
    for (int d = 0; d < 8; ++d) for (int r = 0; r < 16; ++r) o[d][r] *= al_l[crow(r, hi)]; } } while (0)
  f32x16 p0, p1; float mn, al; bf16x8 pa0, pa1, pa2, pa3; const int NT = seq / KVBLK;
  SLOAD2(0); SWRITE2(0); __syncthreads();
  for (int j = 0; j < NT; ++j) { const int b = j & 1;
    if (j + 1 < NT) SLOAD2((j + 1) * KVBLK);
    SBAR(); qkt(p0, p1, (bf16_t*)((char*)K_lds + b * SHM_K), qr, r32, hi);
    partialSM(p0, p1, m_reg, mn, al); RESC2(al);
    finishSM(p0, p1, al, l_reg, pa0, pa1, pa2, pa3); SBAR();
    pv_d0(o, vb0 + b * (int)SHM_V2, pa0, pa1, pa2, pa3);
    pv_d0(o + 4, vb0 + b * (int)SHM_V2 + (int)SHM_V, pa0, pa1, pa2, pa3);
    __syncthreads();
    if (j + 1 < NT) SWRITE2(b ^ 1);
    __syncthreads();
  }
  const int le = lane_id_fresh(), r32e = le & 31, hie = le >> 5;
  if (hie == 0) li_l[r32e] = l_reg; asm volatile("s_waitcnt lgkmcnt(0)" ::: "memory");
  float rli[16];
#pragma unroll
  for (int r = 0; r < 16; ++r) rli[r] = __builtin_amdgcn_rcpf(li_l[crow(r, hie)]);
  epi(o, rli, wid, le);
  asm volatile("s_waitcnt vmcnt(0) lgkmcnt(0)" ::: "memory"); __syncthreads();
#undef SLOAD2
#undef SWRITE2
#undef RESC2
}
#undef KSWZ
#undef SBAR
}

#define XB_TMO      128
#define XB_XCNT(j)  (256  + 64 * (j))
#define XB_XSUB(j)  (1280 + 64 * (j))
#define XB_XGEN(j)  (2304 + 64 * (j))
#define XB_TOP      3328
#define XB_TOPGEN   3392
#define XCD_BAR_WORDS 3456
#define XB_SPIN_CAP (1u << 18)
__device__ __forceinline__ unsigned xb_ld(unsigned* p)              { return __hip_atomic_load(p, __ATOMIC_RELAXED, __HIP_MEMORY_SCOPE_AGENT); }
__device__ __forceinline__ unsigned xb_add(unsigned* p, unsigned v) { return __hip_atomic_fetch_add(p, v, __ATOMIC_RELAXED, __HIP_MEMORY_SCOPE_AGENT); }
__device__ __forceinline__ unsigned xb_xcc_id() { return (unsigned)__builtin_amdgcn_s_getreg((3 << 11) | 20) & 0xFu; }
#define XB_SPIN(cond, bar) do { unsigned _sp = 0; while (cond) { __builtin_amdgcn_s_sleep(1); \
    if ((++_sp & 255u) == 0u) { if (xb_ld(&(bar)[XB_TMO])) break; if (_sp > XB_SPIN_CAP) { atomicAdd(&(bar)[XB_TMO], 1u); break; } } } } while (0)
struct XcdBarrier { unsigned* bar; unsigned x; volatile LAS unsigned* st; };
__device__ __forceinline__ XcdBarrier xcd_barrier_post(unsigned* bar, volatile LAS unsigned* st, const int tid) {
    XcdBarrier b; b.bar = bar; b.x = xb_xcc_id(); b.st = st;
    if (tid == 0) (void)xb_add(&bar[XB_XCNT(b.x)], 1u);
    return b;
}
__device__ __forceinline__ void xcd_barrier_complete(unsigned* bar, unsigned x, unsigned& nloc, unsigned& nx) {
    const unsigned G = gridDim.x * gridDim.y * gridDim.z;
    unsigned sum, cnt, mine, sp = 0u;
    for (;;) {
        sum = 0u; cnt = 0u; mine = 0u;
#pragma unroll
        for (unsigned j = 0; j < 16; ++j) { const unsigned c = xb_ld(&bar[XB_XCNT(j)]); sum += c; cnt += (c > 0u) ? 1u : 0u; mine = (j == x) ? c : mine; }
        if (sum == G) break;
        __builtin_amdgcn_s_sleep(1);
        if ((++sp & 255u) == 0u) { if (xb_ld(&bar[XB_TMO])) break; if (sp > XB_SPIN_CAP) { atomicAdd(&bar[XB_TMO], 1u); break; } }
    }
    nloc = mine > 0u ? mine : 1u; nx = cnt > 0u ? cnt : 1u;
}
__device__ __forceinline__ void xcd_barrier(const XcdBarrier& b, const int tid) {
    asm volatile("s_waitcnt vmcnt(0)" ::: "memory");
    __syncthreads();
    if (tid == 0) {
        unsigned* bar = b.bar;
        __builtin_amdgcn_s_waitcnt(0);
        unsigned nloc = b.st[0], nx = b.st[1];
        if (nloc == 0u) { xcd_barrier_complete(bar, b.x, nloc, nx); b.st[0] = nloc; b.st[1] = nx; }
        const unsigned old = xb_add(&bar[XB_XSUB(b.x)], 1u);
        const unsigned gen = old / nloc;
        if (old + 1u == (gen + 1u) * nloc) {
            __builtin_amdgcn_fence(__ATOMIC_RELEASE, "agent");
            asm volatile("s_waitcnt vmcnt(0)" ::: "memory");
            const unsigned og = xb_add(&bar[XB_TOP], 1u);
            const unsigned tg = og / nx;
            if (og + 1u == (tg + 1u) * nx) xb_add(&bar[XB_TOPGEN], 1u);
            else XB_SPIN(xb_ld(&bar[XB_TOPGEN]) == tg, bar);
            __builtin_amdgcn_fence(__ATOMIC_ACQUIRE, "agent");
            xb_add(&bar[XB_XGEN(b.x)], 1u);
            asm volatile("s_waitcnt vmcnt(0)" ::: "memory");
        } else {
            XB_SPIN(xb_ld(&bar[XB_XGEN(b.x)]) == gen, bar);
            __builtin_amdgcn_fence(__ATOMIC_ACQUIRE, "agent");
            asm volatile("s_waitcnt vmcnt(0)" ::: "memory");
        }
    }
    __syncthreads();
}

constexpr int RING_BYTES = 131072;
constexpr int MISC_OFF = RING_BYTES;
constexpr int LDS_BYTES = 147456;

struct RowStats { float mean, rstd; };
__device__ __forceinline__ RowStats ln_stats(const f32x4 (&v)[8]) {
    float s = 0.f;
#pragma unroll
    for (int j = 0; j < 8; ++j) s += (v[j][0] + v[j][1]) + (v[j][2] + v[j][3]);
    const float mean = wave_sum(s) * (1.f / DM); float q = 0.f;
#pragma unroll
    for (int j = 0; j < 8; ++j) { const f32x4 d = v[j] - mean; q += (d[0] * d[0] + d[1] * d[1]) + (d[2] * d[2] + d[3] * d[3]); }
    RowStats r; r.mean = mean; r.rstd = 1.f / sqrtf(wave_sum(q) * (1.f / DM) + LN_EPS); return r;
}
__device__ __forceinline__ void store_bf16x4(bf16_t* p, const f32x4 v) { u32x2 w; w.x = cvt_pk_bf16(v[0], v[1]); w.y = cvt_pk_bf16(v[2], v[3]); *(u32x2*)p = w; }
__device__ __forceinline__ f32x4 load_bf16x4(const bf16_t* p) { const u32x2 w = *(const u32x2*)p; return (f32x4){bf_lo(w.x), bf_hi(w.x), bf_lo(w.y), bf_hi(w.y)}; }

__device__ __forceinline__ void transpose_item(const float* W, int ldw, int scol0, bf16_t* WT, int K, int drow0, int k0, LAS float*  , int lane) {
    const int kr = lane >> 3, n4 = (lane & 7) * 4;
    const float* src = W + (size_t)(k0 + 8 * kr) * ldw + scol0 + n4;
    f32x4 v[8];
#pragma unroll
    for (int i = 0; i < 8; ++i) v[i] = __builtin_nontemporal_load((const f32x4*)(src + (size_t)i * ldw));
    bf16_t* dst = WT + (size_t)(drow0 + n4) * K + k0 + 8 * kr;
#pragma unroll
    for (int q = 0; q < 4; ++q) { u32x4 o; o.x = cvt_pk_bf16(v[0][q], v[1][q]); o.y = cvt_pk_bf16(v[2][q], v[3][q]); o.z = cvt_pk_bf16(v[4][q], v[5][q]); o.w = cvt_pk_bf16(v[6][q], v[7][q]);
        *(u32x4*)(dst + (size_t)q * K) = o; }
}
__device__ __forceinline__ void tr_plain(const float* W, int K, int N, bf16_t* WT, int it, LAS float* scr, int lane) {
    const int nnb = N / 32, kb = it / nnb, nb = it % nnb;
    transpose_item(W, N, 32 * nb, WT, K, 32 * nb, 64 * kb, scr, lane);
}

struct Args { const float* in[27]; float* out; unsigned char* ws; int ph_lo, ph_hi; int probe_dup, pad; };
enum { I_X = 0, I_C, I_CTX, I_CCTX, I_MODW, I_MODB, I_LNG, I_LNB, I_RGW, I_RGB, I_REW, I_REB, I_EG, I_EU, I_ED, I_CIW, I_CW, I_COW, I_PW, I_PS, I_GQW, I_GQN, I_GOW, I_DQW, I_DL, I_DS, I_DOW };

namespace cq {
constexpr int I_GU = 32 * 48, I_DN = 12 * 64, I_EXP = I_GU + I_DN, I_LEXP = 16 * I_EXP;
constexpr int I_PL = 4 * 8 * 16, I_GQ = 32 * 96, I_GO = 32 * 64, I_DQ = 32 * 192, I_DO = 32 * 64;
constexpr int E0 = I_LEXP, E1 = E0 + I_PL, E2 = E1 + I_LEXP, E3 = E2 + I_GQ, E4 = E3 + I_GO, E5 = E4 + I_LEXP, E6 = E5 + I_DQ, E7 = E6 + I_DO, E8 = E7 + I_LEXP;
constexpr int NQ = E8;
}
constexpr int CW_Q = 16384;
struct __attribute__((packed, aligned(4))) F3 { float x, y, z; };
typedef float f32x3u __attribute__((ext_vector_type(3), aligned(4)));
struct TrDesc { const float* W; int ldw, sc; bf16_t* WT; int K, drow, k0; };
__device__ __forceinline__ TrDesc tr_plain_desc(const float* W, int K, int N, bf16_t* WT, int it) { const int nnb = N / 32, kb = it / nnb, nb = it % nnb; return TrDesc{W, N, 32 * nb, WT, K, 32 * nb, 64 * kb}; }
__device__ __forceinline__ TrDesc tr_expert_desc(const Args& a, int L, int r) {
    const int e = r / cq::I_EXP; r -= e * cq::I_EXP; const int le = L * 16 + e;
    if (r < cq::I_GU) {
        const int kb = r / 48, nb = r % 48, n = 32 * nb, pn = n >> 8, bj = (n >> 7) & 1, i = n & 127;
        const float* src = (bj ? a.in[I_EU] : a.in[I_EG]) + (size_t)le * DM * EFF;
        return TrDesc{src, EFF, 128 * pn + i, (bf16_t*)(a.ws + WS_WGU) + (size_t)le * 1536 * DM, DM, n, 64 * kb}; }
    return tr_plain_desc(a.in[I_ED] + (size_t)le * EFF * DM, EFF, DM, (bf16_t*)(a.ws + WS_WDN) + (size_t)le * DM * EFF, r - cq::I_GU);
}
__device__ __forceinline__ TrDesc cvt_queue_desc(const Args& a, int qi) {
    using namespace cq; TrDesc d;
    if (qi < E0) d = tr_expert_desc(a, 0, qi);
    else if (qi < E1) { const int r = qi - E0, g = r / 128; d = tr_plain_desc(a.in[I_PW] + (size_t)g * 512 * 512, 512, 512, (bf16_t*)(a.ws + WS_WPL) + (size_t)g * 512 * 512, r % 128); }
    else if (qi < E2) d = tr_expert_desc(a, 1, qi - E1);
    else if (qi < E3) d = tr_plain_desc(a.in[I_GQW], DM, 3072, (bf16_t*)(a.ws + WS_WGQ), qi - E2);
    else if (qi < E4) d = tr_plain_desc(a.in[I_GOW], DM, DM, (bf16_t*)(a.ws + WS_WGO), qi - E3);
    else if (qi < E5) d = tr_expert_desc(a, 2, qi - E4);
    else if (qi < E6) {
        const int it = qi - E5, kb = it / 192, nb = it % 192, n = 32 * nb; int sc = n;
        if (n < 4096) { const int pn = n >> 8, wi = n & 255, bj = wi >> 7, wc = (wi >> 5) & 3; sc = pn * 256 + (wc >> 1) * 128 + (2 * (wc & 1) + bj) * 32; }
        d = TrDesc{a.in[I_DQW], 3 * DM, sc, (bf16_t*)(a.ws + WS_WDQ), DM, n, 64 * kb}; }
    else if (qi < E7) d = tr_plain_desc(a.in[I_DOW], DM, DM, (bf16_t*)(a.ws + WS_WDO), qi - E6);
    else d = tr_expert_desc(a, 3, qi - E7);
    return d;
}
__device__ __forceinline__ void transpose_pair(const TrDesc& d0, const TrDesc& d1, int lane) {
    const int kr = lane >> 3, n4 = (lane & 7) * 4;
    const float* s0 = d0.W + (size_t)(d0.k0 + 8 * kr) * d0.ldw + d0.sc + n4; const float* s1 = d1.W + (size_t)(d1.k0 + 8 * kr) * d1.ldw + d1.sc + n4;
    f32x4 v0[8], v1[8];
#pragma unroll
    for (int i = 0; i < 8; ++i) v0[i] = __builtin_nontemporal_load((const f32x4*)(s0 + (size_t)i * d0.ldw));
#pragma unroll
    for (int i = 0; i < 8; ++i) v1[i] = __builtin_nontemporal_load((const f32x4*)(s1 + (size_t)i * d1.ldw));
    bf16_t* t0 = d0.WT + (size_t)(d0.drow + n4) * d0.K + d0.k0 + 8 * kr; bf16_t* t1 = d1.WT + (size_t)(d1.drow + n4) * d1.K + d1.k0 + 8 * kr;
#pragma unroll
    for (int q = 0; q < 4; ++q) { u32x4 o; o.x = cvt_pk_bf16(v0[0][q], v0[1][q]); o.y = cvt_pk_bf16(v0[2][q], v0[3][q]); o.z = cvt_pk_bf16(v0[4][q], v0[5][q]); o.w = cvt_pk_bf16(v0[6][q], v0[7][q]);
        __builtin_nontemporal_store(o, (u32x4*)(t0 + (size_t)q * d0.K)); }
#pragma unroll
    for (int q = 0; q < 4; ++q) { u32x4 o; o.x = cvt_pk_bf16(v1[0][q], v1[1][q]); o.y = cvt_pk_bf16(v1[2][q], v1[3][q]); o.z = cvt_pk_bf16(v1[4][q], v1[5][q]); o.w = cvt_pk_bf16(v1[6][q], v1[7][q]);
        __builtin_nontemporal_store(o, (u32x4*)(t1 + (size_t)q * d1.K)); }
}
__device__ __forceinline__ void cvt_run(const Args& a, int it, int n, int lane) {
    int k = 0;
    for (; k + 1 < n && it + k + 1 < cq::NQ; k += 2) { const TrDesc d0 = cvt_queue_desc(a, it + k), d1 = cvt_queue_desc(a, it + k + 1); transpose_pair(d0, d1, lane); }
    for (; k < n && it + k < cq::NQ; ++k) { const TrDesc d = cvt_queue_desc(a, it + k); transpose_item(d.W, d.ldw, d.sc, d.WT, d.K, d.drow, d.k0, nullptr, lane); }
}
__device__ __forceinline__ void cvt_opportunistic(const Args& a, int n, LAS unsigned char* lds, int tid, int wave, int lane) {
    if (n <= 0) return;
    unsigned* q = (unsigned*)(a.ws + WS_CTL) + CW_Q; volatile LAS int* qs = (volatile LAS int*)(lds + MISC_OFF + 768);
    __syncthreads();
    if (tid == 0) qs[0] = (int)__hip_atomic_fetch_add(q, (unsigned)(8 * n), __ATOMIC_RELAXED, __HIP_MEMORY_SCOPE_AGENT);
    __syncthreads();
    const int it = __builtin_amdgcn_readfirstlane(qs[0]) + wave * n;
    cvt_run(a, it, n, lane);
}
__device__ __forceinline__ void cvt_catchup(const Args& a, int target, LAS unsigned char* lds, int tid, int wave, int lane) {
    unsigned* q = (unsigned*)(a.ws + WS_CTL) + CW_Q; volatile LAS int* qs = (volatile LAS int*)(lds + MISC_OFF + 768);
    for (;;) {
        __syncthreads();
        if (tid == 0) { int h = (int)__hip_atomic_load(q, __ATOMIC_RELAXED, __HIP_MEMORY_SCOPE_AGENT);
            if (h < target) h = (int)__hip_atomic_fetch_add(q, 64u, __ATOMIC_RELAXED, __HIP_MEMORY_SCOPE_AGENT); else h = 0x7fffffff;
            qs[0] = h; }
        __syncthreads();
        const int base = __builtin_amdgcn_readfirstlane(qs[0]);
        if (base == 0x7fffffff) break;
        const int it = base + wave * 8;
        cvt_run(a, it, 8, lane);
    }
}
__device__ __forceinline__ int idle_units(int nwg, int G, int c) { const int mx = (nwg + G - 1) / G, mine = c < nwg ? (nwg - c + G - 1) / G : 0; return mx - mine; }

__device__ __forceinline__ void ph_prologue(const Args& a, LAS unsigned char* lds, int G, int wave, int lane, int tid) {
    unsigned char* ws = a.ws;
    const int bx = blockIdx.x;
    for (int t = bx; t < 256; t += G) {
        const int L = t >> 6, col0 = (t & 63) * 192;
        LAS float* sl = (LAS float*)lds; LAS float* sx = sl + DM; LAS float* red = sx + DM;
        for (int k = tid; k < DM; k += 512) { const float c = a.in[I_C][k], cc = a.in[I_CCTX][k];
            sl[k] = c / (1.f + __expf(-c)); sx[k] = cc / (1.f + __expf(-cc)); }
        __syncthreads();
        const float* W = a.in[I_MODW] + (size_t)L * DM * NMOD + col0 + 3 * lane;
        float al0 = 0.f, al1 = 0.f, al2 = 0.f, ac0 = 0.f, ac1 = 0.f, ac2 = 0.f;
        const int kb = wave * 256;
#pragma unroll 16
        for (int k = 0; k < 256; ++k) { const f32x3u w = __builtin_nontemporal_load((const f32x3u*)(W + (size_t)(kb + k) * NMOD));     const float s1 = sl[kb + k], s2 = sx[kb + k];
            al0 += w.x * s1; al1 += w.y * s1; al2 += w.z * s1; ac0 += w.x * s2; ac1 += w.y * s2; ac2 += w.z * s2; }
        LAS float* rp = red + (wave * 64 + lane) * 6;
        rp[0] = al0; rp[1] = al1; rp[2] = al2; rp[3] = ac0; rp[4] = ac1; rp[5] = ac2;
        __syncthreads();
        if (tid < 384) { const int which = tid / 192, col = tid % 192; float s_ = 0.f;
#pragma unroll
          for (int w = 0; w < 8; ++w) s_ += red[(w * 64 + col / 3) * 6 + which * 3 + col % 3];
          float* modv = (float*)(ws + WS_MODV);
          modv[(size_t)(L * 2 + which) * NMOD + col0 + col] = s_ + a.in[I_MODB][L * NMOD + col0 + col]; }
        __syncthreads();
    }
    if (bx == 0) {
        float* rope = (float*)(ws + WS_ROPE);
        for (int idx = tid; idx < 6144; idx += 512) {
            const int isc = idx >= 4096, e = isc ? idx - 4096 : idx, pos = e >> 5, i = e & 31;
            const float inv = powf(10000.0f, -(float)(2 * i) / 64.0f), ang = (float)pos * inv;
            float* cs = rope + (isc ? 8192 : 0); const int half = isc ? 2048 : 4096;
            cs[e] = cosf(ang); cs[half + e] = sinf(ang);
        }
    } else if (bx >= 2 && bx < 6) {
        const int L = bx - 2; const float* w = a.in[I_REW] + (size_t)L * DM * 16; float* wt = (float*)(ws + WS_WET) + (size_t)L * 4 * DM * 4;
        for (int idx = tid; idx < DM * 16; idx += 512) { const int c = idx >> 4, e = idx & 15; wt[((size_t)(e >> 2) * DM + c) * 4 + (e & 3)] = w[idx]; }
    } else if (bx == 1) {
        if (wave == 0) {
            const float* lv = a.in[I_DL];
            float s1 = lv[lane] * lv[128 + lane] + lv[64 + lane] * lv[192 + lane];
            float s2 = lv[256 + lane] * lv[384 + lane] + lv[320 + lane] * lv[448 + lane];
            s1 = wave_sum(s1); s2 = wave_sum(s2);
            if (lane == 0) { float* sc = (float*)(ws + WS_SCAL); sc[0] = expf(s1) - expf(s2) + LAM_INIT3; sc[1] = 1.0f - LAM_INIT3; }
        }
        if (tid < 256) ((float*)(ws + WS_SCAL + 1024))[tid] = a.in[I_DS][tid];
    }
    LAS float* scr = (LAS float*)(lds + 32768 + wave * 8448);
    const int gw = bx * 8 + wave, NGW = G * 8;
    constexpr int I_CI = 32 * 192, I_CO = 32 * 64;
    for (int it = gw; it < I_CI + I_CO; it += NGW) {
        int r = it;
        if (r < I_CI) {
            const int kb = r / 192, nb = r % 192, n = 32 * nb; int sc;
            if (n < 2048) sc = n; else { const int q = (n - 2048) >> 8, bj = ((n - 2048) >> 7) & 1, i = n & 127; sc = 2048 + bj * 2048 + 128 * q + i; }
            transpose_item(a.in[I_CIW], 3 * DM, sc, (bf16_t*)(ws + WS_WCI), DM, n, 64 * kb, scr, lane); continue; }
        r -= I_CI;
        tr_plain(a.in[I_COW], DM, DM, (bf16_t*)(ws + WS_WCO), r, scr, lane);
    }
    (void)0;
}

template <int NR>
__device__ __forceinline__ void init_rows(const Args& a, int r0, int rstride, int which) {
    const int lane = lane_id_fresh(); const unsigned lo16 = (unsigned)lane * 16u, lo8 = (unsigned)lane * 8u;
    bf16_t* H = (bf16_t*)(a.ws + WS_H);
    const float* mv = (const float*)(a.ws + WS_MODV) + (size_t)which * NMOD;
    const float* src = which ? a.in[I_CTX] : a.in[I_X] - (size_t)NCTX * DM;
    f32x4 v[NR][8];
#pragma unroll
    for (int k = 0; k < NR; ++k)
#pragma unroll
        for (int j = 0; j < 8; ++j) v[k][j] = ULD4(src, (size_t)(r0 + k * rstride) * (DM * 4) + j * 1024, lo16);
#pragma unroll
    for (int j = 0; j < 8; ++j) { const f32x4 sh = ULD4(mv, j * 1024, lo16), sc = ULD4(mv, DM * 4 + j * 1024, lo16) + 1.0f;
#pragma unroll
        for (int k = 0; k < NR; ++k) { const size_t rb = (size_t)(r0 + k * rstride) * (DM * 4) + j * 1024;
            const f32x4 h = v[k][j] * sc + sh;
            u32x2 w; w.x = cvt_pk_bf16(h[0], h[1]); w.y = cvt_pk_bf16(h[2], h[3]); *(u32x2*)((char*)H + (rb >> 1) + lo8) = w; } }
}
__device__ __forceinline__ void ph_init(const Args& a, int G, int bx, int wave) {
    const int gw = bx * 8 + wave, NGW = G * 8, gwT = wave * G + bx;
    int r = NCTX + gw;
    for (; r + 3 * NGW < MTOT; r += 4 * NGW) init_rows<4>(a, r, NGW, 0);
    for (; r < MTOT; r += NGW) init_rows<1>(a, r, NGW, 0);
    for (int rc = gwT; rc < NCTX; rc += NGW) init_rows<1>(a, rc, NGW, 1);
}

__device__ __forceinline__ void conv_tasks(const bf16_t* __restrict__ GB, const bf16_t* __restrict__ PP, bf16_t* __restrict__ Y, const float* __restrict__ cw, int gw, int NGW, int lane) {
#pragma unroll 2
    for (int tk = gw; tk < MTOT; tk += NGW) {
        const int t0 = (tk >> 2) * 4;
        { const int j = tk & 3;
            const int c = 8 * lane + 512 * j;
            float w0[8], w1[8], w2[8];
#pragma unroll
            for (int i = 0; i < 8; i += 4) { const f32x4 x0 = *(const f32x4*)(cw + c + i), x1 = *(const f32x4*)(cw + DM + c + i), x2 = *(const f32x4*)(cw + 2 * DM + c + i);
                for (int q = 0; q < 4; ++q) { w0[i + q] = x0[q]; w1[i + q] = x1[q]; w2[i + q] = x2[q]; } }
            u32x4 prev = {0u, 0u, 0u, 0u}, cur, nxt;
            if (t0 != 0 && t0 != NCTX) prev = *(const u32x4*)(PP + (size_t)(t0 - 1) * DM + c);
            cur = *(const u32x4*)(PP + (size_t)t0 * DM + c);
#pragma unroll
            for (int i = 0; i < 4; ++i) { const int t = t0 + i;
                nxt = (u32x4){0u, 0u, 0u, 0u}; if (t + 1 != NCTX && t + 1 != MTOT) nxt = *(const u32x4*)(PP + (size_t)(t + 1) * DM + c);
                const u32x4 gb = *(const u32x4*)(GB + (size_t)t * DM + c);
                float y[8];
#pragma unroll
                for (int q = 0; q < 4; ++q) {
                    y[2 * q] = bf_lo(gb[q]) * (w0[2 * q] * bf_lo(prev[q]) + w1[2 * q] * bf_lo(cur[q]) + w2[2 * q] * bf_lo(nxt[q]));
                    y[2 * q + 1] = bf_hi(gb[q]) * (w0[2 * q + 1] * bf_hi(prev[q]) + w1[2 * q + 1] * bf_hi(cur[q]) + w2[2 * q + 1] * bf_hi(nxt[q])); }
                u32x4 o; o.x = cvt_pk_bf16(y[0], y[1]); o.y = cvt_pk_bf16(y[2], y[3]); o.z = cvt_pk_bf16(y[4], y[5]); o.w = cvt_pk_bf16(y[6], y[7]);
                *(u32x4*)(Y + (size_t)t * DM + c) = o; prev = cur; cur = nxt; }
        }
    }
}
__device__ __forceinline__ void ph_conv(const Args& a, int gw, int NGW, int lane) {
    const bf16_t* GB = (const bf16_t*)(a.ws + WS_MIX);
    conv_tasks(GB, GB + (size_t)33 * MiB / 2, (bf16_t*)(a.ws + WS_MIX + 66 * MiB), a.in[I_CW], gw, NGW, lane);
}

template <int GI>
__device__ __forceinline__ void pool_task(const Args& a, int t0, int jj) {
    constexpr int HW = 1 << GI, NRW = 8 + 2 * HW;
    const int lane = lane_id_fresh(); const unsigned lo16 = (unsigned)lane * 16u, lo8 = (unsigned)lane * 8u;
    const float* X = (const float*)(a.ws + WS_X); bf16_t* PO = (bf16_t*)(a.ws + WS_MIX);
    const int which = t0 < NCTX, slo = which ? 0 : NCTX, shi = which ? NCTX : MTOT;
    const float* mv = (const float*)(a.ws + WS_MODV) + (size_t)(2 + which) * NMOD + DM;
    const size_t cb = (size_t)(GI * 512 + 256 * jj) * 4;
    f32x4 xr[NRW];
#pragma unroll
    for (int i = 0; i < NRW; ++i) { const int r = t0 - HW + i; xr[i] = (f32x4){0.f, 0.f, 0.f, 0.f}; if (r >= slo && r < shi) xr[i] = ULD4(X, (size_t)r * (DM * 4) + cb, lo16); }
    const f32x4 sc = ULD4(mv, cb, lo16) + 1.0f;
    f32x4 s = {0.f, 0.f, 0.f, 0.f};
#pragma unroll
    for (int i = 0; i < 2 * HW; ++i) s += xr[i];
#pragma unroll
    for (int o = 0; o < 8; ++o) { const int t = t0 + o; const int lo = (t - HW) > slo ? (t - HW) : slo, hi = (t + HW) < shi ? (t + HW) : shi;
        const f32x4 p = (s * (1.0f / (float)(hi - lo)) - xr[o + HW]) * sc;
        u32x2 w; w.x = cvt_pk_bf16(p[0], p[1]); w.y = cvt_pk_bf16(p[2], p[3]);
        *(u32x2*)((char*)PO + ((size_t)GI * MTOT + t) * 1024 + jj * 512 + lo8) = w;
        if (o < 7) s += xr[o + 2 * HW] - xr[o]; }
}
__device__ __forceinline__ void ph_pool(const Args& a, int gw, int NGW, int  ) {
    int k = 0;
    for (int T = gw; T < MTOT; T += NGW, ++k) { const int strip = T >> 3, sub = ((T & 7) + k) & 7, g = sub >> 1, jj = sub & 1, t0 = strip * 8;
        if (g == 0) pool_task<0>(a, t0, jj); else if (g == 1) pool_task<1>(a, t0, jj); else if (g == 2) pool_task<2>(a, t0, jj); else pool_task<3>(a, t0, jj); }
}

template <bool NORM>
__device__ __forceinline__ void head_pass(bf16_t* p, const float* gain, int quarter, int row, const float* rope, bf16_t* po) {
    u32x4 raw[4], par[4];
#pragma unroll
    for (int k = 0; k < 4; ++k) raw[k] = *(const u32x4*)(p + 8 * k);
    float rstd = 1.0f;
    if (NORM) { float ss = 0.f;
#pragma unroll
        for (int k = 0; k < 4; ++k)
#pragma unroll
            for (int q = 0; q < 4; ++q) { const float lo = bf_lo(raw[k][q]), hi = bf_hi(raw[k][q]); ss += lo * lo + hi * hi; }
        ss += __shfl_xor(ss, 1); ss += __shfl_xor(ss, 2);
        rstd = 1.0f / sqrtf(ss * (1.0f / 128.0f) + RMS_EPS); }
#pragma unroll
    for (int k = 0; k < 4; ++k)
#pragma unroll
        for (int q = 0; q < 4; ++q) par[k][q] = (unsigned)__shfl_xor((int)raw[k][q], 1);
    const bool do_rope = row >= NCTX; const int t = row - NCTX;
    const int pos = (quarter < 2) ? (t >> 6) : (t & 63);
    const float* cs = rope + ((quarter < 2) ? 0 : 8192) + pos * 32; const float* sn = cs + ((quarter < 2) ? 4096 : 2048);
    const float sgn = (quarter & 1) ? 1.0f : -1.0f;
#pragma unroll
    for (int k = 0; k < 4; ++k) {
        float a_[8], b_[8];
#pragma unroll
        for (int q = 0; q < 4; ++q) { a_[2 * q] = bf_lo(raw[k][q]) * rstd; a_[2 * q + 1] = bf_hi(raw[k][q]) * rstd; b_[2 * q] = bf_lo(par[k][q]) * rstd; b_[2 * q + 1] = bf_hi(par[k][q]) * rstd; }
        if (NORM) {
#pragma unroll
            for (int i = 0; i < 8; i += 4) { const f32x4 go = *(const f32x4*)(gain + 32 * quarter + 8 * k + i), gp = *(const f32x4*)(gain + 32 * (quarter ^ 1) + 8 * k + i);
                for (int q = 0; q < 4; ++q) { a_[i + q] *= go[q]; b_[i + q] *= gp[q]; } } }
        float o_[8];
        if (do_rope) {
#pragma unroll
            for (int i = 0; i < 8; i += 4) { const f32x4 c4 = *(const f32x4*)(cs + 8 * k + i), s4 = *(const f32x4*)(sn + 8 * k + i);
                for (int q = 0; q < 4; ++q) o_[i + q] = a_[i + q] * c4[q] + sgn * b_[i + q] * s4[q]; }
        } else {
#pragma unroll
            for (int i = 0; i < 8; ++i) o_[i] = a_[i];
        }
        u32x4 o; o.x = cvt_pk_bf16(o_[0], o_[1]); o.y = cvt_pk_bf16(o_[2], o_[3]); o.z = cvt_pk_bf16(o_[4], o_[5]); o.w = cvt_pk_bf16(o_[6], o_[7]);
        *(u32x4*)(po + 8 * k) = o;
    }
}

#define LLD4(off, lo) (*(const LAS f32x4*)(lds + (off) + (lo)))
__device__ __forceinline__ void ln1_stage(const Args& a, int L, LAS unsigned char* lds, int tid) {
    const float* mv = (const float*)(a.ws + WS_MODV) + (size_t)(L * 2) * NMOD;
    const float* lg_ = a.in[I_LNG] + (size_t)(L * 2 + 0) * DM; const float* lb_ = a.in[I_LNB] + (size_t)(L * 2 + 0) * DM;
    const float* wg = a.in[I_RGW] + (size_t)L * DM * 4; const float* ps = a.in[I_PS];
    LAS f32x4* d = (LAS f32x4*)lds; const int t = tid;
    __syncthreads();
    d[t] = ((const f32x4*)lg_)[t]; d[512 + t] = ((const f32x4*)lb_)[t];
    const f32x4 psv = (L == 1) ? ((const f32x4*)ps)[t] : (f32x4){1.f, 1.f, 1.f, 1.f};
#pragma unroll
    for (int w = 0; w < 2; ++w) { const float* m = mv + (size_t)w * NMOD;
        d[1024 + w * 1536 + t] = ((const f32x4*)(m + 3 * DM))[t]; d[1536 + w * 1536 + t] = ((const f32x4*)(m + 4 * DM))[t] + 1.0f; d[2048 + w * 1536 + t] = ((const f32x4*)(m + 2 * DM))[t] * psv; }
#pragma unroll
    for (int q = 0; q < 4; ++q) d[4096 + q * 512 + t] = ((const f32x4*)wg)[q * 512 + t];
    __syncthreads();
}
struct Ln1Row { f32x4 v[8]; u32x2 dw[8]; };
__device__ __forceinline__ void ln1_load(const Args& a, int L, Ln1Row& R, int r, int which, unsigned lo16, unsigned lo8) {
    const float* X = (L == 0) ? (which ? a.in[I_CTX] : a.in[I_X] - (size_t)NCTX * DM) : (const float*)(a.ws + WS_X);
    const bf16_t* Dm = (const bf16_t*)(a.ws + WS_D);
#pragma unroll
    for (int j = 0; j < 8; ++j) { R.v[j] = ULD4N(X, (size_t)r * (DM * 4) + j * 1024, lo16); R.dw[j] = __builtin_nontemporal_load((const u32x2*)((const char*)Dm + (size_t)r * (DM * 2) + j * 512 + lo8)); }
}
__device__ __forceinline__ void ln1_compute(const Args& a, int L, Ln1Row& R, int r, int which, LAS unsigned char* lds, bool dup, int lane, unsigned lo16, unsigned lo8) {
    bf16_t* HS = (bf16_t*)(a.ws + WS_MOE); bf16_t* XB = (bf16_t*)(a.ws + (dup ? WS_DUMH : WS_H));
    const float* wet = (const float*)(a.ws + WS_WET) + (size_t)L * 4 * DM * 4;
    const float* bg = a.in[I_RGB] + L * 4; const float* be = a.in[I_REB] + L * 16;
    unsigned* cnt = (unsigned*)(a.ws + WS_CTL) + CW_CNT + (dup ? 4 : L) * 16 * 64;
    int* route = (int*)(a.ws + WS_ROUTE + (dup ? 512 * 1024 : 0));
    const unsigned lo64 = (unsigned)lane * 64u, pw = which ? 24576u : 0u;
    asm volatile("" ::: "memory");
#pragma unroll
    for (int j = 0; j < 8; ++j) { const f32x4 g2 = LLD4(32768 + pw + j * 1024, lo16);
        const f32x4 dv = {bf_lo(R.dw[j].x), bf_hi(R.dw[j].x), bf_lo(R.dw[j].y), bf_hi(R.dw[j].y)};
        R.v[j] = R.v[j] * ALPHA + g2 * dv; }
    float s1_[1], q1_[1]; s1_[0] = 0.f;
#pragma unroll
    for (int j = 0; j < 8; ++j) s1_[0] += (R.v[j][0] + R.v[j][1]) + (R.v[j][2] + R.v[j][3]);
    wave_sum_n(s1_, lane);
    const float mean = s1_[0] * (1.f / DM); q1_[0] = 0.f;
#pragma unroll
    for (int j = 0; j < 8; ++j) { const f32x4 d = R.v[j] - mean; q1_[0] += (d[0] * d[0] + d[1] * d[1]) + (d[2] * d[2] + d[3] * d[3]); }
    wave_sum_n(q1_, lane);
    const float rstd = 1.f / sqrtf(q1_[0] * (1.f / DM) + LN_EPS);
    float lg[4] = {0.f, 0.f, 0.f, 0.f};
#pragma unroll
    for (int j = 0; j < 8; ++j) {
        const f32x4 gm = LLD4(j * 1024, lo16), bt = LLD4(8192 + j * 1024, lo16), sh = LLD4(16384 + pw + j * 1024, lo16), sc = LLD4(24576 + pw + j * 1024, lo16);
        f32x4 w4[4];
#pragma unroll
        for (int i = 0; i < 4; ++i) w4[i] = LLD4(65536 + j * 4096 + i * 16, lo64);
        const f32x4 xn = (R.v[j] - mean) * rstd * gm + bt;
        { u32x2 xw_; xw_.x = cvt_pk_bf16(xn[0], xn[1]); xw_.y = cvt_pk_bf16(xn[2], xn[3]); *(u32x2*)((char*)XB + (size_t)r * (DM * 2) + j * 512 + lo8) = xw_; }
        const f32x4 hm = xn * sc + sh; R.v[j] = hm;
#pragma unroll
        for (int i = 0; i < 4; ++i) { lg[0] += hm[i] * w4[i][0]; lg[1] += hm[i] * w4[i][1]; lg[2] += hm[i] * w4[i][2]; lg[3] += hm[i] * w4[i][3]; }
        if (j & 1) asm volatile("" ::: "memory"); }
    wave_sum_n(lg, lane);
    int g_ = 0; float best = lg[0] + bg[0];
#pragma unroll
    for (int q = 1; q < 4; ++q) { const float x = lg[q] + bg[q]; if (x > best) { best = x; g_ = q; } }
    float den = 0.f;
#pragma unroll
    for (int q = 0; q < 4; ++q) den += __expf(lg[q] + bg[q] - best);
    const float pg = 1.0f / den; const int gs = __builtin_amdgcn_readfirstlane(g_);
    float le[4] = {0.f, 0.f, 0.f, 0.f};
#pragma unroll
    for (int j = 0; j < 8; ++j) {
#pragma unroll
        for (int i = 0; i < 4; ++i) { const f32x4 w = ULD4(wet, (size_t)gs * (DM * 16) + j * 4096 + i * 16, lo64); le[0] += R.v[j][i] * w[0]; le[1] += R.v[j][i] * w[1]; le[2] += R.v[j][i] * w[2]; le[3] += R.v[j][i] * w[3]; }
        if ((j & 3) == 3) asm volatile("" ::: "memory"); }
    wave_sum_n(le, lane);
    float l4[4];
#pragma unroll
    for (int q = 0; q < 4; ++q) l4[q] = le[q] + be[gs * 4 + q];
    int i0 = 0; float b0 = l4[0];
#pragma unroll
    for (int q = 1; q < 4; ++q) if (l4[q] > b0) { b0 = l4[q]; i0 = q; }
    int i1 = -1; float b1 = -3.0e38f;
#pragma unroll
    for (int q = 0; q < 4; ++q) if (q != i0 && l4[q] > b1) { b1 = l4[q]; i1 = q; }
    const float tv0 = 1.0f / (1.0f + __expf(b1 - b0));
    const int me0 = gs * 4 + i0, me1 = gs * 4 + i1;
    unsigned p0 = 0u, p1 = 0u;
    if (lane == 0) {
        p0 = __hip_atomic_fetch_add(cnt + me0 * 64, 1u, __ATOMIC_RELAXED, __HIP_MEMORY_SCOPE_AGENT);
        p1 = __hip_atomic_fetch_add(cnt + me1 * 64, 1u, __ATOMIC_RELAXED, __HIP_MEMORY_SCOPE_AGENT);
        int* rp = route + (size_t)r * 8;
        *(u32x4*)rp = (u32x4){(unsigned)me0, (unsigned)me1, p0, p1};
        *(u32x4*)(rp + 4) = (u32x4){__float_as_uint(pg * tv0), __float_as_uint(pg * (1.0f - tv0)), 0u, 0u};
    }
    if (!dup) {
        const size_t d0 = ((size_t)__builtin_amdgcn_readfirstlane(me0) * MTOT + (unsigned)__builtin_amdgcn_readfirstlane((int)p0)) * (DM * 2);
        const size_t d1 = ((size_t)__builtin_amdgcn_readfirstlane(me1) * MTOT + (unsigned)__builtin_amdgcn_readfirstlane((int)p1)) * (DM * 2);
#pragma unroll
        for (int j = 0; j < 8; ++j) { u32x2 w; w.x = cvt_pk_bf16(R.v[j][0], R.v[j][1]); w.y = cvt_pk_bf16(R.v[j][2], R.v[j][3]);
            *(u32x2*)((char*)HS + d0 + j * 512 + lo8) = w; *(u32x2*)((char*)HS + d1 + j * 512 + lo8) = w; }
    }
}
__device__ __forceinline__ void ph_ln1(const Args& a, int L, int rowlo, LAS unsigned char* lds, int tid, int G, int bx, int wave, bool dup = false) {
    const int gw = bx * 8 + wave, NGW = G * 8, gwT = wave * G + bx;
    ln1_stage(a, L, lds, tid);
    int rbase = NCTX + gw;
    for (; rbase + 3 * NGW < MTOT; rbase += 4 * NGW) {
        const int lane = lane_id_fresh(); const unsigned lo16 = (unsigned)lane * 16u, lo8 = (unsigned)lane * 8u;
        Ln1Row A, B;
        ln1_load(a, L, A, rbase, 0, lo16, lo8);
        ln1_load(a, L, B, rbase + NGW, 0, lo16, lo8);
        ln1_compute(a, L, A, rbase, 0, lds, dup, lane, lo16, lo8);
        ln1_load(a, L, A, rbase + 2 * NGW, 0, lo16, lo8);
        ln1_compute(a, L, B, rbase + NGW, 0, lds, dup, lane, lo16, lo8);
        ln1_load(a, L, B, rbase + 3 * NGW, 0, lo16, lo8);
        ln1_compute(a, L, A, rbase + 2 * NGW, 0, lds, dup, lane, lo16, lo8);
        ln1_compute(a, L, B, rbase + 3 * NGW, 0, lds, dup, lane, lo16, lo8);
    }
    for (; rbase < MTOT; rbase += NGW) { const int lane = lane_id_fresh(); const unsigned lo16 = (unsigned)lane * 16u, lo8 = (unsigned)lane * 8u;
        Ln1Row A; ln1_load(a, L, A, rbase, 0, lo16, lo8); ln1_compute(a, L, A, rbase, 0, lds, dup, lane, lo16, lo8); }
    if (rowlo == 0) for (int rc = gwT; rc < NCTX; rc += NGW) { const int lane = lane_id_fresh(); const unsigned lo16 = (unsigned)lane * 16u, lo8 = (unsigned)lane * 8u;
        Ln1Row A; ln1_load(a, L, A, rc, 1, lo16, lo8); ln1_compute(a, L, A, rc, 1, lds, dup, lane, lo16, lo8); }
}

__device__ __forceinline__ void moe_table(const Args& a, int L, LAS unsigned char* lds, int tid) {
    volatile LAS int* tb = (volatile LAS int*)(lds + MISC_OFF + 64); volatile LAS int* t2e = (volatile LAS int*)(lds + MISC_OFF + 192);
    unsigned* cnt = (unsigned*)(a.ws + WS_CTL) + CW_CNT + L * 16 * 64;
    __syncthreads();
    if (tid < 64) {
        int nt = 0;
        if (tid < 16) nt = ((int)__hip_atomic_load(cnt + tid * 64, __ATOMIC_RELAXED, __HIP_MEMORY_SCOPE_AGENT) + 255) >> 8;
        int inc = nt;
#pragma unroll
        for (int o = 1; o < 16; o <<= 1) { const int up = __shfl_up(inc, o); if ((tid & 63) >= o) inc += up; }
        if (tid < 16) { const int ex = inc - nt; tb[tid] = ex < MAXT ? ex : MAXT; if (tid == 15) tb[16] = inc < MAXT ? inc : MAXT; }
    }
    __syncthreads();
    if (tid < 96) { int e = 0;
#pragma unroll
        for (int k = 1; k < 16; ++k) e += (tb[k] <= tid) ? 1 : 0;
        t2e[tid] = e; }
    __syncthreads();
}

__device__ __forceinline__ void ph_gather(const Args& a, int rowlo, LAS unsigned char* lds, int gw, int NGW, int lane) {
    const LAS int* tb = (const LAS int*)(lds + MISC_OFF + 64);
    const bf16_t* H = (const bf16_t*)(a.ws + WS_H); bf16_t* HS = (bf16_t*)(a.ws + WS_MOE);
    const int* route = (const int*)(a.ws + WS_ROUTE);
    for (int r = rowlo + gw; r < MTOT; r += NGW) {
        const u32x4 rt = *(const u32x4*)(route + (size_t)r * 8);
        const size_t s0 = (size_t)tb[rt[0]] * 256 + rt[2], s1 = (size_t)tb[rt[1]] * 256 + rt[3];
        const u32x4* src = (const u32x4*)(H + (size_t)r * DM); u32x4* d0 = (u32x4*)(HS + s0 * DM); u32x4* d1 = (u32x4*)(HS + s1 * DM);
#pragma unroll
        for (int j = 0; j < 4; ++j) { const u32x4 x = src[lane + 64 * j]; d0[lane + 64 * j] = x; d1[lane + 64 * j] = x; }
    }
}

__device__ __forceinline__ void ln2_stage(const Args& a, int L, bool last, LAS unsigned char* lds, int tid) {
    const float* mv = (const float*)(a.ws + WS_MODV) + (size_t)(L * 2) * NMOD;
    const float* mn = (const float*)(a.ws + WS_MODV) + (size_t)((last ? L : L + 1) * 2) * NMOD;
    const float* lg_ = a.in[I_LNG] + (size_t)(L * 2 + 1) * DM; const float* lb_ = a.in[I_LNB] + (size_t)(L * 2 + 1) * DM;
    LAS f32x4* d = (LAS f32x4*)lds; const int t = tid;
    __syncthreads();
    d[t] = ((const f32x4*)lg_)[t]; d[512 + t] = ((const f32x4*)lb_)[t];
#pragma unroll
    for (int w = 0; w < 2; ++w) { const float* m = mv + (size_t)w * NMOD; const float* n = mn + (size_t)w * NMOD;
        d[1024 + w * 1536 + t] = ((const f32x4*)(m + 5 * DM))[t]; d[1536 + w * 1536 + t] = ((const f32x4*)n)[t]; d[2048 + w * 1536 + t] = ((const f32x4*)(n + DM))[t] + 1.0f; }
    __syncthreads();
}
struct Ln2Row { u32x2 xw[8], ya[8], yb[8]; };
__device__ __forceinline__ void ln2_load(const Args& a, Ln2Row& R, int r, int s0, int s1, unsigned lo16, unsigned lo8) {
    const bf16_t* XB = (const bf16_t*)(a.ws + WS_H); const bf16_t* Y2 = (const bf16_t*)(a.ws + WS_MOE + MOE_Y2);
#pragma unroll
    for (int j = 0; j < 8; ++j) { R.xw[j] = __builtin_nontemporal_load((const u32x2*)((const char*)XB + (size_t)r * (DM * 2) + j * 512 + lo8));
        R.ya[j] = __builtin_nontemporal_load((const u32x2*)((const char*)Y2 + (size_t)s0 * (DM * 2) + j * 512 + lo8)); R.yb[j] = __builtin_nontemporal_load((const u32x2*)((const char*)Y2 + (size_t)s1 * (DM * 2) + j * 512 + lo8)); }
}
__device__ __forceinline__ void ln2_compute(const Args& a, int L, Ln2Row& R, int r, float w0, float w1, int which, bool last, LAS unsigned char* lds, bool dup, int lane, unsigned lo16, unsigned lo8) {
    bf16_t* H = (bf16_t*)(a.ws + (dup ? WS_DUMH : WS_H)); float* XO = (float*)(a.ws + (dup ? WS_DUMX : WS_X)); float* OUT = dup ? (float*)(a.ws + WS_DUMX) : a.out;
    const unsigned pw = which ? 24576u : 0u;
    asm volatile("" ::: "memory");
    f32x4 v[8];
#pragma unroll
    for (int j = 0; j < 8; ++j) { const f32x4 g5 = LLD4(16384 + pw + j * 1024, lo16);
        const f32x4 y0 = {bf_lo(R.ya[j].x), bf_hi(R.ya[j].x), bf_lo(R.ya[j].y), bf_hi(R.ya[j].y)}, y1 = {bf_lo(R.yb[j].x), bf_hi(R.yb[j].x), bf_lo(R.yb[j].y), bf_hi(R.yb[j].y)};
        const f32x4 x1 = {bf_lo(R.xw[j].x), bf_hi(R.xw[j].x), bf_lo(R.xw[j].y), bf_hi(R.xw[j].y)};
        v[j] = x1 * ALPHA + g5 * (y0 * w0 + y1 * w1); }
    float s1_[1], q1_[1]; s1_[0] = 0.f;
#pragma unroll
    for (int j = 0; j < 8; ++j) s1_[0] += (v[j][0] + v[j][1]) + (v[j][2] + v[j][3]);
    wave_sum_n(s1_, lane);
    const float mean = s1_[0] * (1.f / DM); q1_[0] = 0.f;
#pragma unroll
    for (int j = 0; j < 8; ++j) { const f32x4 d = v[j] - mean; q1_[0] += (d[0] * d[0] + d[1] * d[1]) + (d[2] * d[2] + d[3] * d[3]); }
    wave_sum_n(q1_, lane);
    const float rstd = 1.f / sqrtf(q1_[0] * (1.f / DM) + LN_EPS);
#pragma unroll
    for (int j = 0; j < 8; ++j) {
        const f32x4 gm = LLD4(j * 1024, lo16), bt = LLD4(8192 + j * 1024, lo16), sh = LLD4(24576 + pw + j * 1024, lo16), sc = LLD4(32768 + pw + j * 1024, lo16);
        const f32x4 xn = (v[j] - mean) * rstd * gm + bt;
        if (last) { UST4(OUT, (size_t)(r - NCTX) * (DM * 4) + j * 1024, lo16, xn); }
        else { UST4N(XO, (size_t)r * (DM * 4) + j * 1024, lo16, xn);
               if (L != 0) { const f32x4 hm = xn * sc + sh;
                   u32x2 w; w.x = cvt_pk_bf16(hm[0], hm[1]); w.y = cvt_pk_bf16(hm[2], hm[3]); *(u32x2*)((char*)H + (size_t)r * (DM * 2) + j * 512 + lo8) = w; } }
        if (j & 1) asm volatile("" ::: "memory"); }
}
__device__ __forceinline__ void ph_ln2(const Args& a, int L, int rowlo, bool last, LAS unsigned char* lds, int tid, int G, int bx, int wave, bool dup = false) {
    const int gw = bx * 8 + wave, NGW = G * 8, gwT = wave * G + bx;
    ln2_stage(a, L, last, lds, tid);
    const LAS int* tb = (const LAS int*)(lds + MISC_OFF + 64);
    const int* route = (const int*)(a.ws + WS_ROUTE);
    int rbase = NCTX + gw;
    for (; rbase + 3 * NGW < MTOT; rbase += 4 * NGW) {
        const int lane = lane_id_fresh(); const unsigned lo16 = (unsigned)lane * 16u, lo8 = (unsigned)lane * 8u;
        int s0[4], s1[4]; float w0[4], w1[4];
#pragma unroll
        for (int i = 0; i < 4; ++i) { const int* rp = route + (size_t)(rbase + i * NGW) * 8; const u32x4 rt = *(const u32x4*)rp; const u32x4 rw = *(const u32x4*)(rp + 4);
            s0[i] = __builtin_amdgcn_readfirstlane(tb[rt[0]] * 256 + (int)rt[2]); s1[i] = __builtin_amdgcn_readfirstlane(tb[rt[1]] * 256 + (int)rt[3]);
            w0[i] = __uint_as_float(__builtin_amdgcn_readfirstlane(rw[0])); w1[i] = __uint_as_float(__builtin_amdgcn_readfirstlane(rw[1])); }
        Ln2Row A, B;
        ln2_load(a, A, rbase, s0[0], s1[0], lo16, lo8);
        ln2_load(a, B, rbase + NGW, s0[1], s1[1], lo16, lo8);
        ln2_compute(a, L, A, rbase, w0[0], w1[0], 0, last, lds, dup, lane, lo16, lo8);
        ln2_load(a, A, rbase + 2 * NGW, s0[2], s1[2], lo16, lo8);
        ln2_compute(a, L, B, rbase + NGW, w0[1], w1[1], 0, last, lds, dup, lane, lo16, lo8);
        ln2_load(a, B, rbase + 3 * NGW, s0[3], s1[3], lo16, lo8);
        ln2_compute(a, L, A, rbase + 2 * NGW, w0[2], w1[2], 0, last, lds, dup, lane, lo16, lo8);
        ln2_compute(a, L, B, rbase + 3 * NGW, w0[3], w1[3], 0, last, lds, dup, lane, lo16, lo8);
    }
    for (; rbase < MTOT; rbase += NGW) {
        const int lane = lane_id_fresh(); const unsigned lo16 = (unsigned)lane * 16u, lo8 = (unsigned)lane * 8u;
        const int* rp = route + (size_t)rbase * 8; const u32x4 rt = *(const u32x4*)rp; const u32x4 rw = *(const u32x4*)(rp + 4);
        const int s0 = __builtin_amdgcn_readfirstlane(tb[rt[0]] * 256 + (int)rt[2]), s1 = __builtin_amdgcn_readfirstlane(tb[rt[1]] * 256 + (int)rt[3]);
        Ln2Row A; ln2_load(a, A, rbase, s0, s1, lo16, lo8);
        ln2_compute(a, L, A, rbase, __uint_as_float(__builtin_amdgcn_readfirstlane(rw[0])), __uint_as_float(__builtin_amdgcn_readfirstlane(rw[1])), 0, last, lds, dup, lane, lo16, lo8);
    }
    if (rowlo == 0) for (int rc = gwT; rc < NCTX; rc += NGW) {
        const int lane = lane_id_fresh(); const unsigned lo16 = (unsigned)lane * 16u, lo8 = (unsigned)lane * 8u;
        const int* rp = route + (size_t)rc * 8; const u32x4 rt = *(const u32x4*)rp; const u32x4 rw = *(const u32x4*)(rp + 4);
        const int s0 = __builtin_amdgcn_readfirstlane(tb[rt[0]] * 256 + (int)rt[2]), s1 = __builtin_amdgcn_readfirstlane(tb[rt[1]] * 256 + (int)rt[3]);
        Ln2Row A; ln2_load(a, A, rc, s0, s1, lo16, lo8);
        ln2_compute(a, L, A, rc, __uint_as_float(__builtin_amdgcn_readfirstlane(rw[0])), __uint_as_float(__builtin_amdgcn_readfirstlane(rw[1])), 1, last, lds, dup, lane, lo16, lo8);
    }
}

constexpr int NPH = 36;
__global__ void __launch_bounds__(512, 2) mega(Args a) {
    extern __shared__ __attribute__((aligned(16))) unsigned char lds_raw[];
    LAS unsigned char* lds = (LAS unsigned char*)lds_raw;
    const int wave = __builtin_amdgcn_readfirstlane((int)threadIdx.x >> 6);
    const int G = gridDim.x, bx = blockIdx.x;
    const int gw = bx * 8 + wave, NGW = G * 8;
    unsigned char* ws = a.ws;
    unsigned* ctl = (unsigned*)(ws + WS_CTL);
#if MK_ONE_LAUNCH
#define PDUP (rp_ != 0)
#else
#define PDUP (a.probe_dup != 0)
#endif
#define FRESH() const int lane = lane_id_fresh(); const int tid = wave * 64 + lane; (void)tid; (void)lane
    { FRESH(); for (int u = tid; u < (LDS_BYTES - MISC_OFF) / 4; u += 512) ((LAS unsigned*)(lds + MISC_OFF))[u] = 0u; }
    __syncthreads();
    const int lo = a.ph_lo, hi = a.ph_hi;
    XcdBarrier bar; bar.bar = ctl + CW_BAR; bar.x = 0; bar.st = (volatile LAS unsigned*)(lds + MISC_OFF);
    if (hi - lo > 1) { FRESH(); bar = xcd_barrier_post(ctl + CW_BAR, (volatile LAS unsigned*)(lds + MISC_OFF), tid); }
#define IN(k) (lo <= (k) && (k) < hi)
#define SEAM(k) do { if (IN(k) && IN((k) + 1)) { FRESH(); xcd_barrier(bar, tid); } } while (0)

    float* X = (float*)(ws + WS_X); bf16_t* H = (bf16_t*)(ws + WS_H);
    const float* modv = (const float*)(ws + WS_MODV);
    unsigned char* mix = ws + WS_MIX; unsigned char* moe = ws + WS_MOE;

#define MOE_TAIL(L, p0, rowlo, last) do { \
    if (IN((p0))) for (int rp_ = 0; rp_ <= REPC((p0)); ++rp_) { FRESH(); cvt_catchup(a, (L) == 0 ? cq::E0 : (L) == 1 ? cq::E2 : (L) == 2 ? cq::E5 : cq::E8, lds, tid, wave, lane); ph_ln1(a, (L), (rowlo), lds, tid, G, bx, wave, PDUP); } SEAM((p0)); \
      \
    if (IN((p0) + 2)) for (int rp_ = 0; rp_ <= REPC((p0) + 2); ++rp_) { FRESH(); moe_table(a, (L), lds, tid); const int T = ((const LAS int*)(lds + MISC_OFF + 64))[16]; \
        pg8::Gemm g{(const bf16_t*)moe, (const bf16_t*)(ws + WS_WGU) + (size_t)(L) * 16 * 1536 * DM, DM, (size_t)1536 * DM}; \
        pg8::MoeOrder S; S.init(T, 6, G, bx); S.t2e = (const LAS int*)(lds + MISC_OFF + 192); S.tb = (const LAS int*)(lds + MISC_OFF + 64); S.sparse_a = true; pg8::EpiMoeA E{(bf16_t*)(moe + MOE_ACT)}; \
        pg8::gemm_phase<pg8::EpiMoeA, pg8::MoeOrder, true, true>(lds, g, S, E, tid); cvt_opportunistic(a, 20 * idle_units(T * 6, G, bx), lds, tid, wave, lane); } SEAM((p0) + 2); \
    if (IN((p0) + 3)) for (int rp_ = 0; rp_ <= REPC((p0) + 3); ++rp_) { FRESH(); moe_table(a, (L), lds, tid); const int T = ((const LAS int*)(lds + MISC_OFF + 64))[16]; \
        pg8::Gemm g{(const bf16_t*)(moe + MOE_ACT), (const bf16_t*)(ws + WS_WDN) + (size_t)(L) * 16 * DM * EFF, EFF, (size_t)DM * EFF}; \
        pg8::MoeOrder S; S.init(T, 8, G, bx); S.t2e = (const LAS int*)(lds + MISC_OFF + 192); S.tb = (const LAS int*)(lds + MISC_OFF + 64); S.sparse_a = false; pg8::EpiQKV E{(bf16_t*)(moe + MOE_Y2), DM, 1 << 20, nullptr, 1 << 20, nullptr, 0}; \
        pg8::gemm_phase<pg8::EpiQKV, pg8::MoeOrder, true, true>(lds, g, S, E, tid); cvt_opportunistic(a, 6 * idle_units(T * 8, G, bx), lds, tid, wave, lane); } SEAM((p0) + 3); \
    if (IN((p0) + 4)) for (int rp_ = 0; rp_ <= REPC((p0) + 4); ++rp_) { FRESH(); if ((L) == 1) cvt_catchup(a, cq::E3, lds, tid, wave, lane); if ((L) == 2) cvt_catchup(a, cq::E6, lds, tid, wave, lane); moe_table(a, (L), lds, tid); ph_ln2(a, (L), (rowlo), (last), lds, tid, G, bx, wave, PDUP); } \
    } while (0)

    if (IN(0)) for (int rp_ = 0; rp_ <= REPC(0); ++rp_) { FRESH(); ph_prologue(a, lds, G, wave, lane, tid); } SEAM(0);
    if (IN(1)) for (int rp_ = 0; rp_ <= REPC(1); ++rp_) { FRESH(); ph_init(a, G, bx, wave); } SEAM(1);
    if (IN(2)) for (int rp_ = 0; rp_ <= REPC(2); ++rp_) { FRESH(); pg8::Gemm g{H, (const bf16_t*)(ws + WS_WCI), DM, 0}; pg8::GridOrder S; S.init(NMT, 24, G, bx);
        pg8::EpiConv1 E{(bf16_t*)mix, (bf16_t*)(mix + 33 * MiB)};
        pg8::gemm_phase<pg8::EpiConv1, pg8::GridOrder, true, true>(lds, g, S, E, tid); cvt_opportunistic(a, 12 * idle_units(NMT * 24, G, bx), lds, tid, wave, lane); } SEAM(2);
    if (IN(3)) for (int rp_ = 0; rp_ <= REPC(3); ++rp_) { FRESH(); ph_conv(a, gw, NGW, lane); } SEAM(3);
    if (IN(4)) for (int rp_ = 0; rp_ <= REPC(4); ++rp_) { FRESH(); pg8::Gemm g{(const bf16_t*)(mix + 66 * MiB), (const bf16_t*)(ws + WS_WCO), DM, 0}; pg8::GridOrder S; S.init(NMT, 8, G, bx);
        pg8::EpiDelta E{(bf16_t*)(ws + WS_D), 0, 1 << 20, 0};
        pg8::gemm_phase<pg8::EpiDelta, pg8::GridOrder, true, true>(lds, g, S, E, tid); cvt_opportunistic(a, 12 * idle_units(NMT * 8, G, bx), lds, tid, wave, lane); } SEAM(4);
    MOE_TAIL(0, 5, 0, false); SEAM(9);
    if (IN(10)) for (int rp_ = 0; rp_ <= REPC(10); ++rp_) { FRESH(); cvt_catchup(a, cq::E1, lds, tid, wave, lane); ph_pool(a, gw, NGW, lane); } SEAM(10);
    if (IN(11)) for (int rp_ = 0; rp_ <= REPC(11); ++rp_) { FRESH(); pg8::Gemm g{(const bf16_t*)mix, (const bf16_t*)(ws + WS_WPL), 512, (size_t)512 * 512}; pg8::PoolOrder S; S.init(4 * NMT, 2, G, bx);
        pg8::EpiDelta E{(bf16_t*)(ws + WS_D), 0, NMT, 512};
        pg8::gemm_phase<pg8::EpiDelta, pg8::PoolOrder, true, true>(lds, g, S, E, tid); cvt_opportunistic(a, 3 * idle_units(4 * NMT * 2, G, bx), lds, tid, wave, lane); } SEAM(11);
    MOE_TAIL(1, 12, 0, false); SEAM(16);
    if (IN(17)) for (int rp_ = 0; rp_ <= REPC(17); ++rp_) { FRESH(); pg8::Gemm g{H, (const bf16_t*)(ws + WS_WGQ), DM, 0}; pg8::GridOrder S; S.init(NMT, 12, G, bx);
        pg8::EpiQKV E{(bf16_t*)mix, DM, 8, (bf16_t*)(mix + 33 * MiB), 10, (bf16_t*)(mix + 42 * MiB), KVHS};
        pg8::gemm_phase<pg8::EpiQKV, pg8::GridOrder, true, true>(lds, g, S, E, tid); cvt_opportunistic(a, 12 * idle_units(NMT * 12, G, bx), lds, tid, wave, lane); } SEAM(17);
    if (IN(18)) for (int rp_ = 0; rp_ <= REPC(18); ++rp_) { FRESH(); cvt_catchup(a, cq::E4, lds, tid, wave, lane);
        bf16_t* Q = (bf16_t*)mix; bf16_t* Kb = (bf16_t*)(mix + 33 * MiB); const float* rope = (const float*)(ws + WS_ROPE);
        const float* gq = a.in[I_GQN]; const float* gk = gq + 128;
        for (int task = gw; task < MTOT / 4; task += NGW) {
            const int r = task * 4 + (lane >> 4); bf16_t* pp = Kb + (size_t)((lane >> 2) & 3) * KVHS + (size_t)r * 128 + (lane & 3) * 32;
            head_pass<true>(pp, gk, lane & 3, r, rope, PDUP ? (bf16_t*)(ws + WS_DUMQ) + (size_t)r * 512 + (lane & 15) * 32 : pp); }
    } SEAM(18);
    if (IN(19)) for (int rp_ = 0; rp_ <= REPC(19); ++rp_) { FRESH();
        const bf16_t* Q = (const bf16_t*)mix; const bf16_t* Kb = (const bf16_t*)(mix + 33 * MiB); const bf16_t* Vb = (const bf16_t*)(mix + 42 * MiB); bf16_t* O = (bf16_t*)(mix + 51 * MiB);
        for (int i = 0;; ++i) { const int idx = i * G + bx; if (idx >= 528) break;
            int h, kvh, row0, seq;
            if (idx < 512) { const int ii = idx >> 8, c = idx & 255, x = c & 7, wl = c >> 3, j = (x >> 2) * 64 + wl * 2 + ii; kvh = x & 3; h = kvh * 4 + (j >> 5); row0 = NCTX + (j & 31) * 256; seq = MTOT; }
            else { h = idx - 512; kvh = h >> 2; row0 = 0; seq = NCTX; }
            att::attn_unit<DM, 128, 128, DM>(Q + (size_t)row0 * DM + h * 128, Kb + (size_t)kvh * KVHS, Vb + (size_t)kvh * KVHS, O + (size_t)row0 * DM + h * 128, seq, (char*)lds_raw, wave, a.in[I_GQN], (const float*)(ws + WS_ROPE), row0 - NCTX);
        }
    } SEAM(19);
    if (IN(20)) for (int rp_ = 0; rp_ <= REPC(20); ++rp_) { FRESH(); pg8::Gemm g{(const bf16_t*)(mix + 51 * MiB), (const bf16_t*)(ws + WS_WGO), DM, 0}; pg8::GridOrder S; S.init(NMT, 8, G, bx);
        pg8::EpiDelta E{(bf16_t*)(ws + WS_D), 0, 1 << 20, 0};
        pg8::gemm_phase<pg8::EpiDelta, pg8::GridOrder, true, true>(lds, g, S, E, tid); cvt_opportunistic(a, 12 * idle_units(NMT * 8, G, bx), lds, tid, wave, lane); } SEAM(20);
    MOE_TAIL(2, 21, 0, false); SEAM(25);
    if (IN(26)) for (int rp_ = 0; rp_ <= REPC(26); ++rp_) { FRESH(); pg8::Gemm g{H, (const bf16_t*)(ws + WS_WDQ), DM, 0}; pg8::GridOrder S; S.init(NMT, 24, G, bx);
        pg8::EpiQKVRope E{(bf16_t*)mix, (bf16_t*)(mix + 33 * MiB), (bf16_t*)(mix + 66 * MiB), KVHS, (const float*)(ws + WS_ROPE)};
        pg8::gemm_phase<pg8::EpiQKVRope, pg8::GridOrder, true, true>(lds, g, S, E, tid); cvt_opportunistic(a, 12 * idle_units(NMT * 24, G, bx), lds, tid, wave, lane); } SEAM(26);
    if (IN(28)) for (int rp_ = 0; rp_ <= REPC(28); ++rp_) { FRESH();
        const bf16_t* Q = (const bf16_t*)mix; const bf16_t* Kb = (const bf16_t*)(mix + 33 * MiB); const bf16_t* Vb = (const bf16_t*)(mix + 66 * MiB);
#pragma unroll 1
        for (int i = 0;; ++i) { const int u = bx + (i >> 1) * G; if (u >= 256) break;
            { const int m = i & 1, h = u & 7, qb = u >> 3;
                auto epi = [&](f32x16 (&o)[8], float (&rli)[16], const int wid, const int le) __attribute__((always_inline)) {
                    int i2 = i; asm volatile("" : "+s"(i2)); const int u2 = bx + (i2 >> 1) * G, m2 = i2 & 1;
                    const int r32e = le & 31, hie = le >> 5;
                    char* st = (char*)a.ws + WS_MIX + 99 * MiB + (size_t)u2 * 131072 + (unsigned)(wid * 16384) + (unsigned)le * 16u;
                    if (m2 == 0) {
#pragma unroll
                        for (int r = 0; r < 16; ++r) { const float s_ = rli[r]; u32x4 w; w.x = cvt_pk_bf16(o[0][r] * s_, o[1][r] * s_); w.y = cvt_pk_bf16(o[2][r] * s_, o[3][r] * s_); w.z = cvt_pk_bf16(o[4][r] * s_, o[5][r] * s_); w.w = cvt_pk_bf16(o[6][r] * s_, o[7][r] * s_);
                            *(u32x4*)(st + r * 1024) = w; }
                    } else {
                        const float lam = __uint_as_float(__hip_atomic_load((unsigned*)(a.ws + WS_SCAL), __ATOMIC_RELAXED, __HIP_MEMORY_SCOPE_AGENT));
                        const float oml = __uint_as_float(__hip_atomic_load((unsigned*)(a.ws + WS_SCAL) + 1, __ATOMIC_RELAXED, __HIP_MEMORY_SCOPE_AGENT));
                        const float* sub = (const float*)(a.ws + WS_SCAL + 1024); char* A2b = (char*)a.ws + WS_MIX + 163 * MiB + ((size_t)((u2 >> 3) * 256) * DM + (u2 & 7) * 256) * 2;
                        float gl[8];
#pragma unroll
                        for (int d0 = 0; d0 < 8; ++d0) gl[d0] = sub[d0 * 32 + r32e];
#pragma unroll
                        for (int r = 0; r < 16; ++r) { if ((r & 3) == 0) asm volatile("" ::: "memory");
                            const unsigned offA = (unsigned)((wid * 32 + att::crow(r, hie)) * DM + r32e) * 2u;
                            const u32x4 w = *(const u32x4*)(st + r * 1024);
                            float d[8]; float ss = 0.f; const float s_ = rli[r] * lam;
                            d[0] = bf_lo(w.x) - o[0][r] * s_; d[1] = bf_hi(w.x) - o[1][r] * s_; d[2] = bf_lo(w.y) - o[2][r] * s_; d[3] = bf_hi(w.y) - o[3][r] * s_;
                            d[4] = bf_lo(w.z) - o[4][r] * s_; d[5] = bf_hi(w.z) - o[5][r] * s_; d[6] = bf_lo(w.w) - o[6][r] * s_; d[7] = bf_hi(w.w) - o[7][r] * s_;
#pragma unroll
                            for (int d0 = 0; d0 < 8; ++d0) ss += d[d0] * d[d0];
#pragma unroll
                            for (int mk = 1; mk < 32; mk <<= 1) ss += __int_as_float(__builtin_amdgcn_ds_bpermute((le ^ mk) << 2, __float_as_int(ss)));
                            const float rs = oml / sqrtf(ss * (1.0f / 256.0f) + RMS_EPS);
#pragma unroll
                            for (int d0 = 0; d0 < 8; ++d0) { const float v = d[d0] * rs * gl[d0]; *(bf16_t*)(A2b + offA + d0 * 64) = (bf16_t)(cvt_pk_bf16(v, v) & 0xffffu); } }
                    }
                };
                att::attn_unit2<DM, 128, 128>(Q + (size_t)(NCTX + qb * 256) * DM + (h * 2 + m) * 128, Kb + (size_t)(h * 2 + m) * KVHS, Vb + (size_t)(h * 2) * KVHS, Vb + (size_t)(h * 2 + 1) * KVHS, MTOT, (char*)lds_raw, wave, epi);
            }
        }
    } SEAM(28);
    if (IN(30)) for (int rp_ = 0; rp_ <= REPC(30); ++rp_) { FRESH(); cvt_catchup(a, cq::E7, lds, tid, wave, lane); pg8::Gemm g{(const bf16_t*)(mix + 163 * MiB), (const bf16_t*)(ws + WS_WDO), DM, 0}; pg8::GridOrder S; S.init(NLAT / 256, 8, G, bx);
        pg8::EpiDelta E{(bf16_t*)(ws + WS_D), NCTX, 1 << 20, 0};
        pg8::gemm_phase<pg8::EpiDelta, pg8::GridOrder, true, true>(lds, g, S, E, tid); } SEAM(30);
    MOE_TAIL(3, 31, NCTX, true);
#undef IN
#undef FRESH
#undef SEAM
#undef MOE_TAIL
}

extern "C" void kernel_launch(void* const* d_in, const int* in_sizes, int n_in, void* d_out, int out_size, void* d_ws, size_t ws_size, hipStream_t stream) {
    static int grid = 0;
    if (grid == 0) {
        if (n_in != 27 || out_size != NLAT * DM || ws_size < WS_END) { fprintf(stderr, "kernel_launch: unexpected shapes (n_in %d out %d ws %zu)\n", n_in, out_size, ws_size); grid = -1; return; }
        int dev = 0, cus = 0, per_cu = 0;
        if (hipGetDevice(&dev) != hipSuccess || hipDeviceGetAttribute(&cus, hipDeviceAttributeMultiprocessorCount, dev) != hipSuccess) { grid = -1; return; }
        if (hipFuncSetAttribute((const void*)mega, hipFuncAttributeMaxDynamicSharedMemorySize, LDS_BYTES) != hipSuccess) { fprintf(stderr, "kernel_launch: hipFuncSetAttribute failed\n"); grid = -1; return; }
        if (hipOccupancyMaxActiveBlocksPerMultiprocessor(&per_cu, (const void*)mega, 512, LDS_BYTES) != hipSuccess || per_cu < 1) fprintf(stderr, "kernel_launch: occupancy query says %d\n", per_cu);
        (void)hipGetLastError();
        grid = cus;
    }
    if (grid < 0) return;
    (void)hipMemsetAsync((char*)d_ws + WS_CTL, 0, CTL_ZERO_BYTES, stream);
    Args a{};
    for (int i = 0; i < 27; ++i) a.in[i] = (const float*)d_in[i];
    a.out = (float*)d_out; a.ws = (unsigned char*)d_ws;
#if MK_ONE_LAUNCH
    a.ph_lo = 0; a.ph_hi = NPH;
    hipLaunchKernelGGL(mega, dim3(grid), dim3(512), LDS_BYTES, stream, a);
#else
    for (int p = 0; p < NPH; ++p) { a.ph_lo = p; a.ph_hi = p + 1; const int reps = 1 + (int)((PROBE_REP_MASK >> p) & 1ull);
        for (int r = 0; r < reps; ++r) { a.probe_dup = r; hipLaunchKernelGGL(mega, dim3(grid), dim3(512), LDS_BYTES, stream, a); } }
#endif
}
```

```cpp
#include <hip/hip_runtime.h>
#include <hip/hip_bf16.h>
#include <cstdio>
#include <cstdint>

#ifndef MK_ONE_LAUNCH
#define MK_ONE_LAUNCH 1
#endif
#ifndef PROBE_REP_MASK
#define PROBE_REP_MASK 0ull
#endif
#if MK_ONE_LAUNCH
#define REPC(k) ((int)((PROBE_REP_MASK >> (k)) & 1ull))
#else
#define REPC(k) 0
#endif

#define LAS __attribute__((address_space(3)))
#define GAS __attribute__((address_space(1)))
typedef unsigned short bf16_t;
typedef short bf16x8 __attribute__((ext_vector_type(8)));
typedef short s16x4 __attribute__((ext_vector_type(4)));
typedef float f32x4 __attribute__((ext_vector_type(4)));
typedef float f32x16 __attribute__((ext_vector_type(16)));
typedef unsigned u32x4 __attribute__((ext_vector_type(4)));
typedef unsigned u32x2 __attribute__((ext_vector_type(2)));

constexpr int DM = 2048, NLAT = 8192, NCTX = 256, MTOT = NLAT + NCTX, NMT = MTOT / 256;
constexpr int NMOD = 6 * DM;
constexpr int EFF = 768, NEXP = 16;
constexpr float ALPHA = 1.6817928305074290f;
constexpr float LN_EPS = 1e-6f, RMS_EPS = 1e-6f;
constexpr float LAM_INIT3 = 0.55605820415f;
constexpr int MAXT = 82;
constexpr size_t KVHS = (size_t)MTOT * 128;

constexpr size_t MiB = 1ull << 20;
constexpr size_t WS_CTL = 0, CTL_ZERO_BYTES = 1 * MiB;
constexpr size_t WS_MODV = 1 * MiB;
constexpr size_t WS_ROPE = 1 * MiB + 512 * 1024;
constexpr size_t WS_SCAL = WS_ROPE + 64 * 1024;
constexpr size_t WS_ROUTE = 2 * MiB;
constexpr size_t WS_WET = 3 * MiB;
constexpr size_t WS_WCI = 4 * MiB, WS_WCO = 28 * MiB, WS_WPL = 36 * MiB, WS_WGQ = 38 * MiB, WS_WGO = 50 * MiB, WS_WDQ = 58 * MiB, WS_WDO = 82 * MiB;
constexpr size_t WS_WGU = 90 * MiB, WS_WDN = 474 * MiB;
constexpr size_t WS_X = 666 * MiB, WS_H = 732 * MiB;
constexpr size_t WS_MIX = 765 * MiB;
constexpr size_t WS_MOE = 965 * MiB;
constexpr size_t MOE_ACT = 528 * MiB, MOE_Y2 = 559 * MiB;
constexpr size_t WS_D = 1606 * MiB;
constexpr size_t WS_END = 1639 * MiB;
constexpr size_t WS_DUMX = 1640 * MiB, WS_DUMH = 1707 * MiB, WS_DUMQ = 1741 * MiB;
constexpr int CW_BAR = 4096;
constexpr int CW_CNT = 8192;

__device__ __forceinline__ unsigned cvt_pk_bf16(float lo, float hi) { unsigned r; asm volatile("v_cvt_pk_bf16_f32 %0, %1, %2" : "=v"(r) : "v"(lo), "v"(hi)); return r; }
__device__ __forceinline__ float bf_lo(unsigned w) { return __uint_as_float(w << 16); }
__device__ __forceinline__ float bf_hi(unsigned w) { return __uint_as_float(w & 0xffff0000u); }
__device__ __forceinline__ float wave_sum(float v) {
#pragma unroll
    for (int o = 1; o < 64; o <<= 1) v += __shfl_xor(v, o);
    return v;
}
template <int N> __device__ __forceinline__ void wave_sum_n(float (&x)[N], const int lane) {
#pragma unroll
    for (int o = 1; o < 64; o <<= 1) { const int idx = (lane ^ o) << 2;
#pragma unroll
        for (int i = 0; i < N; ++i) x[i] += __builtin_bit_cast(float, __builtin_amdgcn_ds_bpermute(idx, __builtin_bit_cast(int, x[i])));
    }
}
__device__ __forceinline__ int lane_id_fresh() { int l; asm volatile("v_mbcnt_lo_u32_b32 %0, -1, 0\n\tv_mbcnt_hi_u32_b32 %0, -1, %0" : "=v"(l)); return l; }
#define ULD4(base, cb, lo) (*(const f32x4*)((const char*)(base) + (size_t)(cb) + (lo)))
#define UST4(base, cb, lo, val) (*(f32x4*)((char*)(base) + (size_t)(cb) + (lo)) = (val))
#define ULD4N(base, cb, lo) __builtin_nontemporal_load((const f32x4*)((const char*)(base) + (size_t)(cb) + (lo)))
#define UST4N(base, cb, lo, val) __builtin_nontemporal_store((val), (f32x4*)((char*)(base) + (size_t)(cb) + (lo)))
#define LDS_WAIT() asm volatile("s_waitcnt lgkmcnt(0)" ::: "memory")
#define VM_WAIT() asm volatile("s_waitcnt vmcnt(0)" ::: "memory")

namespace pg8 {
constexpr int BM = 256, BK = 64, HALF = 128, HTB = HALF * BK * 2, STAGE_BYTES = 8 * HTB, NXCD = 8, WGM = 8;
__host__ __device__ __forceinline__ int lds_byte(int r, int c) { const int st = (r >> 4) * 2 + (c >> 5), rr = r & 15, cc = c & 31, ob = rr * 64 + cc * 2; return st * 1024 + (ob ^ (((ob >> 9) & 1) << 5)); }
__host__ __device__ __forceinline__ void stage_rc(int b, int& R, int& C) { const int st = b / 1024, sb = b % 1024, swz = sb ^ (((sb >> 9) & 1) << 5); R = (st >> 1) * 16 + swz / 64; C = (st & 1) * 32 + (swz % 64) / 2; }
__host__ __device__ __forceinline__ int perm32(int rho) { const int n = rho >> 4, i = rho & 15; return 8 * (i >> 2) + 4 * n + (i & 3); }

struct Unit { int pm, pn, bsel, pa; };
struct Gemm { const bf16_t* A; const bf16_t* Bt; int K; size_t bstride; };

struct GridOrder {
    int nM, nN, nwg, G, c;
    __device__ void init(int nM_, int nN_, int G_, int c_) { nM = nM_; nN = nN_; nwg = nM * nN; G = G_; c = c_; }
    __device__ bool base_next(int i, Unit& u) const {
        const long L = (long)i * G + c; if (L >= nwg) return false;
        int wgid = (int)L; { const int q = nwg / NXCD, r = nwg % NXCD, xcd = wgid % NXCD, off = wgid / NXCD; wgid = (xcd < r ? xcd * (q + 1) : r * (q + 1) + (xcd - r) * q) + off; }
        const int nig = WGM * nN, gid = wgid / nig, fm = gid * WGM, gsz = (nM - fm) < WGM ? (nM - fm) : WGM;
        u.pm = fm + ((wgid % nig) % gsz); u.pn = (wgid % nig) / gsz; u.bsel = 0; u.pa = u.pm; return true;
    }
    __device__ bool next(int i, Unit& u) const { return base_next(i, u); }
};
struct PoolOrder : GridOrder {
    __device__ bool next(int i, Unit& u) const { if (!base_next(i, u)) return false; u.bsel = u.pm / NMT; return true; }
};
struct MoeOrder : GridOrder {
    const LAS int* t2e; const LAS int* tb; bool sparse_a;
    __device__ bool next(int i, Unit& u) const { if (!base_next(i, u)) return false; const int e = __builtin_amdgcn_readfirstlane(t2e[u.pm]); u.bsel = e;
        if (sparse_a) u.pa = e * NMT + (u.pm - __builtin_amdgcn_readfirstlane(tb[e])); return true; }
};

__device__ __forceinline__ u32x4 pack8(const f32x4 v0, const f32x4 v1) { u32x4 w; w.x = cvt_pk_bf16(v0[0], v0[1]); w.y = cvt_pk_bf16(v0[2], v0[3]); w.z = cvt_pk_bf16(v1[0], v1[1]); w.w = cvt_pk_bf16(v1[2], v1[3]); return w; }

struct EpiQKV {
    static constexpr bool PERM = true;
    bf16_t* P0; int ld0; int pn1; bf16_t* P1; int pn2; bf16_t* P2; size_t hs;
    __device__ __forceinline__ void operator()(const f32x4 (&acc)[2][2][4][2], const Unit& u, int wr, int wc, int fr, int fq) const {
        const int row0 = u.pm * BM + wr * 64 + fr;
        if (u.pn < pn1) {
            bf16_t* base = P0 + u.pn * BM + wc * 32 + 8 * fq;
#pragma unroll
            for (int ai = 0; ai < 2; ++ai)
#pragma unroll
                for (int m = 0; m < 4; ++m) { bf16_t* rowp = base + (size_t)(row0 + ai * HALF + m * 16) * ld0;
#pragma unroll
                    for (int bj = 0; bj < 2; ++bj) *(u32x4*)(rowp + bj * HALF) = pack8(acc[ai][bj][m][0], acc[ai][bj][m][1]); }
        } else {
            const bool s1 = u.pn < pn2; bf16_t* base = (s1 ? P1 : P2) + (size_t)(2 * (u.pn - (s1 ? pn1 : pn2))) * hs + wc * 32 + 8 * fq;
#pragma unroll
            for (int ai = 0; ai < 2; ++ai)
#pragma unroll
                for (int m = 0; m < 4; ++m) { bf16_t* rowp = base + (size_t)(row0 + ai * HALF + m * 16) * 128;
#pragma unroll
                    for (int bj = 0; bj < 2; ++bj) *(u32x4*)(rowp + bj * hs) = pack8(acc[ai][bj][m][0], acc[ai][bj][m][1]); }
        }
    }
};
struct EpiQKVRope {
    static constexpr bool PERM = true;
    bf16_t* Q; bf16_t* Kb; bf16_t* Vb; size_t hs; const float* rope;
    __device__ __forceinline__ void operator()(const f32x4 (&acc)[2][2][4][2], const Unit& u, int wr, int wc, int fr, int fq) const {
        const int row0 = u.pm * BM + wr * 64 + fr;
        if (u.pn >= 16) {
            bf16_t* base = Vb + (size_t)(2 * (u.pn - 16)) * hs + wc * 32 + 8 * fq;
#pragma unroll
            for (int ai = 0; ai < 2; ++ai)
#pragma unroll
                for (int m = 0; m < 4; ++m) { bf16_t* rowp = base + (size_t)(row0 + ai * HALF + m * 16) * 128;
#pragma unroll
                    for (int bj = 0; bj < 2; ++bj) *(u32x4*)(rowp + bj * hs) = pack8(acc[ai][bj][m][0], acc[ai][bj][m][1]); }
        } else {
            const bool isk = u.pn >= 8; const int head = (u.pn - (isk ? 8 : 0)) * 2 + (wc >> 1), qp = wc & 1;
            const bool dorope = u.pm != 0;
            const float* tab = rope + (qp ? 8192 : 0) + 8 * fq; const int sno = qp ? 2048 : 4096;
#pragma unroll
            for (int ai = 0; ai < 2; ++ai)
#pragma unroll
                for (int m = 0; m < 4; ++m) { const int row = row0 + ai * HALF + m * 16;
                    f32x4 a0 = acc[ai][0][m][0], a1 = acc[ai][0][m][1], b0 = acc[ai][1][m][0], b1 = acc[ai][1][m][1];
                    if (dorope) { const int t = row - NCTX, pos = qp ? (t & 63) : (t >> 6); const float* cs = tab + pos * 32;
                        const f32x4 c0 = *(const f32x4*)cs, c1 = *(const f32x4*)(cs + 4), s0 = *(const f32x4*)(cs + sno), s1 = *(const f32x4*)(cs + sno + 4);
                        const f32x4 na0 = a0 * c0 - b0 * s0, na1 = a1 * c1 - b1 * s1, nb0 = b0 * c0 + a0 * s0, nb1 = b1 * c1 + a1 * s1;
                        a0 = na0; a1 = na1; b0 = nb0; b1 = nb1; }
                    bf16_t* dst = isk ? Kb + (size_t)head * hs + (size_t)row * 128 : Q + (size_t)row * DM + head * 128;
                    *(u32x4*)(dst + (2 * qp) * 32 + 8 * fq) = pack8(a0, a1); *(u32x4*)(dst + (2 * qp + 1) * 32 + 8 * fq) = pack8(b0, b1); }
        }
    }
};
struct EpiConv1 {
    static constexpr bool PERM = true;
    bf16_t* GB; bf16_t* PP;
    __device__ __forceinline__ void operator()(const f32x4 (&acc)[2][2][4][2], const Unit& u, int wr, int wc, int fr, int fq) const {
        const int row0 = u.pm * BM + wr * 64 + fr;
        if (u.pn < 8) {
            const int col0 = u.pn * BM + wc * 32 + 8 * fq;
#pragma unroll
            for (int ai = 0; ai < 2; ++ai)
#pragma unroll
                for (int m = 0; m < 4; ++m) { bf16_t* rowp = GB + (size_t)(row0 + ai * HALF + m * 16) * DM + col0;
#pragma unroll
                    for (int bj = 0; bj < 2; ++bj) *(u32x4*)(rowp + bj * HALF) = pack8(acc[ai][bj][m][0], acc[ai][bj][m][1]); }
        } else {
            const int col0 = (u.pn - 8) * HALF + wc * 32 + 8 * fq;
#pragma unroll
            for (int ai = 0; ai < 2; ++ai)
#pragma unroll
                for (int m = 0; m < 4; ++m) { bf16_t* rowp = PP + (size_t)(row0 + ai * HALF + m * 16) * DM + col0;
                    *(u32x4*)rowp = pack8(acc[ai][0][m][0] * acc[ai][1][m][0], acc[ai][0][m][1] * acc[ai][1][m][1]); }
        }
    }
};
struct EpiMoeA {
    static constexpr bool PERM = true;
    bf16_t* ACT;
    __device__ __forceinline__ f32x4 act(const f32x4 g, const f32x4 u) const { f32x4 r;
#pragma unroll
        for (int j = 0; j < 4; ++j) r[j] = g[j] * __builtin_amdgcn_rcpf(1.0f + __expf(-g[j])) * u[j];
        return r; }
    __device__ __forceinline__ void operator()(const f32x4 (&acc)[2][2][4][2], const Unit& u, int wr, int wc, int fr, int fq) const {
        const int row0 = u.pm * BM + wr * 64 + fr, col0 = u.pn * HALF + wc * 32 + 8 * fq;
#pragma unroll
        for (int ai = 0; ai < 2; ++ai)
#pragma unroll
            for (int m = 0; m < 4; ++m) { bf16_t* rowp = ACT + (size_t)(row0 + ai * HALF + m * 16) * EFF + col0;
                *(u32x4*)rowp = pack8(act(acc[ai][0][m][0], acc[ai][1][m][0]), act(acc[ai][0][m][1], acc[ai][1][m][1])); }
    }
};
struct EpiDelta {
    static constexpr bool PERM = true;
    bf16_t* D; int rowbase; int mper; int gcols;
    __device__ __forceinline__ void operator()(const f32x4 (&acc)[2][2][4][2], const Unit& u, int wr, int wc, int fr, int fq) const {
        const int g = u.pm / mper, rt = u.pm - g * mper;
        const int row0 = rowbase + rt * BM + wr * 64 + fr, col0 = g * gcols + u.pn * BM + wc * 32 + 8 * fq;
#pragma unroll
        for (int ai = 0; ai < 2; ++ai)
#pragma unroll
            for (int m = 0; m < 4; ++m) { bf16_t* rowp = D + (size_t)(row0 + ai * HALF + m * 16) * DM + col0;
#pragma unroll
                for (int bj = 0; bj < 2; ++bj) *(u32x4*)(rowp + bj * HALF) = pack8(acc[ai][bj][m][0], acc[ai][bj][m][1]); }
    }
};
struct EpiResid {
    static constexpr bool PERM = false;
    float* X; const float* gate_lat; const float* gate_ctx; const float* colscale; int rowbase; int mper; int gcols;
    __device__ __forceinline__ void operator()(const f32x4 (&acc)[2][2][4][2], const Unit& u, int wr, int wc, int fr, int fq) const {
        const int g = u.pm / mper, rt = u.pm - g * mper;
        const int rowt = rowbase + rt * BM, row0 = rowt + wr * 64 + fr, col0 = g * gcols + u.pn * BM + wc * 32 + 4 * fq;
        const float* gate = (rowt < NCTX) ? gate_ctx : gate_lat;
        f32x4 gv[2][2];
#pragma unroll
        for (int bj = 0; bj < 2; ++bj)
#pragma unroll
            for (int n = 0; n < 2; ++n) { gv[bj][n] = *(const f32x4*)(gate + col0 + bj * HALF + n * 16); if (colscale) gv[bj][n] = gv[bj][n] * *(const f32x4*)(colscale + col0 + bj * HALF + n * 16); }
#pragma unroll
        for (int ai = 0; ai < 2; ++ai)
#pragma unroll
            for (int m = 0; m < 4; ++m) { float* rowp = X + (size_t)(row0 + ai * HALF + m * 16) * DM + col0;
#pragma unroll
                for (int bj = 0; bj < 2; ++bj)
#pragma unroll
                    for (int n = 0; n < 2; ++n) { float* p = rowp + bj * HALF + n * 16; const f32x4 xv = *(const f32x4*)p; *(f32x4*)p = xv * ALPHA + gv[bj][n] * acc[ai][bj][m][n]; }
                asm volatile("" ::: "memory"); }
    }
};

template <class Epi, class Sched, bool ALIGN_EPI, bool SP2>
__device__ __forceinline__ void gemm_phase(LAS unsigned char* lds, const Gemm g, const Sched& S, const Epi& E, const int tid) {
    const int wid = __builtin_amdgcn_readfirstlane(tid >> 6), lane = tid & 63, wr = wid >> 2, wc = wid & 3, fr = lane & 15, fq = lane >> 4;
    const int K = g.K, nt = K / BK;
    unsigned voffA[2], voffB[2];
#pragma unroll
    for (int i = 0; i < 2; ++i) { int R, C; stage_rc(tid * 16 + i * 8192, R, C); const int Rb = Epi::PERM ? ((R & ~31) + perm32(R & 31)) : R;
        voffA[i] = (unsigned)(R * K + C) * 2u; voffB[i] = (unsigned)(Rb * K + C) * 2u; }
    const size_t kstep = (size_t)(BK * 2);
    const size_t hstep = (size_t)HALF * K * 2;
    const size_t tstep = 2 * hstep;
    const size_t bstep = g.bstride * 2;
    const unsigned ldsw = (unsigned)wid * 1024u;
    const int aoff = lds_byte(wr * 64 + fr, fq * 8), boff = lds_byte(wc * 32 + fr, fq * 8);
#define PG8_SA(b, h) (((b) * 2 + (h)) * HTB)
#define PG8_SB(b, h) ((4 + (b) * 2 + (h)) * HTB)
#define PG8_STAGE(bufoff, gbase, voff) do { _Pragma("unroll") for (int _i = 0; _i < 2; ++_i) \
        __builtin_amdgcn_global_load_lds((const unsigned*)((const char*)(gbase) + (voff)[_i]), (LAS unsigned*)(lds + (bufoff) + ldsw + _i * 8192), 16, 0, 0); } while (0)
#define PG8_LDA(dst, b, h) do { _Pragma("unroll") for (int m = 0; m < 4; ++m) _Pragma("unroll") for (int k = 0; k < 2; ++k) dst[m][k] = *(const LAS bf16x8*)(lds + PG8_SA(b, h) + aoff + m * 2048 + k * 1024); } while (0)
#define PG8_LDB(dst, b, h) do { _Pragma("unroll") for (int n = 0; n < 2; ++n) _Pragma("unroll") for (int k = 0; k < 2; ++k) dst[n][k] = *(const LAS bf16x8*)(lds + PG8_SB(b, h) + boff + n * 2048 + k * 1024); } while (0)
#define PG8_MMA(ai, bj, At, Bt) do { __builtin_amdgcn_s_setprio(1); _Pragma("unroll") for (int m = 0; m < 4; ++m) _Pragma("unroll") for (int n = 0; n < 2; ++n) _Pragma("unroll") for (int k = 0; k < 2; ++k) \
        acc[ai][bj][m][n] = __builtin_amdgcn_mfma_f32_16x16x32_bf16(Bt[n][k], At[m][k], acc[ai][bj][m][n], 0, 0, 0); __builtin_amdgcn_s_setprio(0); } while (0)
#define PG8_WAIT_V(n) asm volatile("s_waitcnt vmcnt(" #n ")" ::: "memory")
#define PG8_WAIT_L(n) asm volatile("s_waitcnt lgkmcnt(" #n ")" ::: "memory")
#define PG8_BAR __builtin_amdgcn_s_barrier()
#define PG8_SCHED __builtin_amdgcn_sched_barrier(0)
    Unit cur, nxt; int ui = 0;
    if (!S.next(0, cur)) return;
    f32x4 acc[2][2][4][2];
#pragma unroll
    for (int a = 0; a < 2; ++a)
#pragma unroll
        for (int b = 0; b < 2; ++b)
#pragma unroll
            for (int m = 0; m < 4; ++m)
#pragma unroll
                for (int n = 0; n < 2; ++n) acc[a][b][m][n] = (f32x4){0.f, 0.f, 0.f, 0.f};
    bf16x8 At[4][2], B0[2][2], B1[2][2];
    const char* cA = (const char*)g.A + (size_t)cur.pa * tstep; const char* cB = (const char*)g.Bt + (size_t)cur.bsel * bstep + (size_t)cur.pn * tstep;
    if constexpr (SP2) {
        PG8_STAGE(PG8_SB(0, 0), cB, voffB); PG8_STAGE(PG8_SB(0, 1), cB + hstep, voffB); PG8_STAGE(PG8_SA(0, 0), cA, voffA); PG8_STAGE(PG8_SA(0, 1), cA + hstep, voffA);
        if (wr == 1) PG8_BAR;
        PG8_WAIT_V(2); PG8_BAR;
        PG8_STAGE(PG8_SB(1, 0), cB + kstep, voffB); PG8_STAGE(PG8_SA(1, 0), cA + kstep, voffA); PG8_STAGE(PG8_SB(1, 1), cB + hstep + kstep, voffB);
        PG8_WAIT_V(6); PG8_BAR;
    } else {
        PG8_STAGE(PG8_SB(0, 0), cB, voffB); PG8_STAGE(PG8_SA(0, 0), cA, voffA); PG8_STAGE(PG8_SB(0, 1), cB + hstep, voffB); PG8_STAGE(PG8_SA(0, 1), cA + hstep, voffA);
        if (wr == 1) PG8_BAR;
        PG8_WAIT_V(4); PG8_BAR;
        PG8_STAGE(PG8_SB(1, 0), cB + kstep, voffB); PG8_STAGE(PG8_SA(1, 0), cA + kstep, voffA); PG8_STAGE(PG8_SB(1, 1), cB + hstep + kstep, voffB);
        PG8_WAIT_V(6); PG8_BAR;
    }
    for (;;) {
        const bool has_next = S.next(ui + 1, nxt);
        const char* nA = has_next ? (const char*)g.A + (size_t)nxt.pa * tstep : cA; const char* nB = has_next ? (const char*)g.Bt + (size_t)nxt.bsel * bstep + (size_t)nxt.pn * tstep : cB;
        for (int t = 0; t < nt; t += 2) {
            const bool last = (t == nt - 2);
            const char* a1 = cA + (size_t)(t + 1) * kstep;
            const char* a2 = last ? nA : cA + (size_t)(t + 2) * kstep; const char* b2 = last ? nB : cB + (size_t)(t + 2) * kstep;
            const char* a3 = a2 + kstep; const char* b3 = b2 + kstep;
            if constexpr (SP2) {
            PG8_LDB(B0, 0, 0); PG8_LDB(B1, 0, 1); PG8_SCHED; PG8_LDA(At, 0, 0); PG8_STAGE(PG8_SA(1, 1), a1 + hstep, voffA);
            PG8_WAIT_V(8); PG8_WAIT_L(0); PG8_BAR; PG8_MMA(0, 0, At, B0); PG8_MMA(0, 1, At, B1); PG8_BAR; PG8_SCHED;
            PG8_LDA(At, 0, 1); PG8_STAGE(PG8_SB(0, 0), b2, voffB); PG8_STAGE(PG8_SB(0, 1), b2 + hstep, voffB); PG8_STAGE(PG8_SA(0, 0), a2, voffA);
            PG8_WAIT_V(8); PG8_WAIT_L(0); PG8_BAR; PG8_MMA(1, 0, At, B0); PG8_MMA(1, 1, At, B1); PG8_BAR; PG8_SCHED;
            PG8_LDB(B0, 1, 0); PG8_LDB(B1, 1, 1); PG8_SCHED; PG8_LDA(At, 1, 0); PG8_STAGE(PG8_SA(0, 1), a2 + hstep, voffA);
            PG8_WAIT_V(8); PG8_WAIT_L(0); PG8_BAR; PG8_MMA(0, 0, At, B0); PG8_MMA(0, 1, At, B1); PG8_BAR; PG8_SCHED;
            PG8_LDA(At, 1, 1); PG8_STAGE(PG8_SB(1, 0), b3, voffB); PG8_STAGE(PG8_SB(1, 1), b3 + hstep, voffB); PG8_STAGE(PG8_SA(1, 0), a3, voffA);
            PG8_WAIT_V(8); PG8_WAIT_L(0); PG8_BAR; PG8_MMA(1, 0, At, B0); PG8_MMA(1, 1, At, B1); PG8_BAR; PG8_SCHED;
            } else {
            PG8_LDB(B0, 0, 0); PG8_SCHED; PG8_LDA(At, 0, 0); PG8_STAGE(PG8_SA(1, 1), a1 + hstep, voffA);
            PG8_WAIT_L(8); PG8_BAR; PG8_WAIT_L(0); PG8_MMA(0, 0, At, B0); PG8_BAR; PG8_SCHED;
            PG8_LDB(B1, 0, 1); PG8_STAGE(PG8_SB(0, 0), b2, voffB);
            PG8_BAR; PG8_WAIT_L(0); PG8_MMA(0, 1, At, B1); PG8_BAR;
            PG8_LDA(At, 0, 1); PG8_STAGE(PG8_SA(0, 0), a2, voffA);
            PG8_BAR; PG8_WAIT_L(0); PG8_MMA(1, 0, At, B0); PG8_BAR; PG8_SCHED;
            PG8_STAGE(PG8_SB(0, 1), b2 + hstep, voffB);
            PG8_WAIT_V(6); PG8_BAR; PG8_MMA(1, 1, At, B1); PG8_BAR;
            PG8_LDB(B0, 1, 0); PG8_SCHED; PG8_LDA(At, 1, 0); PG8_STAGE(PG8_SA(0, 1), a2 + hstep, voffA);
            PG8_WAIT_L(8); PG8_BAR; PG8_WAIT_L(0); PG8_MMA(0, 0, At, B0); PG8_BAR; PG8_SCHED;
            PG8_LDB(B1, 1, 1); PG8_STAGE(PG8_SB(1, 0), b3, voffB);
            PG8_BAR; PG8_WAIT_L(0); PG8_MMA(0, 1, At, B1); PG8_BAR;
            PG8_LDA(At, 1, 1); PG8_STAGE(PG8_SA(1, 0), a3, voffA);
            PG8_BAR; PG8_WAIT_L(0); PG8_MMA(1, 0, At, B0); PG8_BAR; PG8_SCHED;
            PG8_STAGE(PG8_SB(1, 1), b3 + hstep, voffB);
            PG8_WAIT_V(6); PG8_BAR; PG8_MMA(1, 1, At, B1); PG8_BAR;
            }
        }
        if constexpr (ALIGN_EPI) { if (wr == 0) PG8_BAR; }
        E(acc, cur, wr, wc, fr, fq);
        if (!has_next) break;
#pragma unroll
        for (int a = 0; a < 2; ++a)
#pragma unroll
            for (int b = 0; b < 2; ++b)
#pragma unroll
                for (int m = 0; m < 4; ++m)
#pragma unroll
                    for (int n = 0; n < 2; ++n) acc[a][b][m][n] = (f32x4){0.f, 0.f, 0.f, 0.f};
        cur = nxt; cA = nA; cB = nB; ++ui;
        if constexpr (ALIGN_EPI) { if (wr == 1) PG8_BAR; }
    }
    PG8_WAIT_V(0);
    if constexpr (!ALIGN_EPI) { if (wr == 0) PG8_BAR; }
    PG8_BAR;
#undef PG8_SA
#undef PG8_SB
#undef PG8_STAGE
#undef PG8_LDA
#undef PG8_LDB
#undef PG8_MMA
#undef PG8_WAIT_V
#undef PG8_WAIT_L
#undef PG8_BAR
#undef PG8_SCHED
}
}

namespace att {
constexpr int D = 128, NW = 8, QBLK = 32, KVBLK = 64;
constexpr float SCALE = 0.088388347648318440f;
constexpr float THR = 8.f;
constexpr size_t SHM_V = KVBLK * D * 2, SHM_K = KVBLK * D * 2, SHM_ATTN = 2 * SHM_V + 2 * SHM_K + NW * 64 * 4;
#define KSWZ(row, colB) ((row) * 256 + ((colB) ^ (((row) & 7) << 4)))
#define SBAR() __builtin_amdgcn_sched_barrier(0)
__device__ __forceinline__ int crow(int r, int hi) { return (r & 3) + 8 * (r >> 2) + 4 * hi; }
__device__ __forceinline__ unsigned cvtpk(float lo, float hi) { unsigned r; asm volatile("v_cvt_pk_bf16_f32 %0, %1, %2" : "=v"(r) : "v"(lo), "v"(hi)); return r; }
__device__ __forceinline__ void partialSM(f32x16& p0, f32x16& p1, float& m_reg, float& mn, float& alpha) {
  constexpr float C = SCALE * 1.4426950408889634f;
  float pmax = p0[0]; for (int r = 1; r < 16; ++r) pmax = fmaxf(pmax, p0[r]); for (int r = 0; r < 16; ++r) pmax = fmaxf(pmax, p1[r]);
  { auto rr = __builtin_amdgcn_permlane32_swap(__float_as_uint(pmax), __float_as_uint(pmax), false, false);
    pmax = fmaxf(__uint_as_float(rr[0]), __uint_as_float(rr[1])); }
  if (__builtin_expect(__all(pmax - m_reg <= THR / SCALE), 1)) { mn = m_reg; alpha = 1.f; }
  else { mn = fmaxf(m_reg, pmax); alpha = __builtin_amdgcn_exp2f((m_reg - mn) * C); m_reg = mn; }
  float mnC = -mn * C;
  for (int r = 0; r < 16; ++r) p0[r] = fmaf(p0[r], C, mnC); for (int r = 0; r < 16; ++r) p1[r] = fmaf(p1[r], C, mnC);
  for (int r = 0; r < 16; ++r) p0[r] = __builtin_amdgcn_exp2f(p0[r]);
}
__device__ __forceinline__ void finishSM(f32x16& p0, f32x16& p1, float alpha, float& l_reg, bf16x8& pa0, bf16x8& pa1, bf16x8& pa2, bf16x8& pa3) {
  for (int r = 0; r < 16; ++r) p1[r] = __builtin_amdgcn_exp2f(p1[r]);
  float ps = 0; for (int r = 0; r < 16; ++r) ps += p0[r]; for (int r = 0; r < 16; ++r) ps += p1[r];
  { auto rr = __builtin_amdgcn_permlane32_swap(__float_as_uint(ps), __float_as_uint(ps), false, false);
    ps = __uint_as_float(rr[0]) + __uint_as_float(rr[1]); }
  l_reg = l_reg * alpha + ps;
#define PK4(P, BASE, OUT) do { unsigned a0 = cvtpk(P[BASE + 0], P[BASE + 1]), a1 = cvtpk(P[BASE + 2], P[BASE + 3]);   \
    unsigned b0 = cvtpk(P[BASE + 4], P[BASE + 5]), b1 = cvtpk(P[BASE + 6], P[BASE + 7]);                              \
    auto r0 = __builtin_amdgcn_permlane32_swap(a0, b0, false, false); auto r1 = __builtin_amdgcn_permlane32_swap(a1, b1, false, false); \
    u32x4 w = {r0[0], r1[0], r0[1], r1[1]}; OUT = *reinterpret_cast<bf16x8*>(&w); } while (0)
  PK4(p0, 0, pa0); PK4(p0, 8, pa1); PK4(p1, 0, pa2); PK4(p1, 8, pa3);
#undef PK4
}
__device__ __forceinline__ void qkt(f32x16& p0, f32x16& p1, const bf16_t* Ks, const bf16x8* qr, int r32, int hi) {
  p0 = f32x16{}; p1 = f32x16{};
  for (int d0 = 0; d0 < 8; ++d0) { int cb = (d0 * 16 + hi * 8) * 2;
    bf16x8 b0 = *reinterpret_cast<const bf16x8*>((const char*)Ks + KSWZ(r32, cb));
    bf16x8 b1 = *reinterpret_cast<const bf16x8*>((const char*)Ks + KSWZ(32 + r32, cb));
    p0 = __builtin_amdgcn_mfma_f32_32x32x16_bf16(b0, qr[d0], p0, 0, 0, 0);
    p1 = __builtin_amdgcn_mfma_f32_32x32x16_bf16(b1, qr[d0], p1, 0, 0, 0); }
}
__device__ __forceinline__ int v_st(int k, int c) { const int kk = (k & ~0xC) | ((k & 4) << 1) | ((k & 8) >> 1); return ((kk >> 3) * 4 + (c >> 5)) * 512 + ((kk & 7) * 32 + (c & 31)) * 2; }
__device__ __forceinline__ int v_rd_base(int lane) { return ((lane & 3) << 3) | (((lane >> 2) & 3) << 6) | (((lane >> 4) & 1) << 5) | (((lane >> 5) & 1) << 8); }
constexpr int v_rd_off(int d0, int ks, int half) { return d0 * 512 + ks * 4096 + half * 2048; }
template <int OFF> __device__ __forceinline__ s16x4 tr_read(int vb) {
  s16x4 r; asm volatile("ds_read_b64_tr_b16 %0, %1 offset:%2" : "=&v"(r) : "v"(vb), "i"(OFF) : "memory"); return r;
}
template <int D0> __device__ __forceinline__ void pv_one(f32x16& od, int vb, bf16x8 pa0, bf16x8 pa1, bf16x8 pa2, bf16x8 pa3) {
  const s16x4 l0 = tr_read<v_rd_off(D0, 0, 0)>(vb), h0 = tr_read<v_rd_off(D0, 0, 1)>(vb), l1 = tr_read<v_rd_off(D0, 1, 0)>(vb), h1 = tr_read<v_rd_off(D0, 1, 1)>(vb);
  const s16x4 l2 = tr_read<v_rd_off(D0, 2, 0)>(vb), h2 = tr_read<v_rd_off(D0, 2, 1)>(vb), l3 = tr_read<v_rd_off(D0, 3, 0)>(vb), h3 = tr_read<v_rd_off(D0, 3, 1)>(vb);
  asm volatile("s_waitcnt lgkmcnt(0)" ::: "memory"); SBAR();
#define PK(L, H) (bf16x8){L[0], L[1], L[2], L[3], H[0], H[1], H[2], H[3]}
  od = __builtin_amdgcn_mfma_f32_32x32x16_bf16(pa0, PK(l0, h0), od, 0, 0, 0);
  od = __builtin_amdgcn_mfma_f32_32x32x16_bf16(pa1, PK(l1, h1), od, 0, 0, 0);
  od = __builtin_amdgcn_mfma_f32_32x32x16_bf16(pa2, PK(l2, h2), od, 0, 0, 0);
  od = __builtin_amdgcn_mfma_f32_32x32x16_bf16(pa3, PK(l3, h3), od, 0, 0, 0);
#undef PK
}
__device__ __forceinline__ void pv_d0(f32x16* o, int vb, bf16x8 pa0, bf16x8 pa1, bf16x8 pa2, bf16x8 pa3) {
  pv_one<0>(o[0], vb, pa0, pa1, pa2, pa3); pv_one<1>(o[1], vb, pa0, pa1, pa2, pa3); pv_one<2>(o[2], vb, pa0, pa1, pa2, pa3); pv_one<3>(o[3], vb, pa0, pa1, pa2, pa3);
}
template <int LDQ, int LDK, int LDV, int LDO>
__device__ __forceinline__ void attn_unit(const bf16_t* __restrict__ Qb, const bf16_t* __restrict__ Kh, const bf16_t* __restrict__ Vh, bf16_t* __restrict__ Ob, int seq, char* lds, const int wid,
                                          const float* qgain = nullptr, const float* rope = nullptr, int qpos0 = -1) {
  const int lane = lane_id_fresh(), tid = wid * 64 + lane, r32 = lane & 31, hi = lane >> 5;
  bf16_t* V_lds = (bf16_t*)lds; bf16_t* K_lds = (bf16_t*)(lds + 2 * SHM_V);
  float* ws = (float*)(lds + 2 * SHM_V + 2 * SHM_K) + wid * 64; float* li_l = ws; float* al_l = ws + 32;
  float m_reg = -1e30f, l_reg = 0; f32x16 o[4] = {}; bf16x8 qr[8];
  { const unsigned offQ = (unsigned)((wid * QBLK + r32) * LDQ + hi * 8) * 2u;
#pragma unroll
  for (int d0 = 0; d0 < 8; ++d0) qr[d0] = *reinterpret_cast<const bf16x8*>((const char*)Qb + offQ + d0 * 32); }
  if (qgain) {
    float x[8][8]; float ss = 0.f;
#pragma unroll
    for (int d0 = 0; d0 < 8; ++d0) { const u32x4 w = *reinterpret_cast<const u32x4*>(&qr[d0]);
#pragma unroll
      for (int q = 0; q < 4; ++q) { x[d0][2 * q] = bf_lo(w[q]); x[d0][2 * q + 1] = bf_hi(w[q]); ss += x[d0][2 * q] * x[d0][2 * q] + x[d0][2 * q + 1] * x[d0][2 * q + 1]; } }
    { auto rr = __builtin_amdgcn_permlane32_swap(__float_as_uint(ss), __float_as_uint(ss), false, false); ss = __uint_as_float(rr[0]) + __uint_as_float(rr[1]); }
    const float rstd = 1.0f / sqrtf(ss * (1.0f / 128.0f) + RMS_EPS);
#pragma unroll
    for (int d0 = 0; d0 < 8; ++d0) { const f32x4 g0 = *(const f32x4*)(qgain + d0 * 16 + hi * 8), g1 = *(const f32x4*)(qgain + d0 * 16 + hi * 8 + 4);
#pragma unroll
      for (int j = 0; j < 4; ++j) { x[d0][j] *= rstd * g0[j]; x[d0][4 + j] *= rstd * g1[j]; } }
    if (qpos0 >= 0) { const int t = qpos0 + wid * QBLK + r32;
#pragma unroll
      for (int pr = 0; pr < 4; ++pr) { const int da = (pr >> 1) * 4 + (pr & 1), db = da + 2;
        const int pos = (pr < 2) ? (t >> 6) : (t & 63); const float* cs = rope + ((pr < 2) ? 0 : 8192) + pos * 32 + (pr & 1) * 16 + hi * 8; const float* sn = cs + ((pr < 2) ? 4096 : 2048);
        const f32x4 c0 = *(const f32x4*)cs, c1 = *(const f32x4*)(cs + 4), s0 = *(const f32x4*)sn, s1 = *(const f32x4*)(sn + 4);
#pragma unroll
        for (int j = 0; j < 8; ++j) { const float c = j < 4 ? c0[j & 3] : c1[j & 3], sv = j < 4 ? s0[j & 3] : s1[j & 3]; const float xa = x[da][j], xb = x[db][j];
          x[da][j] = xa * c - xb * sv; x[db][j] = xb * c + xa * sv; } } }
#pragma unroll
    for (int d0 = 0; d0 < 8; ++d0) { u32x4 w; w.x = cvtpk(x[d0][0], x[d0][1]); w.y = cvtpk(x[d0][2], x[d0][3]); w.z = cvtpk(x[d0][4], x[d0][5]); w.w = cvtpk(x[d0][6], x[d0][7]); qr[d0] = *reinterpret_cast<bf16x8*>(&w); }
  }
  const int sr = tid >> 4, sc = (tid & 15) * 8, vst0 = v_st(sr, sc), vst1 = v_st(32 + sr, sc);
  const int vb0 = (int)(uintptr_t)V_lds + v_rd_base(lane);
  struct { bf16x8 vs0, vs1, ks0, ks1; } sr_[2];
  const int offV = (sr * LDV + sc) * 2, offK = (sr * LDK + sc) * 2;
  const __amdgpu_buffer_rsrc_t rV = __builtin_amdgcn_make_buffer_rsrc((void*)Vh, 0, 0x7ffffff0, 0x00020000);
  const __amdgpu_buffer_rsrc_t rK = __builtin_amdgcn_make_buffer_rsrc((void*)Kh, 0, 0x7ffffff0, 0x00020000);
#define SLOAD(i, k0) do { const int sv_ = (k0) * (LDV * 2), sk_ = (k0) * (LDK * 2); \
    { u32x4 t_ = __builtin_amdgcn_raw_buffer_load_b128(rV, offV, sv_, 0); sr_[i].vs0 = *reinterpret_cast<bf16x8*>(&t_); } \
    { u32x4 t_ = __builtin_amdgcn_raw_buffer_load_b128(rV, offV, sv_ + 32 * LDV * 2, 0); sr_[i].vs1 = *reinterpret_cast<bf16x8*>(&t_); } \
    { u32x4 t_ = __builtin_amdgcn_raw_buffer_load_b128(rK, offK, sk_, 0); sr_[i].ks0 = *reinterpret_cast<bf16x8*>(&t_); } \
    { u32x4 t_ = __builtin_amdgcn_raw_buffer_load_b128(rK, offK, sk_ + 32 * LDK * 2, 0); sr_[i].ks1 = *reinterpret_cast<bf16x8*>(&t_); } } while (0)
#define SWRITE(b, i) do { *(bf16x8*)((char*)V_lds + (b) * SHM_V + vst0) = sr_[i].vs0;          \
    *(bf16x8*)((char*)V_lds + (b) * SHM_V + vst1) = sr_[i].vs1; int kc = sc * 2;               \
    *(bf16x8*)((char*)K_lds + (b) * SHM_K + KSWZ(sr, kc)) = sr_[i].ks0;                       \
    *(bf16x8*)((char*)K_lds + (b) * SHM_K + KSWZ(32 + sr, kc)) = sr_[i].ks1; } while (0)
#define SWAIT() asm volatile("s_waitcnt vmcnt(4)" ::: "memory")
#define RESC(a) do { if (__any((a) < 1.f)) { if (hi == 0) al_l[r32] = (a); asm volatile("s_waitcnt lgkmcnt(0)" ::: "memory"); \
    for (int d = 0; d < 4; ++d) for (int r = 0; r < 16; ++r) o[d][r] *= al_l[crow(r, hi)]; } } while (0)
  f32x16 pA0, pA1, pB0, pB1; float mnA, mnB, alA, alB; bf16x8 pa0, pa1, pa2, pa3; const int NT = seq / KVBLK;
  constexpr int SE = 0, SO = 1;
  SLOAD(SE, 0); asm volatile("s_waitcnt vmcnt(0)" ::: "memory"); SWRITE(0, SE); __syncthreads();
  qkt(pA0, pA1, K_lds, qr, r32, hi); partialSM(pA0, pA1, m_reg, mnA, alA);
  SLOAD(SO, KVBLK); if (2 < NT) SLOAD(SE, 2 * KVBLK);
  SWAIT(); SWRITE(1, SO); __syncthreads();
  for (int j = 1; j + 1 < NT; j += 2) {
    SBAR(); qkt(pB0, pB1, (bf16_t*)((char*)K_lds + SHM_K), qr, r32, hi);
    finishSM(pA0, pA1, alA, l_reg, pa0, pa1, pa2, pa3); SBAR();
    SLOAD(SO, (j + 2) * KVBLK); SBAR();
    pv_d0(o, vb0, pa0, pa1, pa2, pa3); partialSM(pB0, pB1, m_reg, mnB, alB);
    __syncthreads(); SWAIT(); SWRITE(0, SE);
    RESC(alB); __syncthreads();
    SBAR(); qkt(pA0, pA1, K_lds, qr, r32, hi);
    finishSM(pB0, pB1, alB, l_reg, pa0, pa1, pa2, pa3); SBAR();
    if (j + 3 < NT) SLOAD(SE, (j + 3) * KVBLK); SBAR();
    pv_d0(o, vb0 + (int)SHM_V, pa0, pa1, pa2, pa3); partialSM(pA0, pA1, m_reg, mnA, alA);
    __syncthreads(); SWAIT(); SWRITE(1, SO);
    RESC(alA); __syncthreads();
  }
  SBAR(); qkt(pB0, pB1, (bf16_t*)((char*)K_lds + SHM_K), qr, r32, hi);
  finishSM(pA0, pA1, alA, l_reg, pa0, pa1, pa2, pa3); SBAR();
  pv_d0(o, vb0, pa0, pa1, pa2, pa3); partialSM(pB0, pB1, m_reg, mnB, alB);
  __syncthreads(); RESC(alB);
  finishSM(pB0, pB1, alB, l_reg, pa0, pa1, pa2, pa3); SBAR();
  pv_d0(o, vb0 + (int)SHM_V, pa0, pa1, pa2, pa3);
  if (hi == 0) li_l[r32] = l_reg; asm volatile("s_waitcnt lgkmcnt(0)" ::: "memory");
  float rli[16];
#pragma unroll
  for (int r = 0; r < 16; ++r) rli[r] = __builtin_amdgcn_rcpf(li_l[crow(r, hi)]);
#pragma unroll
  for (int r = 0; r < 16; ++r) { const unsigned offO = (unsigned)((wid * QBLK + crow(r, hi)) * LDO + r32) * 2u;
    for (int d0 = 0; d0 < 4; ++d0) { const float v = o[d0][r] * rli[r]; *(bf16_t*)((char*)Ob + offO + d0 * 64) = (bf16_t)(cvtpk(v, v) & 0xffffu); } }
  asm volatile("s_waitcnt vmcnt(0) lgkmcnt(0)" ::: "memory"); __syncthreads();
#undef SLOAD
#undef SWRITE
#undef SWAIT
#undef RESC
}
constexpr size_t SHM_V2 = 2 * SHM_V;
template <int LDQ, int LDK, int LDV, class EPI>
__device__ __forceinline__ void attn_unit2(const bf16_t* __restrict__ Qb, const bf16_t* __restrict__ Kh, const bf16_t* __restrict__ Vh0, const bf16_t* __restrict__ Vh1, int seq, char* lds, const int wid, EPI&& epi) {
  const int lane = lane_id_fresh(), tid = wid * 64 + lane, r32 = lane & 31, hi = lane >> 5;
  bf16_t* V_lds = (bf16_t*)lds; bf16_t* K_lds = (bf16_t*)(lds + 2 * SHM_V2);
  float* ws = (float*)(lds + 2 * SHM_V2 + 2 * SHM_K) + wid * 64; float* li_l = ws; float* al_l = ws + 32;
  float m_reg = -1e30f, l_reg = 0; f32x16 o[8] = {}; bf16x8 qr[8];
  { const unsigned offQ = (unsigned)((wid * QBLK + r32) * LDQ + hi * 8) * 2u;
#pragma unroll
  for (int d0 = 0; d0 < 8; ++d0) qr[d0] = *reinterpret_cast<const bf16x8*>((const char*)Qb + offQ + d0 * 32); }
  const int sr = tid >> 4, sc = (tid & 15) * 8, vst0 = v_st(sr, sc), vst1 = v_st(32 + sr, sc);
  const int vb0 = (int)(uintptr_t)V_lds + v_rd_base(lane);
  const int offV = (sr * LDV + sc) * 2, offK = (sr * LDK + sc) * 2;
  const __amdgpu_buffer_rsrc_t rV0 = __builtin_amdgcn_make_buffer_rsrc((void*)Vh0, 0, 0x7ffffff0, 0x00020000);
  const __amdgpu_buffer_rsrc_t rV1 = __builtin_amdgcn_make_buffer_rsrc((void*)Vh1, 0, 0x7ffffff0, 0x00020000);
  const __amdgpu_buffer_rsrc_t rK = __builtin_amdgcn_make_buffer_rsrc((void*)Kh, 0, 0x7ffffff0, 0x00020000);
  u32x4 sv0, sv1, sv2, sv3, sk0, sk1;
#define SLOAD2(k0) do { const int sv_ = (k0) * (LDV * 2), sk_ = (k0) * (LDK * 2); \
    sv0 = __builtin_amdgcn_raw_buffer_load_b128(rV0, offV, sv_, 0); sv1 = __builtin_amdgcn_raw_buffer_load_b128(rV0, offV, sv_ + 32 * LDV * 2, 0); \
    sv2 = __builtin_amdgcn_raw_buffer_load_b128(rV1, offV, sv_, 0); sv3 = __builtin_amdgcn_raw_buffer_load_b128(rV1, offV, sv_ + 32 * LDV * 2, 0); \
    sk0 = __builtin_amdgcn_raw_buffer_load_b128(rK, offK, sk_, 0); sk1 = __builtin_amdgcn_raw_buffer_load_b128(rK, offK, sk_ + 32 * LDK * 2, 0); } while (0)
#define SWRITE2(b) do { char* vb_ = (char*)V_lds + (b) * SHM_V2; const int kc = sc * 2; \
    *(u32x4*)(vb_ + vst0) = sv0; *(u32x4*)(vb_ + vst1) = sv1; *(u32x4*)(vb_ + SHM_V + vst0) = sv2; *(u32x4*)(vb_ + SHM_V + vst1) = sv3; \
    *(u32x4*)((char*)K_lds + (b) * SHM_K + KSWZ(sr, kc)) = sk0; *(u32x4*)((char*)K_lds + (b) * SHM_K + KSWZ(32 + sr, kc)) = sk1; } while (0)
#define RESC2(a) do { if (__any((a) < 1.f)) { if (hi == 0) al_l[r32] = (a); asm volatile("s_waitcnt lgkmcnt(0)" ::: "memory"); \
    for (int d = 0; d < 8; ++d) for (int r = 0; r < 16; ++r) o[d][r] *= al_l[crow(r, hi)]; } } while (0)
  f32x16 p0, p1; float mn, al; bf16x8 pa0, pa1, pa2, pa3; const int NT = seq / KVBLK;
  SLOAD2(0); SWRITE2(0); __syncthreads();
  for (int j = 0; j < NT; ++j) { const int b = j & 1;
    if (j + 1 < NT) SLOAD2((j + 1) * KVBLK);
    SBAR(); qkt(p0, p1, (bf16_t*)((char*)K_lds + b * SHM_K), qr, r32, hi);
    partialSM(p0, p1, m_reg, mn, al); RESC2(al);
    finishSM(p0, p1, al, l_reg, pa0, pa1, pa2, pa3); SBAR();
    pv_d0(o, vb0 + b * (int)SHM_V2, pa0, pa1, pa2, pa3);
    pv_d0(o + 4, vb0 + b * (int)SHM_V2 + (int)SHM_V, pa0, pa1, pa2, pa3);
    __syncthreads();
    if (j + 1 < NT) SWRITE2(b ^ 1);
    __syncthreads();
  }
  const int le = lane_id_fresh(), r32e = le & 31, hie = le >> 5;
  if (hie == 0) li_l[r32e] = l_reg; asm volatile("s_waitcnt lgkmcnt(0)" ::: "memory");
  float rli[16];
#pragma unroll
  for (int r = 0; r < 16; ++r) rli[r] = __builtin_amdgcn_rcpf(li_l[crow(r, hie)]);
  epi(o, rli, wid, le);
  asm volatile("s_waitcnt vmcnt(0) lgkmcnt(0)" ::: "memory"); __syncthreads();
#undef SLOAD2
#undef SWRITE2
#undef RESC2
}
#undef KSWZ
#undef SBAR
}

#define XB_TMO      128
#define XB_XCNT(j)  (256  + 64 * (j))
#define XB_XSUB(j)  (1280 + 64 * (j))
#define XB_XGEN(j)  (2304 + 64 * (j))
#define XB_TOP      3328
#define XB_TOPGEN   3392
#define XCD_BAR_WORDS 3456
#define XB_SPIN_CAP (1u << 18)
__device__ __forceinline__ unsigned xb_ld(unsigned* p)              { return __hip_atomic_load(p, __ATOMIC_RELAXED, __HIP_MEMORY_SCOPE_AGENT); }
__device__ __forceinline__ unsigned xb_add(unsigned* p, unsigned v) { return __hip_atomic_fetch_add(p, v, __ATOMIC_RELAXED, __HIP_MEMORY_SCOPE_AGENT); }
__device__ __forceinline__ unsigned xb_xcc_id() { return (unsigned)__builtin_amdgcn_s_getreg((3 << 11) | 20) & 0xFu; }
#define XB_SPIN(cond, bar) do { unsigned _sp = 0; while (cond) { __builtin_amdgcn_s_sleep(1); \
    if ((++_sp & 255u) == 0u) { if (xb_ld(&(bar)[XB_TMO])) break; if (_sp > XB_SPIN_CAP) { atomicAdd(&(bar)[XB_TMO], 1u); break; } } } } while (0)
struct XcdBarrier { unsigned* bar; unsigned x; volatile LAS unsigned* st; };
__device__ __forceinline__ XcdBarrier xcd_barrier_post(unsigned* bar, volatile LAS unsigned* st, const int tid) {
    XcdBarrier b; b.bar = bar; b.x = xb_xcc_id(); b.st = st;
    if (tid == 0) (void)xb_add(&bar[XB_XCNT(b.x)], 1u);
    return b;
}
__device__ __forceinline__ void xcd_barrier_complete(unsigned* bar, unsigned x, unsigned& nloc, unsigned& nx) {
    const unsigned G = gridDim.x * gridDim.y * gridDim.z;
    unsigned sum, cnt, mine, sp = 0u;
    for (;;) {
        sum = 0u; cnt = 0u; mine = 0u;
#pragma unroll
        for (unsigned j = 0; j < 16; ++j) { const unsigned c = xb_ld(&bar[XB_XCNT(j)]); sum += c; cnt += (c > 0u) ? 1u : 0u; mine = (j == x) ? c : mine; }
        if (sum == G) break;
        __builtin_amdgcn_s_sleep(1);
        if ((++sp & 255u) == 0u) { if (xb_ld(&bar[XB_TMO])) break; if (sp > XB_SPIN_CAP) { atomicAdd(&bar[XB_TMO], 1u); break; } }
    }
    nloc = mine > 0u ? mine : 1u; nx = cnt > 0u ? cnt : 1u;
}
__device__ __forceinline__ void xcd_barrier(const XcdBarrier& b, const int tid) {
    asm volatile("s_waitcnt vmcnt(0)" ::: "memory");
    __syncthreads();
    if (tid == 0) {
        unsigned* bar = b.bar;
        __builtin_amdgcn_s_waitcnt(0);
        unsigned nloc = b.st[0], nx = b.st[1];
        if (nloc == 0u) { xcd_barrier_complete(bar, b.x, nloc, nx); b.st[0] = nloc; b.st[1] = nx; }
        const unsigned old = xb_add(&bar[XB_XSUB(b.x)], 1u);
        const unsigned gen = old / nloc;
        if (old + 1u == (gen + 1u) * nloc) {
            __builtin_amdgcn_fence(__ATOMIC_RELEASE, "agent");
            asm volatile("s_waitcnt vmcnt(0)" ::: "memory");
            const unsigned og = xb_add(&bar[XB_TOP], 1u);
            const unsigned tg = og / nx;
            if (og + 1u == (tg + 1u) * nx) xb_add(&bar[XB_TOPGEN], 1u);
            else XB_SPIN(xb_ld(&bar[XB_TOPGEN]) == tg, bar);
            __builtin_amdgcn_fence(__ATOMIC_ACQUIRE, "agent");
            xb_add(&bar[XB_XGEN(b.x)], 1u);
            asm volatile("s_waitcnt vmcnt(0)" ::: "memory");
        } else {
            XB_SPIN(xb_ld(&bar[XB_XGEN(b.x)]) == gen, bar);
            __builtin_amdgcn_fence(__ATOMIC_ACQUIRE, "agent");
            asm volatile("s_waitcnt vmcnt(0)" ::: "memory");
        }
    }
    __syncthreads();
}

constexpr int RING_BYTES = 131072;
constexpr int MISC_OFF = RING_BYTES;
constexpr int LDS_BYTES = 147456;

struct RowStats { float mean, rstd; };
__device__ __forceinline__ RowStats ln_stats(const f32x4 (&v)[8]) {
    float s = 0.f;
#pragma unroll
    for (int j = 0; j < 8; ++j) s += (v[j][0] + v[j][1]) + (v[j][2] + v[j][3]);
    const float mean = wave_sum(s) * (1.f / DM); float q = 0.f;
#pragma unroll
    for (int j = 0; j < 8; ++j) { const f32x4 d = v[j] - mean; q += (d[0] * d[0] + d[1] * d[1]) + (d[2] * d[2] + d[3] * d[3]); }
    RowStats r; r.mean = mean; r.rstd = 1.f / sqrtf(wave_sum(q) * (1.f / DM) + LN_EPS); return r;
}
__device__ __forceinline__ void store_bf16x4(bf16_t* p, const f32x4 v) { u32x2 w; w.x = cvt_pk_bf16(v[0], v[1]); w.y = cvt_pk_bf16(v[2], v[3]); *(u32x2*)p = w; }
__device__ __forceinline__ f32x4 load_bf16x4(const bf16_t* p) { const u32x2 w = *(const u32x2*)p; return (f32x4){bf_lo(w.x), bf_hi(w.x), bf_lo(w.y), bf_hi(w.y)}; }

__device__ __forceinline__ void transpose_item(const float* W, int ldw, int scol0, bf16_t* WT, int K, int drow0, int k0, LAS float*  , int lane) {
    const int kr = lane >> 3, n4 = (lane & 7) * 4;
    const float* src = W + (size_t)(k0 + 8 * kr) * ldw + scol0 + n4;
    f32x4 v[8];
#pragma unroll
    for (int i = 0; i < 8; ++i) v[i] = __builtin_nontemporal_load((const f32x4*)(src + (size_t)i * ldw));
    bf16_t* dst = WT + (size_t)(drow0 + n4) * K + k0 + 8 * kr;
#pragma unroll
    for (int q = 0; q < 4; ++q) { u32x4 o; o.x = cvt_pk_bf16(v[0][q], v[1][q]); o.y = cvt_pk_bf16(v[2][q], v[3][q]); o.z = cvt_pk_bf16(v[4][q], v[5][q]); o.w = cvt_pk_bf16(v[6][q], v[7][q]);
        *(u32x4*)(dst + (size_t)q * K) = o; }
}
__device__ __forceinline__ void tr_plain(const float* W, int K, int N, bf16_t* WT, int it, LAS float* scr, int lane) {
    const int nnb = N / 32, kb = it / nnb, nb = it % nnb;
    transpose_item(W, N, 32 * nb, WT, K, 32 * nb, 64 * kb, scr, lane);
}

struct Args { const float* in[27]; float* out; unsigned char* ws; int ph_lo, ph_hi; int probe_dup, pad; };
enum { I_X = 0, I_C, I_CTX, I_CCTX, I_MODW, I_MODB, I_LNG, I_LNB, I_RGW, I_RGB, I_REW, I_REB, I_EG, I_EU, I_ED, I_CIW, I_CW, I_COW, I_PW, I_PS, I_GQW, I_GQN, I_GOW, I_DQW, I_DL, I_DS, I_DOW };

namespace cq {
constexpr int I_GU = 32 * 48, I_DN = 12 * 64, I_EXP = I_GU + I_DN, I_LEXP = 16 * I_EXP;
constexpr int I_PL = 4 * 8 * 16, I_GQ = 32 * 96, I_GO = 32 * 64, I_DQ = 32 * 192, I_DO = 32 * 64;
constexpr int E0 = I_LEXP, E1 = E0 + I_PL, E2 = E1 + I_LEXP, E3 = E2 + I_GQ, E4 = E3 + I_GO, E5 = E4 + I_LEXP, E6 = E5 + I_DQ, E7 = E6 + I_DO, E8 = E7 + I_LEXP;
constexpr int NQ = E8;
}
constexpr int CW_Q = 16384;
struct __attribute__((packed, aligned(4))) F3 { float x, y, z; };
typedef float f32x3u __attribute__((ext_vector_type(3), aligned(4)));
struct TrDesc { const float* W; int ldw, sc; bf16_t* WT; int K, drow, k0; };
__device__ __forceinline__ TrDesc tr_plain_desc(const float* W, int K, int N, bf16_t* WT, int it) { const int nnb = N / 32, kb = it / nnb, nb = it % nnb; return TrDesc{W, N, 32 * nb, WT, K, 32 * nb, 64 * kb}; }
__device__ __forceinline__ TrDesc tr_expert_desc(const Args& a, int L, int r) {
    const int e = r / cq::I_EXP; r -= e * cq::I_EXP; const int le = L * 16 + e;
    if (r < cq::I_GU) {
        const int kb = r / 48, nb = r % 48, n = 32 * nb, pn = n >> 8, bj = (n >> 7) & 1, i = n & 127;
        const float* src = (bj ? a.in[I_EU] : a.in[I_EG]) + (size_t)le * DM * EFF;
        return TrDesc{src, EFF, 128 * pn + i, (bf16_t*)(a.ws + WS_WGU) + (size_t)le * 1536 * DM, DM, n, 64 * kb}; }
    return tr_plain_desc(a.in[I_ED] + (size_t)le * EFF * DM, EFF, DM, (bf16_t*)(a.ws + WS_WDN) + (size_t)le * DM * EFF, r - cq::I_GU);
}
__device__ __forceinline__ TrDesc cvt_queue_desc(const Args& a, int qi) {
    using namespace cq; TrDesc d;
    if (qi < E0) d = tr_expert_desc(a, 0, qi);
    else if (qi < E1) { const int r = qi - E0, g = r / 128; d = tr_plain_desc(a.in[I_PW] + (size_t)g * 512 * 512, 512, 512, (bf16_t*)(a.ws + WS_WPL) + (size_t)g * 512 * 512, r % 128); }
    else if (qi < E2) d = tr_expert_desc(a, 1, qi - E1);
    else if (qi < E3) d = tr_plain_desc(a.in[I_GQW], DM, 3072, (bf16_t*)(a.ws + WS_WGQ), qi - E2);
    else if (qi < E4) d = tr_plain_desc(a.in[I_GOW], DM, DM, (bf16_t*)(a.ws + WS_WGO), qi - E3);
    else if (qi < E5) d = tr_expert_desc(a, 2, qi - E4);
    else if (qi < E6) {
        const int it = qi - E5, kb = it / 192, nb = it % 192, n = 32 * nb; int sc = n;
        if (n < 4096) { const int pn = n >> 8, wi = n & 255, bj = wi >> 7, wc = (wi >> 5) & 3; sc = pn * 256 + (wc >> 1) * 128 + (2 * (wc & 1) + bj) * 32; }
        d = TrDesc{a.in[I_DQW], 3 * DM, sc, (bf16_t*)(a.ws + WS_WDQ), DM, n, 64 * kb}; }
    else if (qi < E7) d = tr_plain_desc(a.in[I_DOW], DM, DM, (bf16_t*)(a.ws + WS_WDO), qi - E6);
    else d = tr_expert_desc(a, 3, qi - E7);
    return d;
}
__device__ __forceinline__ void transpose_pair(const TrDesc& d0, const TrDesc& d1, int lane) {
    const int kr = lane >> 3, n4 = (lane & 7) * 4;
    const float* s0 = d0.W + (size_t)(d0.k0 + 8 * kr) * d0.ldw + d0.sc + n4; const float* s1 = d1.W + (size_t)(d1.k0 + 8 * kr) * d1.ldw + d1.sc + n4;
    f32x4 v0[8], v1[8];
#pragma unroll
    for (int i = 0; i < 8; ++i) v0[i] = __builtin_nontemporal_load((const f32x4*)(s0 + (size_t)i * d0.ldw));
#pragma unroll
    for (int i = 0; i < 8; ++i) v1[i] = __builtin_nontemporal_load((const f32x4*)(s1 + (size_t)i * d1.ldw));
    bf16_t* t0 = d0.WT + (size_t)(d0.drow + n4) * d0.K + d0.k0 + 8 * kr; bf16_t* t1 = d1.WT + (size_t)(d1.drow + n4) * d1.K + d1.k0 + 8 * kr;
#pragma unroll
    for (int q = 0; q < 4; ++q) { u32x4 o; o.x = cvt_pk_bf16(v0[0][q], v0[1][q]); o.y = cvt_pk_bf16(v0[2][q], v0[3][q]); o.z = cvt_pk_bf16(v0[4][q], v0[5][q]); o.w = cvt_pk_bf16(v0[6][q], v0[7][q]);
        __builtin_nontemporal_store(o, (u32x4*)(t0 + (size_t)q * d0.K)); }
#pragma unroll
    for (int q = 0; q < 4; ++q) { u32x4 o; o.x = cvt_pk_bf16(v1[0][q], v1[1][q]); o.y = cvt_pk_bf16(v1[2][q], v1[3][q]); o.z = cvt_pk_bf16(v1[4][q], v1[5][q]); o.w = cvt_pk_bf16(v1[6][q], v1[7][q]);
        __builtin_nontemporal_store(o, (u32x4*)(t1 + (size_t)q * d1.K)); }
}
__device__ __forceinline__ void cvt_run(const Args& a, int it, int n, int lane) {
    int k = 0;
    for (; k + 1 < n && it + k + 1 < cq::NQ; k += 2) { const TrDesc d0 = cvt_queue_desc(a, it + k), d1 = cvt_queue_desc(a, it + k + 1); transpose_pair(d0, d1, lane); }
    for (; k < n && it + k < cq::NQ; ++k) { const TrDesc d = cvt_queue_desc(a, it + k); transpose_item(d.W, d.ldw, d.sc, d.WT, d.K, d.drow, d.k0, nullptr, lane); }
}
__device__ __forceinline__ void cvt_opportunistic(const Args& a, int n, LAS unsigned char* lds, int tid, int wave, int lane) {
    if (n <= 0) return;
    unsigned* q = (unsigned*)(a.ws + WS_CTL) + CW_Q; volatile LAS int* qs = (volatile LAS int*)(lds + MISC_OFF + 768);
    __syncthreads();
    if (tid == 0) qs[0] = (int)__hip_atomic_fetch_add(q, (unsigned)(8 * n), __ATOMIC_RELAXED, __HIP_MEMORY_SCOPE_AGENT);
    __syncthreads();
    const int it = __builtin_amdgcn_readfirstlane(qs[0]) + wave * n;
    cvt_run(a, it, n, lane);
}
__device__ __forceinline__ void cvt_catchup(const Args& a, int target, LAS unsigned char* lds, int tid, int wave, int lane) {
    unsigned* q = (unsigned*)(a.ws + WS_CTL) + CW_Q; volatile LAS int* qs = (volatile LAS int*)(lds + MISC_OFF + 768);
    for (;;) {
        __syncthreads();
        if (tid == 0) { int h = (int)__hip_atomic_load(q, __ATOMIC_RELAXED, __HIP_MEMORY_SCOPE_AGENT);
            if (h < target) h = (int)__hip_atomic_fetch_add(q, 64u, __ATOMIC_RELAXED, __HIP_MEMORY_SCOPE_AGENT); else h = 0x7fffffff;
            qs[0] = h; }
        __syncthreads();
        const int base = __builtin_amdgcn_readfirstlane(qs[0]);
        if (base == 0x7fffffff) break;
        const int it = base + wave * 8;
        cvt_run(a, it, 8, lane);
    }
}
__device__ __forceinline__ int idle_units(int nwg, int G, int c) { const int mx = (nwg + G - 1) / G, mine = c < nwg ? (nwg - c + G - 1) / G : 0; return mx - mine; }

__device__ __forceinline__ void ph_prologue(const Args& a, LAS unsigned char* lds, int G, int wave, int lane, int tid) {
    unsigned char* ws = a.ws;
    const int bx = blockIdx.x;
    for (int t = bx; t < 256; t += G) {
        const int L = t >> 6, col0 = (t & 63) * 192;
        LAS float* sl = (LAS float*)lds; LAS float* sx = sl + DM; LAS float* red = sx + DM;
        for (int k = tid; k < DM; k += 512) { const float c = a.in[I_C][k], cc = a.in[I_CCTX][k];
            sl[k] = c / (1.f + __expf(-c)); sx[k] = cc / (1.f + __expf(-cc)); }
        __syncthreads();
        const float* W = a.in[I_MODW] + (size_t)L * DM * NMOD + col0 + 3 * lane;
        float al0 = 0.f, al1 = 0.f, al2 = 0.f, ac0 = 0.f, ac1 = 0.f, ac2 = 0.f;
        const int kb = wave * 256;
#pragma unroll 16
        for (int k = 0; k < 256; ++k) { const f32x3u w = __builtin_nontemporal_load((const f32x3u*)(W + (size_t)(kb + k) * NMOD));     const float s1 = sl[kb + k], s2 = sx[kb + k];
            al0 += w.x * s1; al1 += w.y * s1; al2 += w.z * s1; ac0 += w.x * s2; ac1 += w.y * s2; ac2 += w.z * s2; }
        LAS float* rp = red + (wave * 64 + lane) * 6;
        rp[0] = al0; rp[1] = al1; rp[2] = al2; rp[3] = ac0; rp[4] = ac1; rp[5] = ac2;
        __syncthreads();
        if (tid < 384) { const int which = tid / 192, col = tid % 192; float s_ = 0.f;
#pragma unroll
          for (int w = 0; w < 8; ++w) s_ += red[(w * 64 + col / 3) * 6 + which * 3 + col % 3];
          float* modv = (float*)(ws + WS_MODV);
          modv[(size_t)(L * 2 + which) * NMOD + col0 + col] = s_ + a.in[I_MODB][L * NMOD + col0 + col]; }
        __syncthreads();
    }
    if (bx == 0) {
        float* rope = (float*)(ws + WS_ROPE);
        for (int idx = tid; idx < 6144; idx += 512) {
            const int isc = idx >= 4096, e = isc ? idx - 4096 : idx, pos = e >> 5, i = e & 31;
            const float inv = powf(10000.0f, -(float)(2 * i) / 64.0f), ang = (float)pos * inv;
            float* cs = rope + (isc ? 8192 : 0); const int half = isc ? 2048 : 4096;
            cs[e] = cosf(ang); cs[half + e] = sinf(ang);
        }
    } else if (bx >= 2 && bx < 6) {
        const int L = bx - 2; const float* w = a.in[I_REW] + (size_t)L * DM * 16; float* wt = (float*)(ws + WS_WET) + (size_t)L * 4 * DM * 4;
        for (int idx = tid; idx < DM * 16; idx += 512) { const int c = idx >> 4, e = idx & 15; wt[((size_t)(e >> 2) * DM + c) * 4 + (e & 3)] = w[idx]; }
    } else if (bx == 1) {
        if (wave == 0) {
            const float* lv = a.in[I_DL];
            float s1 = lv[lane] * lv[128 + lane] + lv[64 + lane] * lv[192 + lane];
            float s2 = lv[256 + lane] * lv[384 + lane] + lv[320 + lane] * lv[448 + lane];
            s1 = wave_sum(s1); s2 = wave_sum(s2);
            if (lane == 0) { float* sc = (float*)(ws + WS_SCAL); sc[0] = expf(s1) - expf(s2) + LAM_INIT3; sc[1] = 1.0f - LAM_INIT3; }
        }
        if (tid < 256) ((float*)(ws + WS_SCAL + 1024))[tid] = a.in[I_DS][tid];
    }
    LAS float* scr = (LAS float*)(lds + 32768 + wave * 8448);
    const int gw = bx * 8 + wave, NGW = G * 8;
    constexpr int I_CI = 32 * 192, I_CO = 32 * 64;
    for (int it = gw; it < I_CI + I_CO; it += NGW) {
        int r = it;
        if (r < I_CI) {
            const int kb = r / 192, nb = r % 192, n = 32 * nb; int sc;
            if (n < 2048) sc = n; else { const int q = (n - 2048) >> 8, bj = ((n - 2048) >> 7) & 1, i = n & 127; sc = 2048 + bj * 2048 + 128 * q + i; }
            transpose_item(a.in[I_CIW], 3 * DM, sc, (bf16_t*)(ws + WS_WCI), DM, n, 64 * kb, scr, lane); continue; }
        r -= I_CI;
        tr_plain(a.in[I_COW], DM, DM, (bf16_t*)(ws + WS_WCO), r, scr, lane);
    }
    (void)0;
}

template <int NR>
__device__ __forceinline__ void init_rows(const Args& a, int r0, int rstride, int which) {
    const int lane = lane_id_fresh(); const unsigned lo16 = (unsigned)lane * 16u, lo8 = (unsigned)lane * 8u;
    bf16_t* H = (bf16_t*)(a.ws + WS_H);
    const float* mv = (const float*)(a.ws + WS_MODV) + (size_t)which * NMOD;
    const float* src = which ? a.in[I_CTX] : a.in[I_X] - (size_t)NCTX * DM;
    f32x4 v[NR][8];
#pragma unroll
    for (int k = 0; k < NR; ++k)
#pragma unroll
        for (int j = 0; j < 8; ++j) v[k][j] = ULD4(src, (size_t)(r0 + k * rstride) * (DM * 4) + j * 1024, lo16);
#pragma unroll
    for (int j = 0; j < 8; ++j) { const f32x4 sh = ULD4(mv, j * 1024, lo16), sc = ULD4(mv, DM * 4 + j * 1024, lo16) + 1.0f;
#pragma unroll
        for (int k = 0; k < NR; ++k) { const size_t rb = (size_t)(r0 + k * rstride) * (DM * 4) + j * 1024;
            const f32x4 h = v[k][j] * sc + sh;
            u32x2 w; w.x = cvt_pk_bf16(h[0], h[1]); w.y = cvt_pk_bf16(h[2], h[3]); *(u32x2*)((char*)H + (rb >> 1) + lo8) = w; } }
}
__device__ __forceinline__ void ph_init(const Args& a, int G, int bx, int wave) {
    const int gw = bx * 8 + wave, NGW = G * 8, gwT = wave * G + bx;
    int r = NCTX + gw;
    for (; r + 3 * NGW < MTOT; r += 4 * NGW) init_rows<4>(a, r, NGW, 0);
    for (; r < MTOT; r += NGW) init_rows<1>(a, r, NGW, 0);
    for (int rc = gwT; rc < NCTX; rc += NGW) init_rows<1>(a, rc, NGW, 1);
}

__device__ __forceinline__ void conv_tasks(const bf16_t* __restrict__ GB, const bf16_t* __restrict__ PP, bf16_t* __restrict__ Y, const float* __restrict__ cw, int gw, int NGW, int lane) {
#pragma unroll 2
    for (int tk = gw; tk < MTOT; tk += NGW) {
        const int t0 = (tk >> 2) * 4;
        { const int j = tk & 3;
            const int c = 8 * lane + 512 * j;
            float w0[8], w1[8], w2[8];
#pragma unroll
            for (int i = 0; i < 8; i += 4) { const f32x4 x0 = *(const f32x4*)(cw + c + i), x1 = *(const f32x4*)(cw + DM + c + i), x2 = *(const f32x4*)(cw + 2 * DM + c + i);
                for (int q = 0; q < 4; ++q) { w0[i + q] = x0[q]; w1[i + q] = x1[q]; w2[i + q] = x2[q]; } }
            u32x4 prev = {0u, 0u, 0u, 0u}, cur, nxt;
            if (t0 != 0 && t0 != NCTX) prev = *(const u32x4*)(PP + (size_t)(t0 - 1) * DM + c);
            cur = *(const u32x4*)(PP + (size_t)t0 * DM + c);
#pragma unroll
            for (int i = 0; i < 4; ++i) { const int t = t0 + i;
                nxt = (u32x4){0u, 0u, 0u, 0u}; if (t + 1 != NCTX && t + 1 != MTOT) nxt = *(const u32x4*)(PP + (size_t)(t + 1) * DM + c);
                const u32x4 gb = *(const u32x4*)(GB + (size_t)t * DM + c);
                float y[8];
#pragma unroll
                for (int q = 0; q < 4; ++q) {
                    y[2 * q] = bf_lo(gb[q]) * (w0[2 * q] * bf_lo(prev[q]) + w1[2 * q] * bf_lo(cur[q]) + w2[2 * q] * bf_lo(nxt[q]));
                    y[2 * q + 1] = bf_hi(gb[q]) * (w0[2 * q + 1] * bf_hi(prev[q]) + w1[2 * q + 1] * bf_hi(cur[q]) + w2[2 * q + 1] * bf_hi(nxt[q])); }
                u32x4 o; o.x = cvt_pk_bf16(y[0], y[1]); o.y = cvt_pk_bf16(y[2], y[3]); o.z = cvt_pk_bf16(y[4], y[5]); o.w = cvt_pk_bf16(y[6], y[7]);
                *(u32x4*)(Y + (size_t)t * DM + c) = o; prev = cur; cur = nxt; }
        }
    }
}
__device__ __forceinline__ void ph_conv(const Args& a, int gw, int NGW, int lane) {
    const bf16_t* GB = (const bf16_t*)(a.ws + WS_MIX);
    conv_tasks(GB, GB + (size_t)33 * MiB / 2, (bf16_t*)(a.ws + WS_MIX + 66 * MiB), a.in[I_CW], gw, NGW, lane);
}

template <int GI>
__device__ __forceinline__ void pool_task(const Args& a, int t0, int jj) {
    constexpr int HW = 1 << GI, NRW = 8 + 2 * HW;
    const int lane = lane_id_fresh(); const unsigned lo16 = (unsigned)lane * 16u, lo8 = (unsigned)lane * 8u;
    const float* X = (const float*)(a.ws + WS_X); bf16_t* PO = (bf16_t*)(a.ws + WS_MIX);
    const int which = t0 < NCTX, slo = which ? 0 : NCTX, shi = which ? NCTX : MTOT;
    const float* mv = (const float*)(a.ws + WS_MODV) + (size_t)(2 + which) * NMOD + DM;
    const size_t cb = (size_t)(GI * 512 + 256 * jj) * 4;
    f32x4 xr[NRW];
#pragma unroll
    for (int i = 0; i < NRW; ++i) { const int r = t0 - HW + i; xr[i] = (f32x4){0.f, 0.f, 0.f, 0.f}; if (r >= slo && r < shi) xr[i] = ULD4(X, (size_t)r * (DM * 4) + cb, lo16); }
    const f32x4 sc = ULD4(mv, cb, lo16) + 1.0f;
    f32x4 s = {0.f, 0.f, 0.f, 0.f};
#pragma unroll
    for (int i = 0; i < 2 * HW; ++i) s += xr[i];
#pragma unroll
    for (int o = 0; o < 8; ++o) { const int t = t0 + o; const int lo = (t - HW) > slo ? (t - HW) : slo, hi = (t + HW) < shi ? (t + HW) : shi;
        const f32x4 p = (s * (1.0f / (float)(hi - lo)) - xr[o + HW]) * sc;
        u32x2 w; w.x = cvt_pk_bf16(p[0], p[1]); w.y = cvt_pk_bf16(p[2], p[3]);
        *(u32x2*)((char*)PO + ((size_t)GI * MTOT + t) * 1024 + jj * 512 + lo8) = w;
        if (o < 7) s += xr[o + 2 * HW] - xr[o]; }
}
__device__ __forceinline__ void ph_pool(const Args& a, int gw, int NGW, int  ) {
    int k = 0;
    for (int T = gw; T < MTOT; T += NGW, ++k) { const int strip = T >> 3, sub = ((T & 7) + k) & 7, g = sub >> 1, jj = sub & 1, t0 = strip * 8;
        if (g == 0) pool_task<0>(a, t0, jj); else if (g == 1) pool_task<1>(a, t0, jj); else if (g == 2) pool_task<2>(a, t0, jj); else pool_task<3>(a, t0, jj); }
}

template <bool NORM>
__device__ __forceinline__ void head_pass(bf16_t* p, const float* gain, int quarter, int row, const float* rope, bf16_t* po) {
    u32x4 raw[4], par[4];
#pragma unroll
    for (int k = 0; k < 4; ++k) raw[k] = *(const u32x4*)(p + 8 * k);
    float rstd = 1.0f;
    if (NORM) { float ss = 0.f;
#pragma unroll
        for (int k = 0; k < 4; ++k)
#pragma unroll
            for (int q = 0; q < 4; ++q) { const float lo = bf_lo(raw[k][q]), hi = bf_hi(raw[k][q]); ss += lo * lo + hi * hi; }
        ss += __shfl_xor(ss, 1); ss += __shfl_xor(ss, 2);
        rstd = 1.0f / sqrtf(ss * (1.0f / 128.0f) + RMS_EPS); }
#pragma unroll
    for (int k = 0; k < 4; ++k)
#pragma unroll
        for (int q = 0; q < 4; ++q) par[k][q] = (unsigned)__shfl_xor((int)raw[k][q], 1);
    const bool do_rope = row >= NCTX; const int t = row - NCTX;
    const int pos = (quarter < 2) ? (t >> 6) : (t & 63);
    const float* cs = rope + ((quarter < 2) ? 0 : 8192) + pos * 32; const float* sn = cs + ((quarter < 2) ? 4096 : 2048);
    const float sgn = (quarter & 1) ? 1.0f : -1.0f;
#pragma unroll
    for (int k = 0; k < 4; ++k) {
        float a_[8], b_[8];
#pragma unroll
        for (int q = 0; q < 4; ++q) { a_[2 * q] = bf_lo(raw[k][q]) * rstd; a_[2 * q + 1] = bf_hi(raw[k][q]) * rstd; b_[2 * q] = bf_lo(par[k][q]) * rstd; b_[2 * q + 1] = bf_hi(par[k][q]) * rstd; }
        if (NORM) {
#pragma unroll
            for (int i = 0; i < 8; i += 4) { const f32x4 go = *(const f32x4*)(gain + 32 * quarter + 8 * k + i), gp = *(const f32x4*)(gain + 32 * (quarter ^ 1) + 8 * k + i);
                for (int q = 0; q < 4; ++q) { a_[i + q] *= go[q]; b_[i + q] *= gp[q]; } } }
        float o_[8];
        if (do_rope) {
#pragma unroll
            for (int i = 0; i < 8; i += 4) { const f32x4 c4 = *(const f32x4*)(cs + 8 * k + i), s4 = *(const f32x4*)(sn + 8 * k + i);
                for (int q = 0; q < 4; ++q) o_[i + q] = a_[i + q] * c4[q] + sgn * b_[i + q] * s4[q]; }
        } else {
#pragma unroll
            for (int i = 0; i < 8; ++i) o_[i] = a_[i];
        }
        u32x4 o; o.x = cvt_pk_bf16(o_[0], o_[1]); o.y = cvt_pk_bf16(o_[2], o_[3]); o.z = cvt_pk_bf16(o_[4], o_[5]); o.w = cvt_pk_bf16(o_[6], o_[7]);
        *(u32x4*)(po + 8 * k) = o;
    }
}

#define LLD4(off, lo) (*(const LAS f32x4*)(lds + (off) + (lo)))
__device__ __forceinline__ void ln1_stage(const Args& a, int L, LAS unsigned char* lds, int tid) {
    const float* mv = (const float*)(a.ws + WS_MODV) + (size_t)(L * 2) * NMOD;
    const float* lg_ = a.in[I_LNG] + (size_t)(L * 2 + 0) * DM; const float* lb_ = a.in[I_LNB] + (size_t)(L * 2 + 0) * DM;
    const float* wg = a.in[I_RGW] + (size_t)L * DM * 4; const float* ps = a.in[I_PS];
    LAS f32x4* d = (LAS f32x4*)lds; const int t = tid;
    __syncthreads();
    d[t] = ((const f32x4*)lg_)[t]; d[512 + t] = ((const f32x4*)lb_)[t];
    const f32x4 psv = (L == 1) ? ((const f32x4*)ps)[t] : (f32x4){1.f, 1.f, 1.f, 1.f};
#pragma unroll
    for (int w = 0; w < 2; ++w) { const float* m = mv + (size_t)w * NMOD;
        d[1024 + w * 1536 + t] = ((const f32x4*)(m + 3 * DM))[t]; d[1536 + w * 1536 + t] = ((const f32x4*)(m + 4 * DM))[t] + 1.0f; d[2048 + w * 1536 + t] = ((const f32x4*)(m + 2 * DM))[t] * psv; }
#pragma unroll
    for (int q = 0; q < 4; ++q) d[4096 + q * 512 + t] = ((const f32x4*)wg)[q * 512 + t];
    __syncthreads();
}
struct Ln1Row { f32x4 v[8]; u32x2 dw[8]; };
__device__ __forceinline__ void ln1_load(const Args& a, int L, Ln1Row& R, int r, int which, unsigned lo16, unsigned lo8) {
    const float* X = (L == 0) ? (which ? a.in[I_CTX] : a.in[I_X] - (size_t)NCTX * DM) : (const float*)(a.ws + WS_X);
    const bf16_t* Dm = (const bf16_t*)(a.ws + WS_D);
#pragma unroll
    for (int j = 0; j < 8; ++j) { R.v[j] = ULD4N(X, (size_t)r * (DM * 4) + j * 1024, lo16); R.dw[j] = __builtin_nontemporal_load((const u32x2*)((const char*)Dm + (size_t)r * (DM * 2) + j * 512 + lo8)); }
}
__device__ __forceinline__ void ln1_compute(const Args& a, int L, Ln1Row& R, int r, int which, LAS unsigned char* lds, bool dup, int lane, unsigned lo16, unsigned lo8) {
    bf16_t* HS = (bf16_t*)(a.ws + WS_MOE); bf16_t* XB = (bf16_t*)(a.ws + (dup ? WS_DUMH : WS_H));
    const float* wet = (const float*)(a.ws + WS_WET) + (size_t)L * 4 * DM * 4;
    const float* bg = a.in[I_RGB] + L * 4; const float* be = a.in[I_REB] + L * 16;
    unsigned* cnt = (unsigned*)(a.ws + WS_CTL) + CW_CNT + (dup ? 4 : L) * 16 * 64;
    int* route = (int*)(a.ws + WS_ROUTE + (dup ? 512 * 1024 : 0));
    const unsigned lo64 = (unsigned)lane * 64u, pw = which ? 24576u : 0u;
    asm volatile("" ::: "memory");
#pragma unroll
    for (int j = 0; j < 8; ++j) { const f32x4 g2 = LLD4(32768 + pw + j * 1024, lo16);
        const f32x4 dv = {bf_lo(R.dw[j].x), bf_hi(R.dw[j].x), bf_lo(R.dw[j].y), bf_hi(R.dw[j].y)};
        R.v[j] = R.v[j] * ALPHA + g2 * dv; }
    float s1_[1], q1_[1]; s1_[0] = 0.f;
#pragma unroll
    for (int j = 0; j < 8; ++j) s1_[0] += (R.v[j][0] + R.v[j][1]) + (R.v[j][2] + R.v[j][3]);
    wave_sum_n(s1_, lane);
    const float mean = s1_[0] * (1.f / DM); q1_[0] = 0.f;
#pragma unroll
    for (int j = 0; j < 8; ++j) { const f32x4 d = R.v[j] - mean; q1_[0] += (d[0] * d[0] + d[1] * d[1]) + (d[2] * d[2] + d[3] * d[3]); }
    wave_sum_n(q1_, lane);
    const float rstd = 1.f / sqrtf(q1_[0] * (1.f / DM) + LN_EPS);
    float lg[4] = {0.f, 0.f, 0.f, 0.f};
#pragma unroll
    for (int j = 0; j < 8; ++j) {
        const f32x4 gm = LLD4(j * 1024, lo16), bt = LLD4(8192 + j * 1024, lo16), sh = LLD4(16384 + pw + j * 1024, lo16), sc = LLD4(24576 + pw + j * 1024, lo16);
        f32x4 w4[4];
#pragma unroll
        for (int i = 0; i < 4; ++i) w4[i] = LLD4(65536 + j * 4096 + i * 16, lo64);
        const f32x4 xn = (R.v[j] - mean) * rstd * gm + bt;
        { u32x2 xw_; xw_.x = cvt_pk_bf16(xn[0], xn[1]); xw_.y = cvt_pk_bf16(xn[2], xn[3]); *(u32x2*)((char*)XB + (size_t)r * (DM * 2) + j * 512 + lo8) = xw_; }
        const f32x4 hm = xn * sc + sh; R.v[j] = hm;
#pragma unroll
        for (int i = 0; i < 4; ++i) { lg[0] += hm[i] * w4[i][0]; lg[1] += hm[i] * w4[i][1]; lg[2] += hm[i] * w4[i][2]; lg[3] += hm[i] * w4[i][3]; }
        if (j & 1) asm volatile("" ::: "memory"); }
    wave_sum_n(lg, lane);
    int g_ = 0; float best = lg[0] + bg[0];
#pragma unroll
    for (int q = 1; q < 4; ++q) { const float x = lg[q] + bg[q]; if (x > best) { best = x; g_ = q; } }
    float den = 0.f;
#pragma unroll
    for (int q = 0; q < 4; ++q) den += __expf(lg[q] + bg[q] - best);
    const float pg = 1.0f / den; const int gs = __builtin_amdgcn_readfirstlane(g_);
    float le[4] = {0.f, 0.f, 0.f, 0.f};
#pragma unroll
    for (int j = 0; j < 8; ++j) {
#pragma unroll
        for (int i = 0; i < 4; ++i) { const f32x4 w = ULD4(wet, (size_t)gs * (DM * 16) + j * 4096 + i * 16, lo64); le[0] += R.v[j][i] * w[0]; le[1] += R.v[j][i] * w[1]; le[2] += R.v[j][i] * w[2]; le[3] += R.v[j][i] * w[3]; }
        if ((j & 3) == 3) asm volatile("" ::: "memory"); }
    wave_sum_n(le, lane);
    float l4[4];
#pragma unroll
    for (int q = 0; q < 4; ++q) l4[q] = le[q] + be[gs * 4 + q];
    int i0 = 0; float b0 = l4[0];
#pragma unroll
    for (int q = 1; q < 4; ++q) if (l4[q] > b0) { b0 = l4[q]; i0 = q; }
    int i1 = -1; float b1 = -3.0e38f;
#pragma unroll
    for (int q = 0; q < 4; ++q) if (q != i0 && l4[q] > b1) { b1 = l4[q]; i1 = q; }
    const float tv0 = 1.0f / (1.0f + __expf(b1 - b0));
    const int me0 = gs * 4 + i0, me1 = gs * 4 + i1;
    unsigned p0 = 0u, p1 = 0u;
    if (lane == 0) {
        p0 = __hip_atomic_fetch_add(cnt + me0 * 64, 1u, __ATOMIC_RELAXED, __HIP_MEMORY_SCOPE_AGENT);
        p1 = __hip_atomic_fetch_add(cnt + me1 * 64, 1u, __ATOMIC_RELAXED, __HIP_MEMORY_SCOPE_AGENT);
        int* rp = route + (size_t)r * 8;
        *(u32x4*)rp = (u32x4){(unsigned)me0, (unsigned)me1, p0, p1};
        *(u32x4*)(rp + 4) = (u32x4){__float_as_uint(pg * tv0), __float_as_uint(pg * (1.0f - tv0)), 0u, 0u};
    }
    if (!dup) {
        const size_t d0 = ((size_t)__builtin_amdgcn_readfirstlane(me0) * MTOT + (unsigned)__builtin_amdgcn_readfirstlane((int)p0)) * (DM * 2);
        const size_t d1 = ((size_t)__builtin_amdgcn_readfirstlane(me1) * MTOT + (unsigned)__builtin_amdgcn_readfirstlane((int)p1)) * (DM * 2);
#pragma unroll
        for (int j = 0; j < 8; ++j) { u32x2 w; w.x = cvt_pk_bf16(R.v[j][0], R.v[j][1]); w.y = cvt_pk_bf16(R.v[j][2], R.v[j][3]);
            *(u32x2*)((char*)HS + d0 + j * 512 + lo8) = w; *(u32x2*)((char*)HS + d1 + j * 512 + lo8) = w; }
    }
}
__device__ __forceinline__ void ph_ln1(const Args& a, int L, int rowlo, LAS unsigned char* lds, int tid, int G, int bx, int wave, bool dup = false) {
    const int gw = bx * 8 + wave, NGW = G * 8, gwT = wave * G + bx;
    ln1_stage(a, L, lds, tid);
    int rbase = NCTX + gw;
    for (; rbase + 3 * NGW < MTOT; rbase += 4 * NGW) {
        const int lane = lane_id_fresh(); const unsigned lo16 = (unsigned)lane * 16u, lo8 = (unsigned)lane * 8u;
        Ln1Row A, B;
        ln1_load(a, L, A, rbase, 0, lo16, lo8);
        ln1_load(a, L, B, rbase + NGW, 0, lo16, lo8);
        ln1_compute(a, L, A, rbase, 0, lds, dup, lane, lo16, lo8);
        ln1_load(a, L, A, rbase + 2 * NGW, 0, lo16, lo8);
        ln1_compute(a, L, B, rbase + NGW, 0, lds, dup, lane, lo16, lo8);
        ln1_load(a, L, B, rbase + 3 * NGW, 0, lo16, lo8);
        ln1_compute(a, L, A, rbase + 2 * NGW, 0, lds, dup, lane, lo16, lo8);
        ln1_compute(a, L, B, rbase + 3 * NGW, 0, lds, dup, lane, lo16, lo8);
    }
    for (; rbase < MTOT; rbase += NGW) { const int lane = lane_id_fresh(); const unsigned lo16 = (unsigned)lane * 16u, lo8 = (unsigned)lane * 8u;
        Ln1Row A; ln1_load(a, L, A, rbase, 0, lo16, lo8); ln1_compute(a, L, A, rbase, 0, lds, dup, lane, lo16, lo8); }
    if (rowlo == 0) for (int rc = gwT; rc < NCTX; rc += NGW) { const int lane = lane_id_fresh(); const unsigned lo16 = (unsigned)lane * 16u, lo8 = (unsigned)lane * 8u;
        Ln1Row A; ln1_load(a, L, A, rc, 1, lo16, lo8); ln1_compute(a, L, A, rc, 1, lds, dup, lane, lo16, lo8); }
}

__device__ __forceinline__ void moe_table(const Args& a, int L, LAS unsigned char* lds, int tid) {
    volatile LAS int* tb = (volatile LAS int*)(lds + MISC_OFF + 64); volatile LAS int* t2e = (volatile LAS int*)(lds + MISC_OFF + 192);
    unsigned* cnt = (unsigned*)(a.ws + WS_CTL) + CW_CNT + L * 16 * 64;
    __syncthreads();
    if (tid < 64) {
        int nt = 0;
        if (tid < 16) nt = ((int)__hip_atomic_load(cnt + tid * 64, __ATOMIC_RELAXED, __HIP_MEMORY_SCOPE_AGENT) + 255) >> 8;
        int inc = nt;
#pragma unroll
        for (int o = 1; o < 16; o <<= 1) { const int up = __shfl_up(inc, o); if ((tid & 63) >= o) inc += up; }
        if (tid < 16) { const int ex = inc - nt; tb[tid] = ex < MAXT ? ex : MAXT; if (tid == 15) tb[16] = inc < MAXT ? inc : MAXT; }
    }
    __syncthreads();
    if (tid < 96) { int e = 0;
#pragma unroll
        for (int k = 1; k < 16; ++k) e += (tb[k] <= tid) ? 1 : 0;
        t2e[tid] = e; }
    __syncthreads();
}

__device__ __forceinline__ void ph_gather(const Args& a, int rowlo, LAS unsigned char* lds, int gw, int NGW, int lane) {
    const LAS int* tb = (const LAS int*)(lds + MISC_OFF + 64);
    const bf16_t* H = (const bf16_t*)(a.ws + WS_H); bf16_t* HS = (bf16_t*)(a.ws + WS_MOE);
    const int* route = (const int*)(a.ws + WS_ROUTE);
    for (int r = rowlo + gw; r < MTOT; r += NGW) {
        const u32x4 rt = *(const u32x4*)(route + (size_t)r * 8);
        const size_t s0 = (size_t)tb[rt[0]] * 256 + rt[2], s1 = (size_t)tb[rt[1]] * 256 + rt[3];
        const u32x4* src = (const u32x4*)(H + (size_t)r * DM); u32x4* d0 = (u32x4*)(HS + s0 * DM); u32x4* d1 = (u32x4*)(HS + s1 * DM);
#pragma unroll
        for (int j = 0; j < 4; ++j) { const u32x4 x = src[lane + 64 * j]; d0[lane + 64 * j] = x; d1[lane + 64 * j] = x; }
    }
}

__device__ __forceinline__ void ln2_stage(const Args& a, int L, bool last, LAS unsigned char* lds, int tid) {
    const float* mv = (const float*)(a.ws + WS_MODV) + (size_t)(L * 2) * NMOD;
    const float* mn = (const float*)(a.ws + WS_MODV) + (size_t)((last ? L : L + 1) * 2) * NMOD;
    const float* lg_ = a.in[I_LNG] + (size_t)(L * 2 + 1) * DM; const float* lb_ = a.in[I_LNB] + (size_t)(L * 2 + 1) * DM;
    LAS f32x4* d = (LAS f32x4*)lds; const int t = tid;
    __syncthreads();
    d[t] = ((const f32x4*)lg_)[t]; d[512 + t] = ((const f32x4*)lb_)[t];
#pragma unroll
    for (int w = 0; w < 2; ++w) { const float* m = mv + (size_t)w * NMOD; const float* n = mn + (size_t)w * NMOD;
        d[1024 + w * 1536 + t] = ((const f32x4*)(m + 5 * DM))[t]; d[1536 + w * 1536 + t] = ((const f32x4*)n)[t]; d[2048 + w * 1536 + t] = ((const f32x4*)(n + DM))[t] + 1.0f; }
    __syncthreads();
}
struct Ln2Row { u32x2 xw[8], ya[8], yb[8]; };
__device__ __forceinline__ void ln2_load(const Args& a, Ln2Row& R, int r, int s0, int s1, unsigned lo16, unsigned lo8) {
    const bf16_t* XB = (const bf16_t*)(a.ws + WS_H); const bf16_t* Y2 = (const bf16_t*)(a.ws + WS_MOE + MOE_Y2);
#pragma unroll
    for (int j = 0; j < 8; ++j) { R.xw[j] = __builtin_nontemporal_load((const u32x2*)((const char*)XB + (size_t)r * (DM * 2) + j * 512 + lo8));
        R.ya[j] = __builtin_nontemporal_load((const u32x2*)((const char*)Y2 + (size_t)s0 * (DM * 2) + j * 512 + lo8)); R.yb[j] = __builtin_nontemporal_load((const u32x2*)((const char*)Y2 + (size_t)s1 * (DM * 2) + j * 512 + lo8)); }
}
__device__ __forceinline__ void ln2_compute(const Args& a, int L, Ln2Row& R, int r, float w0, float w1, int which, bool last, LAS unsigned char* lds, bool dup, int lane, unsigned lo16, unsigned lo8) {
    bf16_t* H = (bf16_t*)(a.ws + (dup ? WS_DUMH : WS_H)); float* XO = (float*)(a.ws + (dup ? WS_DUMX : WS_X)); float* OUT = dup ? (float*)(a.ws + WS_DUMX) : a.out;
    const unsigned pw = which ? 24576u : 0u;
    asm volatile("" ::: "memory");
    f32x4 v[8];
#pragma unroll
    for (int j = 0; j < 8; ++j) { const f32x4 g5 = LLD4(16384 + pw + j * 1024, lo16);
        const f32x4 y0 = {bf_lo(R.ya[j].x), bf_hi(R.ya[j].x), bf_lo(R.ya[j].y), bf_hi(R.ya[j].y)}, y1 = {bf_lo(R.yb[j].x), bf_hi(R.yb[j].x), bf_lo(R.yb[j].y), bf_hi(R.yb[j].y)};
        const f32x4 x1 = {bf_lo(R.xw[j].x), bf_hi(R.xw[j].x), bf_lo(R.xw[j].y), bf_hi(R.xw[j].y)};
        v[j] = x1 * ALPHA + g5 * (y0 * w0 + y1 * w1); }
    float s1_[1], q1_[1]; s1_[0] = 0.f;
#pragma unroll
    for (int j = 0; j < 8; ++j) s1_[0] += (v[j][0] + v[j][1]) + (v[j][2] + v[j][3]);
    wave_sum_n(s1_, lane);
    const float mean = s1_[0] * (1.f / DM); q1_[0] = 0.f;
#pragma unroll
    for (int j = 0; j < 8; ++j) { const f32x4 d = v[j] - mean; q1_[0] += (d[0] * d[0] + d[1] * d[1]) + (d[2] * d[2] + d[3] * d[3]); }
    wave_sum_n(q1_, lane);
    const float rstd = 1.f / sqrtf(q1_[0] * (1.f / DM) + LN_EPS);
#pragma unroll
    for (int j = 0; j < 8; ++j) {
        const f32x4 gm = LLD4(j * 1024, lo16), bt = LLD4(8192 + j * 1024, lo16), sh = LLD4(24576 + pw + j * 1024, lo16), sc = LLD4(32768 + pw + j * 1024, lo16);
        const f32x4 xn = (v[j] - mean) * rstd * gm + bt;
        if (last) { UST4(OUT, (size_t)(r - NCTX) * (DM * 4) + j * 1024, lo16, xn); }
        else { UST4N(XO, (size_t)r * (DM * 4) + j * 1024, lo16, xn);
               if (L != 0) { const f32x4 hm = xn * sc + sh;
                   u32x2 w; w.x = cvt_pk_bf16(hm[0], hm[1]); w.y = cvt_pk_bf16(hm[2], hm[3]); *(u32x2*)((char*)H + (size_t)r * (DM * 2) + j * 512 + lo8) = w; } }
        if (j & 1) asm volatile("" ::: "memory"); }
}
__device__ __forceinline__ void ph_ln2(const Args& a, int L, int rowlo, bool last, LAS unsigned char* lds, int tid, int G, int bx, int wave, bool dup = false) {
    const int gw = bx * 8 + wave, NGW = G * 8, gwT = wave * G + bx;
    ln2_stage(a, L, last, lds, tid);
    const LAS int* tb = (const LAS int*)(lds + MISC_OFF + 64);
    const int* route = (const int*)(a.ws + WS_ROUTE);
    int rbase = NCTX + gw;
    for (; rbase + 3 * NGW < MTOT; rbase += 4 * NGW) {
        const int lane = lane_id_fresh(); const unsigned lo16 = (unsigned)lane * 16u, lo8 = (unsigned)lane * 8u;
        int s0[4], s1[4]; float w0[4], w1[4];
#pragma unroll
        for (int i = 0; i < 4; ++i) { const int* rp = route + (size_t)(rbase + i * NGW) * 8; const u32x4 rt = *(const u32x4*)rp; const u32x4 rw = *(const u32x4*)(rp + 4);
            s0[i] = __builtin_amdgcn_readfirstlane(tb[rt[0]] * 256 + (int)rt[2]); s1[i] = __builtin_amdgcn_readfirstlane(tb[rt[1]] * 256 + (int)rt[3]);
            w0[i] = __uint_as_float(__builtin_amdgcn_readfirstlane(rw[0])); w1[i] = __uint_as_float(__builtin_amdgcn_readfirstlane(rw[1])); }
        Ln2Row A, B;
        ln2_load(a, A, rbase, s0[0], s1[0], lo16, lo8);
        ln2_load(a, B, rbase + NGW, s0[1], s1[1], lo16, lo8);
        ln2_compute(a, L, A, rbase, w0[0], w1[0], 0, last, lds, dup, lane, lo16, lo8);
        ln2_load(a, A, rbase + 2 * NGW, s0[2], s1[2], lo16, lo8);
        ln2_compute(a, L, B, rbase + NGW, w0[1], w1[1], 0, last, lds, dup, lane, lo16, lo8);
        ln2_load(a, B, rbase + 3 * NGW, s0[3], s1[3], lo16, lo8);
        ln2_compute(a, L, A, rbase + 2 * NGW, w0[2], w1[2], 0, last, lds, dup, lane, lo16, lo8);
        ln2_compute(a, L, B, rbase + 3 * NGW, w0[3], w1[3], 0, last, lds, dup, lane, lo16, lo8);
    }
    for (; rbase < MTOT; rbase += NGW) {
        const int lane = lane_id_fresh(); const unsigned lo16 = (unsigned)lane * 16u, lo8 = (unsigned)lane * 8u;
        const int* rp = route + (size_t)rbase * 8; const u32x4 rt = *(const u32x4*)rp; const u32x4 rw = *(const u32x4*)(rp + 4);
        const int s0 = __builtin_amdgcn_readfirstlane(tb[rt[0]] * 256 + (int)rt[2]), s1 = __builtin_amdgcn_readfirstlane(tb[rt[1]] * 256 + (int)rt[3]);
        Ln2Row A; ln2_load(a, A, rbase, s0, s1, lo16, lo8);
        ln2_compute(a, L, A, rbase, __uint_as_float(__builtin_amdgcn_readfirstlane(rw[0])), __uint_as_float(__builtin_amdgcn_readfirstlane(rw[1])), 0, last, lds, dup, lane, lo16, lo8);
    }
    if (rowlo == 0) for (int rc = gwT; rc < NCTX; rc += NGW) {
        const int lane = lane_id_fresh(); const unsigned lo16 = (unsigned)lane * 16u, lo8 = (unsigned)lane * 8u;
        const int* rp = route + (size_t)rc * 8; const u32x4 rt = *(const u32x4*)rp; const u32x4 rw = *(const u32x4*)(rp + 4);
        const int s0 = __builtin_amdgcn_readfirstlane(tb[rt[0]] * 256 + (int)rt[2]), s1 = __builtin_amdgcn_readfirstlane(tb[rt[1]] * 256 + (int)rt[3]);
        Ln2Row A; ln2_load(a, A, rc, s0, s1, lo16, lo8);
        ln2_compute(a, L, A, rc, __uint_as_float(__builtin_amdgcn_readfirstlane(rw[0])), __uint_as_float(__builtin_amdgcn_readfirstlane(rw[1])), 1, last, lds, dup, lane, lo16, lo8);
    }
}

constexpr int NPH = 36;
__global__ void __launch_bounds__(512, 2) mega(Args a) {
    extern __shared__ __attribute__((aligned(16))) unsigned char lds_raw[];
    LAS unsigned char* lds = (LAS unsigned char*)lds_raw;
    const int wave = __builtin_amdgcn_readfirstlane((int)threadIdx.x >> 6);
    const int G = gridDim.x, bx = blockIdx.x;
    const int gw = bx * 8 + wave, NGW = G * 8;
    unsigned char* ws = a.ws;
    unsigned* ctl = (unsigned*)(ws + WS_CTL);
#if MK_ONE_LAUNCH
#define PDUP (rp_ != 0)
#else
#define PDUP (a.probe_dup != 0)
#endif
#define FRESH() const int lane = lane_id_fresh(); const int tid = wave * 64 + lane; (void)tid; (void)lane
    { FRESH(); for (int u = tid; u < (LDS_BYTES - MISC_OFF) / 4; u += 512) ((LAS unsigned*)(lds + MISC_OFF))[u] = 0u; }
    __syncthreads();
    const int lo = a.ph_lo, hi = a.ph_hi;
    XcdBarrier bar; bar.bar = ctl + CW_BAR; bar.x = 0; bar.st = (volatile LAS unsigned*)(lds + MISC_OFF);
    if (hi - lo > 1) { FRESH(); bar = xcd_barrier_post(ctl + CW_BAR, (volatile LAS unsigned*)(lds + MISC_OFF), tid); }
#define IN(k) (lo <= (k) && (k) < hi)
#define SEAM(k) do { if (IN(k) && IN((k) + 1)) { FRESH(); xcd_barrier(bar, tid); } } while (0)

    float* X = (float*)(ws + WS_X); bf16_t* H = (bf16_t*)(ws + WS_H);
    const float* modv = (const float*)(ws + WS_MODV);
    unsigned char* mix = ws + WS_MIX; unsigned char* moe = ws + WS_MOE;

#define MOE_TAIL(L, p0, rowlo, last) do { \
    if (IN((p0))) for (int rp_ = 0; rp_ <= REPC((p0)); ++rp_) { FRESH(); cvt_catchup(a, (L) == 0 ? cq::E0 : (L) == 1 ? cq::E2 : (L) == 2 ? cq::E5 : cq::E8, lds, tid, wave, lane); ph_ln1(a, (L), (rowlo), lds, tid, G, bx, wave, PDUP); } SEAM((p0)); \
      \
    if (IN((p0) + 2)) for (int rp_ = 0; rp_ <= REPC((p0) + 2); ++rp_) { FRESH(); moe_table(a, (L), lds, tid); const int T = ((const LAS int*)(lds + MISC_OFF + 64))[16]; \
        pg8::Gemm g{(const bf16_t*)moe, (const bf16_t*)(ws + WS_WGU) + (size_t)(L) * 16 * 1536 * DM, DM, (size_t)1536 * DM}; \
        pg8::MoeOrder S; S.init(T, 6, G, bx); S.t2e = (const LAS int*)(lds + MISC_OFF + 192); S.tb = (const LAS int*)(lds + MISC_OFF + 64); S.sparse_a = true; pg8::EpiMoeA E{(bf16_t*)(moe + MOE_ACT)}; \
        pg8::gemm_phase<pg8::EpiMoeA, pg8::MoeOrder, true, true>(lds, g, S, E, tid); cvt_opportunistic(a, 20 * idle_units(T * 6, G, bx), lds, tid, wave, lane); } SEAM((p0) + 2); \
    if (IN((p0) + 3)) for (int rp_ = 0; rp_ <= REPC((p0) + 3); ++rp_) { FRESH(); moe_table(a, (L), lds, tid); const int T = ((const LAS int*)(lds + MISC_OFF + 64))[16]; \
        pg8::Gemm g{(const bf16_t*)(moe + MOE_ACT), (const bf16_t*)(ws + WS_WDN) + (size_t)(L) * 16 * DM * EFF, EFF, (size_t)DM * EFF}; \
        pg8::MoeOrder S; S.init(T, 8, G, bx); S.t2e = (const LAS int*)(lds + MISC_OFF + 192); S.tb = (const LAS int*)(lds + MISC_OFF + 64); S.sparse_a = false; pg8::EpiQKV E{(bf16_t*)(moe + MOE_Y2), DM, 1 << 20, nullptr, 1 << 20, nullptr, 0}; \
        pg8::gemm_phase<pg8::EpiQKV, pg8::MoeOrder, true, true>(lds, g, S, E, tid); cvt_opportunistic(a, 6 * idle_units(T * 8, G, bx), lds, tid, wave, lane); } SEAM((p0) + 3); \
    if (IN((p0) + 4)) for (int rp_ = 0; rp_ <= REPC((p0) + 4); ++rp_) { FRESH(); if ((L) == 1) cvt_catchup(a, cq::E3, lds, tid, wave, lane); if ((L) == 2) cvt_catchup(a, cq::E6, lds, tid, wave, lane); moe_table(a, (L), lds, tid); ph_ln2(a, (L), (rowlo), (last), lds, tid, G, bx, wave, PDUP); } \
    } while (0)

    if (IN(0)) for (int rp_ = 0; rp_ <= REPC(0); ++rp_) { FRESH(); ph_prologue(a, lds, G, wave, lane, tid); } SEAM(0);
    if (IN(1)) for (int rp_ = 0; rp_ <= REPC(1); ++rp_) { FRESH(); ph_init(a, G, bx, wave); } SEAM(1);
    if (IN(2)) for (int rp_ = 0; rp_ <= REPC(2); ++rp_) { FRESH(); pg8::Gemm g{H, (const bf16_t*)(ws + WS_WCI), DM, 0}; pg8::GridOrder S; S.init(NMT, 24, G, bx);
        pg8::EpiConv1 E{(bf16_t*)mix, (bf16_t*)(mix + 33 * MiB)};
        pg8::gemm_phase<pg8::EpiConv1, pg8::GridOrder, true, true>(lds, g, S, E, tid); cvt_opportunistic(a, 12 * idle_units(NMT * 24, G, bx), lds, tid, wave, lane); } SEAM(2);
    if (IN(3)) for (int rp_ = 0; rp_ <= REPC(3); ++rp_) { FRESH(); ph_conv(a, gw, NGW, lane); } SEAM(3);
    if (IN(4)) for (int rp_ = 0; rp_ <= REPC(4); ++rp_) { FRESH(); pg8::Gemm g{(const bf16_t*)(mix + 66 * MiB), (const bf16_t*)(ws + WS_WCO), DM, 0}; pg8::GridOrder S; S.init(NMT, 8, G, bx);
        pg8::EpiDelta E{(bf16_t*)(ws + WS_D), 0, 1 << 20, 0};
        pg8::gemm_phase<pg8::EpiDelta, pg8::GridOrder, true, true>(lds, g, S, E, tid); cvt_opportunistic(a, 12 * idle_units(NMT * 8, G, bx), lds, tid, wave, lane); } SEAM(4);
    MOE_TAIL(0, 5, 0, false); SEAM(9);
    if (IN(10)) for (int rp_ = 0; rp_ <= REPC(10); ++rp_) { FRESH(); cvt_catchup(a, cq::E1, lds, tid, wave, lane); ph_pool(a, gw, NGW, lane); } SEAM(10);
    if (IN(11)) for (int rp_ = 0; rp_ <= REPC(11); ++rp_) { FRESH(); pg8::Gemm g{(const bf16_t*)mix, (const bf16_t*)(ws + WS_WPL), 512, (size_t)512 * 512}; pg8::PoolOrder S; S.init(4 * NMT, 2, G, bx);
        pg8::EpiDelta E{(bf16_t*)(ws + WS_D), 0, NMT, 512};
        pg8::gemm_phase<pg8::EpiDelta, pg8::PoolOrder, true, true>(lds, g, S, E, tid); cvt_opportunistic(a, 3 * idle_units(4 * NMT * 2, G, bx), lds, tid, wave, lane); } SEAM(11);
    MOE_TAIL(1, 12, 0, false); SEAM(16);
    if (IN(17)) for (int rp_ = 0; rp_ <= REPC(17); ++rp_) { FRESH(); pg8::Gemm g{H, (const bf16_t*)(ws + WS_WGQ), DM, 0}; pg8::GridOrder S; S.init(NMT, 12, G, bx);
        pg8::EpiQKV E{(bf16_t*)mix, DM, 8, (bf16_t*)(mix + 33 * MiB), 10, (bf16_t*)(mix + 42 * MiB), KVHS};
        pg8::gemm_phase<pg8::EpiQKV, pg8::GridOrder, true, true>(lds, g, S, E, tid); cvt_opportunistic(a, 12 * idle_units(NMT * 12, G, bx), lds, tid, wave, lane); } SEAM(17);
    if (IN(18)) for (int rp_ = 0; rp_ <= REPC(18); ++rp_) { FRESH(); cvt_catchup(a, cq::E4, lds, tid, wave, lane);
        bf16_t* Q = (bf16_t*)mix; bf16_t* Kb = (bf16_t*)(mix + 33 * MiB); const float* rope = (const float*)(ws + WS_ROPE);
        const float* gq = a.in[I_GQN]; const float* gk = gq + 128;
        for (int task = gw; task < MTOT / 4; task += NGW) {
            const int r = task * 4 + (lane >> 4); bf16_t* pp = Kb + (size_t)((lane >> 2) & 3) * KVHS + (size_t)r * 128 + (lane & 3) * 32;
            head_pass<true>(pp, gk, lane & 3, r, rope, PDUP ? (bf16_t*)(ws + WS_DUMQ) + (size_t)r * 512 + (lane & 15) * 32 : pp); }
    } SEAM(18);
    if (IN(19)) for (int rp_ = 0; rp_ <= REPC(19); ++rp_) { FRESH();
        const bf16_t* Q = (const bf16_t*)mix; const bf16_t* Kb = (const bf16_t*)(mix + 33 * MiB); const bf16_t* Vb = (const bf16_t*)(mix + 42 * MiB); bf16_t* O = (bf16_t*)(mix + 51 * MiB);
        for (int i = 0;; ++i) { const int idx = i * G + bx; if (idx >= 528) break;
            int h, kvh, row0, seq;
            if (idx < 512) { const int ii = idx >> 8, c = idx & 255, x = c & 7, wl = c >> 3, j = (x >> 2) * 64 + wl * 2 + ii; kvh = x & 3; h = kvh * 4 + (j >> 5); row0 = NCTX + (j & 31) * 256; seq = MTOT; }
            else { h = idx - 512; kvh = h >> 2; row0 = 0; seq = NCTX; }
            att::attn_unit<DM, 128, 128, DM>(Q + (size_t)row0 * DM + h * 128, Kb + (size_t)kvh * KVHS, Vb + (size_t)kvh * KVHS, O + (size_t)row0 * DM + h * 128, seq, (char*)lds_raw, wave, a.in[I_GQN], (const float*)(ws + WS_ROPE), row0 - NCTX);
        }
    } SEAM(19);
    if (IN(20)) for (int rp_ = 0; rp_ <= REPC(20); ++rp_) { FRESH(); pg8::Gemm g{(const bf16_t*)(mix + 51 * MiB), (const bf16_t*)(ws + WS_WGO), DM, 0}; pg8::GridOrder S; S.init(NMT, 8, G, bx);
        pg8::EpiDelta E{(bf16_t*)(ws + WS_D), 0, 1 << 20, 0};
        pg8::gemm_phase<pg8::EpiDelta, pg8::GridOrder, true, true>(lds, g, S, E, tid); cvt_opportunistic(a, 12 * idle_units(NMT * 8, G, bx), lds, tid, wave, lane); } SEAM(20);
    MOE_TAIL(2, 21, 0, false); SEAM(25);
    if (IN(26)) for (int rp_ = 0; rp_ <= REPC(26); ++rp_) { FRESH(); pg8::Gemm g{H, (const bf16_t*)(ws + WS_WDQ), DM, 0}; pg8::GridOrder S; S.init(NMT, 24, G, bx);
        pg8::EpiQKVRope E{(bf16_t*)mix, (bf16_t*)(mix + 33 * MiB), (bf16_t*)(mix + 66 * MiB), KVHS, (const float*)(ws + WS_ROPE)};
        pg8::gemm_phase<pg8::EpiQKVRope, pg8::GridOrder, true, true>(lds, g, S, E, tid); cvt_opportunistic(a, 12 * idle_units(NMT * 24, G, bx), lds, tid, wave, lane); } SEAM(26);
    if (IN(28)) for (int rp_ = 0; rp_ <= REPC(28); ++rp_) { FRESH();
        const bf16_t* Q = (const bf16_t*)mix; const bf16_t* Kb = (const bf16_t*)(mix + 33 * MiB); const bf16_t* Vb = (const bf16_t*)(mix + 66 * MiB);
#pragma unroll 1
        for (int i = 0;; ++i) { const int u = bx + (i >> 1) * G; if (u >= 256) break;
            { const int m = i & 1, h = u & 7, qb = u >> 3;
                auto epi = [&](f32x16 (&o)[8], float (&rli)[16], const int wid, const int le) __attribute__((always_inline)) {
                    int i2 = i; asm volatile("" : "+s"(i2)); const int u2 = bx + (i2 >> 1) * G, m2 = i2 & 1;
                    const int r32e = le & 31, hie = le >> 5;
                    char* st = (char*)a.ws + WS_MIX + 99 * MiB + (size_t)u2 * 131072 + (unsigned)(wid * 16384) + (unsigned)le * 16u;
                    if (m2 == 0) {
#pragma unroll
                        for (int r = 0; r < 16; ++r) { const float s_ = rli[r]; u32x4 w; w.x = cvt_pk_bf16(o[0][r] * s_, o[1][r] * s_); w.y = cvt_pk_bf16(o[2][r] * s_, o[3][r] * s_); w.z = cvt_pk_bf16(o[4][r] * s_, o[5][r] * s_); w.w = cvt_pk_bf16(o[6][r] * s_, o[7][r] * s_);
                            __builtin_nontemporal_store(w, (u32x4*)(st + r * 1024)); }
                    } else {
                        const float lam = __uint_as_float(__hip_atomic_load((unsigned*)(a.ws + WS_SCAL), __ATOMIC_RELAXED, __HIP_MEMORY_SCOPE_AGENT));
                        const float oml = __uint_as_float(__hip_atomic_load((unsigned*)(a.ws + WS_SCAL) + 1, __ATOMIC_RELAXED, __HIP_MEMORY_SCOPE_AGENT));
                        const float* sub = (const float*)(a.ws + WS_SCAL + 1024); char* A2b = (char*)a.ws + WS_MIX + 163 * MiB + ((size_t)((u2 >> 3) * 256) * DM + (u2 & 7) * 256) * 2;
                        float gl[8];
#pragma unroll
                        for (int d0 = 0; d0 < 8; ++d0) gl[d0] = sub[d0 * 32 + r32e];
#pragma unroll
                        for (int r = 0; r < 16; ++r) { if ((r & 3) == 0) asm volatile("" ::: "memory");
                            const unsigned offA = (unsigned)((wid * 32 + att::crow(r, hie)) * DM + r32e) * 2u;
                            const u32x4 w = __builtin_nontemporal_load((const u32x4*)(st + r * 1024));
                            float d[8]; float ss = 0.f; const float s_ = rli[r] * lam;
                            d[0] = bf_lo(w.x) - o[0][r] * s_; d[1] = bf_hi(w.x) - o[1][r] * s_; d[2] = bf_lo(w.y) - o[2][r] * s_; d[3] = bf_hi(w.y) - o[3][r] * s_;
                            d[4] = bf_lo(w.z) - o[4][r] * s_; d[5] = bf_hi(w.z) - o[5][r] * s_; d[6] = bf_lo(w.w) - o[6][r] * s_; d[7] = bf_hi(w.w) - o[7][r] * s_;
#pragma unroll
                            for (int d0 = 0; d0 < 8; ++d0) ss += d[d0] * d[d0];
#pragma unroll
                            for (int mk = 1; mk < 32; mk <<= 1) ss += __int_as_float(__builtin_amdgcn_ds_bpermute((le ^ mk) << 2, __float_as_int(ss)));
                            const float rs = oml / sqrtf(ss * (1.0f / 256.0f) + RMS_EPS);
#pragma unroll
                            for (int d0 = 0; d0 < 8; ++d0) { const float v = d[d0] * rs * gl[d0]; *(bf16_t*)(A2b + offA + d0 * 64) = (bf16_t)(cvt_pk_bf16(v, v) & 0xffffu); } }
                    }
                };
                att::attn_unit2<DM, 128, 128>(Q + (size_t)(NCTX + qb * 256) * DM + (h * 2 + m) * 128, Kb + (size_t)(h * 2 + m) * KVHS, Vb + (size_t)(h * 2) * KVHS, Vb + (size_t)(h * 2 + 1) * KVHS, MTOT, (char*)lds_raw, wave, epi);
            }
        }
    } SEAM(28);
    if (IN(30)) for (int rp_ = 0; rp_ <= REPC(30); ++rp_) { FRESH(); cvt_catchup(a, cq::E7, lds, tid, wave, lane); pg8::Gemm g{(const bf16_t*)(mix + 163 * MiB), (const bf16_t*)(ws + WS_WDO), DM, 0}; pg8::GridOrder S; S.init(NLAT / 256, 8, G, bx);
        pg8::EpiDelta E{(bf16_t*)(ws + WS_D), NCTX, 1 << 20, 0};
        pg8::gemm_phase<pg8::EpiDelta, pg8::GridOrder, true, true>(lds, g, S, E, tid); } SEAM(30);
    MOE_TAIL(3, 31, NCTX, true);
#undef IN
#undef FRESH
#undef SEAM
#undef MOE_TAIL
}

extern "C" void kernel_launch(void* const* d_in, const int* in_sizes, int n_in, void* d_out, int out_size, void* d_ws, size_t ws_size, hipStream_t stream) {
    static int grid = 0;
    if (grid == 0) {
        if (n_in != 27 || out_size != NLAT * DM || ws_size < WS_END) { fprintf(stderr, "kernel_launch: unexpected shapes (n_in %d out %d ws %zu)\n", n_in, out_size, ws_size); grid = -1; return; }
        int dev = 0, cus = 0, per_cu = 0;
        if (hipGetDevice(&dev) != hipSuccess || hipDeviceGetAttribute(&cus, hipDeviceAttributeMultiprocessorCount, dev) != hipSuccess) { grid = -1; return; }
        if (hipFuncSetAttribute((const void*)mega, hipFuncAttributeMaxDynamicSharedMemorySize, LDS_BYTES) != hipSuccess) { fprintf(stderr, "kernel_launch: hipFuncSetAttribute failed\n"); grid = -1; return; }
        if (hipOccupancyMaxActiveBlocksPerMultiprocessor(&per_cu, (const void*)mega, 512, LDS_BYTES) != hipSuccess || per_cu < 1) fprintf(stderr, "kernel_launch: occupancy query says %d\n", per_cu);
        (void)hipGetLastError();
        grid = cus;
    }
    if (grid < 0) return;
    (void)hipMemsetAsync((char*)d_ws + WS_CTL, 0, CTL_ZERO_BYTES, stream);
    Args a{};
    for (int i = 0; i < 27; ++i) a.in[i] = (const float*)d_in[i];
    a.out = (float*)d_out; a.ws = (unsigned char*)d_ws;
#if MK_ONE_LAUNCH
    a.ph_lo = 0; a.ph_hi = NPH;
    hipLaunchKernelGGL(mega, dim3(grid), dim3(512), LDS_BYTES, stream, a);
#else
    for (int p = 0; p < NPH; ++p) { a.ph_lo = p; a.ph_hi = p + 1; const int reps = 1 + (int)((PROBE_REP_MASK >> p) & 1ull);
        for (int r = 0; r < reps; ++r) { a.probe_dup = r; hipLaunchKernelGGL(mega, dim3(grid), dim3(512), LDS_BYTES, stream, a); } }
#endif
}
```
